# Optimizing an MI355X kernel written in HIP

```python
import math
import jax, jax.numpy as jnp
from jax import lax
import numpy as np

D_MODEL = 1024
BATCH = 8
SEQ = 4096
DEPTH = 1

ATT_HEADS = 8
ATT_HEAD_DIM = 64
ATT_WIDTH = ATT_HEADS * ATT_HEAD_DIM
MOBA_BLOCK = 256
MOBA_TOPK = 3
MOBA_QBLOCK = 16
ROPE_THETA = 10000.0
HGRN_HEADS = 4
HGRN_KEY_DIM = 128
HGRN_VAL_DIM = 128
HGRN_FDIM = HGRN_HEADS * HGRN_KEY_DIM
HGRN_VDIM = HGRN_HEADS * HGRN_VAL_DIM
HGRN_CHUNK = 64
N_EXPERTS = 32
TOP_K = 4
D_EXPERT = 1024
SWIGLU_LIMIT = 7.0
SWIGLU_ALPHA = 1.702
MOE_BLOCK = 128
RMS_EPS = 1e-6
NEG = -1e30

IN_WIDTHS = [ATT_WIDTH, ATT_WIDTH, ATT_WIDTH,
             HGRN_FDIM, HGRN_FDIM, HGRN_VDIM, HGRN_VDIM,
             D_MODEL, D_MODEL]
D_IN = sum(IN_WIDTHS)
IN_SPLITS = list(np.cumsum(IN_WIDTHS)[:-1].tolist())

kernel_name = 'hybrid_moba_hgrn2_moe_block'


def rmsnorm(x, w):
    xf = x.astype(jnp.float32)
    y = xf * lax.rsqrt(jnp.mean(xf * xf, axis=-1, keepdims=True) + RMS_EPS)
    return (y * w.astype(jnp.float32)).astype(x.dtype)


def apply_rope(t, pos):
    dh = t.shape[-1]
    half = dh // 2
    inv = ROPE_THETA ** (-(jnp.arange(half, dtype=jnp.float32) * 2.0 / dh))
    ang = pos.astype(jnp.float32)[:, None] * inv[None, :]
    cos, sin = jnp.cos(ang), jnp.sin(ang)
    tf = t.astype(jnp.float32)
    t1, t2 = tf[..., :half], tf[..., half:]
    out = jnp.concatenate([t1 * cos - t2 * sin, t2 * cos + t1 * sin], axis=-1)
    return out.astype(t.dtype)


def moba_attention(q, k, v):
    B, H, S, Dh = q.shape
    nb = -(-S // MOBA_BLOCK)
    pad = nb * MOBA_BLOCK - S
    kp = jnp.pad(k, ((0, 0), (0, 0), (0, pad), (0, 0)))
    vp = jnp.pad(v, ((0, 0), (0, 0), (0, pad), (0, 0)))
    kb = kp.reshape(B, H, nb, MOBA_BLOCK, Dh)
    vb = vp.reshape(B, H, nb, MOBA_BLOCK, Dh)
    cnt = jnp.minimum(S - jnp.arange(nb) * MOBA_BLOCK, MOBA_BLOCK).astype(jnp.float32)
    kmean = kb.astype(jnp.float32).sum(axis=3) / cnt[None, None, :, None]
    k_sel = min(MOBA_TOPK, nb)
    scale = Dh ** -0.5
    bi = jnp.arange(B)[:, None, None, None]
    hi = jnp.arange(H)[None, :, None, None]

    def one_qblock(qi):
        q0 = qi * MOBA_QBLOCK
        qblk = lax.dynamic_slice_in_dim(q, q0, MOBA_QBLOCK, axis=2).astype(jnp.float32)
        cur = q0 // MOBA_BLOCK
        qpos = q0 + jnp.arange(MOBA_QBLOCK)
        gate = jnp.einsum('bhqd,bhnd->bhqn', qblk, kmean)
        gate = jnp.where(jnp.arange(nb)[None, None, None, :] < cur, gate, NEG)
        _, sel = lax.top_k(gate, k_sel)
        sel_ok = sel < cur
        ks = kb[bi, hi, sel]
        vs = vb[bi, hi, sel]
        s_sel = jnp.einsum('bhqd,bhqjkd->bhqjk', qblk, ks) * scale
        s_sel = jnp.where(sel_ok[..., None], s_sel, NEG).reshape(B, H, MOBA_QBLOCK, k_sel * MOBA_BLOCK)
        ko = lax.dynamic_slice_in_dim(kp, cur * MOBA_BLOCK, MOBA_BLOCK, axis=2)
        vo = lax.dynamic_slice_in_dim(vp, cur * MOBA_BLOCK, MOBA_BLOCK, axis=2)
        kpos = cur * MOBA_BLOCK + jnp.arange(MOBA_BLOCK)
        s_own = jnp.einsum('bhqd,bhkd->bhqk', qblk, ko) * scale
        s_own = jnp.where(kpos[None, :] <= qpos[:, None], s_own, NEG)
        p = jax.nn.softmax(jnp.concatenate([s_sel, s_own], axis=-1), axis=-1)
        p_sel = p[..., :k_sel * MOBA_BLOCK].reshape(B, H, MOBA_QBLOCK, k_sel, MOBA_BLOCK)
        p_own = p[..., k_sel * MOBA_BLOCK:]
        out = (jnp.einsum('bhqjk,bhqjkd->bhqd', p_sel, vs)
               + jnp.einsum('bhqk,bhkd->bhqd', p_own, vo))
        return out.astype(q.dtype)

    outs = lax.map(one_qblock, jnp.arange(S // MOBA_QBLOCK))
    return outs.transpose(1, 2, 0, 3, 4).reshape(B, H, S, Dh)


def hgrn2(q_in, f_in, i_in, g_in, lb, norm_w):
    B, S, _ = q_in.shape
    H, dk, dv, C = HGRN_HEADS, HGRN_KEY_DIM, HGRN_VAL_DIM, HGRN_CHUNK
    nc = S // C
    qf = jax.nn.silu(q_in.astype(jnp.float32))
    f = lb.astype(jnp.float32) + (1.0 - lb.astype(jnp.float32)) * jax.nn.sigmoid(f_in.astype(jnp.float32))
    logf = jnp.log(f)
    kf = 1.0 - f
    iv = i_in.astype(jnp.float32)

    def to_chunks(t, d):
        return t.reshape(B, nc, C, H, d).transpose(1, 0, 3, 2, 4)

    causal = jnp.tril(jnp.ones((C, C), dtype=bool))

    def step(state, xs):
        qc, kc, ic, lc = xs
        b = jnp.cumsum(lc, axis=2)
        diff = b[:, :, :, None, :] - b[:, :, None, :, :]
        decay = jnp.exp(jnp.where(causal[None, None, :, :, None], diff, -jnp.inf))
        attn = jnp.einsum('bhtd,bhsd,bhtsd->bhts', qc, kc, decay)
        o = (jnp.einsum('bhts,bhsv->bhtv', attn, ic)
             + jnp.einsum('bhtd,bhdv->bhtv', qc * jnp.exp(b), state))
        b_last = b[:, :, -1:, :]
        state = (jnp.exp(b_last[:, :, 0, :])[..., None] * state
                 + jnp.einsum('bhsd,bhsv->bhdv', kc * jnp.exp(b_last - b), ic))
        return state, o

    s0 = jnp.zeros((B, H, dk, dv), jnp.float32)
    _, o = lax.scan(step, s0, (to_chunks(qf, dk), to_chunks(kf, dk), to_chunks(iv, dv), to_chunks(logf, dk)))
    o = o.transpose(1, 0, 3, 2, 4).reshape(B, S, H, dv)
    o = o * lax.rsqrt(jnp.mean(o * o, axis=-1, keepdims=True) + RMS_EPS)
    o = o * norm_w.astype(jnp.float32).reshape(H, dv)
    o = o.reshape(B, S, H * dv) * jax.nn.silu(g_in.astype(jnp.float32))
    return o.astype(q_in.dtype)


def moe_ffn(h, router_w, router_b, w_gate_up, b_gate_up, w_down, b_down):
    B, S, D = h.shape
    T = B * S
    A = T * TOP_K
    hf = h.reshape(T, D)
    logits = (hf @ router_w).astype(jnp.float32) + router_b.astype(jnp.float32)
    top_v, top_e = lax.top_k(logits, TOP_K)
    top_w = jax.nn.softmax(top_v, axis=-1)
    e_flat = top_e.reshape(A)
    w_flat = top_w.reshape(A)
    tok_flat = jnp.repeat(jnp.arange(T, dtype=jnp.int32), TOP_K)
    order = jnp.argsort(e_flat)
    e_sorted = e_flat[order]
    counts = jnp.bincount(e_flat, length=N_EXPERTS)
    start = jnp.cumsum(counts) - counts
    padded = (counts + MOE_BLOCK - 1) // MOE_BLOCK * MOE_BLOCK
    pend = jnp.cumsum(padded)
    pstart = pend - padded
    dest = pstart[e_sorted] + (jnp.arange(A) - start[e_sorted])
    P = A + N_EXPERTS * MOE_BLOCK
    nblk = P // MOE_BLOCK
    row_tok = jnp.zeros((P,), jnp.int32).at[dest].set(tok_flat[order])
    row_w = jnp.zeros((P,), jnp.float32).at[dest].set(w_flat[order])
    blk_e = jnp.minimum(jnp.sum((jnp.arange(nblk) * MOE_BLOCK)[:, None] >= pend[None, :], axis=1), N_EXPERTS - 1)
    xg = hf[row_tok].reshape(nblk, MOE_BLOCK, D)

    def expert_block(args):
        xb, e = args
        gu = xb @ w_gate_up[e] + b_gate_up[e]
        gate = jnp.minimum(gu[:, 0::2], SWIGLU_LIMIT)
        up = jnp.clip(gu[:, 1::2], -SWIGLU_LIMIT, SWIGLU_LIMIT)
        glu = gate * jax.nn.sigmoid(gate * SWIGLU_ALPHA)
        return ((up + 1.0) * glu) @ w_down[e] + b_down[e]

    yg = lax.map(expert_block, (xg, blk_e)).reshape(P, D)
    out = jnp.zeros((T, D), jnp.float32).at[row_tok].add(yg.astype(jnp.float32) * row_w[:, None])
    return out.astype(h.dtype).reshape(B, S, D)


def setup_inputs(seed: int = 0) -> dict:
    key = jax.random.key(seed)
    ks = jax.random.split(key, 16)
    f32 = jnp.float32
    nrm = lambda k, shape, s: jax.random.normal(k, shape, f32) * s
    return {
        'x': jax.random.normal(ks[0], (BATCH, SEQ, D_MODEL), f32),
        'norm1_w': 1.0 + nrm(ks[1], (DEPTH, D_MODEL), 0.02),
        'w_in': nrm(ks[2], (DEPTH, D_MODEL, D_IN), D_MODEL ** -0.5),
        'moba_up': nrm(ks[3], (DEPTH, ATT_WIDTH, D_MODEL), ATT_WIDTH ** -0.5),
        'hgrn_lb_logits': nrm(ks[4], (DEPTH + 1, HGRN_FDIM), 0.1),
        'hgrn_norm_w': 1.0 + nrm(ks[5], (DEPTH, HGRN_VDIM), 0.02),
        'hgrn_up': nrm(ks[6], (DEPTH, HGRN_VDIM, D_MODEL), HGRN_VDIM ** -0.5),
        'w_out': nrm(ks[7], (DEPTH, D_MODEL, D_MODEL), D_MODEL ** -0.5),
        'norm2_w': 1.0 + nrm(ks[8], (DEPTH, D_MODEL), 0.02),
        'router_w': nrm(ks[9], (DEPTH, D_MODEL, N_EXPERTS), D_MODEL ** -0.5),
        'router_b': nrm(ks[10], (DEPTH, N_EXPERTS), 0.01),
        'w_gate_up': nrm(ks[11], (DEPTH, N_EXPERTS, D_MODEL, 2 * D_EXPERT), D_MODEL ** -0.5),
        'b_gate_up': nrm(ks[12], (DEPTH, N_EXPERTS, 2 * D_EXPERT), 0.01),
        'w_down': nrm(ks[13], (DEPTH, N_EXPERTS, D_EXPERT, D_MODEL), D_EXPERT ** -0.5),
        'b_down': nrm(ks[14], (DEPTH, N_EXPERTS, D_MODEL), 0.01),
        'final_norm_w': 1.0 + nrm(ks[15], (D_MODEL,), 0.02),
    }


def reference(x, norm1_w, w_in, moba_up, hgrn_lb_logits, hgrn_norm_w, hgrn_up, w_out,
              norm2_w, router_w, router_b, w_gate_up, b_gate_up, w_down, b_down, final_norm_w):
    B, S, D = x.shape
    pos = jnp.arange(S, dtype=jnp.int32)
    lb_table = jnp.cumsum(jax.nn.softmax(hgrn_lb_logits.astype(jnp.float32), axis=0), axis=0)

    def heads(t):
        return t.reshape(B, S, ATT_HEADS, ATT_HEAD_DIM).transpose(0, 2, 1, 3)

    for l in range(DEPTH):
        h = rmsnorm(x, norm1_w[l])
        proj = h @ w_in[l]
        q_a, k_a, v_a, q_b, f_b, i_b, g_b, gate_a, gate_b = jnp.split(proj, IN_SPLITS, axis=-1)
        q_a = apply_rope(heads(q_a), pos)
        k_a = apply_rope(heads(k_a), pos)
        y_a = moba_attention(q_a, k_a, heads(v_a)).transpose(0, 2, 1, 3).reshape(B, S, ATT_WIDTH)
        y_b = hgrn2(q_b, f_b, i_b, g_b, lb_table[l], hgrn_norm_w[l])
        mixed = (jax.nn.sigmoid(gate_a) * (y_a @ moba_up[l])
                 + jax.nn.sigmoid(gate_b) * (y_b @ hgrn_up[l]))
        x = x + mixed @ w_out[l]
        h2 = rmsnorm(x, norm2_w[l])
        x = x + moe_ffn(h2, router_w[l], router_b[l], w_gate_up[l], b_gate_up[l], w_down[l], b_down[l])
    return rmsnorm(x, final_norm_w)
```

```cpp
#include <hip/hip_runtime.h>
#include <hip/hip_cooperative_groups.h>
#include <cstdio>
#include <cstdint>
namespace cg = cooperative_groups;
#ifndef USE_COOP
#define USE_COOP 1
#endif

#define LAS __attribute__((address_space(3)))
#define GAS __attribute__((address_space(1)))
typedef unsigned short bf16_t;
typedef short bf16x8 __attribute__((ext_vector_type(8)));
typedef float f32x4 __attribute__((ext_vector_type(4)));
typedef float f32x2 __attribute__((ext_vector_type(2)));
typedef unsigned u32x4 __attribute__((ext_vector_type(4)));
typedef unsigned u32x2 __attribute__((ext_vector_type(2)));

constexpr int NTOK = 32768, DM = 1024, SEQ = 4096, NBATCH = 8;
constexpr int DIN = 5632;
constexpr int AH = 8, AD = 64;
constexpr int HH = 4, HK = 128;
constexpr int NE = 32, DE = 1024, CAP = 32768;
constexpr float RMS_EPS = 1e-6f;
constexpr float QSCALE = 0.125f * 1.4426950408889634f;
constexpr int C_QA = 0, C_KA = 512, C_VA = 1024, C_QB = 1536, C_FB = 2048, C_IB = 2560, C_GB = 3072, C_GA = 3584, C_GBT = 4608;

constexpr size_t MiB = 1u << 20;
constexpr size_t WS_CTL = 0, CTL_BYTES = 32768;
constexpr size_t WS_ROPE = 1 * MiB;
constexpr size_t WS_WIN = 2 * MiB;
constexpr size_t WS_MUP = 13 * MiB;
constexpr size_t WS_WOUT = 15 * MiB;
constexpr size_t WS_LB = 17 * MiB;
constexpr size_t WS_KMEAN = 17 * MiB + 65536;
constexpr size_t WS_SLOTW = 18 * MiB;
constexpr size_t WS_ROWS = 19 * MiB;
constexpr size_t WS_ROWW = 25 * MiB;
constexpr size_t WS_WGS = 18 * MiB;
constexpr size_t WS_ROWHS = 672 * MiB;
constexpr size_t WS_GDEC = 24 * MiB;
constexpr size_t WS_WGU = 32 * MiB;
constexpr size_t WS_WD = 160 * MiB;
constexpr size_t WS_XN = 224 * MiB;
constexpr size_t WS_PROJ = 288 * MiB;
constexpr size_t WS_LOGF = 640 * MiB;
constexpr size_t WS_YA = 704 * MiB;
constexpr size_t WS_OB = 768 * MiB;
constexpr size_t WS_HST = 768 * MiB;
constexpr size_t WS_MIXED = 832 * MiB;
constexpr size_t WS_HID = 288 * MiB;
constexpr size_t WS_YG = 560 * MiB;
constexpr size_t WS_X1 = 896 * MiB;
constexpr size_t WS_END = 960 * MiB;
constexpr int CW_CNT = 64;
constexpr int CW_BAR = 4096;
static_assert((CW_BAR + 3456) * 4 <= (int)CTL_BYTES, "barrier words inside the zeroed control region");

constexpr int RING_BYTES = 131072;
constexpr int MISC_OFF = RING_BYTES;
constexpr int LDS_BYTES = 147456;

#ifndef MOE1_I8_
#define MOE1_I8_ 1
#endif
#ifndef MOE_FP8_
#define MOE_FP8_ 1
#endif
constexpr bool MOE1_I8 = (MOE1_I8_ != 0) && (MOE_FP8_ != 0);
constexpr bool MOE_FP8 = MOE_FP8_ != 0;
constexpr float S_H2 = 16.0f, S_HID = 4.0f, S_W = 512.0f, S_YG = 32.0f;
constexpr float DQ1 = MOE_FP8 ? 1.0f / (S_H2 * S_W) : 1.0f, DQ2 = MOE_FP8 ? 1.0f / (S_HID * S_W) : 1.0f;
typedef int v8i __attribute__((ext_vector_type(8)));
typedef int v4i __attribute__((ext_vector_type(4)));
__device__ __forceinline__ unsigned pk4_i8(float a, float b, float c, float d) {
    const int ia = (int)__builtin_rintf(fminf(fmaxf(a, -127.f), 127.f)), ib = (int)__builtin_rintf(fminf(fmaxf(b, -127.f), 127.f)), ic = (int)__builtin_rintf(fminf(fmaxf(c, -127.f), 127.f)), id = (int)__builtin_rintf(fminf(fmaxf(d, -127.f), 127.f));
    return (unsigned)(ia & 255) | ((unsigned)(ib & 255) << 8) | ((unsigned)(ic & 255) << 16) | ((unsigned)id << 24); }
typedef _Float16 h16x4 __attribute__((ext_vector_type(4)));
typedef _Float16 h16x8 __attribute__((ext_vector_type(8)));
typedef float f32x8 __attribute__((ext_vector_type(8)));
__device__ __forceinline__ unsigned pk4_fp8_nc(float a, float b, float c, float d, float s) { unsigned w = 0u; w = __builtin_amdgcn_cvt_pk_fp8_f32(a * s, b * s, w, false); w = __builtin_amdgcn_cvt_pk_fp8_f32(c * s, d * s, w, true); return w; }
__device__ __forceinline__ unsigned pk4_u8(float a, float b, float c, float d) { unsigned w = 0u;
    w = __builtin_amdgcn_cvt_pk_u8_f32(fmaxf(a * 255.0f, 1.0f), 0, w); w = __builtin_amdgcn_cvt_pk_u8_f32(fmaxf(b * 255.0f, 1.0f), 1, w);
    w = __builtin_amdgcn_cvt_pk_u8_f32(fmaxf(c * 255.0f, 1.0f), 2, w); w = __builtin_amdgcn_cvt_pk_u8_f32(fmaxf(d * 255.0f, 1.0f), 3, w); return w; }
__device__ __forceinline__ f32x4 un4_u8(unsigned w) { return (f32x4){(float)(w & 0xffu), (float)((w >> 8) & 0xffu), (float)((w >> 16) & 0xffu), (float)(w >> 24)}; }
constexpr int GATE_BYTE0 = 2 * 3584;
__device__ __forceinline__ unsigned pk4_fp8(float a, float b, float c, float d, float s) {
    const float L = 440.0f;
    a = fminf(fmaxf(a * s, -L), L); b = fminf(fmaxf(b * s, -L), L); c = fminf(fmaxf(c * s, -L), L); d = fminf(fmaxf(d * s, -L), L);
    unsigned w = 0u; w = __builtin_amdgcn_cvt_pk_fp8_f32(a, b, w, false); w = __builtin_amdgcn_cvt_pk_fp8_f32(c, d, w, true); return w;
}
__device__ __forceinline__ unsigned f2bf(float f) { unsigned u = __builtin_bit_cast(unsigned, f); return (u + 0x7fffu + ((u >> 16) & 1u)) >> 16; }
typedef __bf16 bf16x2_t_ __attribute__((ext_vector_type(2)));
__device__ __forceinline__ unsigned pk2(float lo, float hi) { f32x2 v = {lo, hi}; bf16x2_t_ b = __builtin_convertvector(v, bf16x2_t_); return __builtin_bit_cast(unsigned, b); }
__device__ __forceinline__ float bf_lo(unsigned u) { return __builtin_bit_cast(float, u << 16); }
__device__ __forceinline__ float bf_hi(unsigned u) { return __builtin_bit_cast(float, u & 0xffff0000u); }
__device__ __forceinline__ float bf2f(bf16_t h) { return __builtin_bit_cast(float, (unsigned)h << 16); }
__device__ __forceinline__ float wave_sum(float v) {
#pragma unroll
    for (int o = 1; o < 64; o <<= 1) v += __shfl_xor(v, o);
    return v;
}
__device__ __forceinline__ float wave_max(float v) {
#pragma unroll
    for (int o = 1; o < 64; o <<= 1) v = fmaxf(v, __shfl_xor(v, o));
    return v;
}
__device__ __forceinline__ float sigmoidf_(float x) { return __builtin_amdgcn_rcpf(1.0f + __builtin_amdgcn_exp2f(-1.4426950408889634f * x)); }
__device__ __forceinline__ int lane_id_() { int l; asm volatile("v_mbcnt_lo_u32_b32 %0, -1, 0\n\tv_mbcnt_hi_u32_b32 %0, -1, %0" : "=v"(l)); return l; }
__device__ __forceinline__ float rdlane(float v, int l) { return __builtin_bit_cast(float, __builtin_amdgcn_readlane(__builtin_bit_cast(int, v), l)); }

namespace pg8 {
constexpr int BM = 256, BK = 64, HALF = 128, HTB = HALF * BK * 2, STAGE_BYTES = 8 * HTB, NXCD = 8, WGM = 8;
__host__ __device__ __forceinline__ int lds_byte(int r, int c) { const int st = (r >> 4) * 2 + (c >> 5), rr = r & 15, cc = c & 31, ob = rr * 64 + cc * 2; return st * 1024 + (ob ^ (((ob >> 9) & 1) << 5)); }
__host__ __device__ __forceinline__ void stage_rc(int b, int& R, int& C) { const int st = b / 1024, sb = b % 1024, swz = sb ^ (((sb >> 9) & 1) << 5); R = (st >> 1) * 16 + swz / 64; C = (st & 1) * 32 + (swz % 64) / 2; }
__host__ __device__ __forceinline__ int perm32(int rho) { const int n = rho >> 4, i = rho & 15; return 8 * (i >> 2) + 4 * n + (i & 3); }

struct Unit { int pm, pn, e, lt, nvalid; };
struct Gemm { const bf16_t* A; const bf16_t* Bt; int N, K; const int* rows; };

struct Order {
    int nM, nN, nwg, G, c;
    __device__ void init(int nM_, int nN_, int G_, int c_) { nM = nM_; nN = nN_; nwg = nM * nN; G = G_; c = c_; }
    __device__ bool map(int i, int& pm, int& pn) const {
        const long L = (long)i * G + c; if (L >= nwg) return false;
        int wgid = (int)L; { const int q = nwg / NXCD, r = nwg % NXCD, xcd = wgid % NXCD, off = wgid / NXCD; wgid = (xcd < r ? xcd * (q + 1) : r * (q + 1) + (xcd - r) * q) + off; }
        const int nig = WGM * nN, gid = wgid / nig, fm = gid * WGM, gsz = (nM - fm) < WGM ? (nM - fm) : WGM;
        pm = fm + ((wgid % nig) % gsz); pn = (wgid % nig) / gsz; return true;
    }
};
struct DenseSched {
    Order o;
    __device__ bool next(int i, Unit& u) const { if (!o.map(i, u.pm, u.pn)) return false; u.e = 0; u.lt = u.pm; u.nvalid = 256; return true; }
};
struct MoeSched {
    Order o; const LAS int* ts;
    __device__ bool next(int i, Unit& u) const {
        if (!o.map(i, u.pm, u.pn)) return false;
        const int lane = lane_id_(); const int tv = ts[(lane & 31) + 1];
        const unsigned long long bal = __ballot(lane < NE - 1 && tv <= u.pm);
        const int e = __builtin_amdgcn_readfirstlane((int)__popcll(bal));
        const int t0 = __builtin_amdgcn_readfirstlane(ts[e]), cn = __builtin_amdgcn_readfirstlane(ts[33 + e]);
        u.e = e; u.lt = u.pm - t0; const int rem = cn - u.lt * 256; u.nvalid = rem < 256 ? rem : 256; return true;
    }
};

template <class Epi, class Sched, bool GATHER, bool FP8 = false, bool NOEPI = false, bool HOOK = false, bool I8 = false>
__device__ __forceinline__ void gemm_phase(LAS unsigned char* lds, const Gemm g, const Sched& S, const Epi& E, const int wid) {
    const int lane = lane_id_(), tid = wid * 64 + lane, wr = wid >> 2, wc = wid & 3, fr = lane & 15, fq = lane >> 4;
    const int K = g.K, RP = (FP8 || I8) ? K : 2 * K, nt = RP / 128;
    unsigned voffB[2];
#pragma unroll
    for (int i = 0; i < 2; ++i) { int R, C; stage_rc(tid * 16 + i * 8192, R, C); const int Rb = (R & ~31) + perm32(R & 31); voffB[i] = (unsigned)(Rb * RP + C * 2); }
    const size_t kstep = 128;
    const size_t hstep = (size_t)HALF * RP;
    const size_t tstep = 2 * hstep;
    const size_t estride = (size_t)g.N * RP;
    const unsigned ldsw = (unsigned)wid * 1024u;
    const int aoff = lds_byte(wr * 64 + fr, fq * 8), boff = lds_byte(wc * 32 + fr, fq * 8);
    constexpr int KOFF = 1024;
#define PG8_SA(b, h) (((b) * 2 + (h)) * HTB)
#define PG8_SB(b, h) ((4 + (b) * 2 + (h)) * HTB)
#define PG8_STAGE(bufoff, gbase, voff) do { _Pragma("unroll") for (int _i = 0; _i < 2; ++_i) { unsigned _o = (voff)[_i]; asm volatile("" : "+v"(_o));     \
        __builtin_amdgcn_global_load_lds((const unsigned*)((const char*)(gbase) + _o), (LAS unsigned*)(lds + (bufoff) + ldsw + _i * 8192), 16, 0, 0); } } while (0)
#define PG8_STAGE2(bufoff, gbase, h) PG8_STAGE(bufoff, gbase, vC[h])
#define PG8_LDA(dst, b, h) do { _Pragma("unroll") for (int m = 0; m < 4; ++m) _Pragma("unroll") for (int k = 0; k < 2; ++k) dst[m][k] = *(const LAS bf16x8*)(lds + PG8_SA(b, h) + aoff + m * 2048 + k * KOFF); } while (0)
#define PG8_LDB(dst, b, h) do { _Pragma("unroll") for (int n = 0; n < 2; ++n) _Pragma("unroll") for (int k = 0; k < 2; ++k) dst[n][k] = *(const LAS bf16x8*)(lds + PG8_SB(b, h) + boff + n * 2048 + k * KOFF); } while (0)
#define PG8_CAT(x) __builtin_bit_cast(v8i, __builtin_shufflevector((x)[0], (x)[1], 0, 1, 2, 3, 4, 5, 6, 7, 8, 9, 10, 11, 12, 13, 14, 15))
#define PG8_MMA(ai, bj, At, Bt) do { __builtin_amdgcn_s_setprio(1); _Pragma("unroll") for (int m = 0; m < 4; ++m) _Pragma("unroll") for (int n = 0; n < 2; ++n) { \
        if constexpr (FP8) acc[ai][bj][m][n] = __builtin_amdgcn_mfma_scale_f32_16x16x128_f8f6f4(PG8_CAT(Bt[n]), PG8_CAT(At[m]), acc[ai][bj][m][n], 0, 0, 0, 0, 0, 0); \
        else if constexpr (I8) { _Pragma("unroll") for (int k = 0; k < 2; ++k) acci[ai][bj][m][n] = __builtin_amdgcn_mfma_i32_16x16x64_i8(__builtin_bit_cast(v4i, Bt[n][k]), __builtin_bit_cast(v4i, At[m][k]), acci[ai][bj][m][n], 0, 0, 0); } \
        else { _Pragma("unroll") for (int k = 0; k < 2; ++k) acc[ai][bj][m][n] = __builtin_amdgcn_mfma_f32_16x16x32_bf16(Bt[n][k], At[m][k], acc[ai][bj][m][n], 0, 0, 0); } } \
        __builtin_amdgcn_s_setprio(0); } while (0)
#define PG8_WAIT_V(n) asm volatile("s_waitcnt vmcnt(" #n ")" ::: "memory")
#define PG8_WAIT_V8R() do { if (NOEPI || Epi::NVMEM == 0 || !relax) asm volatile("s_waitcnt vmcnt(8)" ::: "memory"); else asm volatile("s_waitcnt vmcnt(%0)" :: "n"(8 + (NOEPI ? 0 : Epi::NVMEM)) : "memory"); } while (0)
#define PG8_WAIT_L(n) asm volatile("s_waitcnt lgkmcnt(" #n ")" ::: "memory")
#define PG8_BAR __builtin_amdgcn_s_barrier()
#define PG8_SCHED __builtin_amdgcn_sched_barrier(0)
#define PG8_SETV(u, v) do { _Pragma("unroll") for (int _h = 0; _h < 2; ++_h) _Pragma("unroll") for (int _i = 0; _i < 2; ++_i) { int _R, _C; stage_rc((wid * 64 + lane_id_()) * 16 + _i * 8192, _R, _C); \
        if (GATHER) { int _r = _h * HALF + _R; _r = _r < (u).nvalid ? _r : (u).nvalid - 1; const int _s = g.rows[(size_t)(u).e * CAP + (u).lt * 256 + _r]; \
                      (v)[_h][_i] = (unsigned)(_s >> 2) * (unsigned)RP + (unsigned)(_C * 2); } \
        else (v)[_h][_i] = (unsigned)(_R * RP + _C * 2) + (unsigned)(_h * hstep); } } while (0)
#define PG8_ABASE(u) (GATHER ? (const char*)g.A : (const char*)g.A + (size_t)(u).pm * tstep)
#define PG8_BBASE(u) ((const char*)g.Bt + (size_t)(u).e * estride + (size_t)(u).pn * tstep)
    Unit cur, nxt, nn; int ui = 0;
    if (!S.next(0, cur)) return;
    bool has_next = S.next(1, nxt);
    unsigned vC[2][2];
    PG8_SETV(cur, vC);
#define PG8_PARK ((LAS unsigned*)(lds + MISC_OFF) + (wid * 64 + lane_id_()) * 4)
    if (GATHER) { unsigned vP[2][2];
        if (has_next) PG8_SETV(nxt, vP); else { vP[0][0] = vC[0][0]; vP[0][1] = vC[0][1]; vP[1][0] = vC[1][0]; vP[1][1] = vC[1][1]; }
        LAS unsigned* pk = PG8_PARK; pk[0] = vP[0][0]; pk[1] = vP[0][1]; pk[2] = vP[1][0]; pk[3] = vP[1][1]; }
    f32x4 acc[2][2][4][2]; v4i acci[2][2][4][2];
#pragma unroll
    for (int a = 0; a < 2; ++a)
#pragma unroll
        for (int b = 0; b < 2; ++b)
#pragma unroll
            for (int m = 0; m < 4; ++m)
#pragma unroll
                for (int n = 0; n < 2; ++n) { acc[a][b][m][n] = (f32x4){0.f, 0.f, 0.f, 0.f}; acci[a][b][m][n] = (v4i){0, 0, 0, 0}; }
    bf16x8 At[4][2], B0[2][2], B1[2][2];
    const char* cA = PG8_ABASE(cur); const char* cB = PG8_BBASE(cur);
    PG8_STAGE(PG8_SB(0, 0), cB, voffB); PG8_STAGE(PG8_SB(0, 1), cB + hstep, voffB); PG8_STAGE(PG8_SA(0, 0), cA, vC[0]); PG8_STAGE(PG8_SA(0, 1), cA, vC[1]);
    if (wr == 1) PG8_BAR;
    PG8_WAIT_V(2); PG8_BAR;
    PG8_STAGE(PG8_SB(1, 0), cB + kstep, voffB); PG8_STAGE(PG8_SA(1, 0), cA + kstep, vC[0]); PG8_STAGE(PG8_SB(1, 1), cB + hstep + kstep, voffB);
    PG8_WAIT_V(6); PG8_BAR;
    for (;;) {
        const char* nA = has_next ? PG8_ABASE(nxt) : cA; const char* nB = has_next ? PG8_BBASE(nxt) : cB;
#pragma unroll 1
        for (int t = 0; t < nt; t += 2) {
            const bool last = (t == nt - 2); const bool relax = false;
            if constexpr (HOOK) { if (t == nt / 2) { const int l_ = lane_id_(); E.mid(acc, cur, wr, wc, l_ & 15, l_ >> 4); } }
            const char* a1 = cA + (size_t)(t + 1) * kstep;
            const char* a2 = last ? nA : cA + (size_t)(t + 2) * kstep; const char* b2 = last ? nB : cB + (size_t)(t + 2) * kstep;
            const char* a3 = a2 + kstep; const char* b3 = b2 + kstep;
            PG8_LDB(B0, 0, 0); PG8_LDB(B1, 0, 1); PG8_SCHED; PG8_LDA(At, 0, 0); PG8_STAGE(PG8_SA(1, 1), a1, vC[1]);
            if (GATHER && last) { const LAS unsigned* pk = PG8_PARK; vC[0][0] = pk[0]; vC[0][1] = pk[1]; vC[1][0] = pk[2]; vC[1][1] = pk[3]; }
            PG8_WAIT_V8R(); PG8_WAIT_L(0); PG8_BAR; PG8_MMA(0, 0, At, B0); PG8_MMA(0, 1, At, B1); PG8_BAR; PG8_SCHED;
            PG8_LDA(At, 0, 1); PG8_STAGE(PG8_SB(0, 0), b2, voffB); PG8_STAGE(PG8_SB(0, 1), b2 + hstep, voffB); PG8_STAGE2(PG8_SA(0, 0), a2, 0);
            PG8_WAIT_V8R(); PG8_WAIT_L(0); PG8_BAR; PG8_MMA(1, 0, At, B0); PG8_MMA(1, 1, At, B1); PG8_BAR; PG8_SCHED;
            PG8_LDB(B0, 1, 0); PG8_LDB(B1, 1, 1); PG8_SCHED; PG8_LDA(At, 1, 0); PG8_STAGE2(PG8_SA(0, 1), a2, 1);
            PG8_WAIT_V(8); PG8_WAIT_L(0); PG8_BAR; PG8_MMA(0, 0, At, B0); PG8_MMA(0, 1, At, B1); PG8_BAR; PG8_SCHED;
            PG8_LDA(At, 1, 1); PG8_STAGE(PG8_SB(1, 0), b3, voffB); PG8_STAGE(PG8_SB(1, 1), b3 + hstep, voffB); PG8_STAGE2(PG8_SA(1, 0), a3, 0);
            PG8_WAIT_V(8); PG8_WAIT_L(0); PG8_BAR; PG8_MMA(1, 0, At, B0); PG8_MMA(1, 1, At, B1); PG8_BAR; PG8_SCHED;
        }
        if (wr == 0) PG8_BAR;
        bool has_nn = false; unsigned vT[2][2];
        if (has_next) has_nn = S.next(ui + 2, nn);
        if (GATHER && has_nn) PG8_SETV(nn, vT);
        if constexpr (I8) {
#pragma unroll
            for (int a = 0; a < 2; ++a)
#pragma unroll
                for (int b = 0; b < 2; ++b)
#pragma unroll
                    for (int m = 0; m < 4; ++m)
#pragma unroll
                        for (int n = 0; n < 2; ++n) acc[a][b][m][n] = __builtin_bit_cast(f32x4, acci[a][b][m][n]);
        }
        { const int l_ = lane_id_();
          if constexpr (!NOEPI) E(acc, cur, wr, wc, l_ & 15, l_ >> 4);
          else { _Pragma("unroll") for (int a_ = 0; a_ < 2; ++a_) _Pragma("unroll") for (int b_ = 0; b_ < 2; ++b_) _Pragma("unroll") for (int m_ = 0; m_ < 4; ++m_) _Pragma("unroll") for (int n_ = 0; n_ < 2; ++n_) asm volatile("" :: "v"(acc[a_][b_][m_][n_])); } }
        if (!has_next) break;
#pragma unroll
        for (int a = 0; a < 2; ++a)
#pragma unroll
            for (int b = 0; b < 2; ++b)
#pragma unroll
                for (int m = 0; m < 4; ++m)
#pragma unroll
                    for (int n = 0; n < 2; ++n) { acc[a][b][m][n] = (f32x4){0.f, 0.f, 0.f, 0.f}; acci[a][b][m][n] = (v4i){0, 0, 0, 0}; }
        cur = nxt; cA = nA; cB = nB; ++ui;
        if (GATHER && has_nn) { LAS unsigned* pk = PG8_PARK; pk[0] = vT[0][0]; pk[1] = vT[0][1]; pk[2] = vT[1][0]; pk[3] = vT[1][1]; }
        nxt = nn; has_next = has_nn;
        if (wr == 1) PG8_BAR;
    }
    PG8_WAIT_V(0);
    PG8_BAR;
#undef PG8_SA
#undef PG8_SB
#undef PG8_STAGE
#undef PG8_STAGE2
#undef PG8_PARK
#undef PG8_LDA
#undef PG8_LDB
#undef PG8_MMA
#undef PG8_CAT
#undef PG8_WAIT_V
#undef PG8_WAIT_V8R
#undef PG8_WAIT_L
#undef PG8_BAR
#undef PG8_SCHED
#undef PG8_SETV
#undef PG8_ABASE
#undef PG8_BBASE
}

template <class F> struct EpiOct {
    F f;
    __device__ __forceinline__ void operator()(const f32x4 (&acc)[2][2][4][2], const Unit& u, int wr, int wc, int fr, int fq) const {
#pragma unroll
        for (int ai = 0; ai < 2; ++ai)
#pragma unroll
            for (int m = 0; m < 4; ++m) {
                const int r = ai * HALF + wr * 64 + m * 16 + fr;
#pragma unroll
                for (int bj = 0; bj < 2; ++bj) f(u, r, bj * HALF + wc * 32 + 8 * fq, acc[ai][bj][m][0], acc[ai][bj][m][1]);
            }
    }
};
}
using pg8::Unit;

__device__ __forceinline__ u32x4 pack8(f32x4 a, f32x4 b) { u32x4 w; w.x = pk2(a[0], a[1]); w.y = pk2(a[2], a[3]); w.z = pk2(b[0], b[1]); w.w = pk2(b[2], b[3]); return w; }
__device__ __forceinline__ void unpack8(u32x4 w, f32x4& a, f32x4& b) { a = (f32x4){bf_lo(w.x), bf_hi(w.x), bf_lo(w.y), bf_hi(w.y)}; b = (f32x4){bf_lo(w.z), bf_hi(w.z), bf_lo(w.w), bf_hi(w.w)}; }

template <bool NOSTORE = false> struct EpiProj_ {
    static constexpr int NVMEM = NOSTORE ? 0 : 16;
    bf16_t* proj; float* logf; const float* rope; const float* lb;
    __device__ __forceinline__ void operator()(const f32x4 (&acc)[2][2][4][2], const Unit& u, int wr, int wc, int fr, int fq) const {
        const int pn = u.pn, colb = pn * 256 + wc * 32 + 8 * fq, rowb = u.pm * 256 + wr * 64 + fr;
        if (pn < 4) {
            const int i0 = (colb & 63) >> 1; const float sc = pn < 2 ? QSCALE : 1.0f;
            f32x4 cs[2][4][2];
#pragma unroll
            for (int ai = 0; ai < 2; ++ai)
#pragma unroll
                for (int m = 0; m < 4; ++m) { const int pos = (rowb + ai * 128 + m * 16) & (SEQ - 1); const float* tp = rope + ((size_t)pos * 32 + i0) * 2; cs[ai][m][0] = *(const f32x4*)tp; cs[ai][m][1] = *(const f32x4*)(tp + 4); }
#pragma unroll
            for (int ai = 0; ai < 2; ++ai)
#pragma unroll
                for (int m = 0; m < 4; ++m) { const f32x4 c0 = cs[ai][m][0] * sc, c1 = cs[ai][m][1] * sc;
#pragma unroll
                    for (int bj = 0; bj < 2; ++bj) { const f32x4 v0 = acc[ai][bj][m][0], v1 = acc[ai][bj][m][1]; f32x4 o0, o1;
                        o0[0] = v0[0] * c0[0] - v0[1] * c0[1]; o0[1] = v0[1] * c0[0] + v0[0] * c0[1]; o0[2] = v0[2] * c0[2] - v0[3] * c0[3]; o0[3] = v0[3] * c0[2] + v0[2] * c0[3];
                        o1[0] = v1[0] * c1[0] - v1[1] * c1[1]; o1[1] = v1[1] * c1[0] + v1[0] * c1[1]; o1[2] = v1[2] * c1[2] - v1[3] * c1[3]; o1[3] = v1[3] * c1[2] + v1[2] * c1[3];
                        { const u32x4 w_ = pack8(o0, o1); if (NOSTORE) asm volatile("" :: "v"(w_)); else __builtin_nontemporal_store(w_, (u32x4*)(proj + (size_t)(rowb + ai * 128 + m * 16) * DIN + colb + bj * 128)); } } }
        } else if (pn == 8 || pn == 9) {
            f32x4 l[2][2];
#pragma unroll
            for (int bj = 0; bj < 2; ++bj) { const float* lp = lb + (colb - C_FB) + bj * 128; l[bj][0] = *(const f32x4*)lp; l[bj][1] = *(const f32x4*)(lp + 4); }
#pragma unroll
            for (int ai = 0; ai < 2; ++ai)
#pragma unroll
                for (int m = 0; m < 4; ++m)
#pragma unroll
                    for (int bj = 0; bj < 2; ++bj) { f32x4 o[2];
#pragma unroll
                        for (int n = 0; n < 2; ++n)
#pragma unroll
                            for (int j = 0; j < 4; ++j) o[n][j] = __logf(l[bj][n][j] + (1.0f - l[bj][n][j]) * sigmoidf_(acc[ai][bj][m][n][j]));
                        _Float16* p = (_Float16*)logf + (size_t)(rowb + ai * 128 + m * 16) * 512 + (colb - C_FB) + bj * 128;
                        const h16x8 hv = {(_Float16)o[0][0], (_Float16)o[0][1], (_Float16)o[0][2], (_Float16)o[0][3], (_Float16)o[1][0], (_Float16)o[1][1], (_Float16)o[1][2], (_Float16)o[1][3]};
                        if (NOSTORE) asm volatile("" :: "v"(hv)); else *(h16x8*)p = hv; }
        } else {
            const int mode = (pn == 6 || pn == 7 || pn == 12 || pn == 13) ? 1 : (pn >= 14 ? 2 : 0);
#define EPROJ_LOOP(EXPR) _Pragma("unroll") for (int ai = 0; ai < 2; ++ai) _Pragma("unroll") for (int m = 0; m < 4; ++m) _Pragma("unroll") for (int bj = 0; bj < 2; ++bj) { f32x4 o[2]; \
                _Pragma("unroll") for (int n = 0; n < 2; ++n) _Pragma("unroll") for (int j = 0; j < 4; ++j) { const float x = acc[ai][bj][m][n][j]; o[n][j] = (EXPR); } \
                const u32x4 w_ = pack8(o[0], o[1]); if (NOSTORE) asm volatile("" :: "v"(w_)); else __builtin_nontemporal_store(w_, (u32x4*)(proj + (size_t)(rowb + ai * 128 + m * 16) * DIN + colb + bj * 128)); }
            if (mode == 0) { EPROJ_LOOP(x) } else if (mode == 1) { EPROJ_LOOP(x * sigmoidf_(x)) } else {
#pragma unroll
                for (int ai = 0; ai < 2; ++ai)
#pragma unroll
                    for (int m = 0; m < 4; ++m)
#pragma unroll
                        for (int bj = 0; bj < 2; ++bj) { f32x4 o[2];
#pragma unroll
                            for (int n = 0; n < 2; ++n)
#pragma unroll
                                for (int j = 0; j < 4; ++j) o[n][j] = sigmoidf_(acc[ai][bj][m][n][j]);
                            u32x2 w_; w_.x = pk4_u8(o[0][0], o[0][1], o[0][2], o[0][3]); w_.y = pk4_u8(o[1][0], o[1][1], o[1][2], o[1][3]);
                            unsigned char* gp = (unsigned char*)(proj + (size_t)(rowb + ai * 128 + m * 16) * DIN) + GATE_BYTE0 + (colb - C_GA) + bj * 128;
                            if (NOSTORE) asm volatile("" :: "v"(w_)); else *(u32x2*)gp = w_; }
            }
#undef EPROJ_LOOP
        }
    }
};
typedef EpiProj_<false> EpiProj;
template <bool ACCUM> struct EpiMix {
    bf16_t* mixed; const bf16_t* proj; int gcol;
    __device__ __forceinline__ void operator()(const f32x4 (&acc)[2][2][4][2], const Unit& u, int wr, int wc, int fr, int fq) const {
        const int colb = u.pn * 256 + wc * 32 + 8 * fq, rowb = u.pm * 256 + wr * 64 + fr;
#pragma unroll
        for (int ai = 0; ai < 2; ++ai) {
            u32x4 g[4][2], mx[4][2];
#pragma unroll
            for (int m = 0; m < 4; ++m)
#pragma unroll
                for (int bj = 0; bj < 2; ++bj) { const size_t row = (size_t)(rowb + ai * 128 + m * 16); g[m][bj] = *(const u32x4*)(proj + row * DIN + gcol + colb + bj * 128);
                    if (ACCUM) mx[m][bj] = *(const u32x4*)(mixed + row * DM + colb + bj * 128); }
#pragma unroll
            for (int m = 0; m < 4; ++m)
#pragma unroll
                for (int bj = 0; bj < 2; ++bj) { f32x4 g0, g1; unpack8(g[m][bj], g0, g1); f32x4 v0 = acc[ai][bj][m][0] * g0, v1 = acc[ai][bj][m][1] * g1;
                    if (ACCUM) { f32x4 m0, m1; unpack8(mx[m][bj], m0, m1); v0 = v0 + m0; v1 = v1 + m1; }
                    *(u32x4*)(mixed + (size_t)(rowb + ai * 128 + m * 16) * DM + colb + bj * 128) = pack8(v0, v1); }
        }
    }
};
struct EpiMixF {         static constexpr int NVMEM = 16;
    bf16_t* mixed; const bf16_t* proj;
    __device__ __forceinline__ void mid(f32x4 (&acc)[2][2][4][2], const Unit& u, int wr, int wc, int fr, int fq) const {
        const int colb = u.pn * 256 + wc * 32 + 8 * fq, rowb = u.pm * 256 + wr * 64 + fr;
#pragma unroll
        for (int ai = 0; ai < 2; ++ai) {
            u32x2 ga[4][2], gb[4][2];
#pragma unroll
            for (int m = 0; m < 4; ++m)
#pragma unroll
                for (int bj = 0; bj < 2; ++bj) { const unsigned char* p = (const unsigned char*)(proj + (size_t)(rowb + ai * 128 + m * 16) * DIN) + GATE_BYTE0 + colb + bj * 128; ga[m][bj] = *(const u32x2*)p; gb[m][bj] = *(const u32x2*)(p + 1024); }
#pragma unroll
            for (int m = 0; m < 4; ++m)
#pragma unroll
                for (int bj = 0; bj < 2; ++bj) { const f32x4 a0 = un4_u8(ga[m][bj].x), a1 = un4_u8(ga[m][bj].y), b0 = un4_u8(gb[m][bj].x), b1 = un4_u8(gb[m][bj].y);
#pragma unroll
                    for (int j = 0; j < 4; ++j) { acc[ai][bj][m][0][j] *= a0[j] * __builtin_amdgcn_rcpf(b0[j]); acc[ai][bj][m][1][j] *= a1[j] * __builtin_amdgcn_rcpf(b1[j]); } }
        }
    }
    __device__ __forceinline__ void operator()(const f32x4 (&acc)[2][2][4][2], const Unit& u, int wr, int wc, int fr, int fq) const {
        const int colb = u.pn * 256 + wc * 32 + 8 * fq, rowb = u.pm * 256 + wr * 64 + fr;
#pragma unroll
        for (int ai = 0; ai < 2; ++ai) {
            u32x2 gb[4][2];
#pragma unroll
            for (int m = 0; m < 4; ++m)
#pragma unroll
                for (int bj = 0; bj < 2; ++bj) gb[m][bj] = *(const u32x2*)((const unsigned char*)(proj + (size_t)(rowb + ai * 128 + m * 16) * DIN) + GATE_BYTE0 + 1024 + colb + bj * 128);
#pragma unroll
            for (int m = 0; m < 4; ++m)
#pragma unroll
                for (int bj = 0; bj < 2; ++bj) { const f32x4 b0 = un4_u8(gb[m][bj].x) * (1.0f / 255.0f), b1 = un4_u8(gb[m][bj].y) * (1.0f / 255.0f);
                    *(u32x4*)(mixed + (size_t)(rowb + ai * 128 + m * 16) * DM + colb + bj * 128) = pack8(acc[ai][bj][m][0] * b0, acc[ai][bj][m][1] * b1); }
        }
    }
};
struct EpiOut {
    static constexpr int NVMEM = 16;
    const float* x; bf16_t* x1;
    __device__ __forceinline__ void operator()(const f32x4 (&acc)[2][2][4][2], const Unit& u, int wr, int wc, int fr, int fq) const {
        const int colb = u.pn * 256 + wc * 32 + 8 * fq, rowb = u.pm * 256 + wr * 64 + fr;
#pragma unroll
        for (int ai = 0; ai < 2; ++ai) {
            f32x4 xv[4][2][2];
#pragma unroll
            for (int m = 0; m < 4; ++m)
#pragma unroll
                for (int bj = 0; bj < 2; ++bj) { const float* p = x + (size_t)(rowb + ai * 128 + m * 16) * DM + colb + bj * 128; xv[m][bj][0] = __builtin_nontemporal_load((const f32x4*)p); xv[m][bj][1] = __builtin_nontemporal_load((const f32x4*)(p + 4)); }
#pragma unroll
            for (int m = 0; m < 4; ++m)
#pragma unroll
                for (int bj = 0; bj < 2; ++bj) *(u32x4*)(x1 + (size_t)(rowb + ai * 128 + m * 16) * DM + colb + bj * 128) = pack8(xv[m][bj][0] + acc[ai][bj][m][0], xv[m][bj][1] + acc[ai][bj][m][1]);
        }
    }
};
struct EpiMoe1 {         static constexpr int NVMEM = 8;
    bf16_t* hid; const float* bias;
    const float* rowhs; const float* wgs;
    __device__ __forceinline__ void operator()(const f32x4 (&acc)[2][2][4][2], const Unit& u, int wr, int wc, int fr, int fq) const {
        const int jj0 = wc * 32 + 8 * fq, J0 = 128 * u.pn + jj0;
        const float* bp = bias + (size_t)u.e * 2048 + 2 * J0;
        f32x4 b[4];
#pragma unroll
        for (int j = 0; j < 4; ++j) b[j] = *(const f32x4*)(bp + 4 * j);
        const float bg[8] = {b[0][0], b[0][2], b[1][0], b[1][2], b[2][0], b[2][2], b[3][0], b[3][2]};
        const float bu[8] = {b[0][1], b[0][3], b[1][1], b[1][3], b[2][1], b[2][3], b[3][1], b[3][3]};
        float sg[8], su[8], hs[2][4];
        if constexpr (MOE1_I8) {
            const float* sp = wgs + (size_t)u.e * 2048 + 256 * u.pn + jj0; const f32x4 g0 = *(const f32x4*)sp, g1 = *(const f32x4*)(sp + 4), u0 = *(const f32x4*)(sp + 128), u1 = *(const f32x4*)(sp + 132);
#pragma unroll
            for (int j = 0; j < 4; ++j) { sg[j] = g0[j]; sg[4 + j] = g1[j]; su[j] = u0[j]; su[4 + j] = u1[j]; }
#pragma unroll
            for (int ai = 0; ai < 2; ++ai)
#pragma unroll
                for (int m = 0; m < 4; ++m) { int r = ai * 128 + wr * 64 + m * 16 + fr; r = r < u.nvalid ? r : u.nvalid - 1; hs[ai][m] = rowhs[(size_t)u.e * CAP + u.lt * 256 + r]; }
        }
#pragma unroll
        for (int ai = 0; ai < 2; ++ai)
#pragma unroll
            for (int m = 0; m < 4; ++m) {
                const int r = ai * 128 + wr * 64 + m * 16 + fr;
                float h[8];
#pragma unroll
                for (int j = 0; j < 8; ++j) {
                    float gt, up;
                    if constexpr (MOE1_I8) { const float ag = acc[ai][0][m][j >> 2][j & 3], au = acc[ai][1][m][j >> 2][j & 3];
                        gt = (float)__builtin_bit_cast(int, ag) * (hs[ai][m] * sg[j]) + bg[j]; up = (float)__builtin_bit_cast(int, au) * (hs[ai][m] * su[j]) + bu[j]; }
                    else { gt = acc[ai][0][m][j >> 2][j & 3] * DQ1 + bg[j]; up = acc[ai][1][m][j >> 2][j & 3] * DQ1 + bu[j]; }
                    gt = fminf(gt, 7.0f); up = __builtin_amdgcn_fmed3f(up, -7.0f, 7.0f);
                    h[j] = (up + 1.0f) * gt * __builtin_amdgcn_rcpf(1.0f + __builtin_amdgcn_exp2f(gt * (-1.702f * 1.4426950408889634f)));
                }
                if constexpr (MOE_FP8) { u32x2 w; w.x = pk4_fp8_nc(h[0], h[1], h[2], h[3], S_HID); w.y = pk4_fp8_nc(h[4], h[5], h[6], h[7], S_HID);
                    *(u32x2*)((unsigned char*)hid + (size_t)(u.pm * 256 + r) * DE + J0) = w; }
                else { u32x4 w; w.x = pk2(h[0], h[1]); w.y = pk2(h[2], h[3]); w.z = pk2(h[4], h[5]); w.w = pk2(h[6], h[7]);
                    *(u32x4*)(hid + (size_t)(u.pm * 256 + r) * DE + J0) = w; }
            }
    }
};
struct EpiMoe2 {
    static constexpr int NVMEM = 16;
    bf16_t* yg; const float* bias; const int* rows; const float* roww;
    __device__ __forceinline__ void operator()(const f32x4 (&acc)[2][2][4][2], const Unit& u, int wr, int wc, int fr, int fq) const {
        f32x4 b[2][2];
#pragma unroll
        for (int bj = 0; bj < 2; ++bj) { const float* bp = bias + (size_t)u.e * DM + u.pn * 256 + bj * 128 + wc * 32 + 8 * fq; b[bj][0] = *(const f32x4*)bp; b[bj][1] = *(const f32x4*)(bp + 4); }
        int slot[2][4]; float wgt[2][4];
#pragma unroll
        for (int ai = 0; ai < 2; ++ai)
#pragma unroll
            for (int m = 0; m < 4; ++m) { int r = ai * 128 + wr * 64 + m * 16 + fr; r = r < u.nvalid ? r : u.nvalid - 1; const size_t p = (size_t)u.e * CAP + u.lt * 256 + r; slot[ai][m] = rows[p]; wgt[ai][m] = roww[p]; }
#pragma unroll
        for (int ai = 0; ai < 2; ++ai)
#pragma unroll
            for (int m = 0; m < 4; ++m) {
                const int r = ai * 128 + wr * 64 + m * 16 + fr; const float w = wgt[ai][m];
                if (r < u.nvalid) {
#pragma unroll
                    for (int bj = 0; bj < 2; ++bj)
                    { const f32x4 y0 = (acc[ai][bj][m][0] * DQ2 + b[bj][0]) * w, y1 = (acc[ai][bj][m][1] * DQ2 + b[bj][1]) * w;
                      if constexpr (MOE_FP8) { u32x2 q; q.x = pk4_fp8(y0[0], y0[1], y0[2], y0[3], S_YG); q.y = pk4_fp8(y1[0], y1[1], y1[2], y1[3], S_YG);
                          *(u32x2*)((unsigned char*)yg + (size_t)slot[ai][m] * DM + u.pn * 256 + bj * 128 + wc * 32 + 8 * fq) = q; }
                      else *(u32x4*)(yg + (size_t)slot[ai][m] * DM + u.pn * 256 + bj * 128 + wc * 32 + 8 * fq) = pack8(y0, y1); }
                }
            }
    }
};

struct Args { const float* in[16]; float* out; unsigned char* ws; int ph_lo, ph_hi; };
enum { I_X = 0, I_N1, I_WIN, I_MUP, I_LBL, I_HNW, I_HUP, I_WOUT, I_N2, I_RW, I_RB, I_WGU, I_BGU, I_WD, I_BD, I_FNW };
constexpr int NPHASE = 11;

struct Frame { LAS unsigned char* lds; int tid, lane, wave, G, bid; };
__device__ __forceinline__ Frame fresh(const Frame& F0) { Frame F = F0; const int l = lane_id_(); F.lane = l; F.tid = F0.wave * 64 + l; return F; }

template <int MAP> __device__ __forceinline__ int rowmap(int n) {
    if (MAP == 1) return n < 1024 ? ((n & ~63) | (2 * (n & 31) + ((n >> 5) & 1))) : n;
    if (MAP == 2) { const int J = n >> 1, s = n & 1; return 256 * (J >> 7) + 128 * s + (J & 127); }
    return n;
}
template <int MAP> __device__ __forceinline__ void transpose_item(const float* W, int K, int N, bf16_t* WT, LAS float* scr, int item, int lane, int KP = 0) {
    if (KP == 0) KP = K;
    const int nblk = N / 32, kb = item / nblk, nb = item % nblk, k0 = 64 * kb, n0 = 32 * nb;
    f32x4 v[8];
#pragma unroll
    for (int i = 0; i < 8; ++i) v[i] = __builtin_nontemporal_load((const f32x4*)(W + (size_t)(k0 + 8 * i + (lane >> 3)) * N + n0 + 4 * (lane & 7)));
#pragma unroll
    for (int i = 0; i < 8; ++i) { LAS float* p = scr + (8 * i + (lane >> 3)) * 33 + 4 * (lane & 7); p[0] = v[i].x; p[1] = v[i].y; p[2] = v[i].z; p[3] = v[i].w; }
    asm volatile("s_waitcnt lgkmcnt(0)" ::: "memory");
    const int c = lane & 7;
#pragma unroll
    for (int j = 0; j < 4; ++j) { const int n = (lane >> 3) + 8 * j; const LAS float* s = scr + (8 * c) * 33 + n;
        u32x4 o; o.x = pk2(s[0 * 33], s[1 * 33]); o.y = pk2(s[2 * 33], s[3 * 33]); o.z = pk2(s[4 * 33], s[5 * 33]); o.w = pk2(s[6 * 33], s[7 * 33]);
        *(u32x4*)(WT + (size_t)rowmap<MAP>(n0 + n) * KP + k0 + 8 * c) = o; }
    asm volatile("s_waitcnt lgkmcnt(0)" ::: "memory");
}
template <int MAP> __device__ __forceinline__ void transpose_item_fp8(const float* W, int K, int N, unsigned char* WT, LAS float* scr, int item, int lane) {
    const int nblk = N / 32, kb = item / nblk, nb = item % nblk, k0 = 64 * kb, n0 = 32 * nb;
    f32x4 v[8];
#pragma unroll
    for (int i = 0; i < 8; ++i) v[i] = __builtin_nontemporal_load((const f32x4*)(W + (size_t)(k0 + 8 * i + (lane >> 3)) * N + n0 + 4 * (lane & 7)));
#pragma unroll
    for (int i = 0; i < 8; ++i) { LAS float* p = scr + (8 * i + (lane >> 3)) * 33 + 4 * (lane & 7); p[0] = v[i].x; p[1] = v[i].y; p[2] = v[i].z; p[3] = v[i].w; }
    asm volatile("s_waitcnt lgkmcnt(0)" ::: "memory");
    const int n = lane >> 1, hf = lane & 1; const LAS float* s = scr + (32 * hf) * 33 + n;
    u32x4 o0, o1;
    o0.x = pk4_fp8(s[0 * 33], s[1 * 33], s[2 * 33], s[3 * 33], S_W);     o0.y = pk4_fp8(s[4 * 33], s[5 * 33], s[6 * 33], s[7 * 33], S_W);
    o0.z = pk4_fp8(s[8 * 33], s[9 * 33], s[10 * 33], s[11 * 33], S_W);   o0.w = pk4_fp8(s[12 * 33], s[13 * 33], s[14 * 33], s[15 * 33], S_W);
    o1.x = pk4_fp8(s[16 * 33], s[17 * 33], s[18 * 33], s[19 * 33], S_W); o1.y = pk4_fp8(s[20 * 33], s[21 * 33], s[22 * 33], s[23 * 33], S_W);
    o1.z = pk4_fp8(s[24 * 33], s[25 * 33], s[26 * 33], s[27 * 33], S_W); o1.w = pk4_fp8(s[28 * 33], s[29 * 33], s[30 * 33], s[31 * 33], S_W);
    unsigned char* dst = WT + (size_t)rowmap<MAP>(n0 + n) * K + k0 + 32 * hf;
    *(u32x4*)dst = o0; *(u32x4*)(dst + 16) = o1;
    asm volatile("s_waitcnt lgkmcnt(0)" ::: "memory");
}
template <int MAP> __device__ __forceinline__ void quant_cols_item(const float* W, int N, unsigned char* WT, float* scl, LAS unsigned char* lds, int item, int wave, int lane) {
    LAS float* s = (LAS float*)lds; LAS float* pmax = (LAS float*)(lds + 1024 * 33 * 4);
    const int n0 = 32 * item;
    { f32x4 v[16];
#pragma unroll
      for (int i = 0; i < 16; ++i) v[i] = __builtin_nontemporal_load((const f32x4*)(W + (size_t)(128 * wave + 8 * i + (lane >> 3)) * N + n0 + 4 * (lane & 7)));
#pragma unroll
      for (int i = 0; i < 16; ++i) { LAS float* p = s + (128 * wave + 8 * i + (lane >> 3)) * 33 + 4 * (lane & 7); p[0] = v[i].x; p[1] = v[i].y; p[2] = v[i].z; p[3] = v[i].w; } }
    __syncthreads();
    const int n = lane & 31, kb = 128 * wave + 64 * (lane >> 5);
    float x[64]; float am = 0.f;
#pragma unroll
    for (int kk = 0; kk < 64; ++kk) { x[kk] = s[(kb + kk) * 33 + n]; am = fmaxf(am, fabsf(x[kk])); }
    pmax[(2 * wave + (lane >> 5)) * 32 + n] = am;
    __syncthreads();
    am = 0.f;
#pragma unroll
    for (int p = 0; p < 16; ++p) am = fmaxf(am, pmax[p * 32 + n]);
    const float inv = am > 0.f ? 127.0f / am : 0.f;
    const int r = rowmap<MAP>(n0 + n);
    if (wave == 0 && lane < 32) scl[r] = am * (1.0f / 127.0f);
    unsigned char* dst = WT + (size_t)r * 1024 + kb;
#pragma unroll
    for (int q = 0; q < 4; ++q) { u32x4 o;
        o.x = pk4_i8(x[16 * q + 0] * inv, x[16 * q + 1] * inv, x[16 * q + 2] * inv, x[16 * q + 3] * inv);   o.y = pk4_i8(x[16 * q + 4] * inv, x[16 * q + 5] * inv, x[16 * q + 6] * inv, x[16 * q + 7] * inv);
        o.z = pk4_i8(x[16 * q + 8] * inv, x[16 * q + 9] * inv, x[16 * q + 10] * inv, x[16 * q + 11] * inv); o.w = pk4_i8(x[16 * q + 12] * inv, x[16 * q + 13] * inv, x[16 * q + 14] * inv, x[16 * q + 15] * inv);
        *(u32x4*)(dst + 16 * q) = o; }
    __syncthreads();
}
__device__ __forceinline__ void rms_row_to_bf16(const float* xrow, const float* w, bf16_t* orow, int lane) {
    const f32x4* xr = (const f32x4*)xrow + lane; const f32x4* wr = (const f32x4*)w + lane;
    f32x4 v[4]; float s = 0.f;
#pragma unroll
    for (int j = 0; j < 4; ++j) { v[j] = __builtin_nontemporal_load(xr + 64 * j); s += (v[j].x * v[j].x + v[j].y * v[j].y) + (v[j].z * v[j].z + v[j].w * v[j].w); }
    const float rstd = 1.0f / sqrtf(wave_sum(s) * (1.0f / DM) + RMS_EPS);
    u32x2* o8 = (u32x2*)orow + lane;
#pragma unroll
    for (int j = 0; j < 4; ++j) { const f32x4 ww = wr[64 * j]; u32x2 o; o.x = pk2(v[j].x * rstd * ww.x, v[j].y * rstd * ww.y); o.y = pk2(v[j].z * rstd * ww.z, v[j].w * rstd * ww.w); o8[64 * j] = o; }
}

__device__ __forceinline__ void p0_prologue(const Frame& F0, const Args& a) {
    const Frame F = fresh(F0);
    unsigned char* ws = a.ws;
    LAS float* scr = (LAS float*)(F.lds + F.wave * 16384);
    const int gw = F.bid * 8 + F.wave, NGW = F.G * 8;
    constexpr int I_IN = 16 * (DIN / 32), I_UP = 8 * 32, I_O = 16 * 32, I_GU = MOE1_I8 ? 0 : 16 * 64, I_D = 16 * 32;
    constexpr int NITEMS = I_IN + 2 * I_UP + I_O + NE * (I_GU + I_D);
    for (int it = gw; it < NITEMS; it += NGW) {
        int r = it;
        if (r < I_IN) { transpose_item<1>(a.in[I_WIN], DM, DIN, (bf16_t*)(ws + WS_WIN), scr, r, F.lane); continue; } r -= I_IN;
        if (r < I_UP) { transpose_item<0>(a.in[I_MUP], 512, DM, (bf16_t*)(ws + WS_MUP), scr, r, F.lane, 1024); continue; } r -= I_UP;
        if (r < I_UP) { transpose_item<0>(a.in[I_HUP], 512, DM, (bf16_t*)(ws + WS_MUP) + 512, scr, r, F.lane, 1024); continue; } r -= I_UP;
        if (r < I_O) { transpose_item<0>(a.in[I_WOUT], DM, DM, (bf16_t*)(ws + WS_WOUT), scr, r, F.lane); continue; } r -= I_O;
        if (I_GU > 0 && r < NE * I_GU) { const int e = r / (I_GU > 0 ? I_GU : 1);
            if constexpr (MOE_FP8) transpose_item_fp8<2>(a.in[I_WGU] + (size_t)e * DM * 2 * DE, DM, 2 * DE, (unsigned char*)(ws + WS_WGU) + (size_t)e * 2 * DE * DM, scr, r % (I_GU > 0 ? I_GU : 1), F.lane);
            else transpose_item<2>(a.in[I_WGU] + (size_t)e * DM * 2 * DE, DM, 2 * DE, (bf16_t*)(ws + WS_WGU) + (size_t)e * 2 * DE * DM, scr, r % (I_GU > 0 ? I_GU : 1), F.lane);
            continue; } r -= NE * I_GU;
        { const int e = r / I_D;
            if constexpr (MOE_FP8) transpose_item_fp8<0>(a.in[I_WD] + (size_t)e * DE * DM, DE, DM, (unsigned char*)(ws + WS_WD) + (size_t)e * DM * DE, scr, r % I_D, F.lane);
            else transpose_item<0>(a.in[I_WD] + (size_t)e * DE * DM, DE, DM, (bf16_t*)(ws + WS_WD) + (size_t)e * DM * DE, scr, r % I_D, F.lane); }
    }
    for (int m = gw; m < NTOK; m += NGW) rms_row_to_bf16(a.in[I_X] + (size_t)m * DM, a.in[I_N1], (bf16_t*)(ws + WS_XN) + (size_t)m * DM, F.lane);
    if constexpr (MOE1_I8) {
        __syncthreads();
        for (int wi = F.bid; wi < NE * 64; wi += F.G) { const int e = wi >> 6;
            quant_cols_item<2>(a.in[I_WGU] + (size_t)e * DM * 2 * DE, 2 * DE, (unsigned char*)(ws + WS_WGU) + (size_t)e * 2 * DE * DM, (float*)(ws + WS_WGS) + (size_t)e * 2 * DE, F.lds, wi & 63, F.wave, F.lane); }
    }
    float* rope = (float*)(ws + WS_ROPE);
    for (int idx = F.bid * 512 + F.tid; idx < SEQ * 32; idx += F.G * 512) {
        const int pos = idx >> 5, i = idx & 31;
        const double inv = exp2(-(double)i * (13.287712379549449 / 32.0));
        const double rev = (double)pos * inv * 0.15915494309189535;
        const float fr = (float)(rev - floor(rev));
        rope[2 * idx] = __builtin_amdgcn_cosf(fr); rope[2 * idx + 1] = __builtin_amdgcn_sinf(fr);
    }
    if (F.bid == 0) { const float* l = a.in[I_LBL]; const float a0 = l[F.tid], a1 = l[512 + F.tid]; ((float*)(ws + WS_LB))[F.tid] = 1.0f / (1.0f + __expf(a1 - a0)); }
}

__device__ __forceinline__ void p2_kmean(const Frame& F0, const Args& a) {
    const Frame F = fresh(F0);
    const bf16_t* proj = (const bf16_t*)(a.ws + WS_PROJ); bf16_t* km = (bf16_t*)(a.ws + WS_KMEAN);
    LAS float* red = (LAS float*)F.lds;
    for (int it = F.bid; it < 128; it += F.G) {
        const int b = it >> 4, n = it & 15;
        float s[8] = {0, 0, 0, 0, 0, 0, 0, 0};
        const bf16_t* base = proj + (size_t)(b * SEQ + n * 256 + F.wave * 32) * DIN + C_KA + F.lane * 8;
#pragma unroll 8
        for (int r = 0; r < 32; ++r) { const u32x4 w = *(const u32x4*)(base + (size_t)r * DIN); f32x4 x0, x1; unpack8(w, x0, x1);
            s[0] += x0[0]; s[1] += x0[1]; s[2] += x0[2]; s[3] += x0[3]; s[4] += x1[0]; s[5] += x1[1]; s[6] += x1[2]; s[7] += x1[3]; }
#pragma unroll
        for (int j = 0; j < 8; ++j) red[F.wave * 512 + F.lane * 8 + j] = s[j];
        __syncthreads();
        float t = 0.f;
#pragma unroll
        for (int w = 0; w < 8; ++w) t += red[w * 512 + F.tid];
        km[((size_t)b * 64 + n) * 512 + F.tid] = (bf16_t)f2bf(t * (1.0f / 256.0f));
        km[((size_t)b * 64 + n + 16) * 512 + F.tid] = 0; km[((size_t)b * 64 + n + 32) * 512 + F.tid] = 0; km[((size_t)b * 64 + n + 48) * 512 + F.tid] = 0;
        __syncthreads();
    }
}

constexpr int HP = 72, HQ = 136;
__device__ __forceinline__ void h2_scan(const Frame& F0, const Args& a) {
    const Frame F = fresh(F0);
    bf16_t* hst = (bf16_t*)(a.ws + WS_HST); const float* gdec = (const float*)(a.ws + WS_GDEC);
    for (int idx = F.bid * 512 + F.tid; idx < 32 * 128 * 32; idx += F.G * 512) {
        const int bh = idx >> 12, v = (idx >> 5) & 127, d4 = idx & 31;
        bf16_t* p = hst + ((size_t)bh * 64 * 128 + v) * 128 + d4 * 4; const float* g = gdec + (size_t)bh * 64 * 128 + d4 * 4;
        f32x4 s = {0.f, 0.f, 0.f, 0.f};
#pragma unroll 8
        for (int c = 0; c < 64; ++c) {
            const u32x2 u = __builtin_nontemporal_load((const u32x2*)(p + (size_t)c * 16384)); const f32x4 gg = *(const f32x4*)(g + c * 128);
            u32x2 w; w.x = pk2(s[0], s[1]); w.y = pk2(s[2], s[3]); *(u32x2*)(p + (size_t)c * 16384) = w;
            s = gg * s + (f32x4){bf_lo(u.x), bf_hi(u.x), bf_lo(u.y), bf_hi(u.y)};
        }
    }
}
constexpr int LFP = 132;
#define H_LOAD_LQI(it_, LFR, QR, IR, WITHQ) do { const int bh_ = (it_) >> 6, c_ = (it_) & 63; const size_t r_ = (size_t)(bh_ >> 2) * SEQ + c_ * 64 + t_r; const int hh_ = (bh_ & 3) * 128 + 16 * seg; \
    _Pragma("unroll") for (int j_ = 0; j_ < 2; ++j_) { const h16x8 h_ = __builtin_nontemporal_load((const h16x8*)((const _Float16*)logf + r_ * 512 + hh_ + 8 * j_)); const f32x8 f_ = __builtin_convertvector(h_, f32x8); \
        LFR[2 * j_] = (f32x4){f_[0], f_[1], f_[2], f_[3]}; LFR[2 * j_ + 1] = (f32x4){f_[4], f_[5], f_[6], f_[7]}; } \
    _Pragma("unroll") for (int j_ = 0; j_ < 2; ++j_) { if (WITHQ) QR[j_] = __builtin_nontemporal_load((const u32x4*)(proj + r_ * DIN + C_QB + hh_ + 8 * j_)); IR[j_] = __builtin_nontemporal_load((const u32x4*)(proj + r_ * DIN + C_IB + hh_ + 8 * j_)); } } while (0)
__device__ __forceinline__ void scatter_it(LAS bf16_t* It, const u32x4 (&ir)[2], int seg, int t_r) {
#pragma unroll
    for (int j = 0; j < 2; ++j) { const unsigned w[4] = {ir[j].x, ir[j].y, ir[j].z, ir[j].w};
#pragma unroll
        for (int q = 0; q < 4; ++q) { It[(16 * seg + 8 * j + 2 * q) * HP + t_r] = (bf16_t)(w[q] & 0xffffu); It[(16 * seg + 8 * j + 2 * q + 1) * HP + t_r] = (bf16_t)(w[q] >> 16); } }
}
__device__ __forceinline__ void h1_local_states_p(const Frame& F0, const Args& a) {
    const Frame F = fresh(F0);
    const bf16_t* proj = (const bf16_t*)(a.ws + WS_PROJ); const float* logf = (const float*)(a.ws + WS_LOGF);
    bf16_t* hst = (bf16_t*)(a.ws + WS_HST); float* gdec = (float*)(a.ws + WS_GDEC);
    LAS float* LF = (LAS float*)F.lds; LAS bf16_t* Kp = (LAS bf16_t*)(F.lds + 64 * LFP * 4); LAS bf16_t* It = Kp + 128 * HP;
    const int t_r = F.tid >> 3, seg = F.tid & 7, l15 = F.lane & 15, lq = F.lane >> 4;
    f32x4 lfr[4], lfn[4]; u32x4 qdum[2], ir[2], in_[2];
    int it = F.bid;
    if (it < 2048) H_LOAD_LQI(it, lfr, qdum, ir, false);
    for (; it < 2048; it += F.G) {
        const int bh = it >> 6, c = it & 63;
#pragma unroll
        for (int j = 0; j < 4; ++j) *(LAS f32x4*)(LF + t_r * LFP + 16 * seg + 4 * j) = lfr[j];
        scatter_it(It, ir, seg, t_r);
        const int itn = it + F.G;
        if (itn < 2048) H_LOAD_LQI(itn, lfn, qdum, in_, false);
        __syncthreads();
        if (F.tid < 128) { float run = 0.f;
#pragma unroll 16
            for (int t = 0; t < 64; ++t) { run += LF[t * LFP + F.tid]; LF[t * LFP + F.tid] = run; }
            gdec[((size_t)bh * 64 + c) * 128 + F.tid] = __expf(run); }
        __syncthreads();
        {
            f32x4 bb[4], bl[4];
#pragma unroll
            for (int j = 0; j < 4; ++j) { bb[j] = *(const LAS f32x4*)(LF + t_r * LFP + 16 * seg + 4 * j); bl[j] = *(const LAS f32x4*)(LF + 63 * LFP + 16 * seg + 4 * j); }
#pragma unroll
            for (int j = 0; j < 4; ++j)
#pragma unroll
                for (int q = 0; q < 4; ++q) { const float kv = (1.0f - __expf(lfr[j][q])) * __expf(bl[j][q] - bb[j][q]); Kp[(16 * seg + 4 * j + q) * HP + t_r] = (bf16_t)f2bf(kv); }
        }
        __syncthreads();
        bf16x8 af[2];
#pragma unroll
        for (int ks = 0; ks < 2; ++ks) af[ks] = *(const LAS bf16x8*)(Kp + (16 * F.wave + l15) * HP + ks * 32 + 8 * lq);
#pragma unroll
        for (int vt = 0; vt < 8; ++vt) {
            f32x4 acc = {0.f, 0.f, 0.f, 0.f};
#pragma unroll
            for (int ks = 0; ks < 2; ++ks) { const bf16x8 bfr = *(const LAS bf16x8*)(It + (16 * vt + l15) * HP + ks * 32 + 8 * lq); acc = __builtin_amdgcn_mfma_f32_16x16x32_bf16(af[ks], bfr, acc, 0, 0, 0); }
            u32x2 w; w.x = pk2(acc[0], acc[1]); w.y = pk2(acc[2], acc[3]);
            *(u32x2*)(hst + (((size_t)bh * 64 + c) * 128 + 16 * vt + l15) * 128 + 16 * F.wave + 4 * lq) = w;
        }
        __syncthreads();
#pragma unroll
        for (int j = 0; j < 4; ++j) lfr[j] = lfn[j];
        ir[0] = in_[0]; ir[1] = in_[1];
    }
}
#define H3_LOAD_LATE(it_, SF, GR) do { const int bh_ = (it_) >> 6, c_ = (it_) & 63; const size_t row0_ = (size_t)(bh_ >> 2) * SEQ + c_ * 64; \
    _Pragma("unroll") for (int ks_ = 0; ks_ < 4; ++ks_) SF[ks_] = __builtin_nontemporal_load((const bf16x8*)(hst + (((size_t)bh_ * 64 + c_) * 128 + 16 * w + l15) * 128 + ks_ * 32 + 8 * lq)); \
    _Pragma("unroll") for (int tt_ = 0; tt_ < 4; ++tt_) GR[tt_] = __builtin_nontemporal_load((const u32x2*)(proj + (row0_ + 16 * tt_ + l15) * DIN + C_GB + (bh_ & 3) * 128 + 16 * w + 4 * lq)); } while (0)
__device__ __forceinline__ void h3_outputs_p(const Frame& F0, const Args& a) {
    const Frame F = fresh(F0);
    const bf16_t* proj = (const bf16_t*)(a.ws + WS_PROJ); const float* logf = (const float*)(a.ws + WS_LOGF);
    const bf16_t* hst = (const bf16_t*)(a.ws + WS_HST); bf16_t* yb = (bf16_t*)(a.ws + WS_YA); const float* nw = a.in[I_HNW];
    LAS float* LF = (LAS float*)F.lds; LAS bf16_t* Qt = (LAS bf16_t*)(F.lds + 64 * LFP * 4); LAS bf16_t* Kt = Qt + 64 * HQ; LAS bf16_t* It = Kt + 64 * HQ; LAS bf16_t* Pm = It + 128 * HP;
    LAS float* rsq = (LAS float*)(Pm + 64 * HP);
    const int t_r = F.tid >> 3, seg = F.tid & 7, l15 = F.lane & 15, lq = F.lane >> 4, w = F.wave;
    f32x4 lfr[4], lfn[4]; u32x4 qr[2], qn[2], ir[2], in_[2]; bf16x8 sf[4], sfn[4]; u32x2 gr[4], grn[4];
    int it = F.bid;
    if (it < 2048) { H_LOAD_LQI(it, lfr, qr, ir, true); H3_LOAD_LATE(it, sf, gr); }
    for (; it < 2048; it += F.G) {
        const int bh = it >> 6, c = it & 63, b = bh >> 2, h = bh & 3; const size_t row0 = (size_t)b * SEQ + c * 64;
#pragma unroll
        for (int j = 0; j < 4; ++j) *(LAS f32x4*)(LF + t_r * LFP + 16 * seg + 4 * j) = lfr[j];
        scatter_it(It, ir, seg, t_r);
        const int itn = it + F.G;
        if (itn < 2048) { H_LOAD_LQI(itn, lfn, qn, in_, true); H3_LOAD_LATE(itn, sfn, grn); }
        __syncthreads();
        if (F.tid < 128) { float run = 0.f;
#pragma unroll 16
            for (int t = 0; t < 64; ++t) { run += LF[t * LFP + F.tid]; LF[t * LFP + F.tid] = run; } }
        __syncthreads();
        {
            float qv[16], kv[16];
#pragma unroll
            for (int j = 0; j < 4; ++j) { const f32x4 bb = *(const LAS f32x4*)(LF + t_r * LFP + 16 * seg + 4 * j);
#pragma unroll
                for (int q = 0; q < 4; ++q) { const float eb = __expf(bb[q]); const unsigned qw = (j < 2 ? qr[0] : qr[1])[(2 * j + (q >> 1)) & 3];
                    const float qs = (q & 1) ? bf_hi(qw) : bf_lo(qw);
                    qv[4 * j + q] = qs * eb; kv[4 * j + q] = (1.0f - __expf(lfr[j][q])) * __builtin_amdgcn_rcpf(eb); } }
            u32x4 o0, o1;
            o0.x = pk2(qv[0], qv[1]); o0.y = pk2(qv[2], qv[3]); o0.z = pk2(qv[4], qv[5]); o0.w = pk2(qv[6], qv[7]); o1.x = pk2(qv[8], qv[9]); o1.y = pk2(qv[10], qv[11]); o1.z = pk2(qv[12], qv[13]); o1.w = pk2(qv[14], qv[15]);
            *(LAS u32x4*)(Qt + t_r * HQ + 16 * seg) = o0; *(LAS u32x4*)(Qt + t_r * HQ + 16 * seg + 8) = o1;
            o0.x = pk2(kv[0], kv[1]); o0.y = pk2(kv[2], kv[3]); o0.z = pk2(kv[4], kv[5]); o0.w = pk2(kv[6], kv[7]); o1.x = pk2(kv[8], kv[9]); o1.y = pk2(kv[10], kv[11]); o1.z = pk2(kv[12], kv[13]); o1.w = pk2(kv[14], kv[15]);
            *(LAS u32x4*)(Kt + t_r * HQ + 16 * seg) = o0; *(LAS u32x4*)(Kt + t_r * HQ + 16 * seg + 8) = o1;
        }
        __syncthreads();
        {
            const int tt = w >> 1; bf16x8 qa[4];
#pragma unroll
            for (int ks = 0; ks < 4; ++ks) qa[ks] = *(const LAS bf16x8*)(Qt + (16 * tt + l15) * HQ + ks * 32 + 8 * lq);
#pragma unroll
            for (int j = 0; j < 2; ++j) {
                const int st = (w & 1) * 2 + j; f32x4 acc = {0.f, 0.f, 0.f, 0.f};
#pragma unroll
                for (int ks = 0; ks < 4; ++ks) { const bf16x8 kb = *(const LAS bf16x8*)(Kt + (16 * st + l15) * HQ + ks * 32 + 8 * lq); acc = __builtin_amdgcn_mfma_f32_16x16x32_bf16(qa[ks], kb, acc, 0, 0, 0); }
                const int s = 16 * st + l15;
#pragma unroll
                for (int r = 0; r < 4; ++r) { const int t = 16 * tt + 4 * lq + r; Pm[t * HP + s] = (bf16_t)(s <= t ? f2bf(acc[r]) : 0u); }
            }
        }
        __syncthreads();
        f32x4 o[4];
        {
            bf16x8 ia[2];
#pragma unroll
            for (int ks = 0; ks < 2; ++ks) ia[ks] = *(const LAS bf16x8*)(It + (16 * w + l15) * HP + ks * 32 + 8 * lq);
#pragma unroll
            for (int tt = 0; tt < 4; ++tt) {
                f32x4 acc = {0.f, 0.f, 0.f, 0.f};
#pragma unroll
                for (int ks = 0; ks < 2; ++ks) { const bf16x8 pb = *(const LAS bf16x8*)(Pm + (16 * tt + l15) * HP + ks * 32 + 8 * lq); acc = __builtin_amdgcn_mfma_f32_16x16x32_bf16(ia[ks], pb, acc, 0, 0, 0); }
#pragma unroll
                for (int ks = 0; ks < 4; ++ks) { const bf16x8 qb = *(const LAS bf16x8*)(Qt + (16 * tt + l15) * HQ + ks * 32 + 8 * lq); acc = __builtin_amdgcn_mfma_f32_16x16x32_bf16(sf[ks], qb, acc, 0, 0, 0); }
                o[tt] = acc;
                float sq = (acc[0] * acc[0] + acc[1] * acc[1]) + (acc[2] * acc[2] + acc[3] * acc[3]);
                sq += __shfl_xor(sq, 16); sq += __shfl_xor(sq, 32);
                if (F.lane < 16) rsq[w * 64 + 16 * tt + F.lane] = sq;
            }
        }
        __syncthreads();
        const int v0 = 16 * w + 4 * lq; const f32x4 nw4 = *(const f32x4*)(nw + h * 128 + v0);
#pragma unroll
        for (int tt = 0; tt < 4; ++tt) {
            const int t = 16 * tt + l15; float tot = 0.f;
#pragma unroll
            for (int ww = 0; ww < 8; ++ww) tot += rsq[ww * 64 + t];
            const float rstd = __builtin_amdgcn_rsqf(tot * (1.0f / 128.0f) + RMS_EPS);
            const u32x2 gg = gr[tt];
            u32x2 y; y.x = pk2(o[tt][0] * rstd * nw4[0] * bf_lo(gg.x), o[tt][1] * rstd * nw4[1] * bf_hi(gg.x)); y.y = pk2(o[tt][2] * rstd * nw4[2] * bf_lo(gg.y), o[tt][3] * rstd * nw4[3] * bf_hi(gg.y));
            *(u32x2*)(yb + (row0 + t) * 1024 + 512 + h * 128 + v0) = y;
        }
        __syncthreads();
#pragma unroll
        for (int j = 0; j < 4; ++j) lfr[j] = lfn[j];
        qr[0] = qn[0]; qr[1] = qn[1]; ir[0] = in_[0]; ir[1] = in_[1];
#pragma unroll
        for (int j = 0; j < 4; ++j) { sf[j] = sfn[j]; gr[j] = grn[j]; }
    }
}
#undef H3_LOAD_LATE

#include <hip/hip_bf16.h>
#include <cmath>
namespace attn_body {
using bf16=__hip_bfloat16;
using bf16x8=__attribute__((ext_vector_type(8)))short;
using s16x4=__attribute__((ext_vector_type(4)))short;
using f32x16=__attribute__((ext_vector_type(16)))float;
using u32x4=__attribute__((ext_vector_type(4)))unsigned;
constexpr int BATCH=8,NHEAD=8,SEQ=4096,D=64,PIN=5632,POUT=1024,PKM=512;
constexpr int NW=8,QBLK=32,QB=QBLK*NW,KVBLK=64,NQB=SEQ/QB;
constexpr int ATTN_UNIT_ROWS=QB;
__device__ __forceinline__ int crow(int r,int hi){return (r&3)+8*(r>>2)+4*hi;}
#define SBAR() __builtin_amdgcn_sched_barrier(0)
__device__ __forceinline__ void cmask(f32x16&p0,f32x16&p1,int jb,int qrel,int hi){
  const float NEG=-INFINITY; int kb=64*jb+4*hi;
  #pragma unroll
  for(int r=0;r<16;++r){int kv=kb+(r&3)+8*(r>>2); if(kv>qrel)p0[r]=NEG; if(kv+32>qrel)p1[r]=NEG;}
}

__device__ __forceinline__ void smask(f32x16&p0,f32x16&p1,unsigned selm,int n){ if(!((selm>>n)&1u)){ const float NEG=-INFINITY;
  #pragma unroll
  for(int r=0;r<16;++r){p0[r]=NEG;p1[r]=NEG;} } }
constexpr int NSLOT=3, SLOTB=8192;
constexpr int LDS_K=0, LDS_V=NSLOT*SLOTB, LDS_WS=2*NSLOT*SLOTB, LDS_OST=LDS_WS+NW*64*4, LDS_BYTES=LDS_OST+NW*4096;
constexpr float C2=0.125f*1.4426950408889634f;
__device__ __forceinline__ void glds16(const void*gsrc,unsigned lds_dst){unsigned keep;
  asm volatile("s_mov_b32 %0, m0\n\ts_mov_b32 m0, %2\n\ts_nop 0\n\tglobal_load_lds_dwordx4 %1, off\n\ts_mov_b32 m0, %0":"=&s"(keep):"v"(gsrc),"s"(lds_dst):"memory");}
__device__ __forceinline__ float max3f(float a,float b,float c){float r;asm("v_max3_f32 %0, %1, %2, %3":"=v"(r):"v"(a),"v"(b),"v"(c));return r;}
__device__ __forceinline__ float max2f(float a,float b){float r;asm("v_max_f32_e32 %0, %1, %2":"=v"(r):"v"(a),"v"(b));return r;}
__device__ __forceinline__ float fadd_s(float a,float b){float r;asm("v_add_f32_e32 %0, %1, %2":"=v"(r):"v"(a),"v"(b));return r;}
__device__ __forceinline__ float fsub_s(float a,float b){float r;asm("v_sub_f32_e32 %0, %1, %2":"=v"(r):"v"(a),"v"(b));return r;}
typedef float f32x2_t __attribute__((ext_vector_type(2))); typedef __bf16 bf16x2_t __attribute__((ext_vector_type(2)));
__device__ __forceinline__ unsigned cvtpk_s(float lo,float hi){f32x2_t v={lo,hi};bf16x2_t b=__builtin_convertvector(v,bf16x2_t);return __builtin_bit_cast(unsigned,b);}
#define WAIT_BAR(N) asm volatile("s_waitcnt vmcnt(" #N ") lgkmcnt(0)\n\ts_barrier":::"memory")

__device__ __forceinline__ void qkt(f32x16&p0,f32x16&p1,const char*Kslot,const bf16x8*qr,int r32,int hi){
  const char*kb=Kslot+hi*1024+r32*16;
  #pragma unroll
  for(int d0=0;d0<4;++d0){
    const bf16x8 b0=*reinterpret_cast<const bf16x8*>(kb+d0*2048);
    const bf16x8 b1=*reinterpret_cast<const bf16x8*>(kb+d0*2048+512);
    if(d0==0){p0=__builtin_amdgcn_mfma_f32_32x32x16_bf16(b0,qr[0],f32x16{},0,0,0);p1=__builtin_amdgcn_mfma_f32_32x32x16_bf16(b1,qr[0],f32x16{},0,0,0);}
    else{p0=__builtin_amdgcn_mfma_f32_32x32x16_bf16(b0,qr[d0],p0,0,0,0);p1=__builtin_amdgcn_mfma_f32_32x32x16_bf16(b1,qr[d0],p1,0,0,0);}}
}
typedef __attribute__((address_space(3))) const char* lds_cptr;
typedef short v4i16_t __attribute__((ext_vector_type(4)));
__device__ __forceinline__ void kload8(bf16x8*kf,lds_cptr kp){
  kf[0]=*(const __attribute__((address_space(3))) bf16x8*)(kp);      kf[1]=*(const __attribute__((address_space(3))) bf16x8*)(kp+512);
  kf[2]=*(const __attribute__((address_space(3))) bf16x8*)(kp+2048); kf[3]=*(const __attribute__((address_space(3))) bf16x8*)(kp+2560);
  kf[4]=*(const __attribute__((address_space(3))) bf16x8*)(kp+4096); kf[5]=*(const __attribute__((address_space(3))) bf16x8*)(kp+4608);
  kf[6]=*(const __attribute__((address_space(3))) bf16x8*)(kp+6144); kf[7]=*(const __attribute__((address_space(3))) bf16x8*)(kp+6656);
}
__device__ __forceinline__ void kload2(bf16x8*kf,lds_cptr kp,int j){ kf[2*j]=*(const __attribute__((address_space(3))) bf16x8*)(kp+j*2048); kf[2*j+1]=*(const __attribute__((address_space(3))) bf16x8*)(kp+j*2048+512); }
__device__ __forceinline__ s16x4 vtr(lds_cptr p){ return __builtin_bit_cast(s16x4,__builtin_amdgcn_ds_read_tr16_b64_v4i16((__attribute__((address_space(3))) v4i16_t*)p)); }
__device__ __forceinline__ float rowmax(const f32x16&p0,const f32x16&p1){
  float a=max3f(p0[0],p0[1],p1[0]),b=max3f(p0[2],p0[3],p1[1]);a=max3f(a,p1[2],p1[3]);
  #pragma unroll
  for(int r=4;r<16;r+=4){a=max3f(a,p0[r],p0[r+1]);b=max3f(b,p0[r+2],p0[r+3]);a=max3f(a,p1[r],p1[r+1]);b=max3f(b,p1[r+2],p1[r+3]);}
  const float m=max2f(a,b);
  auto rr=__builtin_amdgcn_permlane32_swap(__float_as_uint(m),__float_as_uint(m),false,false);
  return max2f(__uint_as_float(rr[0]),__uint_as_float(rr[1]));
}
__device__ __forceinline__ void pv(f32x16*o,int vb,bf16x8 pa0,bf16x8 pa1,bf16x8 pa2,bf16x8 pa3){
  #pragma unroll
  for(int d0=0;d0<2;++d0){s16x4 lo[4],hi[4];
    #pragma unroll
    for(int ks=0;ks<4;++ks){
      asm volatile("ds_read_b64_tr_b16 %0,%1 offset:%c2":"=&v"(lo[ks]):"v"(vb),"i"(d0*4096+ks*1024):"memory");
      asm volatile("ds_read_b64_tr_b16 %0,%1 offset:%c2":"=&v"(hi[ks]):"v"(vb),"i"(d0*4096+ks*1024+512):"memory");}
    asm volatile("s_waitcnt lgkmcnt(0)":::"memory");SBAR();
    #define PK(k) (bf16x8){lo[k][0],lo[k][1],lo[k][2],lo[k][3],hi[k][0],hi[k][1],hi[k][2],hi[k][3]}
    o[d0]=__builtin_amdgcn_mfma_f32_32x32x16_bf16(pa0,PK(0),o[d0],0,0,0);
    o[d0]=__builtin_amdgcn_mfma_f32_32x32x16_bf16(pa1,PK(1),o[d0],0,0,0);
    o[d0]=__builtin_amdgcn_mfma_f32_32x32x16_bf16(pa2,PK(2),o[d0],0,0,0);
    o[d0]=__builtin_amdgcn_mfma_f32_32x32x16_bf16(pa3,PK(3),o[d0],0,0,0);
    #undef PK
  }
}

#ifndef ATTN_STORE16
#define ATTN_STORE16(p,v) (*(u32x4*)(p)=(v))
#endif
template<int THRL> __device__ __forceinline__ void attn_unit(int wave_,int b,int h,int qb,const bf16*Q,const bf16*__restrict__ K,const bf16*__restrict__ V,const bf16*__restrict__ KM,bf16*O,char*shm){
  const int lane=lane_id_(),tid=wave_*64+lane,r32=lane&31,hi=lane>>5; const int wid=wave_;
  const long rowbase=(long)b*SEQ; const int q0=qb*QB;
  const bf16*Qw=Q+(rowbase+q0+wid*QBLK)*PIN+h*D;
  const bf16*Kh=K+rowbase*PIN+h*D,*Vh=V+rowbase*PIN+h*D;
  const unsigned lds0=(unsigned)(uintptr_t)shm;
  float*wsf=(float*)(shm+LDS_WS)+wid*64;
  const bf16*ksrc=Kh+(long)lane*PIN+wid*8;
  const bf16*kmsrc=KM+((long)b*64+lane)*PKM+h*D+wid*8;
  const bf16*vsrc=Vh+(long)(16*(wid&3)+(lane>>2))*PIN+(wid>>2)*32+(lane&3)*8;
  const unsigned kdst=lds0+LDS_K+wid*1024, vdst=lds0+LDS_V+wid*1024;
  #define DMA_K(t,slot) glds16(ksrc+(long)(t)*KVBLK*PIN,(unsigned)__builtin_amdgcn_readfirstlane(kdst+(slot)))
  #define DMA_V(t,slot) glds16(vsrc+(long)(t)*KVBLK*PIN,(unsigned)__builtin_amdgcn_readfirstlane(vdst+(slot)))
  const int vb0=(int)(lds0+LDS_V)+((lane>>4)&1)*32+(lane&3)*8+(4*hi+((lane&15)>>2))*64;
  const char*Kbase=shm+LDS_K; bf16x8 kf[8];
  const lds_cptr shm3=(lds_cptr)shm; const lds_cptr kp0=shm3+LDS_K+hi*1024+r32*16; const lds_cptr vp0=shm3+LDS_V+((lane>>4)&1)*32+(lane&3)*8+(4*hi+((lane&15)>>2))*64;
  const int NT=(q0+QB)/KVBLK;
  glds16(kmsrc,(unsigned)__builtin_amdgcn_readfirstlane(lds0+LDS_V+2*SLOTB+wid*1024));
  DMA_K(0,0);DMA_V(0,0);DMA_K(1,SLOTB);
  bf16x8 qr[4];
  #pragma unroll
  for(int d0=0;d0<4;++d0)qr[d0]=*reinterpret_cast<const bf16x8*>(&Qw[(long)r32*PIN+d0*16+hi*8]);
  float mhat=0.f,l_reg=0.f;f32x16 o[2];o[0]=f32x16{};o[1]=f32x16{};
  const int qrel=wid*QBLK+r32;
  #define CMASK(P0,P1,t) do{int jb_=(t)-(NT-4); const float sb_=(jb_>=0||((selm>>((t)>>2))&1u))?mhat:INFINITY; _Pragma("unroll") for(int r_=0;r_<16;++r_){P0[r_]-=sb_;P1[r_]-=sb_;} if(jb_>=0)cmask(P0,P1,jb_,qrel,hi);}while(0)
  bool resc=false;
  #define START(P0,P1) do{ const float rm=rowmax(P0,P1); resc=false; \
    { const float dl=(rm>-1.0e30f)?rm:0.f; mhat=fadd_s(mhat,dl); \
      _Pragma("unroll") for(int r=0;r<16;++r){P0[r]=fsub_s(P0[r],dl);P1[r]=fsub_s(P1[r],dl);} \
      } \
    _Pragma("unroll") for(int r=0;r<16;++r)P0[r]=__builtin_amdgcn_exp2f(P0[r]); }while(0)
  #define RESC() do{ if(resc){ asm volatile("s_waitcnt lgkmcnt(0)":::"memory"); \
      _Pragma("unroll") for(int d_=0;d_<2;++d_) _Pragma("unroll") for(int r=0;r<16;++r)o[d_][r]*=wsf[crow(r,hi)]; } }while(0)
  f32x16 pA0,pA1,pB0,pB1;
  int sl_prev=0,sl_cur=0,sl_next=SLOTB;
  #define ROT() do{sl_prev=sl_cur;sl_cur=sl_next;sl_next=(sl_next==(NSLOT-1)*SLOTB)?0:sl_next+SLOTB;}while(0)
  DMA_K(2,2*SLOTB);
  unsigned selm=0u;
  WAIT_BAR(4);
  { f32x16 g0,g1;
    qkt(g0,g1,shm+LDS_V+2*SLOTB,qr,r32,hi); asm volatile("s_nop 15\n\ts_nop 7":"+v"(g0),"+v"(g1));
    float gm[8],go[8],g[16];
    #pragma unroll
    for(int r=0;r<8;++r){gm[r]=g0[r];go[r]=__shfl_xor(gm[r],32);}
    #pragma unroll
    for(int j=0;j<4;++j){ g[j]=hi?go[j]:gm[j]; g[4+j]=hi?gm[j]:go[j]; g[8+j]=hi?go[4+j]:gm[4+j]; g[12+j]=hi?gm[4+j]:go[4+j]; }
    #pragma unroll
    for(int s=0;s<3;++s){ float best=-3.0e38f; int bi=-1;
      #pragma unroll
      for(int n=0;n<16;++n){ const bool ok=(n<qb)&&!((selm>>n)&1u)&&(g[n]>best); if(ok){best=g[n];bi=n;} }
      if(bi>=0)selm|=1u<<bi; } }
  WAIT_BAR(3);
  qkt(pA0,pA1,Kbase,qr,r32,hi);asm volatile("s_nop 15\n\ts_nop 7":"+v"(pA0),"+v"(pA1));CMASK(pA0,pA1,0);
  START(pA0,pA1);
  _Pragma("unroll") for(int r=0;r<16;++r)pA1[r]=__builtin_amdgcn_exp2f(pA1[r]);
  WAIT_BAR(0);
  DMA_K(3,0);DMA_V(1,SLOTB);
  ROT();
  kload8(kf,kp0+sl_cur);
  WAIT_BAR(2);
  s16x4 vlo[8],vhi[8]; u32x4 pw0,pw1,pw2,pw3;
  #define PKW(P,B) cvtpk_s(P[B],P[B+1])
  #define PAF(k) __builtin_bit_cast(bf16x8,pw##k)
  #define VFR(i) (bf16x8){vlo[i][0],vlo[i][1],vlo[i][2],vlo[i][3],vhi[i][0],vhi[i][1],vhi[i][2],vhi[i][3]}
  #define PIN(x) asm volatile("":"+v"(x))
  #define MX3(a,b,c) __builtin_fmaxf(__builtin_fmaxf((a),(b)),(c))
  #define GAPA(MF,A0,A1,A2,A3,W0,W1,PW) do{ MF; sacc+=A0; sacc+=A1; sacc+=A2; sacc+=A3; PIN(sacc); W0; W1; PIN(PW); SBAR(); }while(0)
  #define EX(v) __builtin_amdgcn_exp2f(v)
  #define GAPB(MF,X,B) do{ MF; X[B]=EX(X[B]); X[B+1]=EX(X[B+1]); X[B+2]=EX(X[B+2]); X[B+3]=EX(X[B+3]); PIN(X); SBAR(); }while(0)
  #define VRD(i) do{ vlo[i]=vtr(vp_+(((i)>>2)*4096+((i)&3)*1024)); vhi[i]=vtr(vp_+(((i)>>2)*4096+((i)&3)*1024+512)); }while(0)
  #define KRD(G,j) do{ if(G){ kload2(kf,kp0+sl_next,j); SBAR(); } }while(0)
  #define STEP(C0,C1,P0,P1,t,GK,GV,GL) do{ SBAR(); \
    const lds_cptr vp_=vp0+sl_prev; \
    VRD(0); SBAR(); float sacc=(P0[0]+P0[1]); \
    GAPA(C0=__builtin_amdgcn_mfma_f32_32x32x16_bf16(kf[0],qr[0],f32x16{},0,0,0), P0[2],P0[3],P0[4],P0[5],     pw0[0]=PKW(P0,0), pw0[1]=PKW(P0,2), pw0); \
    VRD(4); SBAR(); GAPA(C1=__builtin_amdgcn_mfma_f32_32x32x16_bf16(kf[1],qr[0],f32x16{},0,0,0), P0[6],P0[7],P0[8],P0[9],     pw0[2]=PKW(P0,4), pw0[3]=PKW(P0,6), pw0); \
    VRD(1); SBAR(); GAPA(C0=__builtin_amdgcn_mfma_f32_32x32x16_bf16(kf[2],qr[1],C0,0,0,0),   P0[10],P0[11],P0[12],P0[13], pw1[0]=PKW(P0,8), pw1[1]=PKW(P0,10), pw1); \
    VRD(5); SBAR(); GAPA(C1=__builtin_amdgcn_mfma_f32_32x32x16_bf16(kf[3],qr[1],C1,0,0,0),   P0[14],P0[15],P1[0],P1[1],   pw1[2]=PKW(P0,12),pw1[3]=PKW(P0,14), pw1); \
    VRD(2); SBAR(); GAPA(C0=__builtin_amdgcn_mfma_f32_32x32x16_bf16(kf[4],qr[2],C0,0,0,0),   P1[2],P1[3],P1[4],P1[5],     pw2[0]=PKW(P1,0), pw2[1]=PKW(P1,2), pw2); \
    VRD(6); SBAR(); GAPA(C1=__builtin_amdgcn_mfma_f32_32x32x16_bf16(kf[5],qr[2],C1,0,0,0),   P1[6],P1[7],P1[8],P1[9],     pw2[2]=PKW(P1,4), pw2[3]=PKW(P1,6), pw2); \
    VRD(3); SBAR(); GAPA(C0=__builtin_amdgcn_mfma_f32_32x32x16_bf16(kf[6],qr[3],C0,0,0,0),   P1[10],P1[11],P1[12],P1[13], pw3[0]=PKW(P1,8), pw3[1]=PKW(P1,10), pw3); \
    VRD(7); SBAR(); GAPA(C1=__builtin_amdgcn_mfma_f32_32x32x16_bf16(kf[7],qr[3],C1,0,0,0),   P1[14],P1[15],0.f,0.f,       pw3[2]=PKW(P1,12),pw3[3]=PKW(P1,14), pw3); \
    l_reg+=sacc; \
    if(GK){DMA_K((t)+3,sl_cur);} if(GV){DMA_V((t)+1,sl_next);} \
    CMASK(C0,C1,t); \
    { float a=MX3(C0[0],C0[1],C1[0]),b=MX3(C0[2],C0[3],C1[1]); a=MX3(a,C1[2],C1[3]); \
      _Pragma("unroll") for(int r=4;r<16;r+=4){a=MX3(a,C0[r],C0[r+1]);b=MX3(b,C0[r+2],C0[r+3]);a=MX3(a,C1[r],C1[r+1]);b=MX3(b,C1[r+2],C1[r+3]);} \
      float rm=__builtin_fmaxf(a,b); { auto rr=__builtin_amdgcn_permlane32_swap(__float_as_uint(rm),__float_as_uint(rm),false,false); rm=__builtin_fmaxf(__uint_as_float(rr[0]),__uint_as_float(rr[1])); } \
      resc=false; \
      if(__builtin_expect(__any(rm>(float)THRL),0)){ const float dl=__builtin_fmaxf(rm,0.f); mhat+=dl; \
        _Pragma("unroll") for(int r=0;r<16;++r){C0[r]-=dl;C1[r]-=dl;} \
        const float f=__builtin_amdgcn_exp2f(-dl); l_reg*=f; if(hi==0)wsf[r32]=f; resc=true; } } \
    SBAR(); \
    GAPB(o[0]=__builtin_amdgcn_mfma_f32_32x32x16_bf16(PAF(0),VFR(0),o[0],0,0,0), C0,0); \
    GAPB(o[1]=__builtin_amdgcn_mfma_f32_32x32x16_bf16(PAF(0),VFR(4),o[1],0,0,0), C0,4); \
    KRD(GL,0); GAPB(o[0]=__builtin_amdgcn_mfma_f32_32x32x16_bf16(PAF(1),VFR(1),o[0],0,0,0), C0,8); \
    KRD(GL,1); GAPB(o[1]=__builtin_amdgcn_mfma_f32_32x32x16_bf16(PAF(1),VFR(5),o[1],0,0,0), C0,12); \
    KRD(GL,2); GAPB(o[0]=__builtin_amdgcn_mfma_f32_32x32x16_bf16(PAF(2),VFR(2),o[0],0,0,0), C1,0); \
    KRD(GL,3); GAPB(o[1]=__builtin_amdgcn_mfma_f32_32x32x16_bf16(PAF(2),VFR(6),o[1],0,0,0), C1,4); \
    GAPB(o[0]=__builtin_amdgcn_mfma_f32_32x32x16_bf16(PAF(3),VFR(3),o[0],0,0,0), C1,8); \
    GAPB(o[1]=__builtin_amdgcn_mfma_f32_32x32x16_bf16(PAF(3),VFR(7),o[1],0,0,0), C1,12); \
    }while(0)
  int t=1;
  #undef CMASK
  #define CMASK(P0,P1,t) do{ const float sb_=((selm>>((t)>>2))&1u)?mhat:INFINITY; _Pragma("unroll") for(int r_=0;r_<16;++r_){P0[r_]-=sb_;P1[r_]-=sb_;} }while(0)
  for(;t+5<NT;t+=2){
    STEP(pB0,pB1,pA0,pA1,t,true,true,true);     WAIT_BAR(2); RESC(); ROT();
    STEP(pA0,pA1,pB0,pB1,t+1,true,true,true);   WAIT_BAR(2); RESC(); ROT();
  }
  #undef CMASK
  #define CMASK(P0,P1,t) do{int jb_=(t)-(NT-4); const float sb_=(jb_>=0||((selm>>((t)>>2))&1u))?mhat:INFINITY; _Pragma("unroll") for(int r_=0;r_<16;++r_){P0[r_]-=sb_;P1[r_]-=sb_;} if(jb_>=0)cmask(P0,P1,jb_,qrel,hi);}while(0)
  #define ENDW(tt) do{ if((tt)+3<NT){WAIT_BAR(2);} else if((tt)+2<NT){WAIT_BAR(1);} else {WAIT_BAR(0);} }while(0)
  for(;t+1<NT;t+=2){
    STEP(pB0,pB1,pA0,pA1,t,(t+3<NT),(t+1<NT),(t+1<NT));       ENDW(t);   RESC(); ROT();
    STEP(pA0,pA1,pB0,pB1,t+1,(t+4<NT),(t+2<NT),(t+2<NT));     ENDW(t+1); RESC(); ROT();
  }
  STEP(pB0,pB1,pA0,pA1,NT-1,false,false,false); RESC();
  { float sacc=pB0[0]+pB0[1]; _Pragma("unroll") for(int r=2;r<16;++r)sacc+=pB0[r]; _Pragma("unroll") for(int r=0;r<16;++r)sacc+=pB1[r]; l_reg+=sacc;
    pw0=(u32x4){PKW(pB0,0),PKW(pB0,2),PKW(pB0,4),PKW(pB0,6)};pw1=(u32x4){PKW(pB0,8),PKW(pB0,10),PKW(pB0,12),PKW(pB0,14)};pw2=(u32x4){PKW(pB1,0),PKW(pB1,2),PKW(pB1,4),PKW(pB1,6)};pw3=(u32x4){PKW(pB1,8),PKW(pB1,10),PKW(pB1,12),PKW(pB1,14)};
    SBAR(); pv(o,vb0+sl_cur,PAF(0),PAF(1),PAF(2),PAF(3)); }
  #undef PKW
  #undef PAF
  #undef VFR
  #undef PIN
  #undef MX3
  #undef GAPA
  #undef GAPB
  #undef EX
  #undef VRD
  #undef KRD
  #undef STEP
  #undef ENDW
  {auto rr=__builtin_amdgcn_permlane32_swap(__float_as_uint(l_reg),__float_as_uint(l_reg),false,false);l_reg=__uint_as_float(rr[0])+__uint_as_float(rr[1]);}
  if(hi==0)wsf[32+r32]=l_reg;asm volatile("s_waitcnt lgkmcnt(0)":::"memory");
  float rli[16];
  #pragma unroll
  for(int r=0;r<16;++r)rli[r]=__builtin_amdgcn_rcpf(wsf[32+crow(r,hi)]);
  bf16*Ow=O+(rowbase+q0+wid*QBLK)*POUT+h*D;
  { bf16*stg=(bf16*)(shm+LDS_OST)+wid*2048;
    #pragma unroll
    for(int r=0;r<16;++r){const int orow=crow(r,hi);
      #pragma unroll
      for(int d0=0;d0<2;++d0)stg[orow*64+d0*32+r32]=__float2bfloat16(o[d0][r]*rli[r]);}
    asm volatile("s_waitcnt lgkmcnt(0)":::"memory");
    #pragma unroll
    for(int i=0;i<4;++i){const int row=i*8+(lane>>3),ch=lane&7; const u32x4 v=*(const u32x4*)(stg+row*64+ch*8); ATTN_STORE16(Ow+(long)row*POUT+ch*8,v);} }
  asm volatile("s_waitcnt lgkmcnt(0)\n\ts_barrier":::"memory");
  #undef DMA_K
  #undef DMA_V
  #undef CMASK
  #undef START
  #undef RESC
  #undef ROT
}
constexpr int ATTN_LDS_BYTES=LDS_BYTES;
struct AttnTensors { const bf16* Q; const bf16* K; const bf16* V; const bf16* KM; bf16* O; };
struct AttnUnit { int bh; int qb; };
struct StaticOrder {
  int vcu,G,blk;
  __device__ __forceinline__ explicit StaticOrder(int grid,int block):vcu((grid%8==0)?(block%8)*(grid/8)+block/8:block),G(grid),blk(block){}
  __device__ __forceinline__ bool next(int i,AttnUnit&u)const{
    if(G==256){ if(i>=4)return false; const int s=vcu&3; u.bh=vcu>>2; u.qb=(i==0)?s:(i==1)?7-s:(i==2)?8+s:15-s; return true; }
    const int idx=i*G+blk; if(idx>=BATCH*NHEAD*NQB)return false; u.bh=idx/NQB; u.qb=idx%NQB; return true; }
  __device__ __forceinline__ void a_ready(const AttnUnit&)const{}
  __device__ __forceinline__ void done(const AttnUnit&)const{}
};
template<class Sched,int THRL=8> __device__ __forceinline__ void attn_phase(char*lds,const AttnTensors&T,const Sched&S,int wave_){
  AttnUnit u;
  for(int i=0;S.next(i,u);++i){ S.a_ready(u); attn_unit<THRL>(wave_,u.bh/NHEAD,u.bh%NHEAD,u.qb,T.Q,T.K,T.V,T.KM,T.O,lds); S.done(u); }
}
#undef SBAR
#undef WAIT_BAR
}

template <bool DRY = false> __device__ __forceinline__ void p6_route(const Frame& F0, const Args& a) {
    const Frame F = fresh(F0);
    const bf16_t* x1 = (const bf16_t*)(a.ws + WS_X1); bf16_t* xn = (bf16_t*)(a.ws + WS_XN); const float* rw = a.in[I_RW]; const float* rb = a.in[I_RB]; const float* n2 = a.in[I_N2];
    unsigned* cnt = (unsigned*)(a.ws + WS_CTL) + CW_CNT; int* rows = (int*)(a.ws + WS_ROWS); float* roww = (float*)(a.ws + WS_ROWW);
    constexpr int HP2 = 1040;
    LAS float* H2 = (LAS float*)F.lds;
    LAS float* PL = (LAS float*)(F.lds + 16 * HP2 * 4);
    LAS int* lcnt = (LAS int*)(F.lds + MISC_OFF); LAS int* lbase = lcnt + 32; LAS int* ae = lbase + 32; LAS int* ap = ae + 512; LAS float* aw = (LAS float*)(ap + 512); LAS float* hsrow = aw + 512;
    float* rowhs = (float*)(a.ws + WS_ROWHS);
    const int lane = F.lane, e = lane & 31, w = F.wave, l15 = lane & 15, kq = lane >> 4;
    float rwq[8][4][2];
#pragma unroll
    for (int g = 0; g < 8; ++g)
#pragma unroll
        for (int s = 0; s < 4; ++s)
#pragma unroll
            for (int h = 0; h < 2; ++h) rwq[g][s][h] = rw[(size_t)(128 * w + 16 * g + 4 * kq + s) * NE + 16 * h + l15];
    const float bias = rb[e];
    for (int blk = F.bid; blk < NTOK / 128; blk += F.G) {
        if (F.tid < 32) lcnt[F.tid] = 0;
        u32x2 xq[2][4];
#pragma unroll
        for (int rr = 0; rr < 2; ++rr) { const u32x2* xr = (const u32x2*)(x1 + ((size_t)blk * 128 + 2 * w + rr) * DM) + lane;
#pragma unroll
            for (int j = 0; j < 4; ++j) xq[rr][j] = __builtin_nontemporal_load(xr + 64 * j); }
#pragma unroll 1
        for (int sub = 0; sub < 8; ++sub) {
#pragma unroll
            for (int rr = 0; rr < 2; ++rr) {
                const int rl = 2 * w + rr; const size_t row = (size_t)blk * 128 + sub * 16 + rl;
                const f32x4* wr = (const f32x4*)n2 + lane;
                f32x4 v[4]; float s = 0.f;
#pragma unroll
                for (int j = 0; j < 4; ++j) { const u32x2 xw = xq[rr][j]; v[j] = (f32x4){bf_lo(xw.x), bf_hi(xw.x), bf_lo(xw.y), bf_hi(xw.y)}; s += (v[j].x * v[j].x + v[j].y * v[j].y) + (v[j].z * v[j].z + v[j].w * v[j].w); }
                const float rstd = __builtin_amdgcn_rsqf(wave_sum(s) * (1.0f / DM) + RMS_EPS);
                u32x2* o8 = (u32x2*)(xn + row * DM) + lane; unsigned* o4 = (unsigned*)((unsigned char*)xn + row * DM) + lane;
#pragma unroll
                for (int j = 0; j < 4; ++j) { const f32x4 ww = wr[64 * j]; const f32x4 hv = v[j] * rstd * ww;
                    if constexpr (MOE1_I8) v[j] = hv;
                    else if constexpr (MOE_FP8) o4[64 * j] = pk4_fp8(hv.x, hv.y, hv.z, hv.w, S_H2);
                    else { u32x2 o; o.x = pk2(hv.x, hv.y); o.y = pk2(hv.z, hv.w); o8[64 * j] = o; }
                    *(LAS f32x4*)(H2 + rl * HP2 + 256 * j + 4 * lane) = hv; }
                if constexpr (MOE1_I8) {
                    float am = 0.f;
#pragma unroll
                    for (int j = 0; j < 4; ++j) am = fmaxf(fmaxf(am, fmaxf(fabsf(v[j].x), fabsf(v[j].y))), fmaxf(fabsf(v[j].z), fabsf(v[j].w)));
                    am = wave_max(am); const float inv = am > 0.f ? 127.0f / am : 0.f;
#pragma unroll
                    for (int j = 0; j < 4; ++j) o4[64 * j] = pk4_i8(v[j].x * inv, v[j].y * inv, v[j].z * inv, v[j].w * inv);
                    if (lane == 0) hsrow[sub * 16 + rl] = am * (1.0f / 127.0f); }
            }
            if (sub < 7) {
#pragma unroll
                for (int rr = 0; rr < 2; ++rr) { const u32x2* xr = (const u32x2*)(x1 + ((size_t)blk * 128 + (sub + 1) * 16 + 2 * w + rr) * DM) + lane;
#pragma unroll
                    for (int j = 0; j < 4; ++j) xq[rr][j] = __builtin_nontemporal_load(xr + 64 * j); }
            }
            __syncthreads();
            {
                f32x4 acc0 = {0.f, 0.f, 0.f, 0.f}, acc1 = {0.f, 0.f, 0.f, 0.f};
#pragma unroll
                for (int g = 0; g < 8; ++g) {
                    const f32x4 hq = *(const LAS f32x4*)(H2 + l15 * HP2 + 128 * w + 16 * g + 4 * kq);
#pragma unroll
                    for (int s = 0; s < 4; ++s) { acc0 = __builtin_amdgcn_mfma_f32_16x16x4f32(hq[s], rwq[g][s][0], acc0, 0, 0, 0); acc1 = __builtin_amdgcn_mfma_f32_16x16x4f32(hq[s], rwq[g][s][1], acc1, 0, 0, 0); }
                }
#pragma unroll
                for (int r = 0; r < 4; ++r) { PL[(w * 16 + 4 * kq + r) * 32 + l15] = acc0[r]; PL[(w * 16 + 4 * kq + r) * 32 + 16 + l15] = acc1[r]; }
            }
            __syncthreads();
            {
                const int rl = 2 * w + (lane >> 5); float val = bias;
#pragma unroll
                for (int ww = 0; ww < 8; ++ww) val += PL[(ww * 16 + rl) * 32 + e];
                float tv[4]; int te[4];
#pragma unroll
                for (int k = 0; k < 4; ++k) {
                    float bv = val; int bi = e;
#pragma unroll
                    for (int o = 1; o < 32; o <<= 1) { const float ov = __shfl_xor(bv, o); const int oi = __shfl_xor(bi, o); if (ov > bv || (ov == bv && oi < bi)) { bv = ov; bi = oi; } }
                    tv[k] = bv; te[k] = bi; if (e == bi) val = -3.0e38f;
                }
                if (e == 0) {
                    const float p1 = __expf(tv[1] - tv[0]), p2 = __expf(tv[2] - tv[0]), p3 = __expf(tv[3] - tv[0]); const float inv = 1.0f / (1.0f + p1 + p2 + p3);
                    const float w4[4] = {inv, p1 * inv, p2 * inv, p3 * inv};
                    const int rb_ = sub * 16 + rl;
#pragma unroll
                    for (int k = 0; k < 4; ++k) { const int pos = atomicAdd((int*)&lcnt[te[k]], 1); ae[rb_ * 4 + k] = te[k]; ap[rb_ * 4 + k] = pos; aw[rb_ * 4 + k] = w4[k]; }
                }
            }
        }
        __syncthreads();
        if (!DRY) { if (F.tid < 32) lbase[F.tid] = (int)__hip_atomic_fetch_add(cnt + F.tid, (unsigned)lcnt[F.tid], __ATOMIC_RELAXED, __HIP_MEMORY_SCOPE_AGENT); }
        __syncthreads();
        if (!DRY) { const int ee = ae[F.tid]; const size_t p = (size_t)ee * CAP + lbase[ee] + ap[F.tid]; rows[p] = blk * 512 + F.tid; roww[p] = aw[F.tid]; if constexpr (MOE1_I8) rowhs[p] = hsrow[F.tid >> 2]; }
        __syncthreads();
    }
}
__device__ __forceinline__ int moe_tiles(const Frame& F, const Args& a, LAS int* ts) {
    if (F.tid == 0) { const unsigned* cnt = (const unsigned*)(a.ws + WS_CTL) + CW_CNT; int acc = 0;
        for (int e = 0; e < NE; ++e) { const int c = (int)__hip_atomic_load(cnt + e, __ATOMIC_RELAXED, __HIP_MEMORY_SCOPE_AGENT); ts[e] = acc; ts[33 + e] = c; acc += (c + 255) >> 8; }
        ts[32] = acc; }
    __syncthreads();
    return ts[32];
}
__device__ __forceinline__ void p9_final(const Frame& F0, const Args& a) {
    const Frame F = fresh(F0);
    float* out = a.out; const bf16_t* yg = (const bf16_t*)(a.ws + WS_YG); const float* fw = a.in[I_FNW]; const bf16_t* x1 = (const bf16_t*)(a.ws + WS_X1);
    const int gw = F.bid * 8 + F.wave, NGW = F.G * 8;
    for (int row = gw; row < NTOK; row += NGW) {
        f32x4* xr = (f32x4*)(out + (size_t)row * DM) + F.lane;
        f32x4 v[4]; const u32x2* x1r = (const u32x2*)(x1 + (size_t)row * DM) + F.lane;
#pragma unroll
        for (int j = 0; j < 4; ++j) { const u32x2 xw = __builtin_nontemporal_load(x1r + 64 * j); v[j] = (f32x4){bf_lo(xw.x), bf_hi(xw.x), bf_lo(xw.y), bf_hi(xw.y)}; }
#pragma unroll
        for (int k = 0; k < 4; ++k) {
            if constexpr (MOE_FP8) { const unsigned* yp = (const unsigned*)((const unsigned char*)yg + ((size_t)row * 4 + k) * DM) + F.lane;
#pragma unroll
                for (int j = 0; j < 4; ++j) { const unsigned w = __builtin_nontemporal_load(yp + 64 * j); const f32x2 lo = __builtin_amdgcn_cvt_pk_f32_fp8(w, false), hi = __builtin_amdgcn_cvt_pk_f32_fp8(w, true);
                    v[j].x += lo.x * (1.0f / S_YG); v[j].y += lo.y * (1.0f / S_YG); v[j].z += hi.x * (1.0f / S_YG); v[j].w += hi.y * (1.0f / S_YG); } }
            else { const u32x2* yp = (const u32x2*)(yg + ((size_t)row * 4 + k) * DM) + F.lane;
#pragma unroll
                for (int j = 0; j < 4; ++j) { const u32x2 w = yp[64 * j]; v[j].x += bf_lo(w.x); v[j].y += bf_hi(w.x); v[j].z += bf_lo(w.y); v[j].w += bf_hi(w.y); } } }
        float s = 0.f;
#pragma unroll
        for (int j = 0; j < 4; ++j) s += (v[j].x * v[j].x + v[j].y * v[j].y) + (v[j].z * v[j].z + v[j].w * v[j].w);
        const float rstd = 1.0f / sqrtf(wave_sum(s) * (1.0f / DM) + RMS_EPS);
        const f32x4* wr = (const f32x4*)fw + F.lane;
#pragma unroll
        for (int j = 0; j < 4; ++j) xr[64 * j] = v[j] * rstd * wr[64 * j];
    }
}

#define XB_TMO      128
#define XB_XCNT(j)  (256  + 64 * (j))
#define XB_XSUB(j)  (1280 + 64 * (j))
#define XB_XGEN(j)  (2304 + 64 * (j))
#define XB_TOP      3328
#define XB_TOPGEN   3392
#define XCD_BAR_WORDS 3456
#define XB_SPIN_CAP (1u << 18)

__device__ __forceinline__ unsigned xb_ld(unsigned* p)              { return __hip_atomic_load(p, __ATOMIC_RELAXED, __HIP_MEMORY_SCOPE_AGENT); }
__device__ __forceinline__ unsigned xb_add(unsigned* p, unsigned v) { return __hip_atomic_fetch_add(p, v, __ATOMIC_RELAXED, __HIP_MEMORY_SCOPE_AGENT); }
__device__ __forceinline__ unsigned xb_xcc_id() { return (unsigned)__builtin_amdgcn_s_getreg((3 << 11) | 20) & 0xFu; }
#define XB_SPIN(cond, bar) do { unsigned _sp = 0; while (cond) { __builtin_amdgcn_s_sleep(1); \
    if ((++_sp & 255u) == 0u) { if (xb_ld(&(bar)[XB_TMO])) break; if (_sp > XB_SPIN_CAP) { atomicAdd(&(bar)[XB_TMO], 1u); break; } } } } while (0)

struct XcdBarrier {
    unsigned* bar; unsigned x; int w;
    volatile LAS unsigned* st;
};

__device__ __forceinline__ XcdBarrier xcd_barrier_post(unsigned* bar, volatile LAS unsigned* st) {
    XcdBarrier b; b.bar = bar; b.x = xb_xcc_id(); b.st = st;
    if (threadIdx.x == 0) (void)xb_add(&bar[XB_XCNT(b.x)], 1u);
    return b;
}
__device__ __forceinline__ void xcd_barrier_complete(unsigned* bar, unsigned x, unsigned& nloc, unsigned& nx) {
    const unsigned G = gridDim.x * gridDim.y * gridDim.z;
    unsigned sum, cnt, mine, sp = 0u;
    for (;;) {
        sum = 0u; cnt = 0u; mine = 0u;
#pragma unroll
        for (unsigned j = 0; j < 16; ++j) { const unsigned c = xb_ld(&bar[XB_XCNT(j)]); sum += c; cnt += (c > 0u) ? 1u : 0u; mine = (j == x) ? c : mine; }
        if (sum == G) break;
        __builtin_amdgcn_s_sleep(1);
        if ((++sp & 255u) == 0u) { if (xb_ld(&bar[XB_TMO])) break; if (sp > XB_SPIN_CAP) { atomicAdd(&bar[XB_TMO], 1u); break; } }
    }
    nloc = mine > 0u ? mine : 1u; nx = cnt > 0u ? cnt : 1u;
}

__device__ __forceinline__ void xcd_barrier(const XcdBarrier& b) {
    asm volatile("s_waitcnt vmcnt(0)" ::: "memory");
    __syncthreads();
    if (b.w == 0 && lane_id_() == 0) {
        unsigned* bar = b.bar;
        __builtin_amdgcn_s_waitcnt(0);
        unsigned nloc = b.st[0], nx = b.st[1];
        if (nloc == 0u) { xcd_barrier_complete(bar, b.x, nloc, nx); b.st[0] = nloc; b.st[1] = nx; }
        const unsigned old = xb_add(&bar[XB_XSUB(b.x)], 1u);
        const unsigned gen = old / nloc;
        if (old + 1u == (gen + 1u) * nloc) {
            __builtin_amdgcn_fence(__ATOMIC_RELEASE, "agent");
            asm volatile("s_waitcnt vmcnt(0)" ::: "memory");
            const unsigned og = xb_add(&bar[XB_TOP], 1u);
            const unsigned tg = og / nx;
            if (og + 1u == (tg + 1u) * nx) xb_add(&bar[XB_TOPGEN], 1u);
            else XB_SPIN(xb_ld(&bar[XB_TOPGEN]) == tg, bar);
            __builtin_amdgcn_fence(__ATOMIC_ACQUIRE, "agent");
            xb_add(&bar[XB_XGEN(b.x)], 1u);
            asm volatile("s_waitcnt vmcnt(0)" ::: "memory");
        } else {
            XB_SPIN(xb_ld(&bar[XB_XGEN(b.x)]) == gen, bar);
            __builtin_amdgcn_fence(__ATOMIC_ACQUIRE, "agent");
            asm volatile("s_waitcnt vmcnt(0)" ::: "memory");
        }
    }
    __syncthreads();
}


__global__ void __launch_bounds__(512, 2) fwd_kernel(Args args) {
    extern __shared__ __attribute__((aligned(16))) unsigned char lds_raw[];
    Frame F; F.lds = (LAS unsigned char*)lds_raw; F.tid = threadIdx.x; F.lane = F.tid & 63; F.wave = __builtin_amdgcn_readfirstlane(F.tid >> 6); F.G = gridDim.x; F.bid = blockIdx.x;
#if USE_COOP
    cg::grid_group grid = cg::this_grid();
#endif
    volatile LAS unsigned* MISCW = (volatile LAS unsigned*)(F.lds + LDS_BYTES - 256);
    if (F.tid < 64) MISCW[F.tid] = 0u;
    __syncthreads();
    XcdBarrier xbar = xcd_barrier_post((unsigned*)(args.ws + WS_CTL) + CW_BAR, MISCW + 8); xbar.w = F.wave;
    unsigned char* ws = args.ws;
    const int lo = args.ph_lo, hi = args.ph_hi;
#ifndef REPMASK
#define REPMASK 0
#endif
#define NREP(k) (((REPMASK) >> (k)) & 1 ? 2 : 1)
#define IN(k) (lo <= (k) && (k) < hi)
#if USE_COOP
#define SEAM(k) do { if (IN(k) && IN((k) + 1)) xcd_barrier(xbar); } while (0)
#else
#define SEAM(k) do { if (IN(k) && IN((k) + 1)) xcd_barrier(xbar); } while (0)
#endif
    bf16_t* proj = (bf16_t*)(ws + WS_PROJ);

#if USE_COOP
    if (lo < 0) grid.sync();
#endif
    if (IN(0)) for (int rep_ = 0; rep_ < NREP(0); ++rep_) { p0_prologue(F, args); } SEAM(0);
    if (IN(1)) for (int rep_ = 0; rep_ < NREP(1); ++rep_) {
        pg8::Gemm g{(const bf16_t*)(ws + WS_XN), (const bf16_t*)(ws + WS_WIN), DIN, DM, nullptr};
        pg8::DenseSched S; S.o.init(NTOK / 256, DIN / 256, F.G, F.bid);
        EpiProj E{proj, (float*)(ws + WS_LOGF), (const float*)(ws + WS_ROPE), (const float*)(ws + WS_LB)};
        pg8::gemm_phase<EpiProj, pg8::DenseSched, false>(F.lds, g, S, E, F.wave);
    } SEAM(1);
    if (IN(2)) for (int rep_ = 0; rep_ < NREP(2); ++rep_) { p2_kmean(F, args); h1_local_states_p(F, args); } SEAM(2);
    if (IN(3)) {
        h2_scan(F, args);
        const attn_body::AttnTensors AT{(const attn_body::bf16*)(proj + C_QA), (const attn_body::bf16*)(proj + C_KA), (const attn_body::bf16*)(proj + C_VA), (const attn_body::bf16*)(ws + WS_KMEAN), (attn_body::bf16*)(ws + WS_YA)};
        const attn_body::StaticOrder AS((int)F.G, (int)F.bid);
        for (int rep_ = 0; rep_ < NREP(3); ++rep_) attn_body::attn_phase<attn_body::StaticOrder>((char*)lds_raw, AT, AS, F.wave);
    } SEAM(3);
    if (IN(4)) for (int rep_ = 0; rep_ < NREP(4); ++rep_) { h3_outputs_p(F, args); } SEAM(4);
    if (IN(5)) for (int rep_ = 0; rep_ < NREP(5); ++rep_) {
        pg8::DenseSched S; S.o.init(NTOK / 256, DM / 256, F.G, F.bid);
        pg8::Gemm g{(const bf16_t*)(ws + WS_YA), (const bf16_t*)(ws + WS_MUP), DM, DM, nullptr};
        EpiMixF E{(bf16_t*)(ws + WS_MIXED), proj};
        pg8::gemm_phase<EpiMixF, pg8::DenseSched, false, false, false, true>(F.lds, g, S, E, F.wave);
    } SEAM(5);
    if (IN(6)) for (int rep_ = 0; rep_ < NREP(6); ++rep_) {
        pg8::Gemm g{(const bf16_t*)(ws + WS_MIXED), (const bf16_t*)(ws + WS_WOUT), DM, DM, nullptr};
        pg8::DenseSched S; S.o.init(NTOK / 256, DM / 256, F.G, F.bid);
        EpiOut E{args.in[I_X], (bf16_t*)(ws + WS_X1)};
        pg8::gemm_phase<EpiOut, pg8::DenseSched, false>(F.lds, g, S, E, F.wave);
    } SEAM(6);
    if (IN(7)) { if (NREP(7) > 1) p6_route<true>(F, args); p6_route<false>(F, args); } SEAM(7);
    if (IN(8)) for (int rep_ = 0; rep_ < NREP(8); ++rep_) {
        LAS int* ts = (LAS int*)(F.lds + MISC_OFF + 8192);
        const int ntile = moe_tiles(F, args, ts);
        pg8::Gemm g{(const bf16_t*)(ws + WS_XN), (const bf16_t*)(ws + WS_WGU), 2 * DE, DM, (const int*)(ws + WS_ROWS)};
        pg8::MoeSched S; S.o.init(ntile, 2 * DE / 256, F.G, F.bid); S.ts = ts;
        EpiMoe1 E{(bf16_t*)(ws + WS_HID), args.in[I_BGU], (const float*)(ws + WS_ROWHS), (const float*)(ws + WS_WGS)};
        pg8::gemm_phase<EpiMoe1, pg8::MoeSched, true, MOE_FP8 && !MOE1_I8, false, false, MOE1_I8>(F.lds, g, S, E, F.wave);
    } SEAM(8);
    if (IN(9)) for (int rep_ = 0; rep_ < NREP(9); ++rep_) {
        LAS int* ts = (LAS int*)(F.lds + MISC_OFF + 8192);
        const int ntile = moe_tiles(F, args, ts);
        pg8::Gemm g{(const bf16_t*)(ws + WS_HID), (const bf16_t*)(ws + WS_WD), DM, DE, nullptr};
        pg8::MoeSched S; S.o.init(ntile, DM / 256, F.G, F.bid); S.ts = ts;
        EpiMoe2 E{(bf16_t*)(ws + WS_YG), args.in[I_BD], (const int*)(ws + WS_ROWS), (const float*)(ws + WS_ROWW)};
        pg8::gemm_phase<EpiMoe2, pg8::MoeSched, false, MOE_FP8>(F.lds, g, S, E, F.wave);
    } SEAM(9);
    if (IN(10)) for (int rep_ = 0; rep_ < NREP(10); ++rep_) { p9_final(F, args); }
#undef IN
#undef SEAM
}

#ifndef N_LAUNCHES
#define N_LAUNCHES 1
#endif
extern "C" void kernel_launch(void* const* d_in, const int* in_sizes, int n_in, void* d_out, int out_size, void* d_ws, size_t ws_size, hipStream_t stream) {
    static int grid = 0;
    if (grid == 0) {
        if (n_in != 16 || in_sizes[0] != NTOK * DM || out_size != NTOK * DM || ws_size < WS_END) { fprintf(stderr, "kernel_launch: unexpected shapes (n_in %d, in0 %d, out %d, ws %zu)\n", n_in, n_in > 0 ? in_sizes[0] : -1, out_size, ws_size); grid = -1; return; }
        int dev = 0, cus = 0, per_cu = 0;
        (void)hipGetDevice(&dev); (void)hipDeviceGetAttribute(&cus, hipDeviceAttributeMultiprocessorCount, dev);
        if (hipFuncSetAttribute((const void*)fwd_kernel, hipFuncAttributeMaxDynamicSharedMemorySize, LDS_BYTES) != hipSuccess) { fprintf(stderr, "kernel_launch: hipFuncSetAttribute failed\n"); grid = -1; return; }
        if (hipOccupancyMaxActiveBlocksPerMultiprocessor(&per_cu, (const void*)fwd_kernel, 512, LDS_BYTES) != hipSuccess || per_cu < 1) { fprintf(stderr, "kernel_launch: occupancy query says %d\n", per_cu); per_cu = 1; }
        (void)hipGetLastError();
        grid = cus;
    }
    if (grid < 0) return;
    (void)hipMemsetAsync((char*)d_ws + WS_CTL, 0, CTL_BYTES, stream);
    Args a{};
    for (int i = 0; i < 16; ++i) a.in[i] = (const float*)d_in[i];
    a.out = (float*)d_out; a.ws = (unsigned char*)d_ws;
    if (N_LAUNCHES == 1) {
        a.ph_lo = 0; a.ph_hi = NPHASE; void* params[] = {&a};
#if USE_COOP
        hipError_t e = hipLaunchCooperativeKernel((const void*)fwd_kernel, dim3(grid), dim3(512), params, LDS_BYTES, stream);
        if (e != hipSuccess) fprintf(stderr, "cooperative launch failed: %s (grid %d)\n", hipGetErrorString(e), grid);
#else
        (void)params; hipLaunchKernelGGL(fwd_kernel, dim3(grid), dim3(512), LDS_BYTES, stream, a);
#endif
    } else {
        for (int p = 0; p < NPHASE; ++p) { a.ph_lo = p; a.ph_hi = p + 1; hipLaunchKernelGGL(fwd_kernel, dim3(grid), dim3(512), LDS_BYTES, stream, a); }
    }
}
```

```cpp
#include <hip/hip_runtime.h>
#include <hip/hip_cooperative_groups.h>
#include <cstdio>
#include <cstdint>
namespace cg = cooperative_groups;
#ifndef USE_COOP
#define USE_COOP 1
#endif

#define LAS __attribute__((address_space(3)))
#define GAS __attribute__((address_space(1)))
typedef unsigned short bf16_t;
typedef short bf16x8 __attribute__((ext_vector_type(8)));
typedef float f32x4 __attribute__((ext_vector_type(4)));
typedef float f32x2 __attribute__((ext_vector_type(2)));
typedef unsigned u32x4 __attribute__((ext_vector_type(4)));
typedef unsigned u32x2 __attribute__((ext_vector_type(2)));

constexpr int NTOK = 32768, DM = 1024, SEQ = 4096, NBATCH = 8;
constexpr int DIN = 5632;
constexpr int AH = 8, AD = 64;
constexpr int HH = 4, HK = 128;
constexpr int NE = 32, DE = 1024, CAP = 32768;
constexpr float RMS_EPS = 1e-6f;
constexpr float QSCALE = 0.125f * 1.4426950408889634f;
constexpr int C_QA = 0, C_KA = 512, C_VA = 1024, C_QB = 1536, C_FB = 2048, C_IB = 2560, C_GB = 3072, C_GA = 3584, C_GBT = 4608;

constexpr size_t MiB = 1u << 20;
constexpr size_t WS_CTL = 0, CTL_BYTES = 32768;
constexpr size_t WS_ROPE = 1 * MiB;
constexpr size_t WS_WIN = 2 * MiB;
constexpr size_t WS_MUP = 13 * MiB;
constexpr size_t WS_WOUT = 15 * MiB;
constexpr size_t WS_LB = 17 * MiB;
constexpr size_t WS_KMEAN = 17 * MiB + 65536;
constexpr size_t WS_SLOTW = 18 * MiB;
constexpr size_t WS_ROWS = 19 * MiB;
constexpr size_t WS_ROWW = 25 * MiB;
constexpr size_t WS_WGS = 18 * MiB;
constexpr size_t WS_XS = 18 * MiB + 512 * 1024;
constexpr size_t WS_WINS = 18 * MiB + 768 * 1024;
constexpr size_t WS_ROWHS = 672 * MiB;
constexpr size_t WS_GDEC = 24 * MiB;
constexpr size_t WS_WGU = 32 * MiB;
constexpr size_t WS_WD = 160 * MiB;
constexpr size_t WS_XN = 224 * MiB;
constexpr size_t WS_PROJ = 288 * MiB;
constexpr size_t WS_LOGF = 640 * MiB;
constexpr size_t WS_YA = 704 * MiB;
constexpr size_t WS_OB = 768 * MiB;
constexpr size_t WS_HST = 768 * MiB;
constexpr size_t WS_MIXED = 832 * MiB;
constexpr size_t WS_HID = 288 * MiB;
constexpr size_t WS_YG = 560 * MiB;
constexpr size_t WS_X1 = 896 * MiB;
constexpr size_t WS_END = 960 * MiB;
constexpr int CW_CNT = 64;
constexpr int CW_BAR = 4096;
static_assert((CW_BAR + 3456) * 4 <= (int)CTL_BYTES, "barrier words inside the zeroed control region");

constexpr int RING_BYTES = 131072;
constexpr int MISC_OFF = RING_BYTES;
constexpr int LDS_BYTES = 147456;

#ifndef MOE1_I8_
#define MOE1_I8_ 1
#endif
#ifndef MOE_FP8_
#define MOE_FP8_ 1
#endif
constexpr bool MOE1_I8 = (MOE1_I8_ != 0) && (MOE_FP8_ != 0);
#ifndef P1_I8_
#define P1_I8_ 1
#endif
constexpr bool P1_I8 = P1_I8_ != 0;
constexpr bool MOE_FP8 = MOE_FP8_ != 0;
constexpr float S_H2 = 16.0f, S_HID = 4.0f, S_W = 512.0f, S_YG = 32.0f;
constexpr float DQ1 = MOE_FP8 ? 1.0f / (S_H2 * S_W) : 1.0f, DQ2 = MOE_FP8 ? 1.0f / (S_HID * S_W) : 1.0f;
typedef int v8i __attribute__((ext_vector_type(8)));
typedef int v4i __attribute__((ext_vector_type(4)));
__device__ __forceinline__ unsigned pk4_i8(float a, float b, float c, float d) {
    const int ia = (int)__builtin_rintf(fminf(fmaxf(a, -127.f), 127.f)), ib = (int)__builtin_rintf(fminf(fmaxf(b, -127.f), 127.f)), ic = (int)__builtin_rintf(fminf(fmaxf(c, -127.f), 127.f)), id = (int)__builtin_rintf(fminf(fmaxf(d, -127.f), 127.f));
    return (unsigned)(ia & 255) | ((unsigned)(ib & 255) << 8) | ((unsigned)(ic & 255) << 16) | ((unsigned)id << 24); }
typedef _Float16 h16x4 __attribute__((ext_vector_type(4)));
typedef _Float16 h16x8 __attribute__((ext_vector_type(8)));
typedef float f32x8 __attribute__((ext_vector_type(8)));
__device__ __forceinline__ unsigned pk4_fp8_nc(float a, float b, float c, float d, float s) { unsigned w = 0u; w = __builtin_amdgcn_cvt_pk_fp8_f32(a * s, b * s, w, false); w = __builtin_amdgcn_cvt_pk_fp8_f32(c * s, d * s, w, true); return w; }
__device__ __forceinline__ unsigned pk4_u8(float a, float b, float c, float d) { unsigned w = 0u;
    w = __builtin_amdgcn_cvt_pk_u8_f32(fmaxf(a * 255.0f, 1.0f), 0, w); w = __builtin_amdgcn_cvt_pk_u8_f32(fmaxf(b * 255.0f, 1.0f), 1, w);
    w = __builtin_amdgcn_cvt_pk_u8_f32(fmaxf(c * 255.0f, 1.0f), 2, w); w = __builtin_amdgcn_cvt_pk_u8_f32(fmaxf(d * 255.0f, 1.0f), 3, w); return w; }
__device__ __forceinline__ f32x4 un4_u8(unsigned w) { return (f32x4){(float)(w & 0xffu), (float)((w >> 8) & 0xffu), (float)((w >> 16) & 0xffu), (float)(w >> 24)}; }
constexpr int GATE_BYTE0 = 2 * 3584;
__device__ __forceinline__ unsigned pk4_fp8(float a, float b, float c, float d, float s) {
    const float L = 440.0f;
    a = fminf(fmaxf(a * s, -L), L); b = fminf(fmaxf(b * s, -L), L); c = fminf(fmaxf(c * s, -L), L); d = fminf(fmaxf(d * s, -L), L);
    unsigned w = 0u; w = __builtin_amdgcn_cvt_pk_fp8_f32(a, b, w, false); w = __builtin_amdgcn_cvt_pk_fp8_f32(c, d, w, true); return w;
}
__device__ __forceinline__ unsigned f2bf(float f) { unsigned u = __builtin_bit_cast(unsigned, f); return (u + 0x7fffu + ((u >> 16) & 1u)) >> 16; }
typedef __bf16 bf16x2_t_ __attribute__((ext_vector_type(2)));
__device__ __forceinline__ unsigned pk2(float lo, float hi) { f32x2 v = {lo, hi}; bf16x2_t_ b = __builtin_convertvector(v, bf16x2_t_); return __builtin_bit_cast(unsigned, b); }
__device__ __forceinline__ float bf_lo(unsigned u) { return __builtin_bit_cast(float, u << 16); }
__device__ __forceinline__ float bf_hi(unsigned u) { return __builtin_bit_cast(float, u & 0xffff0000u); }
__device__ __forceinline__ float bf2f(bf16_t h) { return __builtin_bit_cast(float, (unsigned)h << 16); }
__device__ __forceinline__ float wave_sum(float v) {
#pragma unroll
    for (int o = 1; o < 64; o <<= 1) v += __shfl_xor(v, o);
    return v;
}
__device__ __forceinline__ float wave_max(float v) {
#pragma unroll
    for (int o = 1; o < 64; o <<= 1) v = fmaxf(v, __shfl_xor(v, o));
    return v;
}
__device__ __forceinline__ float sigmoidf_(float x) { return __builtin_amdgcn_rcpf(1.0f + __builtin_amdgcn_exp2f(-1.4426950408889634f * x)); }
__device__ __forceinline__ int lane_id_() { int l; asm volatile("v_mbcnt_lo_u32_b32 %0, -1, 0\n\tv_mbcnt_hi_u32_b32 %0, -1, %0" : "=v"(l)); return l; }
__device__ __forceinline__ float rdlane(float v, int l) { return __builtin_bit_cast(float, __builtin_amdgcn_readlane(__builtin_bit_cast(int, v), l)); }

namespace pg8 {
constexpr int BM = 256, BK = 64, HALF = 128, HTB = HALF * BK * 2, STAGE_BYTES = 8 * HTB, NXCD = 8, WGM = 8;
__host__ __device__ __forceinline__ int lds_byte(int r, int c) { const int st = (r >> 4) * 2 + (c >> 5), rr = r & 15, cc = c & 31, ob = rr * 64 + cc * 2; return st * 1024 + (ob ^ (((ob >> 9) & 1) << 5)); }
__host__ __device__ __forceinline__ void stage_rc(int b, int& R, int& C) { const int st = b / 1024, sb = b % 1024, swz = sb ^ (((sb >> 9) & 1) << 5); R = (st >> 1) * 16 + swz / 64; C = (st & 1) * 32 + (swz % 64) / 2; }
__host__ __device__ __forceinline__ int perm32(int rho) { const int n = rho >> 4, i = rho & 15; return 8 * (i >> 2) + 4 * n + (i & 3); }

struct Unit { int pm, pn, e, lt, nvalid; };
struct Gemm { const bf16_t* A; const bf16_t* Bt; int N, K; const int* rows; const float* rs = nullptr; const float* cs = nullptr; };

struct Order {
    int nM, nN, nwg, G, c;
    __device__ void init(int nM_, int nN_, int G_, int c_) { nM = nM_; nN = nN_; nwg = nM * nN; G = G_; c = c_; }
    __device__ bool map(int i, int& pm, int& pn) const {
        const long L = (long)i * G + c; if (L >= nwg) return false;
        int wgid = (int)L; { const int q = nwg / NXCD, r = nwg % NXCD, xcd = wgid % NXCD, off = wgid / NXCD; wgid = (xcd < r ? xcd * (q + 1) : r * (q + 1) + (xcd - r) * q) + off; }
        const int nig = WGM * nN, gid = wgid / nig, fm = gid * WGM, gsz = (nM - fm) < WGM ? (nM - fm) : WGM;
        pm = fm + ((wgid % nig) % gsz); pn = (wgid % nig) / gsz; return true;
    }
};
struct DenseSched {
    Order o;
    __device__ bool next(int i, Unit& u) const { if (!o.map(i, u.pm, u.pn)) return false; u.e = 0; u.lt = u.pm; u.nvalid = 256; return true; }
};
struct MoeSched {
    Order o; const LAS int* ts;
    __device__ bool next(int i, Unit& u) const {
        if (!o.map(i, u.pm, u.pn)) return false;
        const int lane = lane_id_(); const int tv = ts[(lane & 31) + 1];
        const unsigned long long bal = __ballot(lane < NE - 1 && tv <= u.pm);
        const int e = __builtin_amdgcn_readfirstlane((int)__popcll(bal));
        const int t0 = __builtin_amdgcn_readfirstlane(ts[e]), cn = __builtin_amdgcn_readfirstlane(ts[33 + e]);
        u.e = e; u.lt = u.pm - t0; const int rem = cn - u.lt * 256; u.nvalid = rem < 256 ? rem : 256; return true;
    }
};

template <class Epi, class Sched, bool GATHER, bool FP8 = false, bool NOEPI = false, bool HOOK = false, bool I8 = false>
__device__ __forceinline__ void gemm_phase(LAS unsigned char* lds, const Gemm g, const Sched& S, const Epi& E, const int wid) {
    const int lane = lane_id_(), tid = wid * 64 + lane, wr = wid >> 2, wc = wid & 3, fr = lane & 15, fq = lane >> 4;
    const int K = g.K, RP = (FP8 || I8) ? K : 2 * K, nt = RP / 128;
    unsigned voffB[2];
#pragma unroll
    for (int i = 0; i < 2; ++i) { int R, C; stage_rc(tid * 16 + i * 8192, R, C); const int Rb = (R & ~31) + perm32(R & 31); voffB[i] = (unsigned)(Rb * RP + C * 2); }
    const size_t kstep = 128;
    const size_t hstep = (size_t)HALF * RP;
    const size_t tstep = 2 * hstep;
    const size_t estride = (size_t)g.N * RP;
    const unsigned ldsw = (unsigned)wid * 1024u;
    const int aoff = lds_byte(wr * 64 + fr, fq * 8), boff = lds_byte(wc * 32 + fr, fq * 8);
    constexpr int KOFF = 1024;
#define PG8_SA(b, h) (((b) * 2 + (h)) * HTB)
#define PG8_SB(b, h) ((4 + (b) * 2 + (h)) * HTB)
#define PG8_STAGE(bufoff, gbase, voff) do { _Pragma("unroll") for (int _i = 0; _i < 2; ++_i) { unsigned _o = (voff)[_i]; asm volatile("" : "+v"(_o));     \
        __builtin_amdgcn_global_load_lds((const unsigned*)((const char*)(gbase) + _o), (LAS unsigned*)(lds + (bufoff) + ldsw + _i * 8192), 16, 0, 0); } } while (0)
#define PG8_STAGE2(bufoff, gbase, h) PG8_STAGE(bufoff, gbase, vC[h])
#define PG8_LDA(dst, b, h) do { _Pragma("unroll") for (int m = 0; m < 4; ++m) _Pragma("unroll") for (int k = 0; k < 2; ++k) dst[m][k] = *(const LAS bf16x8*)(lds + PG8_SA(b, h) + aoff + m * 2048 + k * KOFF); } while (0)
#define PG8_LDB(dst, b, h) do { _Pragma("unroll") for (int n = 0; n < 2; ++n) _Pragma("unroll") for (int k = 0; k < 2; ++k) dst[n][k] = *(const LAS bf16x8*)(lds + PG8_SB(b, h) + boff + n * 2048 + k * KOFF); } while (0)
#define PG8_CAT(x) __builtin_bit_cast(v8i, __builtin_shufflevector((x)[0], (x)[1], 0, 1, 2, 3, 4, 5, 6, 7, 8, 9, 10, 11, 12, 13, 14, 15))
#define PG8_MMA(ai, bj, At, Bt) do { __builtin_amdgcn_s_setprio(1); _Pragma("unroll") for (int m = 0; m < 4; ++m) _Pragma("unroll") for (int n = 0; n < 2; ++n) { \
        if constexpr (FP8) acc[ai][bj][m][n] = __builtin_amdgcn_mfma_scale_f32_16x16x128_f8f6f4(PG8_CAT(Bt[n]), PG8_CAT(At[m]), acc[ai][bj][m][n], 0, 0, 0, 0, 0, 0); \
        else if constexpr (I8) { _Pragma("unroll") for (int k = 0; k < 2; ++k) acci[ai][bj][m][n] = __builtin_amdgcn_mfma_i32_16x16x64_i8(__builtin_bit_cast(v4i, Bt[n][k]), __builtin_bit_cast(v4i, At[m][k]), acci[ai][bj][m][n], 0, 0, 0); } \
        else { _Pragma("unroll") for (int k = 0; k < 2; ++k) acc[ai][bj][m][n] = __builtin_amdgcn_mfma_f32_16x16x32_bf16(Bt[n][k], At[m][k], acc[ai][bj][m][n], 0, 0, 0); } } \
        __builtin_amdgcn_s_setprio(0); } while (0)
#define PG8_WAIT_V(n) asm volatile("s_waitcnt vmcnt(" #n ")" ::: "memory")
#define PG8_WAIT_V8R() do { if (NOEPI || Epi::NVMEM == 0 || !relax) asm volatile("s_waitcnt vmcnt(8)" ::: "memory"); else asm volatile("s_waitcnt vmcnt(%0)" :: "n"(8 + (NOEPI ? 0 : Epi::NVMEM)) : "memory"); } while (0)
#define PG8_WAIT_L(n) asm volatile("s_waitcnt lgkmcnt(" #n ")" ::: "memory")
#define PG8_BAR __builtin_amdgcn_s_barrier()
#define PG8_SCHED __builtin_amdgcn_sched_barrier(0)
#define PG8_SETV(u, v) do { _Pragma("unroll") for (int _h = 0; _h < 2; ++_h) _Pragma("unroll") for (int _i = 0; _i < 2; ++_i) { int _R, _C; stage_rc((wid * 64 + lane_id_()) * 16 + _i * 8192, _R, _C); \
        if (GATHER) { int _r = _h * HALF + _R; _r = _r < (u).nvalid ? _r : (u).nvalid - 1; const int _s = g.rows[(size_t)(u).e * CAP + (u).lt * 256 + _r]; \
                      (v)[_h][_i] = (unsigned)(_s >> 2) * (unsigned)RP + (unsigned)(_C * 2); } \
        else (v)[_h][_i] = (unsigned)(_R * RP + _C * 2) + (unsigned)(_h * hstep); } } while (0)
#define PG8_ABASE(u) (GATHER ? (const char*)g.A : (const char*)g.A + (size_t)(u).pm * tstep)
#define PG8_BBASE(u) ((const char*)g.Bt + (size_t)(u).e * estride + (size_t)(u).pn * tstep)
    Unit cur, nxt, nn; int ui = 0;
    if (!S.next(0, cur)) return;
    bool has_next = S.next(1, nxt);
    unsigned vC[2][2];
    PG8_SETV(cur, vC);
#define PG8_PARK ((LAS unsigned*)(lds + MISC_OFF) + (wid * 64 + lane_id_()) * 4)
    if (GATHER) { unsigned vP[2][2];
        if (has_next) PG8_SETV(nxt, vP); else { vP[0][0] = vC[0][0]; vP[0][1] = vC[0][1]; vP[1][0] = vC[1][0]; vP[1][1] = vC[1][1]; }
        LAS unsigned* pk = PG8_PARK; pk[0] = vP[0][0]; pk[1] = vP[0][1]; pk[2] = vP[1][0]; pk[3] = vP[1][1]; }
    f32x4 acc[2][2][4][2]; v4i acci[2][2][4][2];
#pragma unroll
    for (int a = 0; a < 2; ++a)
#pragma unroll
        for (int b = 0; b < 2; ++b)
#pragma unroll
            for (int m = 0; m < 4; ++m)
#pragma unroll
                for (int n = 0; n < 2; ++n) { acc[a][b][m][n] = (f32x4){0.f, 0.f, 0.f, 0.f}; acci[a][b][m][n] = (v4i){0, 0, 0, 0}; }
    bf16x8 At[4][2], B0[2][2], B1[2][2];
    const char* cA = PG8_ABASE(cur); const char* cB = PG8_BBASE(cur);
    PG8_STAGE(PG8_SB(0, 0), cB, voffB); PG8_STAGE(PG8_SB(0, 1), cB + hstep, voffB); PG8_STAGE(PG8_SA(0, 0), cA, vC[0]); PG8_STAGE(PG8_SA(0, 1), cA, vC[1]);
    if (wr == 1) PG8_BAR;
    PG8_WAIT_V(2); PG8_BAR;
    PG8_STAGE(PG8_SB(1, 0), cB + kstep, voffB); PG8_STAGE(PG8_SA(1, 0), cA + kstep, vC[0]); PG8_STAGE(PG8_SB(1, 1), cB + hstep + kstep, voffB);
    PG8_WAIT_V(6); PG8_BAR;
    for (;;) {
        const char* nA = has_next ? PG8_ABASE(nxt) : cA; const char* nB = has_next ? PG8_BBASE(nxt) : cB;
#pragma unroll 1
        for (int t = 0; t < nt; t += 2) {
            const bool last = (t == nt - 2); const bool relax = false;
            if constexpr (HOOK) { if (t == nt / 2) { const int l_ = lane_id_(); E.mid(acc, cur, wr, wc, l_ & 15, l_ >> 4); } }
            const char* a1 = cA + (size_t)(t + 1) * kstep;
            const char* a2 = last ? nA : cA + (size_t)(t + 2) * kstep; const char* b2 = last ? nB : cB + (size_t)(t + 2) * kstep;
            const char* a3 = a2 + kstep; const char* b3 = b2 + kstep;
            PG8_LDB(B0, 0, 0); PG8_LDB(B1, 0, 1); PG8_SCHED; PG8_LDA(At, 0, 0); PG8_STAGE(PG8_SA(1, 1), a1, vC[1]);
            if (GATHER && last) { const LAS unsigned* pk = PG8_PARK; vC[0][0] = pk[0]; vC[0][1] = pk[1]; vC[1][0] = pk[2]; vC[1][1] = pk[3]; }
            PG8_WAIT_V8R(); PG8_WAIT_L(0); PG8_BAR; PG8_MMA(0, 0, At, B0); PG8_MMA(0, 1, At, B1); PG8_BAR; PG8_SCHED;
            PG8_LDA(At, 0, 1); PG8_STAGE(PG8_SB(0, 0), b2, voffB); PG8_STAGE(PG8_SB(0, 1), b2 + hstep, voffB); PG8_STAGE2(PG8_SA(0, 0), a2, 0);
            PG8_WAIT_V8R(); PG8_WAIT_L(0); PG8_BAR; PG8_MMA(1, 0, At, B0); PG8_MMA(1, 1, At, B1); PG8_BAR; PG8_SCHED;
            PG8_LDB(B0, 1, 0); PG8_LDB(B1, 1, 1); PG8_SCHED; PG8_LDA(At, 1, 0); PG8_STAGE2(PG8_SA(0, 1), a2, 1);
            PG8_WAIT_V(8); PG8_WAIT_L(0); PG8_BAR; PG8_MMA(0, 0, At, B0); PG8_MMA(0, 1, At, B1); PG8_BAR; PG8_SCHED;
            PG8_LDA(At, 1, 1); PG8_STAGE(PG8_SB(1, 0), b3, voffB); PG8_STAGE(PG8_SB(1, 1), b3 + hstep, voffB); PG8_STAGE2(PG8_SA(1, 0), a3, 0);
            PG8_WAIT_V(8); PG8_WAIT_L(0); PG8_BAR; PG8_MMA(1, 0, At, B0); PG8_MMA(1, 1, At, B1); PG8_BAR; PG8_SCHED;
        }
        if (wr == 0) PG8_BAR;
        bool has_nn = false; unsigned vT[2][2];
        if (has_next) has_nn = S.next(ui + 2, nn);
        if (GATHER && has_nn) PG8_SETV(nn, vT);
        if constexpr (I8) {
            const int l_ = lane_id_(); float rsv[2][4]; f32x4 csv[2][2];
            const float* rsp = g.rs + (GATHER ? (size_t)cur.e * CAP : (size_t)0) + (size_t)cur.lt * 256; const float* csp = g.cs + (size_t)cur.e * g.N + cur.pn * 256 + wc * 32 + 8 * (l_ >> 4);
#pragma unroll
            for (int a = 0; a < 2; ++a)
#pragma unroll
                for (int m = 0; m < 4; ++m) { int r = a * 128 + wr * 64 + m * 16 + (l_ & 15); r = r < cur.nvalid ? r : cur.nvalid - 1; rsv[a][m] = rsp[r]; }
#pragma unroll
            for (int b = 0; b < 2; ++b)
#pragma unroll
                for (int n = 0; n < 2; ++n) csv[b][n] = *(const f32x4*)(csp + b * 128 + 4 * n);
#pragma unroll
            for (int a = 0; a < 2; ++a)
#pragma unroll
                for (int b = 0; b < 2; ++b)
#pragma unroll
                    for (int m = 0; m < 4; ++m)
#pragma unroll
                        for (int n = 0; n < 2; ++n)
#pragma unroll
                            for (int i = 0; i < 4; ++i) acc[a][b][m][n][i] = ((float)acci[a][b][m][n][i] * rsv[a][m]) * csv[b][n][i];
        }
        { const int l_ = lane_id_();
          if constexpr (!NOEPI) E(acc, cur, wr, wc, l_ & 15, l_ >> 4);
          else { _Pragma("unroll") for (int a_ = 0; a_ < 2; ++a_) _Pragma("unroll") for (int b_ = 0; b_ < 2; ++b_) _Pragma("unroll") for (int m_ = 0; m_ < 4; ++m_) _Pragma("unroll") for (int n_ = 0; n_ < 2; ++n_) asm volatile("" :: "v"(acc[a_][b_][m_][n_])); } }
        if (!has_next) break;
#pragma unroll
        for (int a = 0; a < 2; ++a)
#pragma unroll
            for (int b = 0; b < 2; ++b)
#pragma unroll
                for (int m = 0; m < 4; ++m)
#pragma unroll
                    for (int n = 0; n < 2; ++n) { acc[a][b][m][n] = (f32x4){0.f, 0.f, 0.f, 0.f}; acci[a][b][m][n] = (v4i){0, 0, 0, 0}; }
        cur = nxt; cA = nA; cB = nB; ++ui;
        if (GATHER && has_nn) { LAS unsigned* pk = PG8_PARK; pk[0] = vT[0][0]; pk[1] = vT[0][1]; pk[2] = vT[1][0]; pk[3] = vT[1][1]; }
        nxt = nn; has_next = has_nn;
        if (wr == 1) PG8_BAR;
    }
    PG8_WAIT_V(0);
    PG8_BAR;
#undef PG8_SA
#undef PG8_SB
#undef PG8_STAGE
#undef PG8_STAGE2
#undef PG8_PARK
#undef PG8_LDA
#undef PG8_LDB
#undef PG8_MMA
#undef PG8_CAT
#undef PG8_WAIT_V
#undef PG8_WAIT_V8R
#undef PG8_WAIT_L
#undef PG8_BAR
#undef PG8_SCHED
#undef PG8_SETV
#undef PG8_ABASE
#undef PG8_BBASE
}

template <class F> struct EpiOct {
    F f;
    __device__ __forceinline__ void operator()(const f32x4 (&acc)[2][2][4][2], const Unit& u, int wr, int wc, int fr, int fq) const {
#pragma unroll
        for (int ai = 0; ai < 2; ++ai)
#pragma unroll
            for (int m = 0; m < 4; ++m) {
                const int r = ai * HALF + wr * 64 + m * 16 + fr;
#pragma unroll
                for (int bj = 0; bj < 2; ++bj) f(u, r, bj * HALF + wc * 32 + 8 * fq, acc[ai][bj][m][0], acc[ai][bj][m][1]);
            }
    }
};
}
using pg8::Unit;

__device__ __forceinline__ u32x4 pack8(f32x4 a, f32x4 b) { u32x4 w; w.x = pk2(a[0], a[1]); w.y = pk2(a[2], a[3]); w.z = pk2(b[0], b[1]); w.w = pk2(b[2], b[3]); return w; }
__device__ __forceinline__ void unpack8(u32x4 w, f32x4& a, f32x4& b) { a = (f32x4){bf_lo(w.x), bf_hi(w.x), bf_lo(w.y), bf_hi(w.y)}; b = (f32x4){bf_lo(w.z), bf_hi(w.z), bf_lo(w.w), bf_hi(w.w)}; }

template <bool NOSTORE = false> struct EpiProj_ {
    static constexpr int NVMEM = NOSTORE ? 0 : 16;
    bf16_t* proj; float* logf; const float* rope; const float* lb;
    __device__ __forceinline__ void operator()(const f32x4 (&acc)[2][2][4][2], const Unit& u, int wr, int wc, int fr, int fq) const {
        const int pn = u.pn, colb = pn * 256 + wc * 32 + 8 * fq, rowb = u.pm * 256 + wr * 64 + fr;
        if (pn < 4) {
            const int i0 = (colb & 63) >> 1; const float sc = pn < 2 ? QSCALE : 1.0f;
            f32x4 cs[2][4][2];
#pragma unroll
            for (int ai = 0; ai < 2; ++ai)
#pragma unroll
                for (int m = 0; m < 4; ++m) { const int pos = (rowb + ai * 128 + m * 16) & (SEQ - 1); const float* tp = rope + ((size_t)pos * 32 + i0) * 2; cs[ai][m][0] = *(const f32x4*)tp; cs[ai][m][1] = *(const f32x4*)(tp + 4); }
#pragma unroll
            for (int ai = 0; ai < 2; ++ai)
#pragma unroll
                for (int m = 0; m < 4; ++m) { const f32x4 c0 = cs[ai][m][0] * sc, c1 = cs[ai][m][1] * sc;
#pragma unroll
                    for (int bj = 0; bj < 2; ++bj) { const f32x4 v0 = acc[ai][bj][m][0], v1 = acc[ai][bj][m][1]; f32x4 o0, o1;
                        o0[0] = v0[0] * c0[0] - v0[1] * c0[1]; o0[1] = v0[1] * c0[0] + v0[0] * c0[1]; o0[2] = v0[2] * c0[2] - v0[3] * c0[3]; o0[3] = v0[3] * c0[2] + v0[2] * c0[3];
                        o1[0] = v1[0] * c1[0] - v1[1] * c1[1]; o1[1] = v1[1] * c1[0] + v1[0] * c1[1]; o1[2] = v1[2] * c1[2] - v1[3] * c1[3]; o1[3] = v1[3] * c1[2] + v1[2] * c1[3];
                        { const u32x4 w_ = pack8(o0, o1); if (NOSTORE) asm volatile("" :: "v"(w_)); else __builtin_nontemporal_store(w_, (u32x4*)(proj + (size_t)(rowb + ai * 128 + m * 16) * DIN + colb + bj * 128)); } } }
        } else if (pn == 8 || pn == 9) {
            f32x4 l[2][2];
#pragma unroll
            for (int bj = 0; bj < 2; ++bj) { const float* lp = lb + (colb - C_FB) + bj * 128; l[bj][0] = *(const f32x4*)lp; l[bj][1] = *(const f32x4*)(lp + 4); }
#pragma unroll
            for (int ai = 0; ai < 2; ++ai)
#pragma unroll
                for (int m = 0; m < 4; ++m)
#pragma unroll
                    for (int bj = 0; bj < 2; ++bj) { f32x4 o[2];
#pragma unroll
                        for (int n = 0; n < 2; ++n)
#pragma unroll
                            for (int j = 0; j < 4; ++j) o[n][j] = __logf(l[bj][n][j] + (1.0f - l[bj][n][j]) * sigmoidf_(acc[ai][bj][m][n][j]));
                        _Float16* p = (_Float16*)logf + (size_t)(rowb + ai * 128 + m * 16) * 512 + (colb - C_FB) + bj * 128;
                        const h16x8 hv = {(_Float16)o[0][0], (_Float16)o[0][1], (_Float16)o[0][2], (_Float16)o[0][3], (_Float16)o[1][0], (_Float16)o[1][1], (_Float16)o[1][2], (_Float16)o[1][3]};
                        if (NOSTORE) asm volatile("" :: "v"(hv)); else *(h16x8*)p = hv; }
        } else {
            const int mode = (pn == 6 || pn == 7 || pn == 12 || pn == 13) ? 1 : (pn >= 14 ? 2 : 0);
#define EPROJ_LOOP(EXPR) _Pragma("unroll") for (int ai = 0; ai < 2; ++ai) _Pragma("unroll") for (int m = 0; m < 4; ++m) _Pragma("unroll") for (int bj = 0; bj < 2; ++bj) { f32x4 o[2]; \
                _Pragma("unroll") for (int n = 0; n < 2; ++n) _Pragma("unroll") for (int j = 0; j < 4; ++j) { const float x = acc[ai][bj][m][n][j]; o[n][j] = (EXPR); } \
                const u32x4 w_ = pack8(o[0], o[1]); if (NOSTORE) asm volatile("" :: "v"(w_)); else __builtin_nontemporal_store(w_, (u32x4*)(proj + (size_t)(rowb + ai * 128 + m * 16) * DIN + colb + bj * 128)); }
            if (mode == 0) { EPROJ_LOOP(x) } else if (mode == 1) { EPROJ_LOOP(x * sigmoidf_(x)) } else {
#pragma unroll
                for (int ai = 0; ai < 2; ++ai)
#pragma unroll
                    for (int m = 0; m < 4; ++m)
#pragma unroll
                        for (int bj = 0; bj < 2; ++bj) { f32x4 o[2];
#pragma unroll
                            for (int n = 0; n < 2; ++n)
#pragma unroll
                                for (int j = 0; j < 4; ++j) o[n][j] = sigmoidf_(acc[ai][bj][m][n][j]);
                            u32x2 w_; w_.x = pk4_u8(o[0][0], o[0][1], o[0][2], o[0][3]); w_.y = pk4_u8(o[1][0], o[1][1], o[1][2], o[1][3]);
                            unsigned char* gp = (unsigned char*)(proj + (size_t)(rowb + ai * 128 + m * 16) * DIN) + GATE_BYTE0 + (colb - C_GA) + bj * 128;
                            if (NOSTORE) asm volatile("" :: "v"(w_)); else *(u32x2*)gp = w_; }
            }
#undef EPROJ_LOOP
        }
    }
};
typedef EpiProj_<false> EpiProj;
template <bool ACCUM> struct EpiMix {
    bf16_t* mixed; const bf16_t* proj; int gcol;
    __device__ __forceinline__ void operator()(const f32x4 (&acc)[2][2][4][2], const Unit& u, int wr, int wc, int fr, int fq) const {
        const int colb = u.pn * 256 + wc * 32 + 8 * fq, rowb = u.pm * 256 + wr * 64 + fr;
#pragma unroll
        for (int ai = 0; ai < 2; ++ai) {
            u32x4 g[4][2], mx[4][2];
#pragma unroll
            for (int m = 0; m < 4; ++m)
#pragma unroll
                for (int bj = 0; bj < 2; ++bj) { const size_t row = (size_t)(rowb + ai * 128 + m * 16); g[m][bj] = *(const u32x4*)(proj + row * DIN + gcol + colb + bj * 128);
                    if (ACCUM) mx[m][bj] = *(const u32x4*)(mixed + row * DM + colb + bj * 128); }
#pragma unroll
            for (int m = 0; m < 4; ++m)
#pragma unroll
                for (int bj = 0; bj < 2; ++bj) { f32x4 g0, g1; unpack8(g[m][bj], g0, g1); f32x4 v0 = acc[ai][bj][m][0] * g0, v1 = acc[ai][bj][m][1] * g1;
                    if (ACCUM) { f32x4 m0, m1; unpack8(mx[m][bj], m0, m1); v0 = v0 + m0; v1 = v1 + m1; }
                    *(u32x4*)(mixed + (size_t)(rowb + ai * 128 + m * 16) * DM + colb + bj * 128) = pack8(v0, v1); }
        }
    }
};
struct EpiMixF {         static constexpr int NVMEM = 16;
    bf16_t* mixed; const bf16_t* proj;
    __device__ __forceinline__ void mid(f32x4 (&acc)[2][2][4][2], const Unit& u, int wr, int wc, int fr, int fq) const {
        const int colb = u.pn * 256 + wc * 32 + 8 * fq, rowb = u.pm * 256 + wr * 64 + fr;
#pragma unroll
        for (int ai = 0; ai < 2; ++ai) {
            u32x2 ga[4][2], gb[4][2];
#pragma unroll
            for (int m = 0; m < 4; ++m)
#pragma unroll
                for (int bj = 0; bj < 2; ++bj) { const unsigned char* p = (const unsigned char*)(proj + (size_t)(rowb + ai * 128 + m * 16) * DIN) + GATE_BYTE0 + colb + bj * 128; ga[m][bj] = *(const u32x2*)p; gb[m][bj] = *(const u32x2*)(p + 1024); }
#pragma unroll
            for (int m = 0; m < 4; ++m)
#pragma unroll
                for (int bj = 0; bj < 2; ++bj) { const f32x4 a0 = un4_u8(ga[m][bj].x), a1 = un4_u8(ga[m][bj].y), b0 = un4_u8(gb[m][bj].x), b1 = un4_u8(gb[m][bj].y);
#pragma unroll
                    for (int j = 0; j < 4; ++j) { acc[ai][bj][m][0][j] *= a0[j] * __builtin_amdgcn_rcpf(b0[j]); acc[ai][bj][m][1][j] *= a1[j] * __builtin_amdgcn_rcpf(b1[j]); } }
        }
    }
    __device__ __forceinline__ void operator()(const f32x4 (&acc)[2][2][4][2], const Unit& u, int wr, int wc, int fr, int fq) const {
        const int colb = u.pn * 256 + wc * 32 + 8 * fq, rowb = u.pm * 256 + wr * 64 + fr;
#pragma unroll
        for (int ai = 0; ai < 2; ++ai) {
            u32x2 gb[4][2];
#pragma unroll
            for (int m = 0; m < 4; ++m)
#pragma unroll
                for (int bj = 0; bj < 2; ++bj) gb[m][bj] = *(const u32x2*)((const unsigned char*)(proj + (size_t)(rowb + ai * 128 + m * 16) * DIN) + GATE_BYTE0 + 1024 + colb + bj * 128);
#pragma unroll
            for (int m = 0; m < 4; ++m)
#pragma unroll
                for (int bj = 0; bj < 2; ++bj) { const f32x4 b0 = un4_u8(gb[m][bj].x) * (1.0f / 255.0f), b1 = un4_u8(gb[m][bj].y) * (1.0f / 255.0f);
                    *(u32x4*)(mixed + (size_t)(rowb + ai * 128 + m * 16) * DM + colb + bj * 128) = pack8(acc[ai][bj][m][0] * b0, acc[ai][bj][m][1] * b1); }
        }
    }
};
struct EpiOut {
    static constexpr int NVMEM = 16;
    const float* x; bf16_t* x1;
    __device__ __forceinline__ void operator()(const f32x4 (&acc)[2][2][4][2], const Unit& u, int wr, int wc, int fr, int fq) const {
        const int colb = u.pn * 256 + wc * 32 + 8 * fq, rowb = u.pm * 256 + wr * 64 + fr;
#pragma unroll
        for (int ai = 0; ai < 2; ++ai) {
            f32x4 xv[4][2][2];
#pragma unroll
            for (int m = 0; m < 4; ++m)
#pragma unroll
                for (int bj = 0; bj < 2; ++bj) { const float* p = x + (size_t)(rowb + ai * 128 + m * 16) * DM + colb + bj * 128; xv[m][bj][0] = __builtin_nontemporal_load((const f32x4*)p); xv[m][bj][1] = __builtin_nontemporal_load((const f32x4*)(p + 4)); }
#pragma unroll
            for (int m = 0; m < 4; ++m)
#pragma unroll
                for (int bj = 0; bj < 2; ++bj) *(u32x4*)(x1 + (size_t)(rowb + ai * 128 + m * 16) * DM + colb + bj * 128) = pack8(xv[m][bj][0] + acc[ai][bj][m][0], xv[m][bj][1] + acc[ai][bj][m][1]);
        }
    }
};
struct EpiMoe1 {         static constexpr int NVMEM = 8;
    bf16_t* hid; const float* bias;
    __device__ __forceinline__ void operator()(const f32x4 (&acc)[2][2][4][2], const Unit& u, int wr, int wc, int fr, int fq) const {
        const int jj0 = wc * 32 + 8 * fq, J0 = 128 * u.pn + jj0;
        const float* bp = bias + (size_t)u.e * 2048 + 2 * J0;
        f32x4 b[4];
#pragma unroll
        for (int j = 0; j < 4; ++j) b[j] = *(const f32x4*)(bp + 4 * j);
        const float bg[8] = {b[0][0], b[0][2], b[1][0], b[1][2], b[2][0], b[2][2], b[3][0], b[3][2]};
        const float bu[8] = {b[0][1], b[0][3], b[1][1], b[1][3], b[2][1], b[2][3], b[3][1], b[3][3]};
        constexpr float DQ = MOE1_I8 ? 1.0f : DQ1;
#pragma unroll
        for (int ai = 0; ai < 2; ++ai)
#pragma unroll
            for (int m = 0; m < 4; ++m) {
                const int r = ai * 128 + wr * 64 + m * 16 + fr;
                float h[8];
#pragma unroll
                for (int j = 0; j < 8; ++j) {
                    float gt, up;
                    gt = acc[ai][0][m][j >> 2][j & 3] * DQ + bg[j]; up = acc[ai][1][m][j >> 2][j & 3] * DQ + bu[j];
                    gt = fminf(gt, 7.0f); up = __builtin_amdgcn_fmed3f(up, -7.0f, 7.0f);
                    h[j] = (up + 1.0f) * gt * __builtin_amdgcn_rcpf(1.0f + __builtin_amdgcn_exp2f(gt * (-1.702f * 1.4426950408889634f)));
                }
                if constexpr (MOE_FP8) { u32x2 w; w.x = pk4_fp8_nc(h[0], h[1], h[2], h[3], S_HID); w.y = pk4_fp8_nc(h[4], h[5], h[6], h[7], S_HID);
                    *(u32x2*)((unsigned char*)hid + (size_t)(u.pm * 256 + r) * DE + J0) = w; }
                else { u32x4 w; w.x = pk2(h[0], h[1]); w.y = pk2(h[2], h[3]); w.z = pk2(h[4], h[5]); w.w = pk2(h[6], h[7]);
                    *(u32x4*)(hid + (size_t)(u.pm * 256 + r) * DE + J0) = w; }
            }
    }
};
struct EpiMoe2 {
    static constexpr int NVMEM = 16;
    bf16_t* yg; const float* bias; const int* rows; const float* roww;
    __device__ __forceinline__ void operator()(const f32x4 (&acc)[2][2][4][2], const Unit& u, int wr, int wc, int fr, int fq) const {
        f32x4 b[2][2];
#pragma unroll
        for (int bj = 0; bj < 2; ++bj) { const float* bp = bias + (size_t)u.e * DM + u.pn * 256 + bj * 128 + wc * 32 + 8 * fq; b[bj][0] = *(const f32x4*)bp; b[bj][1] = *(const f32x4*)(bp + 4); }
        int slot[2][4]; float wgt[2][4];
#pragma unroll
        for (int ai = 0; ai < 2; ++ai)
#pragma unroll
            for (int m = 0; m < 4; ++m) { int r = ai * 128 + wr * 64 + m * 16 + fr; r = r < u.nvalid ? r : u.nvalid - 1; const size_t p = (size_t)u.e * CAP + u.lt * 256 + r; slot[ai][m] = rows[p]; wgt[ai][m] = roww[p]; }
#pragma unroll
        for (int ai = 0; ai < 2; ++ai)
#pragma unroll
            for (int m = 0; m < 4; ++m) {
                const int r = ai * 128 + wr * 64 + m * 16 + fr; const float w = wgt[ai][m];
                if (r < u.nvalid) {
#pragma unroll
                    for (int bj = 0; bj < 2; ++bj)
                    { const f32x4 y0 = (acc[ai][bj][m][0] * DQ2 + b[bj][0]) * w, y1 = (acc[ai][bj][m][1] * DQ2 + b[bj][1]) * w;
                      if constexpr (MOE_FP8) { u32x2 q; q.x = pk4_fp8(y0[0], y0[1], y0[2], y0[3], S_YG); q.y = pk4_fp8(y1[0], y1[1], y1[2], y1[3], S_YG);
                          *(u32x2*)((unsigned char*)yg + (size_t)slot[ai][m] * DM + u.pn * 256 + bj * 128 + wc * 32 + 8 * fq) = q; }
                      else *(u32x4*)(yg + (size_t)slot[ai][m] * DM + u.pn * 256 + bj * 128 + wc * 32 + 8 * fq) = pack8(y0, y1); }
                }
            }
    }
};

struct Args { const float* in[16]; float* out; unsigned char* ws; int ph_lo, ph_hi; };
enum { I_X = 0, I_N1, I_WIN, I_MUP, I_LBL, I_HNW, I_HUP, I_WOUT, I_N2, I_RW, I_RB, I_WGU, I_BGU, I_WD, I_BD, I_FNW };
constexpr int NPHASE = 11;

struct Frame { LAS unsigned char* lds; int tid, lane, wave, G, bid; };
__device__ __forceinline__ Frame fresh(const Frame& F0) { Frame F = F0; const int l = lane_id_(); F.lane = l; F.tid = F0.wave * 64 + l; return F; }

template <int MAP> __device__ __forceinline__ int rowmap(int n) {
    if (MAP == 1) return n < 1024 ? ((n & ~63) | (2 * (n & 31) + ((n >> 5) & 1))) : n;
    if (MAP == 2) { const int J = n >> 1, s = n & 1; return 256 * (J >> 7) + 128 * s + (J & 127); }
    return n;
}
template <int MAP> __device__ __forceinline__ void transpose_item(const float* W, int K, int N, bf16_t* WT, LAS float* scr, int item, int lane, int KP = 0) {
    if (KP == 0) KP = K;
    const int nblk = N / 32, kb = item / nblk, nb = item % nblk, k0 = 64 * kb, n0 = 32 * nb;
    f32x4 v[8];
#pragma unroll
    for (int i = 0; i < 8; ++i) v[i] = __builtin_nontemporal_load((const f32x4*)(W + (size_t)(k0 + 8 * i + (lane >> 3)) * N + n0 + 4 * (lane & 7)));
#pragma unroll
    for (int i = 0; i < 8; ++i) { LAS float* p = scr + (8 * i + (lane >> 3)) * 33 + 4 * (lane & 7); p[0] = v[i].x; p[1] = v[i].y; p[2] = v[i].z; p[3] = v[i].w; }
    asm volatile("s_waitcnt lgkmcnt(0)" ::: "memory");
    const int c = lane & 7;
#pragma unroll
    for (int j = 0; j < 4; ++j) { const int n = (lane >> 3) + 8 * j; const LAS float* s = scr + (8 * c) * 33 + n;
        u32x4 o; o.x = pk2(s[0 * 33], s[1 * 33]); o.y = pk2(s[2 * 33], s[3 * 33]); o.z = pk2(s[4 * 33], s[5 * 33]); o.w = pk2(s[6 * 33], s[7 * 33]);
        *(u32x4*)(WT + (size_t)rowmap<MAP>(n0 + n) * KP + k0 + 8 * c) = o; }
    asm volatile("s_waitcnt lgkmcnt(0)" ::: "memory");
}
template <int MAP> __device__ __forceinline__ void transpose_item_fp8(const float* W, int K, int N, unsigned char* WT, LAS float* scr, int item, int lane) {
    const int nblk = N / 32, kb = item / nblk, nb = item % nblk, k0 = 64 * kb, n0 = 32 * nb;
    f32x4 v[8];
#pragma unroll
    for (int i = 0; i < 8; ++i) v[i] = __builtin_nontemporal_load((const f32x4*)(W + (size_t)(k0 + 8 * i + (lane >> 3)) * N + n0 + 4 * (lane & 7)));
#pragma unroll
    for (int i = 0; i < 8; ++i) { LAS float* p = scr + (8 * i + (lane >> 3)) * 33 + 4 * (lane & 7); p[0] = v[i].x; p[1] = v[i].y; p[2] = v[i].z; p[3] = v[i].w; }
    asm volatile("s_waitcnt lgkmcnt(0)" ::: "memory");
    const int n = lane >> 1, hf = lane & 1; const LAS float* s = scr + (32 * hf) * 33 + n;
    u32x4 o0, o1;
    o0.x = pk4_fp8(s[0 * 33], s[1 * 33], s[2 * 33], s[3 * 33], S_W);     o0.y = pk4_fp8(s[4 * 33], s[5 * 33], s[6 * 33], s[7 * 33], S_W);
    o0.z = pk4_fp8(s[8 * 33], s[9 * 33], s[10 * 33], s[11 * 33], S_W);   o0.w = pk4_fp8(s[12 * 33], s[13 * 33], s[14 * 33], s[15 * 33], S_W);
    o1.x = pk4_fp8(s[16 * 33], s[17 * 33], s[18 * 33], s[19 * 33], S_W); o1.y = pk4_fp8(s[20 * 33], s[21 * 33], s[22 * 33], s[23 * 33], S_W);
    o1.z = pk4_fp8(s[24 * 33], s[25 * 33], s[26 * 33], s[27 * 33], S_W); o1.w = pk4_fp8(s[28 * 33], s[29 * 33], s[30 * 33], s[31 * 33], S_W);
    unsigned char* dst = WT + (size_t)rowmap<MAP>(n0 + n) * K + k0 + 32 * hf;
    *(u32x4*)dst = o0; *(u32x4*)(dst + 16) = o1;
    asm volatile("s_waitcnt lgkmcnt(0)" ::: "memory");
}
struct QItem { const float* W; unsigned char* WT; float* scl; int N, n0, map; };
constexpr int NQ_IN = P1_I8 ? DIN / 32 : 0, NQ_GU = MOE1_I8 ? NE * 64 : 0, NQ = NQ_IN + NQ_GU;
__device__ __forceinline__ QItem q_item(const float* win, const float* wgu, unsigned char* ws, int wi) {
    QItem q;
    if (wi < NQ_IN) { q.W = win; q.WT = ws + WS_WIN; q.scl = (float*)(ws + WS_WINS); q.N = DIN; q.n0 = 32 * wi; q.map = 1; }
    else { wi -= NQ_IN; const int e = wi >> 6; q.W = wgu + (size_t)e * DM * 2 * DE; q.WT = ws + WS_WGU + (size_t)e * 2 * DE * DM; q.scl = (float*)(ws + WS_WGS) + (size_t)e * 2 * DE; q.N = 2 * DE; q.n0 = 32 * (wi & 63); q.map = 2; }
    return q;
}
__device__ __forceinline__ void q_load(const QItem& q, f32x4 (&v)[16], int wave, int lane) {
#pragma unroll
    for (int i = 0; i < 16; ++i) v[i] = __builtin_nontemporal_load((const f32x4*)(q.W + (size_t)(128 * wave + 8 * i + (lane >> 3)) * q.N + q.n0 + 4 * (lane & 7)));
}
__device__ __forceinline__ void quant_cols_loop(const float* win, const float* wgu, unsigned char* ws, LAS unsigned char* lds, int bid, int G, int wave, int lane) {
    if (NQ == 0) return;
    LAS float* s = (LAS float*)lds; LAS float* pmax = (LAS float*)(lds + 1024 * 33 * 4);
    int wi = bid; if (wi >= NQ) return;
    QItem q = q_item(win, wgu, ws, wi); f32x4 v[16]; q_load(q, v, wave, lane);
    for (;;) {
#pragma unroll
        for (int i = 0; i < 16; ++i) { LAS float* p = s + (128 * wave + 8 * i + (lane >> 3)) * 33 + 4 * (lane & 7); p[0] = v[i].x; p[1] = v[i].y; p[2] = v[i].z; p[3] = v[i].w; }
        __syncthreads();
        const int nw = wi + G; const bool more = nw < NQ; QItem qn = q;
        if (more) { qn = q_item(win, wgu, ws, nw); q_load(qn, v, wave, lane); }
        const int n = lane & 31, kb = 128 * wave + 64 * (lane >> 5);
        float x[64]; float am = 0.f;
#pragma unroll
        for (int kk = 0; kk < 64; ++kk) { x[kk] = s[(kb + kk) * 33 + n]; am = fmaxf(am, fabsf(x[kk])); }
        pmax[(2 * wave + (lane >> 5)) * 32 + n] = am;
        __syncthreads();
        am = 0.f;
#pragma unroll
        for (int p = 0; p < 16; ++p) am = fmaxf(am, pmax[p * 32 + n]);
        const float inv = am > 0.f ? 127.0f / am : 0.f;
        const int r = q.map == 1 ? rowmap<1>(q.n0 + n) : rowmap<2>(q.n0 + n);
        if (wave == 0 && lane < 32) q.scl[r] = am * (1.0f / 127.0f);
        unsigned char* dst = q.WT + (size_t)r * 1024 + kb;
#pragma unroll
        for (int qq = 0; qq < 4; ++qq) { u32x4 o;
            o.x = pk4_i8(x[16 * qq + 0] * inv, x[16 * qq + 1] * inv, x[16 * qq + 2] * inv, x[16 * qq + 3] * inv);   o.y = pk4_i8(x[16 * qq + 4] * inv, x[16 * qq + 5] * inv, x[16 * qq + 6] * inv, x[16 * qq + 7] * inv);
            o.z = pk4_i8(x[16 * qq + 8] * inv, x[16 * qq + 9] * inv, x[16 * qq + 10] * inv, x[16 * qq + 11] * inv); o.w = pk4_i8(x[16 * qq + 12] * inv, x[16 * qq + 13] * inv, x[16 * qq + 14] * inv, x[16 * qq + 15] * inv);
            *(u32x4*)(dst + 16 * qq) = o; }
        if (!more) break;
        q = qn; wi = nw;
    }
    __syncthreads();
}
__device__ __forceinline__ void rms_row_to_bf16(const float* xrow, const float* w, bf16_t* orow, int lane) {
    const f32x4* xr = (const f32x4*)xrow + lane; const f32x4* wr = (const f32x4*)w + lane;
    f32x4 v[4]; float s = 0.f;
#pragma unroll
    for (int j = 0; j < 4; ++j) { v[j] = __builtin_nontemporal_load(xr + 64 * j); s += (v[j].x * v[j].x + v[j].y * v[j].y) + (v[j].z * v[j].z + v[j].w * v[j].w); }
    const float rstd = 1.0f / sqrtf(wave_sum(s) * (1.0f / DM) + RMS_EPS);
    u32x2* o8 = (u32x2*)orow + lane;
#pragma unroll
    for (int j = 0; j < 4; ++j) { const f32x4 ww = wr[64 * j]; u32x2 o; o.x = pk2(v[j].x * rstd * ww.x, v[j].y * rstd * ww.y); o.y = pk2(v[j].z * rstd * ww.z, v[j].w * rstd * ww.w); o8[64 * j] = o; }
}
__device__ __forceinline__ void rms_row_to_i8(const float* xrow, const float* w, unsigned char* orow, float* sc, int lane) {
    const f32x4* xr = (const f32x4*)xrow + lane; const f32x4* wr = (const f32x4*)w + lane;
    f32x4 v[4]; float s = 0.f;
#pragma unroll
    for (int j = 0; j < 4; ++j) { v[j] = __builtin_nontemporal_load(xr + 64 * j); s += (v[j].x * v[j].x + v[j].y * v[j].y) + (v[j].z * v[j].z + v[j].w * v[j].w); }
    const float rstd = 1.0f / sqrtf(wave_sum(s) * (1.0f / DM) + RMS_EPS);
    float am = 0.f;
#pragma unroll
    for (int j = 0; j < 4; ++j) { const f32x4 ww = wr[64 * j]; v[j] = v[j] * rstd * ww; am = fmaxf(fmaxf(am, fmaxf(fabsf(v[j].x), fabsf(v[j].y))), fmaxf(fabsf(v[j].z), fabsf(v[j].w))); }
    am = wave_max(am); const float inv = am > 0.f ? 127.0f / am : 0.f;
    unsigned* o4 = (unsigned*)orow + lane;
#pragma unroll
    for (int j = 0; j < 4; ++j) o4[64 * j] = pk4_i8(v[j].x * inv, v[j].y * inv, v[j].z * inv, v[j].w * inv);
    if (lane == 0) *sc = am * (1.0f / 127.0f);
}

__device__ __forceinline__ void p0_prologue(const Frame& F0, const Args& a) {
    const Frame F = fresh(F0);
    unsigned char* ws = a.ws;
    LAS float* scr = (LAS float*)(F.lds + F.wave * 16384);
    const int gw = F.bid * 8 + F.wave, NGW = F.G * 8;
    constexpr int I_IN = P1_I8 ? 0 : 16 * (DIN / 32), I_UP = 8 * 32, I_O = 16 * 32, I_GU = MOE1_I8 ? 0 : 16 * 64, I_D = 16 * 32;
    constexpr int NITEMS = I_IN + 2 * I_UP + I_O + NE * (I_GU + I_D);
    for (int it = gw; it < NITEMS; it += NGW) {
        int r = it;
        if (r < I_IN) { transpose_item<1>(a.in[I_WIN], DM, DIN, (bf16_t*)(ws + WS_WIN), scr, r, F.lane); continue; } r -= I_IN;
        if (r < I_UP) { transpose_item<0>(a.in[I_MUP], 512, DM, (bf16_t*)(ws + WS_MUP), scr, r, F.lane, 1024); continue; } r -= I_UP;
        if (r < I_UP) { transpose_item<0>(a.in[I_HUP], 512, DM, (bf16_t*)(ws + WS_MUP) + 512, scr, r, F.lane, 1024); continue; } r -= I_UP;
        if (r < I_O) { transpose_item<0>(a.in[I_WOUT], DM, DM, (bf16_t*)(ws + WS_WOUT), scr, r, F.lane); continue; } r -= I_O;
        if (I_GU > 0 && r < NE * I_GU) { const int e = r / (I_GU > 0 ? I_GU : 1);
            if constexpr (MOE_FP8) transpose_item_fp8<2>(a.in[I_WGU] + (size_t)e * DM * 2 * DE, DM, 2 * DE, (unsigned char*)(ws + WS_WGU) + (size_t)e * 2 * DE * DM, scr, r % (I_GU > 0 ? I_GU : 1), F.lane);
            else transpose_item<2>(a.in[I_WGU] + (size_t)e * DM * 2 * DE, DM, 2 * DE, (bf16_t*)(ws + WS_WGU) + (size_t)e * 2 * DE * DM, scr, r % (I_GU > 0 ? I_GU : 1), F.lane);
            continue; } r -= NE * I_GU;
        { const int e = r / I_D;
            if constexpr (MOE_FP8) transpose_item_fp8<0>(a.in[I_WD] + (size_t)e * DE * DM, DE, DM, (unsigned char*)(ws + WS_WD) + (size_t)e * DM * DE, scr, r % I_D, F.lane);
            else transpose_item<0>(a.in[I_WD] + (size_t)e * DE * DM, DE, DM, (bf16_t*)(ws + WS_WD) + (size_t)e * DM * DE, scr, r % I_D, F.lane); }
    }
    if constexpr (P1_I8) { for (int m = gw; m < NTOK; m += NGW) rms_row_to_i8(a.in[I_X] + (size_t)m * DM, a.in[I_N1], ws + WS_XN + (size_t)m * DM, (float*)(ws + WS_XS) + m, F.lane); }
    else { for (int m = gw; m < NTOK; m += NGW) rms_row_to_bf16(a.in[I_X] + (size_t)m * DM, a.in[I_N1], (bf16_t*)(ws + WS_XN) + (size_t)m * DM, F.lane); }
    if constexpr (NQ > 0) {
        __syncthreads();
        quant_cols_loop(a.in[I_WIN], a.in[I_WGU], ws, F.lds, F.bid, F.G, F.wave, F.lane);
    }
    float* rope = (float*)(ws + WS_ROPE);
    for (int idx = F.bid * 512 + F.tid; idx < SEQ * 32; idx += F.G * 512) {
        const int pos = idx >> 5, i = idx & 31;
        const double inv = exp2(-(double)i * (13.287712379549449 / 32.0));
        const double rev = (double)pos * inv * 0.15915494309189535;
        const float fr = (float)(rev - floor(rev));
        rope[2 * idx] = __builtin_amdgcn_cosf(fr); rope[2 * idx + 1] = __builtin_amdgcn_sinf(fr);
    }
    if (F.bid == 0) { const float* l = a.in[I_LBL]; const float a0 = l[F.tid], a1 = l[512 + F.tid]; ((float*)(ws + WS_LB))[F.tid] = 1.0f / (1.0f + __expf(a1 - a0)); }
}

__device__ __forceinline__ void p2_kmean(const Frame& F0, const Args& a) {
    const Frame F = fresh(F0);
    const bf16_t* proj = (const bf16_t*)(a.ws + WS_PROJ); bf16_t* km = (bf16_t*)(a.ws + WS_KMEAN);
    LAS float* red = (LAS float*)F.lds;
    for (int it = F.bid; it < 128; it += F.G) {
        const int b = it >> 4, n = it & 15;
        float s[8] = {0, 0, 0, 0, 0, 0, 0, 0};
        const bf16_t* base = proj + (size_t)(b * SEQ + n * 256 + F.wave * 32) * DIN + C_KA + F.lane * 8;
#pragma unroll 8
        for (int r = 0; r < 32; ++r) { const u32x4 w = *(const u32x4*)(base + (size_t)r * DIN); f32x4 x0, x1; unpack8(w, x0, x1);
            s[0] += x0[0]; s[1] += x0[1]; s[2] += x0[2]; s[3] += x0[3]; s[4] += x1[0]; s[5] += x1[1]; s[6] += x1[2]; s[7] += x1[3]; }
#pragma unroll
        for (int j = 0; j < 8; ++j) red[F.wave * 512 + F.lane * 8 + j] = s[j];
        __syncthreads();
        float t = 0.f;
#pragma unroll
        for (int w = 0; w < 8; ++w) t += red[w * 512 + F.tid];
        km[((size_t)b * 64 + n) * 512 + F.tid] = (bf16_t)f2bf(t * (1.0f / 256.0f));
        km[((size_t)b * 64 + n + 16) * 512 + F.tid] = 0; km[((size_t)b * 64 + n + 32) * 512 + F.tid] = 0; km[((size_t)b * 64 + n + 48) * 512 + F.tid] = 0;
        __syncthreads();
    }
}

constexpr int HP = 72, HQ = 136;
__device__ __forceinline__ void h2_scan(const Frame& F0, const Args& a) {
    const Frame F = fresh(F0);
    bf16_t* hst = (bf16_t*)(a.ws + WS_HST); const float* gdec = (const float*)(a.ws + WS_GDEC);
    for (int idx = F.bid * 512 + F.tid; idx < 32 * 128 * 32; idx += F.G * 512) {
        const int bh = idx >> 12, v = (idx >> 5) & 127, d4 = idx & 31;
        bf16_t* p = hst + ((size_t)bh * 64 * 128 + v) * 128 + d4 * 4; const float* g = gdec + (size_t)bh * 64 * 128 + d4 * 4;
        f32x4 s = {0.f, 0.f, 0.f, 0.f};
#pragma unroll 8
        for (int c = 0; c < 64; ++c) {
            const u32x2 u = __builtin_nontemporal_load((const u32x2*)(p + (size_t)c * 16384)); const f32x4 gg = *(const f32x4*)(g + c * 128);
            u32x2 w; w.x = pk2(s[0], s[1]); w.y = pk2(s[2], s[3]); *(u32x2*)(p + (size_t)c * 16384) = w;
            s = gg * s + (f32x4){bf_lo(u.x), bf_hi(u.x), bf_lo(u.y), bf_hi(u.y)};
        }
    }
}
constexpr int LFP = 132;
#define H_LOAD_LQI(it_, LFR, QR, IR, WITHQ) do { const int bh_ = (it_) >> 6, c_ = (it_) & 63; const size_t r_ = (size_t)(bh_ >> 2) * SEQ + c_ * 64 + t_r; const int hh_ = (bh_ & 3) * 128 + 16 * seg; \
    _Pragma("unroll") for (int j_ = 0; j_ < 2; ++j_) { const h16x8 h_ = __builtin_nontemporal_load((const h16x8*)((const _Float16*)logf + r_ * 512 + hh_ + 8 * j_)); const f32x8 f_ = __builtin_convertvector(h_, f32x8); \
        LFR[2 * j_] = (f32x4){f_[0], f_[1], f_[2], f_[3]}; LFR[2 * j_ + 1] = (f32x4){f_[4], f_[5], f_[6], f_[7]}; } \
    _Pragma("unroll") for (int j_ = 0; j_ < 2; ++j_) { if (WITHQ) QR[j_] = __builtin_nontemporal_load((const u32x4*)(proj + r_ * DIN + C_QB + hh_ + 8 * j_)); IR[j_] = __builtin_nontemporal_load((const u32x4*)(proj + r_ * DIN + C_IB + hh_ + 8 * j_)); } } while (0)
__device__ __forceinline__ void scatter_it(LAS bf16_t* It, const u32x4 (&ir)[2], int seg, int t_r) {
#pragma unroll
    for (int j = 0; j < 2; ++j) { const unsigned w[4] = {ir[j].x, ir[j].y, ir[j].z, ir[j].w};
#pragma unroll
        for (int q = 0; q < 4; ++q) { It[(16 * seg + 8 * j + 2 * q) * HP + t_r] = (bf16_t)(w[q] & 0xffffu); It[(16 * seg + 8 * j + 2 * q + 1) * HP + t_r] = (bf16_t)(w[q] >> 16); } }
}
__device__ __forceinline__ void h1_local_states_p(const Frame& F0, const Args& a) {
    const Frame F = fresh(F0);
    const bf16_t* proj = (const bf16_t*)(a.ws + WS_PROJ); const float* logf = (const float*)(a.ws + WS_LOGF);
    bf16_t* hst = (bf16_t*)(a.ws + WS_HST); float* gdec = (float*)(a.ws + WS_GDEC);
    LAS float* LF = (LAS float*)F.lds; LAS bf16_t* Kp = (LAS bf16_t*)(F.lds + 64 * LFP * 4); LAS bf16_t* It = Kp + 128 * HP;
    const int t_r = F.tid >> 3, seg = F.tid & 7, l15 = F.lane & 15, lq = F.lane >> 4;
    f32x4 lfr[4], lfn[4]; u32x4 qdum[2], ir[2], in_[2];
    int it = F.bid;
    if (it < 2048) H_LOAD_LQI(it, lfr, qdum, ir, false);
    for (; it < 2048; it += F.G) {
        const int bh = it >> 6, c = it & 63;
#pragma unroll
        for (int j = 0; j < 4; ++j) *(LAS f32x4*)(LF + t_r * LFP + 16 * seg + 4 * j) = lfr[j];
        scatter_it(It, ir, seg, t_r);
        const int itn = it + F.G;
        if (itn < 2048) H_LOAD_LQI(itn, lfn, qdum, in_, false);
        __syncthreads();
        if (F.tid < 128) { float run = 0.f;
#pragma unroll 16
            for (int t = 0; t < 64; ++t) { run += LF[t * LFP + F.tid]; LF[t * LFP + F.tid] = run; }
            gdec[((size_t)bh * 64 + c) * 128 + F.tid] = __expf(run); }
        __syncthreads();
        {
            f32x4 bb[4], bl[4];
#pragma unroll
            for (int j = 0; j < 4; ++j) { bb[j] = *(const LAS f32x4*)(LF + t_r * LFP + 16 * seg + 4 * j); bl[j] = *(const LAS f32x4*)(LF + 63 * LFP + 16 * seg + 4 * j); }
#pragma unroll
            for (int j = 0; j < 4; ++j)
#pragma unroll
                for (int q = 0; q < 4; ++q) { const float kv = (1.0f - __expf(lfr[j][q])) * __expf(bl[j][q] - bb[j][q]); Kp[(16 * seg + 4 * j + q) * HP + t_r] = (bf16_t)f2bf(kv); }
        }
        __syncthreads();
        bf16x8 af[2];
#pragma unroll
        for (int ks = 0; ks < 2; ++ks) af[ks] = *(const LAS bf16x8*)(Kp + (16 * F.wave + l15) * HP + ks * 32 + 8 * lq);
#pragma unroll
        for (int vt = 0; vt < 8; ++vt) {
            f32x4 acc = {0.f, 0.f, 0.f, 0.f};
#pragma unroll
            for (int ks = 0; ks < 2; ++ks) { const bf16x8 bfr = *(const LAS bf16x8*)(It + (16 * vt + l15) * HP + ks * 32 + 8 * lq); acc = __builtin_amdgcn_mfma_f32_16x16x32_bf16(af[ks], bfr, acc, 0, 0, 0); }
            u32x2 w; w.x = pk2(acc[0], acc[1]); w.y = pk2(acc[2], acc[3]);
            *(u32x2*)(hst + (((size_t)bh * 64 + c) * 128 + 16 * vt + l15) * 128 + 16 * F.wave + 4 * lq) = w;
        }
        __syncthreads();
#pragma unroll
        for (int j = 0; j < 4; ++j) lfr[j] = lfn[j];
        ir[0] = in_[0]; ir[1] = in_[1];
    }
}
#define H3_LOAD_LATE(it_, SF, GR) do { const int bh_ = (it_) >> 6, c_ = (it_) & 63; const size_t row0_ = (size_t)(bh_ >> 2) * SEQ + c_ * 64; \
    _Pragma("unroll") for (int ks_ = 0; ks_ < 4; ++ks_) SF[ks_] = __builtin_nontemporal_load((const bf16x8*)(hst + (((size_t)bh_ * 64 + c_) * 128 + 16 * w + l15) * 128 + ks_ * 32 + 8 * lq)); \
    _Pragma("unroll") for (int tt_ = 0; tt_ < 4; ++tt_) GR[tt_] = __builtin_nontemporal_load((const u32x2*)(proj + (row0_ + 16 * tt_ + l15) * DIN + C_GB + (bh_ & 3) * 128 + 16 * w + 4 * lq)); } while (0)
__device__ __forceinline__ void h3_outputs_p(const Frame& F0, const Args& a) {
    const Frame F = fresh(F0);
    const bf16_t* proj = (const bf16_t*)(a.ws + WS_PROJ); const float* logf = (const float*)(a.ws + WS_LOGF);
    const bf16_t* hst = (const bf16_t*)(a.ws + WS_HST); bf16_t* yb = (bf16_t*)(a.ws + WS_YA); const float* nw = a.in[I_HNW];
    LAS float* LF = (LAS float*)F.lds; LAS bf16_t* Qt = (LAS bf16_t*)(F.lds + 64 * LFP * 4); LAS bf16_t* Kt = Qt + 64 * HQ; LAS bf16_t* It = Kt + 64 * HQ; LAS bf16_t* Pm = It + 128 * HP;
    LAS float* rsq = (LAS float*)(Pm + 64 * HP);
    const int t_r = F.tid >> 3, seg = F.tid & 7, l15 = F.lane & 15, lq = F.lane >> 4, w = F.wave;
    f32x4 lfr[4], lfn[4]; u32x4 qr[2], qn[2], ir[2], in_[2]; bf16x8 sf[4], sfn[4]; u32x2 gr[4], grn[4];
    int it = F.bid;
    if (it < 2048) { H_LOAD_LQI(it, lfr, qr, ir, true); H3_LOAD_LATE(it, sf, gr); }
    for (; it < 2048; it += F.G) {
        const int bh = it >> 6, c = it & 63, b = bh >> 2, h = bh & 3; const size_t row0 = (size_t)b * SEQ + c * 64;
#pragma unroll
        for (int j = 0; j < 4; ++j) *(LAS f32x4*)(LF + t_r * LFP + 16 * seg + 4 * j) = lfr[j];
        scatter_it(It, ir, seg, t_r);
        const int itn = it + F.G;
        if (itn < 2048) { H_LOAD_LQI(itn, lfn, qn, in_, true); H3_LOAD_LATE(itn, sfn, grn); }
        __syncthreads();
        if (F.tid < 128) { float run = 0.f;
#pragma unroll 16
            for (int t = 0; t < 64; ++t) { run += LF[t * LFP + F.tid]; LF[t * LFP + F.tid] = run; } }
        __syncthreads();
        {
            float qv[16], kv[16];
#pragma unroll
            for (int j = 0; j < 4; ++j) { const f32x4 bb = *(const LAS f32x4*)(LF + t_r * LFP + 16 * seg + 4 * j);
#pragma unroll
                for (int q = 0; q < 4; ++q) { const float eb = __expf(bb[q]); const unsigned qw = (j < 2 ? qr[0] : qr[1])[(2 * j + (q >> 1)) & 3];
                    const float qs = (q & 1) ? bf_hi(qw) : bf_lo(qw);
                    qv[4 * j + q] = qs * eb; kv[4 * j + q] = (1.0f - __expf(lfr[j][q])) * __builtin_amdgcn_rcpf(eb); } }
            u32x4 o0, o1;
            o0.x = pk2(qv[0], qv[1]); o0.y = pk2(qv[2], qv[3]); o0.z = pk2(qv[4], qv[5]); o0.w = pk2(qv[6], qv[7]); o1.x = pk2(qv[8], qv[9]); o1.y = pk2(qv[10], qv[11]); o1.z = pk2(qv[12], qv[13]); o1.w = pk2(qv[14], qv[15]);
            *(LAS u32x4*)(Qt + t_r * HQ + 16 * seg) = o0; *(LAS u32x4*)(Qt + t_r * HQ + 16 * seg + 8) = o1;
            o0.x = pk2(kv[0], kv[1]); o0.y = pk2(kv[2], kv[3]); o0.z = pk2(kv[4], kv[5]); o0.w = pk2(kv[6], kv[7]); o1.x = pk2(kv[8], kv[9]); o1.y = pk2(kv[10], kv[11]); o1.z = pk2(kv[12], kv[13]); o1.w = pk2(kv[14], kv[15]);
            *(LAS u32x4*)(Kt + t_r * HQ + 16 * seg) = o0; *(LAS u32x4*)(Kt + t_r * HQ + 16 * seg + 8) = o1;
        }
        __syncthreads();
        {
            const int tt = w >> 1; bf16x8 qa[4];
#pragma unroll
            for (int ks = 0; ks < 4; ++ks) qa[ks] = *(const LAS bf16x8*)(Qt + (16 * tt + l15) * HQ + ks * 32 + 8 * lq);
#pragma unroll
            for (int j = 0; j < 2; ++j) {
                const int st = (w & 1) * 2 + j; f32x4 acc = {0.f, 0.f, 0.f, 0.f};
#pragma unroll
                for (int ks = 0; ks < 4; ++ks) { const bf16x8 kb = *(const LAS bf16x8*)(Kt + (16 * st + l15) * HQ + ks * 32 + 8 * lq); acc = __builtin_amdgcn_mfma_f32_16x16x32_bf16(qa[ks], kb, acc, 0, 0, 0); }
                const int s = 16 * st + l15;
#pragma unroll
                for (int r = 0; r < 4; ++r) { const int t = 16 * tt + 4 * lq + r; Pm[t * HP + s] = (bf16_t)(s <= t ? f2bf(acc[r]) : 0u); }
            }
        }
        __syncthreads();
        f32x4 o[4];
        {
            bf16x8 ia[2];
#pragma unroll
            for (int ks = 0; ks < 2; ++ks) ia[ks] = *(const LAS bf16x8*)(It + (16 * w + l15) * HP + ks * 32 + 8 * lq);
#pragma unroll
            for (int tt = 0; tt < 4; ++tt) {
                f32x4 acc = {0.f, 0.f, 0.f, 0.f};
#pragma unroll
                for (int ks = 0; ks < 2; ++ks) { const bf16x8 pb = *(const LAS bf16x8*)(Pm + (16 * tt + l15) * HP + ks * 32 + 8 * lq); acc = __builtin_amdgcn_mfma_f32_16x16x32_bf16(ia[ks], pb, acc, 0, 0, 0); }
#pragma unroll
                for (int ks = 0; ks < 4; ++ks) { const bf16x8 qb = *(const LAS bf16x8*)(Qt + (16 * tt + l15) * HQ + ks * 32 + 8 * lq); acc = __builtin_amdgcn_mfma_f32_16x16x32_bf16(sf[ks], qb, acc, 0, 0, 0); }
                o[tt] = acc;
                float sq = (acc[0] * acc[0] + acc[1] * acc[1]) + (acc[2] * acc[2] + acc[3] * acc[3]);
                sq += __shfl_xor(sq, 16); sq += __shfl_xor(sq, 32);
                if (F.lane < 16) rsq[w * 64 + 16 * tt + F.lane] = sq;
            }
        }
        __syncthreads();
        const int v0 = 16 * w + 4 * lq; const f32x4 nw4 = *(const f32x4*)(nw + h * 128 + v0);
#pragma unroll
        for (int tt = 0; tt < 4; ++tt) {
            const int t = 16 * tt + l15; float tot = 0.f;
#pragma unroll
            for (int ww = 0; ww < 8; ++ww) tot += rsq[ww * 64 + t];
            const float rstd = __builtin_amdgcn_rsqf(tot * (1.0f / 128.0f) + RMS_EPS);
            const u32x2 gg = gr[tt];
            u32x2 y; y.x = pk2(o[tt][0] * rstd * nw4[0] * bf_lo(gg.x), o[tt][1] * rstd * nw4[1] * bf_hi(gg.x)); y.y = pk2(o[tt][2] * rstd * nw4[2] * bf_lo(gg.y), o[tt][3] * rstd * nw4[3] * bf_hi(gg.y));
            *(u32x2*)(yb + (row0 + t) * 1024 + 512 + h * 128 + v0) = y;
        }
        __syncthreads();
#pragma unroll
        for (int j = 0; j < 4; ++j) lfr[j] = lfn[j];
        qr[0] = qn[0]; qr[1] = qn[1]; ir[0] = in_[0]; ir[1] = in_[1];
#pragma unroll
        for (int j = 0; j < 4; ++j) { sf[j] = sfn[j]; gr[j] = grn[j]; }
    }
}
#undef H3_LOAD_LATE

#include <hip/hip_bf16.h>
#include <cmath>
namespace attn_body {
using bf16=__hip_bfloat16;
using bf16x8=__attribute__((ext_vector_type(8)))short;
using s16x4=__attribute__((ext_vector_type(4)))short;
using f32x16=__attribute__((ext_vector_type(16)))float;
using u32x4=__attribute__((ext_vector_type(4)))unsigned;
constexpr int BATCH=8,NHEAD=8,SEQ=4096,D=64,PIN=5632,POUT=1024,PKM=512;
constexpr int NW=8,QBLK=32,QB=QBLK*NW,KVBLK=64,NQB=SEQ/QB;
constexpr int ATTN_UNIT_ROWS=QB;
__device__ __forceinline__ int crow(int r,int hi){return (r&3)+8*(r>>2)+4*hi;}
#define SBAR() __builtin_amdgcn_sched_barrier(0)
__device__ __forceinline__ void cmask(f32x16&p0,f32x16&p1,int jb,int qrel,int hi){
  const float NEG=-INFINITY; int kb=64*jb+4*hi;
  #pragma unroll
  for(int r=0;r<16;++r){int kv=kb+(r&3)+8*(r>>2); if(kv>qrel)p0[r]=NEG; if(kv+32>qrel)p1[r]=NEG;}
}

__device__ __forceinline__ void smask(f32x16&p0,f32x16&p1,unsigned selm,int n){ if(!((selm>>n)&1u)){ const float NEG=-INFINITY;
  #pragma unroll
  for(int r=0;r<16;++r){p0[r]=NEG;p1[r]=NEG;} } }
constexpr int NSLOT=3, SLOTB=8192;
constexpr int LDS_K=0, LDS_V=NSLOT*SLOTB, LDS_WS=2*NSLOT*SLOTB, LDS_OST=LDS_WS+NW*64*4, LDS_BYTES=LDS_OST+NW*4096;
constexpr float C2=0.125f*1.4426950408889634f;
__device__ __forceinline__ void glds16(const void*gsrc,unsigned lds_dst){unsigned keep;
  asm volatile("s_mov_b32 %0, m0\n\ts_mov_b32 m0, %2\n\ts_nop 0\n\tglobal_load_lds_dwordx4 %1, off\n\ts_mov_b32 m0, %0":"=&s"(keep):"v"(gsrc),"s"(lds_dst):"memory");}
__device__ __forceinline__ float max3f(float a,float b,float c){float r;asm("v_max3_f32 %0, %1, %2, %3":"=v"(r):"v"(a),"v"(b),"v"(c));return r;}
__device__ __forceinline__ float max2f(float a,float b){float r;asm("v_max_f32_e32 %0, %1, %2":"=v"(r):"v"(a),"v"(b));return r;}
__device__ __forceinline__ float fadd_s(float a,float b){float r;asm("v_add_f32_e32 %0, %1, %2":"=v"(r):"v"(a),"v"(b));return r;}
__device__ __forceinline__ float fsub_s(float a,float b){float r;asm("v_sub_f32_e32 %0, %1, %2":"=v"(r):"v"(a),"v"(b));return r;}
typedef float f32x2_t __attribute__((ext_vector_type(2))); typedef __bf16 bf16x2_t __attribute__((ext_vector_type(2)));
__device__ __forceinline__ unsigned cvtpk_s(float lo,float hi){f32x2_t v={lo,hi};bf16x2_t b=__builtin_convertvector(v,bf16x2_t);return __builtin_bit_cast(unsigned,b);}
#define WAIT_BAR(N) asm volatile("s_waitcnt vmcnt(" #N ") lgkmcnt(0)\n\ts_barrier":::"memory")

__device__ __forceinline__ void qkt(f32x16&p0,f32x16&p1,const char*Kslot,const bf16x8*qr,int r32,int hi){
  const char*kb=Kslot+hi*1024+r32*16;
  #pragma unroll
  for(int d0=0;d0<4;++d0){
    const bf16x8 b0=*reinterpret_cast<const bf16x8*>(kb+d0*2048);
    const bf16x8 b1=*reinterpret_cast<const bf16x8*>(kb+d0*2048+512);
    if(d0==0){p0=__builtin_amdgcn_mfma_f32_32x32x16_bf16(b0,qr[0],f32x16{},0,0,0);p1=__builtin_amdgcn_mfma_f32_32x32x16_bf16(b1,qr[0],f32x16{},0,0,0);}
    else{p0=__builtin_amdgcn_mfma_f32_32x32x16_bf16(b0,qr[d0],p0,0,0,0);p1=__builtin_amdgcn_mfma_f32_32x32x16_bf16(b1,qr[d0],p1,0,0,0);}}
}
typedef __attribute__((address_space(3))) const char* lds_cptr;
typedef short v4i16_t __attribute__((ext_vector_type(4)));
__device__ __forceinline__ void kload8(bf16x8*kf,lds_cptr kp){
  kf[0]=*(const __attribute__((address_space(3))) bf16x8*)(kp);      kf[1]=*(const __attribute__((address_space(3))) bf16x8*)(kp+512);
  kf[2]=*(const __attribute__((address_space(3))) bf16x8*)(kp+2048); kf[3]=*(const __attribute__((address_space(3))) bf16x8*)(kp+2560);
  kf[4]=*(const __attribute__((address_space(3))) bf16x8*)(kp+4096); kf[5]=*(const __attribute__((address_space(3))) bf16x8*)(kp+4608);
  kf[6]=*(const __attribute__((address_space(3))) bf16x8*)(kp+6144); kf[7]=*(const __attribute__((address_space(3))) bf16x8*)(kp+6656);
}
__device__ __forceinline__ void kload2(bf16x8*kf,lds_cptr kp,int j){ kf[2*j]=*(const __attribute__((address_space(3))) bf16x8*)(kp+j*2048); kf[2*j+1]=*(const __attribute__((address_space(3))) bf16x8*)(kp+j*2048+512); }
__device__ __forceinline__ s16x4 vtr(lds_cptr p){ return __builtin_bit_cast(s16x4,__builtin_amdgcn_ds_read_tr16_b64_v4i16((__attribute__((address_space(3))) v4i16_t*)p)); }
__device__ __forceinline__ float rowmax(const f32x16&p0,const f32x16&p1){
  float a=max3f(p0[0],p0[1],p1[0]),b=max3f(p0[2],p0[3],p1[1]);a=max3f(a,p1[2],p1[3]);
  #pragma unroll
  for(int r=4;r<16;r+=4){a=max3f(a,p0[r],p0[r+1]);b=max3f(b,p0[r+2],p0[r+3]);a=max3f(a,p1[r],p1[r+1]);b=max3f(b,p1[r+2],p1[r+3]);}
  const float m=max2f(a,b);
  auto rr=__builtin_amdgcn_permlane32_swap(__float_as_uint(m),__float_as_uint(m),false,false);
  return max2f(__uint_as_float(rr[0]),__uint_as_float(rr[1]));
}
__device__ __forceinline__ void pv(f32x16*o,int vb,bf16x8 pa0,bf16x8 pa1,bf16x8 pa2,bf16x8 pa3){
  #pragma unroll
  for(int d0=0;d0<2;++d0){s16x4 lo[4],hi[4];
    #pragma unroll
    for(int ks=0;ks<4;++ks){
      asm volatile("ds_read_b64_tr_b16 %0,%1 offset:%c2":"=&v"(lo[ks]):"v"(vb),"i"(d0*4096+ks*1024):"memory");
      asm volatile("ds_read_b64_tr_b16 %0,%1 offset:%c2":"=&v"(hi[ks]):"v"(vb),"i"(d0*4096+ks*1024+512):"memory");}
    asm volatile("s_waitcnt lgkmcnt(0)":::"memory");SBAR();
    #define PK(k) (bf16x8){lo[k][0],lo[k][1],lo[k][2],lo[k][3],hi[k][0],hi[k][1],hi[k][2],hi[k][3]}
    o[d0]=__builtin_amdgcn_mfma_f32_32x32x16_bf16(pa0,PK(0),o[d0],0,0,0);
    o[d0]=__builtin_amdgcn_mfma_f32_32x32x16_bf16(pa1,PK(1),o[d0],0,0,0);
    o[d0]=__builtin_amdgcn_mfma_f32_32x32x16_bf16(pa2,PK(2),o[d0],0,0,0);
    o[d0]=__builtin_amdgcn_mfma_f32_32x32x16_bf16(pa3,PK(3),o[d0],0,0,0);
    #undef PK
  }
}

#ifndef ATTN_STORE16
#define ATTN_STORE16(p,v) (*(u32x4*)(p)=(v))
#endif
template<int THRL> __device__ __forceinline__ void attn_unit(int wave_,int b,int h,int qb,const bf16*Q,const bf16*__restrict__ K,const bf16*__restrict__ V,const bf16*__restrict__ KM,bf16*O,char*shm){
  const int lane=lane_id_(),tid=wave_*64+lane,r32=lane&31,hi=lane>>5; const int wid=wave_;
  const long rowbase=(long)b*SEQ; const int q0=qb*QB;
  const bf16*Qw=Q+(rowbase+q0+wid*QBLK)*PIN+h*D;
  const bf16*Kh=K+rowbase*PIN+h*D,*Vh=V+rowbase*PIN+h*D;
  const unsigned lds0=(unsigned)(uintptr_t)shm;
  float*wsf=(float*)(shm+LDS_WS)+wid*64;
  const bf16*ksrc=Kh+(long)lane*PIN+wid*8;
  const bf16*kmsrc=KM+((long)b*64+lane)*PKM+h*D+wid*8;
  const bf16*vsrc=Vh+(long)(16*(wid&3)+(lane>>2))*PIN+(wid>>2)*32+(lane&3)*8;
  const unsigned kdst=lds0+LDS_K+wid*1024, vdst=lds0+LDS_V+wid*1024;
  #define DMA_K(t,slot) glds16(ksrc+(long)(t)*KVBLK*PIN,(unsigned)__builtin_amdgcn_readfirstlane(kdst+(slot)))
  #define DMA_V(t,slot) glds16(vsrc+(long)(t)*KVBLK*PIN,(unsigned)__builtin_amdgcn_readfirstlane(vdst+(slot)))
  const int vb0=(int)(lds0+LDS_V)+((lane>>4)&1)*32+(lane&3)*8+(4*hi+((lane&15)>>2))*64;
  const char*Kbase=shm+LDS_K; bf16x8 kf[8];
  const lds_cptr shm3=(lds_cptr)shm; const lds_cptr kp0=shm3+LDS_K+hi*1024+r32*16; const lds_cptr vp0=shm3+LDS_V+((lane>>4)&1)*32+(lane&3)*8+(4*hi+((lane&15)>>2))*64;
  const int NT=(q0+QB)/KVBLK;
  glds16(kmsrc,(unsigned)__builtin_amdgcn_readfirstlane(lds0+LDS_V+2*SLOTB+wid*1024));
  DMA_K(0,0);DMA_V(0,0);DMA_K(1,SLOTB);
  bf16x8 qr[4];
  #pragma unroll
  for(int d0=0;d0<4;++d0)qr[d0]=*reinterpret_cast<const bf16x8*>(&Qw[(long)r32*PIN+d0*16+hi*8]);
  float mhat=0.f,l_reg=0.f;f32x16 o[2];o[0]=f32x16{};o[1]=f32x16{};
  const int qrel=wid*QBLK+r32;
  #define CMASK(P0,P1,t) do{int jb_=(t)-(NT-4); const float sb_=(jb_>=0||((selm>>((t)>>2))&1u))?mhat:INFINITY; _Pragma("unroll") for(int r_=0;r_<16;++r_){P0[r_]-=sb_;P1[r_]-=sb_;} if(jb_>=0)cmask(P0,P1,jb_,qrel,hi);}while(0)
  bool resc=false;
  #define START(P0,P1) do{ const float rm=rowmax(P0,P1); resc=false; \
    { const float dl=(rm>-1.0e30f)?rm:0.f; mhat=fadd_s(mhat,dl); \
      _Pragma("unroll") for(int r=0;r<16;++r){P0[r]=fsub_s(P0[r],dl);P1[r]=fsub_s(P1[r],dl);} \
      } \
    _Pragma("unroll") for(int r=0;r<16;++r)P0[r]=__builtin_amdgcn_exp2f(P0[r]); }while(0)
  #define RESC() do{ if(resc){ asm volatile("s_waitcnt lgkmcnt(0)":::"memory"); \
      _Pragma("unroll") for(int d_=0;d_<2;++d_) _Pragma("unroll") for(int r=0;r<16;++r)o[d_][r]*=wsf[crow(r,hi)]; } }while(0)
  f32x16 pA0,pA1,pB0,pB1;
  int sl_prev=0,sl_cur=0,sl_next=SLOTB;
  #define ROT() do{sl_prev=sl_cur;sl_cur=sl_next;sl_next=(sl_next==(NSLOT-1)*SLOTB)?0:sl_next+SLOTB;}while(0)
  DMA_K(2,2*SLOTB);
  unsigned selm=0u;
  WAIT_BAR(4);
  { f32x16 g0,g1;
    qkt(g0,g1,shm+LDS_V+2*SLOTB,qr,r32,hi); asm volatile("s_nop 15\n\ts_nop 7":"+v"(g0),"+v"(g1));
    float gm[8],go[8],g[16];
    #pragma unroll
    for(int r=0;r<8;++r){gm[r]=g0[r];go[r]=__shfl_xor(gm[r],32);}
    #pragma unroll
    for(int j=0;j<4;++j){ g[j]=hi?go[j]:gm[j]; g[4+j]=hi?gm[j]:go[j]; g[8+j]=hi?go[4+j]:gm[4+j]; g[12+j]=hi?gm[4+j]:go[4+j]; }
    #pragma unroll
    for(int s=0;s<3;++s){ float best=-3.0e38f; int bi=-1;
      #pragma unroll
      for(int n=0;n<16;++n){ const bool ok=(n<qb)&&!((selm>>n)&1u)&&(g[n]>best); if(ok){best=g[n];bi=n;} }
      if(bi>=0)selm|=1u<<bi; } }
  WAIT_BAR(3);
  qkt(pA0,pA1,Kbase,qr,r32,hi);asm volatile("s_nop 15\n\ts_nop 7":"+v"(pA0),"+v"(pA1));CMASK(pA0,pA1,0);
  START(pA0,pA1);
  _Pragma("unroll") for(int r=0;r<16;++r)pA1[r]=__builtin_amdgcn_exp2f(pA1[r]);
  WAIT_BAR(0);
  DMA_K(3,0);DMA_V(1,SLOTB);
  ROT();
  kload8(kf,kp0+sl_cur);
  WAIT_BAR(2);
  s16x4 vlo[8],vhi[8]; u32x4 pw0,pw1,pw2,pw3;
  #define PKW(P,B) cvtpk_s(P[B],P[B+1])
  #define PAF(k) __builtin_bit_cast(bf16x8,pw##k)
  #define VFR(i) (bf16x8){vlo[i][0],vlo[i][1],vlo[i][2],vlo[i][3],vhi[i][0],vhi[i][1],vhi[i][2],vhi[i][3]}
  #define PIN(x) asm volatile("":"+v"(x))
  #define MX3(a,b,c) __builtin_fmaxf(__builtin_fmaxf((a),(b)),(c))
  #define GAPA(MF,A0,A1,A2,A3,W0,W1,PW) do{ MF; sacc+=A0; sacc+=A1; sacc+=A2; sacc+=A3; PIN(sacc); W0; W1; PIN(PW); SBAR(); }while(0)
  #define EX(v) __builtin_amdgcn_exp2f(v)
  #define GAPB(MF,X,B) do{ MF; X[B]=EX(X[B]); X[B+1]=EX(X[B+1]); X[B+2]=EX(X[B+2]); X[B+3]=EX(X[B+3]); PIN(X); SBAR(); }while(0)
  #define VRD(i) do{ vlo[i]=vtr(vp_+(((i)>>2)*4096+((i)&3)*1024)); vhi[i]=vtr(vp_+(((i)>>2)*4096+((i)&3)*1024+512)); }while(0)
  #define KRD(G,j) do{ if(G){ kload2(kf,kp0+sl_next,j); SBAR(); } }while(0)
  #define STEP(C0,C1,P0,P1,t,GK,GV,GL) do{ SBAR(); \
    const lds_cptr vp_=vp0+sl_prev; \
    VRD(0); SBAR(); float sacc=(P0[0]+P0[1]); \
    GAPA(C0=__builtin_amdgcn_mfma_f32_32x32x16_bf16(kf[0],qr[0],f32x16{},0,0,0), P0[2],P0[3],P0[4],P0[5],     pw0[0]=PKW(P0,0), pw0[1]=PKW(P0,2), pw0); \
    VRD(4); SBAR(); GAPA(C1=__builtin_amdgcn_mfma_f32_32x32x16_bf16(kf[1],qr[0],f32x16{},0,0,0), P0[6],P0[7],P0[8],P0[9],     pw0[2]=PKW(P0,4), pw0[3]=PKW(P0,6), pw0); \
    VRD(1); SBAR(); GAPA(C0=__builtin_amdgcn_mfma_f32_32x32x16_bf16(kf[2],qr[1],C0,0,0,0),   P0[10],P0[11],P0[12],P0[13], pw1[0]=PKW(P0,8), pw1[1]=PKW(P0,10), pw1); \
    VRD(5); SBAR(); GAPA(C1=__builtin_amdgcn_mfma_f32_32x32x16_bf16(kf[3],qr[1],C1,0,0,0),   P0[14],P0[15],P1[0],P1[1],   pw1[2]=PKW(P0,12),pw1[3]=PKW(P0,14), pw1); \
    VRD(2); SBAR(); GAPA(C0=__builtin_amdgcn_mfma_f32_32x32x16_bf16(kf[4],qr[2],C0,0,0,0),   P1[2],P1[3],P1[4],P1[5],     pw2[0]=PKW(P1,0), pw2[1]=PKW(P1,2), pw2); \
    VRD(6); SBAR(); GAPA(C1=__builtin_amdgcn_mfma_f32_32x32x16_bf16(kf[5],qr[2],C1,0,0,0),   P1[6],P1[7],P1[8],P1[9],     pw2[2]=PKW(P1,4), pw2[3]=PKW(P1,6), pw2); \
    VRD(3); SBAR(); GAPA(C0=__builtin_amdgcn_mfma_f32_32x32x16_bf16(kf[6],qr[3],C0,0,0,0),   P1[10],P1[11],P1[12],P1[13], pw3[0]=PKW(P1,8), pw3[1]=PKW(P1,10), pw3); \
    VRD(7); SBAR(); GAPA(C1=__builtin_amdgcn_mfma_f32_32x32x16_bf16(kf[7],qr[3],C1,0,0,0),   P1[14],P1[15],0.f,0.f,       pw3[2]=PKW(P1,12),pw3[3]=PKW(P1,14), pw3); \
    l_reg+=sacc; \
    if(GK){DMA_K((t)+3,sl_cur);} if(GV){DMA_V((t)+1,sl_next);} \
    CMASK(C0,C1,t); \
    { float a=MX3(C0[0],C0[1],C1[0]),b=MX3(C0[2],C0[3],C1[1]); a=MX3(a,C1[2],C1[3]); \
      _Pragma("unroll") for(int r=4;r<16;r+=4){a=MX3(a,C0[r],C0[r+1]);b=MX3(b,C0[r+2],C0[r+3]);a=MX3(a,C1[r],C1[r+1]);b=MX3(b,C1[r+2],C1[r+3]);} \
      float rm=__builtin_fmaxf(a,b); { auto rr=__builtin_amdgcn_permlane32_swap(__float_as_uint(rm),__float_as_uint(rm),false,false); rm=__builtin_fmaxf(__uint_as_float(rr[0]),__uint_as_float(rr[1])); } \
      resc=false; \
      if(__builtin_expect(__any(rm>(float)THRL),0)){ const float dl=__builtin_fmaxf(rm,0.f); mhat+=dl; \
        _Pragma("unroll") for(int r=0;r<16;++r){C0[r]-=dl;C1[r]-=dl;} \
        const float f=__builtin_amdgcn_exp2f(-dl); l_reg*=f; if(hi==0)wsf[r32]=f; resc=true; } } \
    SBAR(); \
    GAPB(o[0]=__builtin_amdgcn_mfma_f32_32x32x16_bf16(PAF(0),VFR(0),o[0],0,0,0), C0,0); \
    GAPB(o[1]=__builtin_amdgcn_mfma_f32_32x32x16_bf16(PAF(0),VFR(4),o[1],0,0,0), C0,4); \
    KRD(GL,0); GAPB(o[0]=__builtin_amdgcn_mfma_f32_32x32x16_bf16(PAF(1),VFR(1),o[0],0,0,0), C0,8); \
    KRD(GL,1); GAPB(o[1]=__builtin_amdgcn_mfma_f32_32x32x16_bf16(PAF(1),VFR(5),o[1],0,0,0), C0,12); \
    KRD(GL,2); GAPB(o[0]=__builtin_amdgcn_mfma_f32_32x32x16_bf16(PAF(2),VFR(2),o[0],0,0,0), C1,0); \
    KRD(GL,3); GAPB(o[1]=__builtin_amdgcn_mfma_f32_32x32x16_bf16(PAF(2),VFR(6),o[1],0,0,0), C1,4); \
    GAPB(o[0]=__builtin_amdgcn_mfma_f32_32x32x16_bf16(PAF(3),VFR(3),o[0],0,0,0), C1,8); \
    GAPB(o[1]=__builtin_amdgcn_mfma_f32_32x32x16_bf16(PAF(3),VFR(7),o[1],0,0,0), C1,12); \
    }while(0)
  int t=1;
  #undef CMASK
  #define CMASK(P0,P1,t) do{ const float sb_=((selm>>((t)>>2))&1u)?mhat:INFINITY; _Pragma("unroll") for(int r_=0;r_<16;++r_){P0[r_]-=sb_;P1[r_]-=sb_;} }while(0)
  for(;t+5<NT;t+=2){
    STEP(pB0,pB1,pA0,pA1,t,true,true,true);     WAIT_BAR(2); RESC(); ROT();
    STEP(pA0,pA1,pB0,pB1,t+1,true,true,true);   WAIT_BAR(2); RESC(); ROT();
  }
  #undef CMASK
  #define CMASK(P0,P1,t) do{int jb_=(t)-(NT-4); const float sb_=(jb_>=0||((selm>>((t)>>2))&1u))?mhat:INFINITY; _Pragma("unroll") for(int r_=0;r_<16;++r_){P0[r_]-=sb_;P1[r_]-=sb_;} if(jb_>=0)cmask(P0,P1,jb_,qrel,hi);}while(0)
  #define ENDW(tt) do{ if((tt)+3<NT){WAIT_BAR(2);} else if((tt)+2<NT){WAIT_BAR(1);} else {WAIT_BAR(0);} }while(0)
  for(;t+1<NT;t+=2){
    STEP(pB0,pB1,pA0,pA1,t,(t+3<NT),(t+1<NT),(t+1<NT));       ENDW(t);   RESC(); ROT();
    STEP(pA0,pA1,pB0,pB1,t+1,(t+4<NT),(t+2<NT),(t+2<NT));     ENDW(t+1); RESC(); ROT();
  }
  STEP(pB0,pB1,pA0,pA1,NT-1,false,false,false); RESC();
  { float sacc=pB0[0]+pB0[1]; _Pragma("unroll") for(int r=2;r<16;++r)sacc+=pB0[r]; _Pragma("unroll") for(int r=0;r<16;++r)sacc+=pB1[r]; l_reg+=sacc;
    pw0=(u32x4){PKW(pB0,0),PKW(pB0,2),PKW(pB0,4),PKW(pB0,6)};pw1=(u32x4){PKW(pB0,8),PKW(pB0,10),PKW(pB0,12),PKW(pB0,14)};pw2=(u32x4){PKW(pB1,0),PKW(pB1,2),PKW(pB1,4),PKW(pB1,6)};pw3=(u32x4){PKW(pB1,8),PKW(pB1,10),PKW(pB1,12),PKW(pB1,14)};
    SBAR(); pv(o,vb0+sl_cur,PAF(0),PAF(1),PAF(2),PAF(3)); }
  #undef PKW
  #undef PAF
  #undef VFR
  #undef PIN
  #undef MX3
  #undef GAPA
  #undef GAPB
  #undef EX
  #undef VRD
  #undef KRD
  #undef STEP
  #undef ENDW
  {auto rr=__builtin_amdgcn_permlane32_swap(__float_as_uint(l_reg),__float_as_uint(l_reg),false,false);l_reg=__uint_as_float(rr[0])+__uint_as_float(rr[1]);}
  if(hi==0)wsf[32+r32]=l_reg;asm volatile("s_waitcnt lgkmcnt(0)":::"memory");
  float rli[16];
  #pragma unroll
  for(int r=0;r<16;++r)rli[r]=__builtin_amdgcn_rcpf(wsf[32+crow(r,hi)]);
  bf16*Ow=O+(rowbase+q0+wid*QBLK)*POUT+h*D;
  { bf16*stg=(bf16*)(shm+LDS_OST)+wid*2048;
    #pragma unroll
    for(int r=0;r<16;++r){const int orow=crow(r,hi);
      #pragma unroll
      for(int d0=0;d0<2;++d0)stg[orow*64+d0*32+r32]=__float2bfloat16(o[d0][r]*rli[r]);}
    asm volatile("s_waitcnt lgkmcnt(0)":::"memory");
    #pragma unroll
    for(int i=0;i<4;++i){const int row=i*8+(lane>>3),ch=lane&7; const u32x4 v=*(const u32x4*)(stg+row*64+ch*8); ATTN_STORE16(Ow+(long)row*POUT+ch*8,v);} }
  asm volatile("s_waitcnt lgkmcnt(0)\n\ts_barrier":::"memory");
  #undef DMA_K
  #undef DMA_V
  #undef CMASK
  #undef START
  #undef RESC
  #undef ROT
}
constexpr int ATTN_LDS_BYTES=LDS_BYTES;
struct AttnTensors { const bf16* Q; const bf16* K; const bf16* V; const bf16* KM; bf16* O; };
struct AttnUnit { int bh; int qb; };
struct StaticOrder {
  int vcu,G,blk;
  __device__ __forceinline__ explicit StaticOrder(int grid,int block):vcu((grid%8==0)?(block%8)*(grid/8)+block/8:block),G(grid),blk(block){}
  __device__ __forceinline__ bool next(int i,AttnUnit&u)const{
    if(G==256){ if(i>=4)return false; const int s=vcu&3; u.bh=vcu>>2; u.qb=(i==0)?s:(i==1)?7-s:(i==2)?8+s:15-s; return true; }
    const int idx=i*G+blk; if(idx>=BATCH*NHEAD*NQB)return false; u.bh=idx/NQB; u.qb=idx%NQB; return true; }
  __device__ __forceinline__ void a_ready(const AttnUnit&)const{}
  __device__ __forceinline__ void done(const AttnUnit&)const{}
};
template<class Sched,int THRL=8> __device__ __forceinline__ void attn_phase(char*lds,const AttnTensors&T,const Sched&S,int wave_){
  AttnUnit u;
  for(int i=0;S.next(i,u);++i){ S.a_ready(u); attn_unit<THRL>(wave_,u.bh/NHEAD,u.bh%NHEAD,u.qb,T.Q,T.K,T.V,T.KM,T.O,lds); S.done(u); }
}
#undef SBAR
#undef WAIT_BAR
}

template <bool DRY = false> __device__ __forceinline__ void p6_route(const Frame& F0, const Args& a) {
    const Frame F = fresh(F0);
    const bf16_t* x1 = (const bf16_t*)(a.ws + WS_X1); bf16_t* xn = (bf16_t*)(a.ws + WS_XN); const float* rw = a.in[I_RW]; const float* rb = a.in[I_RB]; const float* n2 = a.in[I_N2];
    unsigned* cnt = (unsigned*)(a.ws + WS_CTL) + CW_CNT; int* rows = (int*)(a.ws + WS_ROWS); float* roww = (float*)(a.ws + WS_ROWW);
    constexpr int HP2 = 1040;
    LAS float* H2 = (LAS float*)F.lds;
    LAS float* PL = (LAS float*)(F.lds + 16 * HP2 * 4);
    LAS int* lcnt = (LAS int*)(F.lds + MISC_OFF); LAS int* lbase = lcnt + 32; LAS int* ae = lbase + 32; LAS int* ap = ae + 512; LAS float* aw = (LAS float*)(ap + 512); LAS float* hsrow = aw + 512;
    float* rowhs = (float*)(a.ws + WS_ROWHS);
    const int lane = F.lane, e = lane & 31, w = F.wave, l15 = lane & 15, kq = lane >> 4;
    float rwq[8][4][2];
#pragma unroll
    for (int g = 0; g < 8; ++g)
#pragma unroll
        for (int s = 0; s < 4; ++s)
#pragma unroll
            for (int h = 0; h < 2; ++h) rwq[g][s][h] = rw[(size_t)(128 * w + 16 * g + 4 * kq + s) * NE + 16 * h + l15];
    const float bias = rb[e];
    for (int blk = F.bid; blk < NTOK / 128; blk += F.G) {
        if (F.tid < 32) lcnt[F.tid] = 0;
        u32x2 xq[2][4];
#pragma unroll
        for (int rr = 0; rr < 2; ++rr) { const u32x2* xr = (const u32x2*)(x1 + ((size_t)blk * 128 + 2 * w + rr) * DM) + lane;
#pragma unroll
            for (int j = 0; j < 4; ++j) xq[rr][j] = __builtin_nontemporal_load(xr + 64 * j); }
#pragma unroll 1
        for (int sub = 0; sub < 8; ++sub) {
#pragma unroll
            for (int rr = 0; rr < 2; ++rr) {
                const int rl = 2 * w + rr; const size_t row = (size_t)blk * 128 + sub * 16 + rl;
                const f32x4* wr = (const f32x4*)n2 + lane;
                f32x4 v[4]; float s = 0.f;
#pragma unroll
                for (int j = 0; j < 4; ++j) { const u32x2 xw = xq[rr][j]; v[j] = (f32x4){bf_lo(xw.x), bf_hi(xw.x), bf_lo(xw.y), bf_hi(xw.y)}; s += (v[j].x * v[j].x + v[j].y * v[j].y) + (v[j].z * v[j].z + v[j].w * v[j].w); }
                const float rstd = __builtin_amdgcn_rsqf(wave_sum(s) * (1.0f / DM) + RMS_EPS);
                u32x2* o8 = (u32x2*)(xn + row * DM) + lane; unsigned* o4 = (unsigned*)((unsigned char*)xn + row * DM) + lane;
#pragma unroll
                for (int j = 0; j < 4; ++j) { const f32x4 ww = wr[64 * j]; const f32x4 hv = v[j] * rstd * ww;
                    if constexpr (MOE1_I8) v[j] = hv;
                    else if constexpr (MOE_FP8) o4[64 * j] = pk4_fp8(hv.x, hv.y, hv.z, hv.w, S_H2);
                    else { u32x2 o; o.x = pk2(hv.x, hv.y); o.y = pk2(hv.z, hv.w); o8[64 * j] = o; }
                    *(LAS f32x4*)(H2 + rl * HP2 + 256 * j + 4 * lane) = hv; }
                if constexpr (MOE1_I8) {
                    float am = 0.f;
#pragma unroll
                    for (int j = 0; j < 4; ++j) am = fmaxf(fmaxf(am, fmaxf(fabsf(v[j].x), fabsf(v[j].y))), fmaxf(fabsf(v[j].z), fabsf(v[j].w)));
                    am = wave_max(am); const float inv = am > 0.f ? 127.0f / am : 0.f;
#pragma unroll
                    for (int j = 0; j < 4; ++j) o4[64 * j] = pk4_i8(v[j].x * inv, v[j].y * inv, v[j].z * inv, v[j].w * inv);
                    if (lane == 0) hsrow[sub * 16 + rl] = am * (1.0f / 127.0f); }
            }
            if (sub < 7) {
#pragma unroll
                for (int rr = 0; rr < 2; ++rr) { const u32x2* xr = (const u32x2*)(x1 + ((size_t)blk * 128 + (sub + 1) * 16 + 2 * w + rr) * DM) + lane;
#pragma unroll
                    for (int j = 0; j < 4; ++j) xq[rr][j] = __builtin_nontemporal_load(xr + 64 * j); }
            }
            __syncthreads();
            {
                f32x4 acc0 = {0.f, 0.f, 0.f, 0.f}, acc1 = {0.f, 0.f, 0.f, 0.f};
#pragma unroll
                for (int g = 0; g < 8; ++g) {
                    const f32x4 hq = *(const LAS f32x4*)(H2 + l15 * HP2 + 128 * w + 16 * g + 4 * kq);
#pragma unroll
                    for (int s = 0; s < 4; ++s) { acc0 = __builtin_amdgcn_mfma_f32_16x16x4f32(hq[s], rwq[g][s][0], acc0, 0, 0, 0); acc1 = __builtin_amdgcn_mfma_f32_16x16x4f32(hq[s], rwq[g][s][1], acc1, 0, 0, 0); }
                }
#pragma unroll
                for (int r = 0; r < 4; ++r) { PL[(w * 16 + 4 * kq + r) * 32 + l15] = acc0[r]; PL[(w * 16 + 4 * kq + r) * 32 + 16 + l15] = acc1[r]; }
            }
            __syncthreads();
            {
                const int rl = 2 * w + (lane >> 5); float val = bias;
#pragma unroll
                for (int ww = 0; ww < 8; ++ww) val += PL[(ww * 16 + rl) * 32 + e];
                float tv[4]; int te[4];
#pragma unroll
                for (int k = 0; k < 4; ++k) {
                    float bv = val; int bi = e;
#pragma unroll
                    for (int o = 1; o < 32; o <<= 1) { const float ov = __shfl_xor(bv, o); const int oi = __shfl_xor(bi, o); if (ov > bv || (ov == bv && oi < bi)) { bv = ov; bi = oi; } }
                    tv[k] = bv; te[k] = bi; if (e == bi) val = -3.0e38f;
                }
                if (e == 0) {
                    const float p1 = __expf(tv[1] - tv[0]), p2 = __expf(tv[2] - tv[0]), p3 = __expf(tv[3] - tv[0]); const float inv = 1.0f / (1.0f + p1 + p2 + p3);
                    const float w4[4] = {inv, p1 * inv, p2 * inv, p3 * inv};
                    const int rb_ = sub * 16 + rl;
#pragma unroll
                    for (int k = 0; k < 4; ++k) { const int pos = atomicAdd((int*)&lcnt[te[k]], 1); ae[rb_ * 4 + k] = te[k]; ap[rb_ * 4 + k] = pos; aw[rb_ * 4 + k] = w4[k]; }
                }
            }
        }
        __syncthreads();
        if (!DRY) { if (F.tid < 32) lbase[F.tid] = (int)__hip_atomic_fetch_add(cnt + F.tid, (unsigned)lcnt[F.tid], __ATOMIC_RELAXED, __HIP_MEMORY_SCOPE_AGENT); }
        __syncthreads();
        if (!DRY) { const int ee = ae[F.tid]; const size_t p = (size_t)ee * CAP + lbase[ee] + ap[F.tid]; rows[p] = blk * 512 + F.tid; roww[p] = aw[F.tid]; if constexpr (MOE1_I8) rowhs[p] = hsrow[F.tid >> 2]; }
        __syncthreads();
    }
}
__device__ __forceinline__ int moe_tiles(const Frame& F, const Args& a, LAS int* ts) {
    if (F.tid == 0) { const unsigned* cnt = (const unsigned*)(a.ws + WS_CTL) + CW_CNT; int acc = 0;
        for (int e = 0; e < NE; ++e) { const int c = (int)__hip_atomic_load(cnt + e, __ATOMIC_RELAXED, __HIP_MEMORY_SCOPE_AGENT); ts[e] = acc; ts[33 + e] = c; acc += (c + 255) >> 8; }
        ts[32] = acc; }
    __syncthreads();
    return ts[32];
}
__device__ __forceinline__ void p9_final(const Frame& F0, const Args& a) {
    const Frame F = fresh(F0);
    float* out = a.out; const bf16_t* yg = (const bf16_t*)(a.ws + WS_YG); const float* fw = a.in[I_FNW]; const bf16_t* x1 = (const bf16_t*)(a.ws + WS_X1);
    const int gw = F.bid * 8 + F.wave, NGW = F.G * 8;
    for (int row = gw; row < NTOK; row += NGW) {
        f32x4* xr = (f32x4*)(out + (size_t)row * DM) + F.lane;
        f32x4 v[4]; const u32x2* x1r = (const u32x2*)(x1 + (size_t)row * DM) + F.lane;
#pragma unroll
        for (int j = 0; j < 4; ++j) { const u32x2 xw = __builtin_nontemporal_load(x1r + 64 * j); v[j] = (f32x4){bf_lo(xw.x), bf_hi(xw.x), bf_lo(xw.y), bf_hi(xw.y)}; }
#pragma unroll
        for (int k = 0; k < 4; ++k) {
            if constexpr (MOE_FP8) { const unsigned* yp = (const unsigned*)((const unsigned char*)yg + ((size_t)row * 4 + k) * DM) + F.lane;
#pragma unroll
                for (int j = 0; j < 4; ++j) { const unsigned w = __builtin_nontemporal_load(yp + 64 * j); const f32x2 lo = __builtin_amdgcn_cvt_pk_f32_fp8(w, false), hi = __builtin_amdgcn_cvt_pk_f32_fp8(w, true);
                    v[j].x += lo.x * (1.0f / S_YG); v[j].y += lo.y * (1.0f / S_YG); v[j].z += hi.x * (1.0f / S_YG); v[j].w += hi.y * (1.0f / S_YG); } }
            else { const u32x2* yp = (const u32x2*)(yg + ((size_t)row * 4 + k) * DM) + F.lane;
#pragma unroll
                for (int j = 0; j < 4; ++j) { const u32x2 w = yp[64 * j]; v[j].x += bf_lo(w.x); v[j].y += bf_hi(w.x); v[j].z += bf_lo(w.y); v[j].w += bf_hi(w.y); } } }
        float s = 0.f;
#pragma unroll
        for (int j = 0; j < 4; ++j) s += (v[j].x * v[j].x + v[j].y * v[j].y) + (v[j].z * v[j].z + v[j].w * v[j].w);
        const float rstd = 1.0f / sqrtf(wave_sum(s) * (1.0f / DM) + RMS_EPS);
        const f32x4* wr = (const f32x4*)fw + F.lane;
#pragma unroll
        for (int j = 0; j < 4; ++j) xr[64 * j] = v[j] * rstd * wr[64 * j];
    }
}

#define XB_TMO      128
#define XB_XCNT(j)  (256  + 64 * (j))
#define XB_XSUB(j)  (1280 + 64 * (j))
#define XB_XGEN(j)  (2304 + 64 * (j))
#define XB_TOP      3328
#define XB_TOPGEN   3392
#define XCD_BAR_WORDS 3456
#define XB_SPIN_CAP (1u << 18)

__device__ __forceinline__ unsigned xb_ld(unsigned* p)              { return __hip_atomic_load(p, __ATOMIC_RELAXED, __HIP_MEMORY_SCOPE_AGENT); }
__device__ __forceinline__ unsigned xb_add(unsigned* p, unsigned v) { return __hip_atomic_fetch_add(p, v, __ATOMIC_RELAXED, __HIP_MEMORY_SCOPE_AGENT); }
__device__ __forceinline__ unsigned xb_xcc_id() { return (unsigned)__builtin_amdgcn_s_getreg((3 << 11) | 20) & 0xFu; }
#define XB_SPIN(cond, bar) do { unsigned _sp = 0; while (cond) { __builtin_amdgcn_s_sleep(1); \
    if ((++_sp & 255u) == 0u) { if (xb_ld(&(bar)[XB_TMO])) break; if (_sp > XB_SPIN_CAP) { atomicAdd(&(bar)[XB_TMO], 1u); break; } } } } while (0)

struct XcdBarrier {
    unsigned* bar; unsigned x; int w;
    volatile LAS unsigned* st;
};

__device__ __forceinline__ XcdBarrier xcd_barrier_post(unsigned* bar, volatile LAS unsigned* st) {
    XcdBarrier b; b.bar = bar; b.x = xb_xcc_id(); b.st = st;
    if (threadIdx.x == 0) (void)xb_add(&bar[XB_XCNT(b.x)], 1u);
    return b;
}
__device__ __forceinline__ void xcd_barrier_complete(unsigned* bar, unsigned x, unsigned& nloc, unsigned& nx) {
    const unsigned G = gridDim.x * gridDim.y * gridDim.z;
    unsigned sum, cnt, mine, sp = 0u;
    for (;;) {
        sum = 0u; cnt = 0u; mine = 0u;
#pragma unroll
        for (unsigned j = 0; j < 16; ++j) { const unsigned c = xb_ld(&bar[XB_XCNT(j)]); sum += c; cnt += (c > 0u) ? 1u : 0u; mine = (j == x) ? c : mine; }
        if (sum == G) break;
        __builtin_amdgcn_s_sleep(1);
        if ((++sp & 255u) == 0u) { if (xb_ld(&bar[XB_TMO])) break; if (sp > XB_SPIN_CAP) { atomicAdd(&bar[XB_TMO], 1u); break; } }
    }
    nloc = mine > 0u ? mine : 1u; nx = cnt > 0u ? cnt : 1u;
}

__device__ __forceinline__ void xcd_barrier(const XcdBarrier& b) {
    asm volatile("s_waitcnt vmcnt(0)" ::: "memory");
    __syncthreads();
    if (b.w == 0 && lane_id_() == 0) {
        unsigned* bar = b.bar;
        __builtin_amdgcn_s_waitcnt(0);
        unsigned nloc = b.st[0], nx = b.st[1];
        if (nloc == 0u) { xcd_barrier_complete(bar, b.x, nloc, nx); b.st[0] = nloc; b.st[1] = nx; }
        const unsigned old = xb_add(&bar[XB_XSUB(b.x)], 1u);
        const unsigned gen = old / nloc;
        if (old + 1u == (gen + 1u) * nloc) {
            __builtin_amdgcn_fence(__ATOMIC_RELEASE, "agent");
            asm volatile("s_waitcnt vmcnt(0)" ::: "memory");
            const unsigned og = xb_add(&bar[XB_TOP], 1u);
            const unsigned tg = og / nx;
            if (og + 1u == (tg + 1u) * nx) xb_add(&bar[XB_TOPGEN], 1u);
            else XB_SPIN(xb_ld(&bar[XB_TOPGEN]) == tg, bar);
            __builtin_amdgcn_fence(__ATOMIC_ACQUIRE, "agent");
            xb_add(&bar[XB_XGEN(b.x)], 1u);
            asm volatile("s_waitcnt vmcnt(0)" ::: "memory");
        } else {
            XB_SPIN(xb_ld(&bar[XB_XGEN(b.x)]) == gen, bar);
            __builtin_amdgcn_fence(__ATOMIC_ACQUIRE, "agent");
            asm volatile("s_waitcnt vmcnt(0)" ::: "memory");
        }
    }
    __syncthreads();
}


__global__ void __launch_bounds__(512, 2) fwd_kernel(Args args) {
    extern __shared__ __attribute__((aligned(16))) unsigned char lds_raw[];
    Frame F; F.lds = (LAS unsigned char*)lds_raw; F.tid = threadIdx.x; F.lane = F.tid & 63; F.wave = __builtin_amdgcn_readfirstlane(F.tid >> 6); F.G = gridDim.x; F.bid = blockIdx.x;
#if USE_COOP
    cg::grid_group grid = cg::this_grid();
#endif
    volatile LAS unsigned* MISCW = (volatile LAS unsigned*)(F.lds + LDS_BYTES - 256);
    if (F.tid < 64) MISCW[F.tid] = 0u;
    __syncthreads();
    XcdBarrier xbar = xcd_barrier_post((unsigned*)(args.ws + WS_CTL) + CW_BAR, MISCW + 8); xbar.w = F.wave;
    unsigned char* ws = args.ws;
    const int lo = args.ph_lo, hi = args.ph_hi;
#ifndef REPMASK
#define REPMASK 0
#endif
#define NREP(k) (((REPMASK) >> (k)) & 1 ? 2 : 1)
#define IN(k) (lo <= (k) && (k) < hi)
#if USE_COOP
#define SEAM(k) do { if (IN(k) && IN((k) + 1)) xcd_barrier(xbar); } while (0)
#else
#define SEAM(k) do { if (IN(k) && IN((k) + 1)) xcd_barrier(xbar); } while (0)
#endif
    bf16_t* proj = (bf16_t*)(ws + WS_PROJ);

#if USE_COOP
    if (lo < 0) grid.sync();
#endif
    if (IN(0)) for (int rep_ = 0; rep_ < NREP(0); ++rep_) { p0_prologue(F, args); } SEAM(0);
    if (IN(1)) for (int rep_ = 0; rep_ < NREP(1); ++rep_) {
        pg8::Gemm g{(const bf16_t*)(ws + WS_XN), (const bf16_t*)(ws + WS_WIN), DIN, DM, nullptr, (const float*)(ws + WS_XS), (const float*)(ws + WS_WINS)};
        pg8::DenseSched S; S.o.init(NTOK / 256, DIN / 256, F.G, F.bid);
        EpiProj E{proj, (float*)(ws + WS_LOGF), (const float*)(ws + WS_ROPE), (const float*)(ws + WS_LB)};
        pg8::gemm_phase<EpiProj, pg8::DenseSched, false, false, false, false, P1_I8>(F.lds, g, S, E, F.wave);
    } SEAM(1);
    if (IN(2)) for (int rep_ = 0; rep_ < NREP(2); ++rep_) { p2_kmean(F, args); h1_local_states_p(F, args); } SEAM(2);
    if (IN(3)) {
        h2_scan(F, args);
        const attn_body::AttnTensors AT{(const attn_body::bf16*)(proj + C_QA), (const attn_body::bf16*)(proj + C_KA), (const attn_body::bf16*)(proj + C_VA), (const attn_body::bf16*)(ws + WS_KMEAN), (attn_body::bf16*)(ws + WS_YA)};
        const attn_body::StaticOrder AS((int)F.G, (int)F.bid);
        for (int rep_ = 0; rep_ < NREP(3); ++rep_) attn_body::attn_phase<attn_body::StaticOrder>((char*)lds_raw, AT, AS, F.wave);
    } SEAM(3);
    if (IN(4)) for (int rep_ = 0; rep_ < NREP(4); ++rep_) { h3_outputs_p(F, args); } SEAM(4);
    if (IN(5)) for (int rep_ = 0; rep_ < NREP(5); ++rep_) {
        pg8::DenseSched S; S.o.init(NTOK / 256, DM / 256, F.G, F.bid);
        pg8::Gemm g{(const bf16_t*)(ws + WS_YA), (const bf16_t*)(ws + WS_MUP), DM, DM, nullptr};
        EpiMixF E{(bf16_t*)(ws + WS_MIXED), proj};
        pg8::gemm_phase<EpiMixF, pg8::DenseSched, false, false, false, true>(F.lds, g, S, E, F.wave);
    } SEAM(5);
    if (IN(6)) for (int rep_ = 0; rep_ < NREP(6); ++rep_) {
        pg8::Gemm g{(const bf16_t*)(ws + WS_MIXED), (const bf16_t*)(ws + WS_WOUT), DM, DM, nullptr};
        pg8::DenseSched S; S.o.init(NTOK / 256, DM / 256, F.G, F.bid);
        EpiOut E{args.in[I_X], (bf16_t*)(ws + WS_X1)};
        pg8::gemm_phase<EpiOut, pg8::DenseSched, false>(F.lds, g, S, E, F.wave);
    } SEAM(6);
    if (IN(7)) { if (NREP(7) > 1) p6_route<true>(F, args); p6_route<false>(F, args); } SEAM(7);
    if (IN(8)) for (int rep_ = 0; rep_ < NREP(8); ++rep_) {
        LAS int* ts = (LAS int*)(F.lds + MISC_OFF + 8192);
        const int ntile = moe_tiles(F, args, ts);
        pg8::Gemm g{(const bf16_t*)(ws + WS_XN), (const bf16_t*)(ws + WS_WGU), 2 * DE, DM, (const int*)(ws + WS_ROWS), (const float*)(ws + WS_ROWHS), (const float*)(ws + WS_WGS)};
        pg8::MoeSched S; S.o.init(ntile, 2 * DE / 256, F.G, F.bid); S.ts = ts;
        EpiMoe1 E{(bf16_t*)(ws + WS_HID), args.in[I_BGU]};
        pg8::gemm_phase<EpiMoe1, pg8::MoeSched, true, MOE_FP8 && !MOE1_I8, false, false, MOE1_I8>(F.lds, g, S, E, F.wave);
    } SEAM(8);
    if (IN(9)) for (int rep_ = 0; rep_ < NREP(9); ++rep_) {
        LAS int* ts = (LAS int*)(F.lds + MISC_OFF + 8192);
        const int ntile = moe_tiles(F, args, ts);
        pg8::Gemm g{(const bf16_t*)(ws + WS_HID), (const bf16_t*)(ws + WS_WD), DM, DE, nullptr};
        pg8::MoeSched S; S.o.init(ntile, DM / 256, F.G, F.bid); S.ts = ts;
        EpiMoe2 E{(bf16_t*)(ws + WS_YG), args.in[I_BD], (const int*)(ws + WS_ROWS), (const float*)(ws + WS_ROWW)};
        pg8::gemm_phase<EpiMoe2, pg8::MoeSched, false, MOE_FP8>(F.lds, g, S, E, F.wave);
    } SEAM(9);
    if (IN(10)) for (int rep_ = 0; rep_ < NREP(10); ++rep_) { p9_final(F, args); }
#undef IN
#undef SEAM
}

#ifndef N_LAUNCHES
#define N_LAUNCHES 1
#endif
extern "C" void kernel_launch(void* const* d_in, const int* in_sizes, int n_in, void* d_out, int out_size, void* d_ws, size_t ws_size, hipStream_t stream) {
    static int grid = 0;
    if (grid == 0) {
        if (n_in != 16 || in_sizes[0] != NTOK * DM || out_size != NTOK * DM || ws_size < WS_END) { fprintf(stderr, "kernel_launch: unexpected shapes (n_in %d, in0 %d, out %d, ws %zu)\n", n_in, n_in > 0 ? in_sizes[0] : -1, out_size, ws_size); grid = -1; return; }
        int dev = 0, cus = 0, per_cu = 0;
        (void)hipGetDevice(&dev); (void)hipDeviceGetAttribute(&cus, hipDeviceAttributeMultiprocessorCount, dev);
        if (hipFuncSetAttribute((const void*)fwd_kernel, hipFuncAttributeMaxDynamicSharedMemorySize, LDS_BYTES) != hipSuccess) { fprintf(stderr, "kernel_launch: hipFuncSetAttribute failed\n"); grid = -1; return; }
        if (hipOccupancyMaxActiveBlocksPerMultiprocessor(&per_cu, (const void*)fwd_kernel, 512, LDS_BYTES) != hipSuccess || per_cu < 1) { fprintf(stderr, "kernel_launch: occupancy query says %d\n", per_cu); per_cu = 1; }
        (void)hipGetLastError();
        grid = cus;
    }
    if (grid < 0) return;
    (void)hipMemsetAsync((char*)d_ws + WS_CTL, 0, CTL_BYTES, stream);
    Args a{};
    for (int i = 0; i < 16; ++i) a.in[i] = (const float*)d_in[i];
    a.out = (float*)d_out; a.ws = (unsigned char*)d_ws;
    if (N_LAUNCHES == 1) {
        a.ph_lo = 0; a.ph_hi = NPHASE; void* params[] = {&a};
#if USE_COOP
        hipError_t e = hipLaunchCooperativeKernel((const void*)fwd_kernel, dim3(grid), dim3(512), params, LDS_BYTES, stream);
        if (e != hipSuccess) fprintf(stderr, "cooperative launch failed: %s (grid %d)\n", hipGetErrorString(e), grid);
#else
        (void)params; hipLaunchKernelGGL(fwd_kernel, dim3(grid), dim3(512), LDS_BYTES, stream, a);
#endif
    } else {
        for (int p = 0; p < NPHASE; ++p) { a.ph_lo = p; a.ph_hi = p + 1; hipLaunchKernelGGL(fwd_kernel, dim3(grid), dim3(512), LDS_BYTES, stream, a); }
    }
}
```

```cpp
#include <hip/hip_runtime.h>
#include <hip/hip_cooperative_groups.h>
#include <cstdio>
#include <cstdint>
namespace cg = cooperative_groups;
#ifndef USE_COOP
#define USE_COOP 1
#endif

#define LAS __attribute__((address_space(3)))
#define GAS __attribute__((address_space(1)))
typedef unsigned short bf16_t;
typedef short bf16x8 __attribute__((ext_vector_type(8)));
typedef float f32x4 __attribute__((ext_vector_type(4)));
typedef float f32x2 __attribute__((ext_vector_type(2)));
typedef unsigned u32x4 __attribute__((ext_vector_type(4)));
typedef unsigned u32x2 __attribute__((ext_vector_type(2)));

constexpr int NTOK = 32768, DM = 1024, SEQ = 4096, NBATCH = 8;
constexpr int DIN = 5632;
constexpr int AH = 8, AD = 64;
constexpr int HH = 4, HK = 128;
constexpr int NE = 32, DE = 1024, CAP = 32768;
constexpr float RMS_EPS = 1e-6f;
constexpr float QSCALE = 0.125f * 1.4426950408889634f;
constexpr int C_QA = 0, C_KA = 512, C_VA = 1024, C_QB = 1536, C_FB = 2048, C_IB = 2560, C_GB = 3072, C_GA = 3584, C_GBT = 4608;

constexpr size_t MiB = 1u << 20;
constexpr size_t WS_CTL = 0, CTL_BYTES = 32768;
constexpr size_t WS_ROPE = 1 * MiB;
constexpr size_t WS_WIN = 2 * MiB;
constexpr size_t WS_MUP = 13 * MiB;
constexpr size_t WS_WOUT = 15 * MiB;
constexpr size_t WS_LB = 17 * MiB;
constexpr size_t WS_KMEAN = 17 * MiB + 65536;
constexpr size_t WS_SLOTW = 18 * MiB;
constexpr size_t WS_ROWS = 19 * MiB;
constexpr size_t WS_ROWW = 25 * MiB;
constexpr size_t WS_WGS = 18 * MiB;
constexpr size_t WS_XS = 18 * MiB + 512 * 1024;
constexpr size_t WS_WINS = 18 * MiB + 768 * 1024;
constexpr size_t WS_ROWHS = 672 * MiB;
constexpr size_t WS_GDEC = 24 * MiB;
constexpr size_t WS_WGU = 32 * MiB;
constexpr size_t WS_WD = 160 * MiB;
constexpr size_t WS_XN = 224 * MiB;
constexpr size_t WS_PROJ = 288 * MiB;
constexpr size_t WS_LOGF = 640 * MiB;
constexpr size_t WS_YA = 704 * MiB;
constexpr size_t WS_OB = 768 * MiB;
constexpr size_t WS_HST = 768 * MiB;
constexpr size_t WS_MIXED = 832 * MiB;
constexpr size_t WS_HID = 288 * MiB;
constexpr size_t WS_YG = 560 * MiB;
constexpr size_t WS_X1 = 896 * MiB;
constexpr size_t WS_END = 960 * MiB;
constexpr int CW_CNT = 64;
constexpr int CW_BAR = 4096;
static_assert((CW_BAR + 3456) * 4 <= (int)CTL_BYTES, "barrier words inside the zeroed control region");

constexpr int RING_BYTES = 131072;
constexpr int MISC_OFF = RING_BYTES;
constexpr int LDS_BYTES = 147456;

#ifndef MOE1_I8_
#define MOE1_I8_ 1
#endif
#ifndef MOE_FP8_
#define MOE_FP8_ 1
#endif
constexpr bool MOE1_I8 = (MOE1_I8_ != 0) && (MOE_FP8_ != 0);
#ifndef P1_I8_
#define P1_I8_ 1
#endif
constexpr bool P1_I8 = P1_I8_ != 0;
#ifndef TIM_PHASE
#define TIM_PHASE 0
#endif
#ifndef TIM_SEL
#define TIM_SEL 0
#endif
#ifndef TIM_UNIT
#define TIM_UNIT 1024
#endif
constexpr bool MOE_FP8 = MOE_FP8_ != 0;
constexpr float S_H2 = 16.0f, S_HID = 4.0f, S_W = 512.0f, S_YG = 32.0f;
constexpr float DQ1 = MOE_FP8 ? 1.0f / (S_H2 * S_W) : 1.0f, DQ2 = MOE_FP8 ? 1.0f / (S_HID * S_W) : 1.0f;
typedef int v8i __attribute__((ext_vector_type(8)));
typedef int v4i __attribute__((ext_vector_type(4)));
__device__ __forceinline__ unsigned pk4_i8(float a, float b, float c, float d) {
    const int ia = (int)__builtin_rintf(fminf(fmaxf(a, -127.f), 127.f)), ib = (int)__builtin_rintf(fminf(fmaxf(b, -127.f), 127.f)), ic = (int)__builtin_rintf(fminf(fmaxf(c, -127.f), 127.f)), id = (int)__builtin_rintf(fminf(fmaxf(d, -127.f), 127.f));
    return (unsigned)(ia & 255) | ((unsigned)(ib & 255) << 8) | ((unsigned)(ic & 255) << 16) | ((unsigned)id << 24); }
typedef _Float16 h16x4 __attribute__((ext_vector_type(4)));
typedef _Float16 h16x8 __attribute__((ext_vector_type(8)));
typedef float f32x8 __attribute__((ext_vector_type(8)));
__device__ __forceinline__ unsigned pk4_fp8_nc(float a, float b, float c, float d, float s) { unsigned w = 0u; w = __builtin_amdgcn_cvt_pk_fp8_f32(a * s, b * s, w, false); w = __builtin_amdgcn_cvt_pk_fp8_f32(c * s, d * s, w, true); return w; }
__device__ __forceinline__ unsigned pk4_u8(float a, float b, float c, float d) { unsigned w = 0u;
    w = __builtin_amdgcn_cvt_pk_u8_f32(fmaxf(a * 255.0f, 1.0f), 0, w); w = __builtin_amdgcn_cvt_pk_u8_f32(fmaxf(b * 255.0f, 1.0f), 1, w);
    w = __builtin_amdgcn_cvt_pk_u8_f32(fmaxf(c * 255.0f, 1.0f), 2, w); w = __builtin_amdgcn_cvt_pk_u8_f32(fmaxf(d * 255.0f, 1.0f), 3, w); return w; }
__device__ __forceinline__ f32x4 un4_u8(unsigned w) { return (f32x4){(float)(w & 0xffu), (float)((w >> 8) & 0xffu), (float)((w >> 16) & 0xffu), (float)(w >> 24)}; }
constexpr int GATE_BYTE0 = 2 * 3584;
__device__ __forceinline__ unsigned pk4_fp8(float a, float b, float c, float d, float s) {
    const float L = 440.0f;
    a = __builtin_amdgcn_fmed3f(a * s, -L, L); b = __builtin_amdgcn_fmed3f(b * s, -L, L); c = __builtin_amdgcn_fmed3f(c * s, -L, L); d = __builtin_amdgcn_fmed3f(d * s, -L, L);
    unsigned w = 0u; w = __builtin_amdgcn_cvt_pk_fp8_f32(a, b, w, false); w = __builtin_amdgcn_cvt_pk_fp8_f32(c, d, w, true); return w;
}
__device__ __forceinline__ unsigned f2bf(float f) { unsigned u = __builtin_bit_cast(unsigned, f); return (u + 0x7fffu + ((u >> 16) & 1u)) >> 16; }
typedef __bf16 bf16x2_t_ __attribute__((ext_vector_type(2)));
__device__ __forceinline__ unsigned pk2(float lo, float hi) { f32x2 v = {lo, hi}; bf16x2_t_ b = __builtin_convertvector(v, bf16x2_t_); return __builtin_bit_cast(unsigned, b); }
__device__ __forceinline__ float bf_lo(unsigned u) { return __builtin_bit_cast(float, u << 16); }
__device__ __forceinline__ float bf_hi(unsigned u) { return __builtin_bit_cast(float, u & 0xffff0000u); }
__device__ __forceinline__ float bf2f(bf16_t h) { return __builtin_bit_cast(float, (unsigned)h << 16); }
template <int CTRL> __device__ __forceinline__ float dppf_(float v) { return __builtin_bit_cast(float, __builtin_amdgcn_update_dpp(0, __builtin_bit_cast(int, v), CTRL, 0xF, 0xF, false)); }
__device__ __forceinline__ float rdlane_(float v, int l) { return __builtin_bit_cast(float, __builtin_amdgcn_readlane(__builtin_bit_cast(int, v), l)); }
__device__ __forceinline__ float wave_sum(float v) {
    v += dppf_<0xB1>(v); v += dppf_<0x4E>(v); v += dppf_<0x141>(v); v += dppf_<0x140>(v);
    return (rdlane_(v, 0) + rdlane_(v, 16)) + (rdlane_(v, 32) + rdlane_(v, 48));
}
__device__ __forceinline__ float wave_max(float v) {
    v = fmaxf(v, dppf_<0xB1>(v)); v = fmaxf(v, dppf_<0x4E>(v)); v = fmaxf(v, dppf_<0x141>(v)); v = fmaxf(v, dppf_<0x140>(v));
    return fmaxf(fmaxf(rdlane_(v, 0), rdlane_(v, 16)), fmaxf(rdlane_(v, 32), rdlane_(v, 48)));
}
__device__ __forceinline__ void lds_barrier() { asm volatile("s_waitcnt lgkmcnt(0)\n\ts_barrier" ::: "memory"); }
__device__ __forceinline__ f32x4 sigmoid4_(f32x4 x) {
    f32x4 t = x * (-1.4426950408889634f); t = (f32x4){__builtin_amdgcn_exp2f(t[0]), __builtin_amdgcn_exp2f(t[1]), __builtin_amdgcn_exp2f(t[2]), __builtin_amdgcn_exp2f(t[3])}; t = t + 1.0f;
    return (f32x4){__builtin_amdgcn_rcpf(t[0]), __builtin_amdgcn_rcpf(t[1]), __builtin_amdgcn_rcpf(t[2]), __builtin_amdgcn_rcpf(t[3])}; }
__device__ __forceinline__ float sigmoidf_(float x) { return __builtin_amdgcn_rcpf(1.0f + __builtin_amdgcn_exp2f(-1.4426950408889634f * x)); }
__device__ __forceinline__ int lane_id_() { int l; asm volatile("v_mbcnt_lo_u32_b32 %0, -1, 0\n\tv_mbcnt_hi_u32_b32 %0, -1, %0" : "=v"(l)); return l; }
__device__ __forceinline__ float rdlane(float v, int l) { return __builtin_bit_cast(float, __builtin_amdgcn_readlane(__builtin_bit_cast(int, v), l)); }

namespace pg8 {
constexpr int BM = 256, BK = 64, HALF = 128, HTB = HALF * BK * 2, STAGE_BYTES = 8 * HTB, NXCD = 8, WGM = 8;
__host__ __device__ __forceinline__ int lds_byte(int r, int c) { const int st = (r >> 4) * 2 + (c >> 5), rr = r & 15, cc = c & 31, ob = rr * 64 + cc * 2; return st * 1024 + (ob ^ (((ob >> 9) & 1) << 5)); }
__host__ __device__ __forceinline__ void stage_rc(int b, int& R, int& C) { const int st = b / 1024, sb = b % 1024, swz = sb ^ (((sb >> 9) & 1) << 5); R = (st >> 1) * 16 + swz / 64; C = (st & 1) * 32 + (swz % 64) / 2; }
__host__ __device__ __forceinline__ int perm32(int rho) { const int n = rho >> 4, i = rho & 15; return 8 * (i >> 2) + 4 * n + (i & 3); }

struct Unit { int pm, pn, e, lt, nvalid; };
struct Gemm { const bf16_t* A; const bf16_t* Bt; int N, K; const int* rows; const float* rs = nullptr; const float* cs = nullptr; unsigned* tim = nullptr; };

template <int NN> struct Order {
    static constexpr int nN = NN;
    int nM, nwg, G, c;
    __device__ void init(int nM_, int nN_, int G_, int c_) { nM = nM_; nwg = nM * nN; G = G_; c = c_; }
    __device__ bool map(int i, int& pm, int& pn) const {
        const long L = (long)i * G + c; if (L >= nwg) return false;
        int wgid = (int)L; { const int q = nwg / NXCD, r = nwg % NXCD, xcd = wgid % NXCD, off = wgid / NXCD; wgid = (xcd < r ? xcd * (q + 1) : r * (q + 1) + (xcd - r) * q) + off; }
        const int nig = WGM * nN, gid = wgid / nig, fm = gid * WGM, gsz = (nM - fm) < WGM ? (nM - fm) : WGM;
        const int rem = wgid - gid * nig;
        pm = fm + rem % gsz; pn = rem / gsz; return true;
    }
};
template <int NN> struct DenseSched {
    Order<NN> o;
    __device__ bool next(int i, Unit& u) const { if (!o.map(i, u.pm, u.pn)) return false; u.e = 0; u.lt = u.pm; u.nvalid = 256; return true; }
};
template <int NN> struct MoeSched {
    Order<NN> o; const LAS int* ts;
    __device__ bool next(int i, Unit& u) const {
        if (!o.map(i, u.pm, u.pn)) return false;
        const int lane = lane_id_(); const int tv = ts[(lane & 31) + 1];
        const unsigned long long bal = __ballot(lane < NE - 1 && tv <= u.pm);
        const int e = __builtin_amdgcn_readfirstlane((int)__popcll(bal));
        const int t0 = __builtin_amdgcn_readfirstlane(ts[e]), cn = __builtin_amdgcn_readfirstlane(ts[33 + e]);
        u.e = e; u.lt = u.pm - t0; const int rem = cn - u.lt * 256; u.nvalid = rem < 256 ? rem : 256; return true;
    }
};

struct NoPre {};
template <class T, class = void> struct HasPre { static constexpr bool v = false; };
template <class T> struct HasPre<T, decltype((void)sizeof(typename T::Pre))> { static constexpr bool v = true; };
template <class T, bool> struct PreOf { typedef NoPre type; };
template <class T> struct PreOf<T, true> { typedef typename T::Pre type; };
template <class Epi, class Sched, bool GATHER, bool FP8 = false, bool NOEPI = false, bool HOOK = false, bool I8 = false, bool P16 = false>
__device__ __forceinline__ void gemm_phase(LAS unsigned char* lds, const Gemm g, const Sched& S, const Epi& E, const int wid) {
    const int lane = lane_id_(), tid = wid * 64 + lane, wr = wid >> 2, wc = wid & 3, fr = lane & 15, fq = lane >> 4;
    const int K = g.K, RP = (FP8 || I8) ? K : 2 * K, nt = RP / 128;
    unsigned voffB[2];
#pragma unroll
    for (int i = 0; i < 2; ++i) { int R, C; stage_rc(tid * 16 + i * 8192, R, C); const int Rb = P16 ? 64 * (R >> 5) + 16 * ((R & 15) >> 2) + 4 * ((R >> 4) & 1) + (R & 3) : (R & ~31) + perm32(R & 31); voffB[i] = (unsigned)(Rb * RP + C * 2); }
    const size_t kstep = 128;
    const size_t hstep = (size_t)HALF * RP, hstepB = P16 ? (size_t)8 * RP : hstep;
    const size_t tstep = 2 * hstep;
    const size_t estride = (size_t)g.N * RP;
    const unsigned ldsw = (unsigned)wid * 1024u;
    const int aoff = lds_byte(wr * 64 + fr, fq * 8), boff = lds_byte(wc * 32 + fr, fq * 8);
    constexpr int KOFF = 1024;
#define PG8_SA(b, h) (((b) * 2 + (h)) * HTB)
#define PG8_SB(b, h) ((4 + (b) * 2 + (h)) * HTB)
#define PG8_STAGE(bufoff, gbase, voff) do { _Pragma("unroll") for (int _i = 0; _i < 2; ++_i) { unsigned _o = (voff)[_i]; asm volatile("" : "+v"(_o));     \
        __builtin_amdgcn_global_load_lds((const unsigned*)((const char*)(gbase) + _o), (LAS unsigned*)(lds + (bufoff) + ldsw + _i * 8192), 16, 0, 0); } } while (0)
#define PG8_STAGE2(bufoff, gbase, h) PG8_STAGE(bufoff, gbase, vC[h])
#define PG8_LDA(dst, b, h) do { _Pragma("unroll") for (int m = 0; m < 4; ++m) _Pragma("unroll") for (int k = 0; k < 2; ++k) dst[m][k] = *(const LAS bf16x8*)(lds + PG8_SA(b, h) + aoff + m * 2048 + k * KOFF); } while (0)
#define PG8_LDB(dst, b, h) do { _Pragma("unroll") for (int n = 0; n < 2; ++n) _Pragma("unroll") for (int k = 0; k < 2; ++k) dst[n][k] = *(const LAS bf16x8*)(lds + PG8_SB(b, h) + boff + n * 2048 + k * KOFF); } while (0)
#define PG8_CAT(x) __builtin_bit_cast(v8i, __builtin_shufflevector((x)[0], (x)[1], 0, 1, 2, 3, 4, 5, 6, 7, 8, 9, 10, 11, 12, 13, 14, 15))
#define PG8_MMA(ai, bj, At, Bt) do { __builtin_amdgcn_s_setprio(1); _Pragma("unroll") for (int m = 0; m < 4; ++m) _Pragma("unroll") for (int n = 0; n < 2; ++n) { \
        if constexpr (FP8) acc[ai][bj][m][n] = __builtin_amdgcn_mfma_scale_f32_16x16x128_f8f6f4(PG8_CAT(Bt[n]), PG8_CAT(At[m]), acc[ai][bj][m][n], 0, 0, 0, 0, 0, 0); \
        else if constexpr (I8) { _Pragma("unroll") for (int k = 0; k < 2; ++k) acci[ai][bj][m][n] = __builtin_amdgcn_mfma_i32_16x16x64_i8(__builtin_bit_cast(v4i, Bt[n][k]), __builtin_bit_cast(v4i, At[m][k]), acci[ai][bj][m][n], 0, 0, 0); } \
        else { _Pragma("unroll") for (int k = 0; k < 2; ++k) acc[ai][bj][m][n] = __builtin_amdgcn_mfma_f32_16x16x32_bf16(Bt[n][k], At[m][k], acc[ai][bj][m][n], 0, 0, 0); } } \
        __builtin_amdgcn_s_setprio(0); } while (0)
#define PG8_WAIT_V(n) asm volatile("s_waitcnt vmcnt(" #n ")" ::: "memory")
#define PG8_WAIT_V8R() do { if (NOEPI || Epi::NVMEM == 0 || !relax) asm volatile("s_waitcnt vmcnt(8)" ::: "memory"); else asm volatile("s_waitcnt vmcnt(%0)" :: "n"(8 + (NOEPI ? 0 : Epi::NVMEM)) : "memory"); } while (0)
#define PG8_WAIT_L(n) asm volatile("s_waitcnt lgkmcnt(" #n ")" ::: "memory")
#define PG8_BAR __builtin_amdgcn_s_barrier()
#define PG8_SCHED __builtin_amdgcn_sched_barrier(0)
#define PG8_SETV(u, v) do { _Pragma("unroll") for (int _h = 0; _h < 2; ++_h) _Pragma("unroll") for (int _i = 0; _i < 2; ++_i) { int _R, _C; stage_rc((wid * 64 + lane_id_()) * 16 + _i * 8192, _R, _C); \
        if (GATHER) { int _r = _h * HALF + _R; _r = _r < (u).nvalid ? _r : (u).nvalid - 1; const int _s = g.rows[(size_t)(u).e * CAP + (u).lt * 256 + _r]; \
                      (v)[_h][_i] = (unsigned)(_s >> 2) * (unsigned)RP + (unsigned)(_C * 2); } \
        else (v)[_h][_i] = (unsigned)(_R * RP + _C * 2) + (unsigned)(_h * hstep); } } while (0)
#define PG8_ABASE(u) (GATHER ? (const char*)g.A : (const char*)g.A + (size_t)(u).pm * tstep)
#define PG8_BBASE(u) ((const char*)g.Bt + (size_t)(u).e * estride + (size_t)(u).pn * tstep)
    Unit cur, nxt, nn; int ui = 0;
    if (!S.next(0, cur)) return;
    bool has_next = S.next(1, nxt);
    unsigned vC[2][2];
    PG8_SETV(cur, vC);
#define PG8_PARK ((LAS unsigned*)(lds + MISC_OFF) + (wid * 64 + lane_id_()) * 4)
    if (GATHER) { unsigned vP[2][2];
        if (has_next) PG8_SETV(nxt, vP); else { vP[0][0] = vC[0][0]; vP[0][1] = vC[0][1]; vP[1][0] = vC[1][0]; vP[1][1] = vC[1][1]; }
        LAS unsigned* pk = PG8_PARK; pk[0] = vP[0][0]; pk[1] = vP[0][1]; pk[2] = vP[1][0]; pk[3] = vP[1][1]; }
    f32x4 acc[2][2][4][2]; v4i acci[2][2][4][2];
#pragma unroll
    for (int a = 0; a < 2; ++a)
#pragma unroll
        for (int b = 0; b < 2; ++b)
#pragma unroll
            for (int m = 0; m < 4; ++m)
#pragma unroll
                for (int n = 0; n < 2; ++n) { acc[a][b][m][n] = (f32x4){0.f, 0.f, 0.f, 0.f}; acci[a][b][m][n] = (v4i){0, 0, 0, 0}; }
    bf16x8 At[4][2], B0[2][2], B1[2][2];
    const char* cA = PG8_ABASE(cur); const char* cB = PG8_BBASE(cur);
    PG8_STAGE(PG8_SB(0, 0), cB, voffB); PG8_STAGE(PG8_SB(0, 1), cB + hstepB, voffB); PG8_STAGE(PG8_SA(0, 0), cA, vC[0]); PG8_STAGE(PG8_SA(0, 1), cA, vC[1]);
    if (wr == 1) PG8_BAR;
    PG8_WAIT_V(2); PG8_BAR;
    PG8_STAGE(PG8_SB(1, 0), cB + kstep, voffB); PG8_STAGE(PG8_SA(1, 0), cA + kstep, vC[0]); PG8_STAGE(PG8_SB(1, 1), cB + hstepB + kstep, voffB);
    PG8_WAIT_V(6); PG8_BAR;
#if TIM_PHASE
    unsigned long long tk_ = 0, ta_ = 0, tb_ = 0, tu_ = 0; unsigned tl_ = 0; const unsigned long long ts_ = __builtin_amdgcn_s_memtime();
#endif
    for (;;) {
#if TIM_PHASE
        const unsigned long long t0_ = __builtin_amdgcn_s_memtime();
#endif
        const char* nA = has_next ? PG8_ABASE(nxt) : cA; const char* nB = has_next ? PG8_BBASE(nxt) : cB;
#pragma unroll 1
        for (int t = 0; t < nt; t += 2) {
            const bool last = (t == nt - 2); const bool relax = false;
            if constexpr (HOOK) { if (t == nt / 2) { const int l_ = lane_id_(); E.mid(acc, cur, wr, wc, l_ & 15, l_ >> 4); } }
            const char* a1 = cA + (size_t)(t + 1) * kstep;
            const char* a2 = last ? nA : cA + (size_t)(t + 2) * kstep; const char* b2 = last ? nB : cB + (size_t)(t + 2) * kstep;
            const char* a3 = a2 + kstep; const char* b3 = b2 + kstep;
            PG8_LDB(B0, 0, 0); PG8_LDB(B1, 0, 1); PG8_SCHED; PG8_LDA(At, 0, 0); PG8_STAGE(PG8_SA(1, 1), a1, vC[1]);
            if (GATHER && last) { const LAS unsigned* pk = PG8_PARK; vC[0][0] = pk[0]; vC[0][1] = pk[1]; vC[1][0] = pk[2]; vC[1][1] = pk[3]; }
            PG8_WAIT_V8R(); PG8_WAIT_L(0); PG8_BAR; PG8_MMA(0, 0, At, B0); PG8_MMA(0, 1, At, B1); PG8_BAR; PG8_SCHED;
            PG8_LDA(At, 0, 1); PG8_STAGE(PG8_SB(0, 0), b2, voffB); PG8_STAGE(PG8_SB(0, 1), b2 + hstepB, voffB); PG8_STAGE2(PG8_SA(0, 0), a2, 0);
            PG8_WAIT_V8R(); PG8_WAIT_L(0); PG8_BAR; PG8_MMA(1, 0, At, B0); PG8_MMA(1, 1, At, B1); PG8_BAR; PG8_SCHED;
            PG8_LDB(B0, 1, 0); PG8_LDB(B1, 1, 1); PG8_SCHED; PG8_LDA(At, 1, 0); PG8_STAGE2(PG8_SA(0, 1), a2, 1);
            PG8_WAIT_V(8); PG8_WAIT_L(0); PG8_BAR; PG8_MMA(0, 0, At, B0); PG8_MMA(0, 1, At, B1); PG8_BAR; PG8_SCHED;
            PG8_LDA(At, 1, 1); PG8_STAGE(PG8_SB(1, 0), b3, voffB); PG8_STAGE(PG8_SB(1, 1), b3 + hstepB, voffB); PG8_STAGE2(PG8_SA(1, 0), a3, 0);
            PG8_WAIT_V(8); PG8_WAIT_L(0); PG8_BAR; PG8_MMA(1, 0, At, B0); PG8_MMA(1, 1, At, B1); PG8_BAR; PG8_SCHED;
        }
#if TIM_PHASE
        const unsigned long long t1_ = __builtin_amdgcn_s_memtime();
#endif
        float rsv[2][4]; f32x4 csv[2][2]; typename PreOf<Epi, HasPre<Epi>::v>::type pf;
        { const int l_ = lane_id_();
          if constexpr (I8) {
            const float* rsp = g.rs + (GATHER ? (size_t)cur.e * CAP : (size_t)0) + (size_t)cur.lt * 256; const float* csp = g.cs + (size_t)cur.e * g.N + cur.pn * 256 + wc * 32 + 8 * (l_ >> 4);
#pragma unroll
            for (int a = 0; a < 2; ++a)
#pragma unroll
                for (int m = 0; m < 4; ++m) { int r = a * 128 + wr * 64 + m * 16 + (l_ & 15); r = r < cur.nvalid ? r : cur.nvalid - 1; rsv[a][m] = rsp[r]; }
#pragma unroll
            for (int b = 0; b < 2; ++b)
#pragma unroll
                for (int n = 0; n < 2; ++n) csv[b][n] = *(const f32x4*)(csp + b * 128 + 4 * n);
          }
          if constexpr (HasPre<Epi>::v && !NOEPI) pf = E.pre(cur, wr, wc, l_ & 15, l_ >> 4); }
        if (wr == 0) PG8_BAR;
        bool has_nn = false; unsigned vT[2][2];
        if (has_next) has_nn = S.next(ui + 2, nn);
        if (GATHER && has_nn) PG8_SETV(nn, vT);
#if TIM_PHASE
        const unsigned long long t2_ = __builtin_amdgcn_s_memtime();
#endif
        if constexpr (I8) {
#pragma unroll
            for (int a = 0; a < 2; ++a)
#pragma unroll
                for (int b = 0; b < 2; ++b)
#pragma unroll
                    for (int m = 0; m < 4; ++m)
#pragma unroll
                        for (int n = 0; n < 2; ++n)
#pragma unroll
                            for (int i = 0; i < 4; ++i) acc[a][b][m][n][i] = ((float)acci[a][b][m][n][i] * rsv[a][m]) * csv[b][n][i];
        }
        { const int l_ = lane_id_();
          if constexpr (!NOEPI) { if constexpr (HasPre<Epi>::v) E(acc, cur, wr, wc, l_ & 15, l_ >> 4, pf); else E(acc, cur, wr, wc, l_ & 15, l_ >> 4); }
          else { _Pragma("unroll") for (int a_ = 0; a_ < 2; ++a_) _Pragma("unroll") for (int b_ = 0; b_ < 2; ++b_) _Pragma("unroll") for (int m_ = 0; m_ < 4; ++m_) _Pragma("unroll") for (int n_ = 0; n_ < 2; ++n_) asm volatile("" :: "v"(acc[a_][b_][m_][n_])); } }
#if TIM_PHASE
        { const unsigned long long t3_ = __builtin_amdgcn_s_memtime(); tk_ += t1_ - t0_; ta_ += t2_ - t1_; tb_ += t3_ - t2_; tu_ += 1;
 }
#endif
        if (!has_next) break;
#pragma unroll
        for (int a = 0; a < 2; ++a)
#pragma unroll
            for (int b = 0; b < 2; ++b)
#pragma unroll
                for (int m = 0; m < 4; ++m)
#pragma unroll
                    for (int n = 0; n < 2; ++n) { acc[a][b][m][n] = (f32x4){0.f, 0.f, 0.f, 0.f}; acci[a][b][m][n] = (v4i){0, 0, 0, 0}; }
        cur = nxt; cA = nA; cB = nB; ++ui;
        if (GATHER && has_nn) { LAS unsigned* pk = PG8_PARK; pk[0] = vT[0][0]; pk[1] = vT[0][1]; pk[2] = vT[1][0]; pk[3] = vT[1][1]; }
        nxt = nn; has_next = has_nn;
        if (wr == 1) PG8_BAR;
    }
    PG8_WAIT_V(0);
    PG8_BAR;
#if TIM_PHASE
    if (g.tim && blockIdx.x == 0 && wid == 0 && lane_id_() == 0) { const unsigned long long te_ = __builtin_amdgcn_s_memtime(); g.tim[0] = (unsigned)tk_; g.tim[1] = (unsigned)ta_; g.tim[2] = (unsigned)tb_; g.tim[3] = (unsigned)tu_; g.tim[4] = (unsigned)(te_ - ts_); g.tim[5] = (unsigned)tl_; }
#endif
#undef PG8_SA
#undef PG8_SB
#undef PG8_STAGE
#undef PG8_STAGE2
#undef PG8_PARK
#undef PG8_LDA
#undef PG8_LDB
#undef PG8_MMA
#undef PG8_CAT
#undef PG8_WAIT_V
#undef PG8_WAIT_V8R
#undef PG8_WAIT_L
#undef PG8_BAR
#undef PG8_SCHED
#undef PG8_SETV
#undef PG8_ABASE
#undef PG8_BBASE
}

template <class F> struct EpiOct {
    F f;
    __device__ __forceinline__ void operator()(const f32x4 (&acc)[2][2][4][2], const Unit& u, int wr, int wc, int fr, int fq) const {
#pragma unroll
        for (int ai = 0; ai < 2; ++ai)
#pragma unroll
            for (int m = 0; m < 4; ++m) {
                const int r = ai * HALF + wr * 64 + m * 16 + fr;
#pragma unroll
                for (int bj = 0; bj < 2; ++bj) f(u, r, bj * HALF + wc * 32 + 8 * fq, acc[ai][bj][m][0], acc[ai][bj][m][1]);
            }
    }
};
}
using pg8::Unit;

__device__ __forceinline__ u32x4 pack8(f32x4 a, f32x4 b) { u32x4 w; w.x = pk2(a[0], a[1]); w.y = pk2(a[2], a[3]); w.z = pk2(b[0], b[1]); w.w = pk2(b[2], b[3]); return w; }
__device__ __forceinline__ void unpack8(u32x4 w, f32x4& a, f32x4& b) { a = (f32x4){bf_lo(w.x), bf_hi(w.x), bf_lo(w.y), bf_hi(w.y)}; b = (f32x4){bf_lo(w.z), bf_hi(w.z), bf_lo(w.w), bf_hi(w.w)}; }

template <bool NOSTORE = false> struct EpiProj_ {
    static constexpr int NVMEM = NOSTORE ? 0 : 16;
    bf16_t* proj; float* logf; const float* rope; const float* lb;
    __device__ __forceinline__ void operator()(const f32x4 (&acc)[2][2][4][2], const Unit& u, int wr, int wc, int fr, int fq) const {
        const int pn = u.pn, colb = pn * 256 + wc * 32 + 8 * fq, rowb = u.pm * 256 + wr * 64 + fr;
        if (pn < 4) {
            const int i0 = (colb & 63) >> 1; const float sc = pn < 2 ? QSCALE : 1.0f;
            f32x4 cs[2][4][2];
#pragma unroll
            for (int ai = 0; ai < 2; ++ai)
#pragma unroll
                for (int m = 0; m < 4; ++m) { const int pos = (rowb + ai * 128 + m * 16) & (SEQ - 1); const float* tp = rope + ((size_t)pos * 32 + i0) * 2; cs[ai][m][0] = *(const f32x4*)tp; cs[ai][m][1] = *(const f32x4*)(tp + 4); }
#pragma unroll
            for (int ai = 0; ai < 2; ++ai)
#pragma unroll
                for (int m = 0; m < 4; ++m) { const f32x4 c0 = cs[ai][m][0] * sc, c1 = cs[ai][m][1] * sc;
#pragma unroll
                    for (int bj = 0; bj < 2; ++bj) { const f32x4 v0 = acc[ai][bj][m][0], v1 = acc[ai][bj][m][1]; f32x4 o0, o1;
                        o0[0] = v0[0] * c0[0] - v0[1] * c0[1]; o0[1] = v0[1] * c0[0] + v0[0] * c0[1]; o0[2] = v0[2] * c0[2] - v0[3] * c0[3]; o0[3] = v0[3] * c0[2] + v0[2] * c0[3];
                        o1[0] = v1[0] * c1[0] - v1[1] * c1[1]; o1[1] = v1[1] * c1[0] + v1[0] * c1[1]; o1[2] = v1[2] * c1[2] - v1[3] * c1[3]; o1[3] = v1[3] * c1[2] + v1[2] * c1[3];
                        { const u32x4 w_ = pack8(o0, o1); if (NOSTORE) asm volatile("" :: "v"(w_)); else __builtin_nontemporal_store(w_, (u32x4*)(proj + (size_t)(rowb + ai * 128 + m * 16) * DIN + colb + bj * 128)); } } }
        } else if (pn == 8 || pn == 9) {
            f32x4 l[2][2];
#pragma unroll
            for (int bj = 0; bj < 2; ++bj) { const float* lp = lb + (colb - C_FB) + bj * 128; l[bj][0] = *(const f32x4*)lp; l[bj][1] = *(const f32x4*)(lp + 4); }
#pragma unroll
            for (int ai = 0; ai < 2; ++ai)
#pragma unroll
                for (int m = 0; m < 4; ++m)
#pragma unroll
                    for (int bj = 0; bj < 2; ++bj) { f32x4 o[2];
#pragma unroll
                        for (int n = 0; n < 2; ++n) { const f32x4 sg = sigmoid4_(acc[ai][bj][m][n]), lv = l[bj][n], t = lv + (1.0f - lv) * sg;
                            o[n] = (f32x4){__logf(t[0]), __logf(t[1]), __logf(t[2]), __logf(t[3])}; }
                        _Float16* p = (_Float16*)logf + (size_t)(rowb + ai * 128 + m * 16) * 512 + (colb - C_FB) + bj * 128;
                        const h16x8 hv = {(_Float16)o[0][0], (_Float16)o[0][1], (_Float16)o[0][2], (_Float16)o[0][3], (_Float16)o[1][0], (_Float16)o[1][1], (_Float16)o[1][2], (_Float16)o[1][3]};
                        if (NOSTORE) asm volatile("" :: "v"(hv)); else *(h16x8*)p = hv; }
        } else {
            const int mode = (pn == 6 || pn == 7 || pn == 12 || pn == 13) ? 1 : (pn >= 14 ? 2 : 0);
#define EPROJ_LOOP(EXPR) _Pragma("unroll") for (int ai = 0; ai < 2; ++ai) _Pragma("unroll") for (int m = 0; m < 4; ++m) _Pragma("unroll") for (int bj = 0; bj < 2; ++bj) { f32x4 o[2]; \
                _Pragma("unroll") for (int n = 0; n < 2; ++n) { const f32x4 x = acc[ai][bj][m][n]; o[n] = (EXPR); } \
                const u32x4 w_ = pack8(o[0], o[1]); if (NOSTORE) asm volatile("" :: "v"(w_)); else __builtin_nontemporal_store(w_, (u32x4*)(proj + (size_t)(rowb + ai * 128 + m * 16) * DIN + colb + bj * 128)); }
            if (mode == 0) { EPROJ_LOOP(x) } else if (mode == 1) { EPROJ_LOOP(x * sigmoid4_(x)) } else {
#pragma unroll
                for (int ai = 0; ai < 2; ++ai)
#pragma unroll
                    for (int m = 0; m < 4; ++m)
#pragma unroll
                        for (int bj = 0; bj < 2; ++bj) { f32x4 o[2];
#pragma unroll
                            for (int n = 0; n < 2; ++n) o[n] = sigmoid4_(acc[ai][bj][m][n]);
                            u32x2 w_; w_.x = pk4_u8(o[0][0], o[0][1], o[0][2], o[0][3]); w_.y = pk4_u8(o[1][0], o[1][1], o[1][2], o[1][3]);
                            unsigned char* gp = (unsigned char*)(proj + (size_t)(rowb + ai * 128 + m * 16) * DIN) + GATE_BYTE0 + (colb - C_GA) + bj * 128;
                            if (NOSTORE) asm volatile("" :: "v"(w_)); else *(u32x2*)gp = w_; }
            }
#undef EPROJ_LOOP
        }
    }
};
typedef EpiProj_<false> EpiProj;
template <bool ACCUM> struct EpiMix {
    bf16_t* mixed; const bf16_t* proj; int gcol;
    __device__ __forceinline__ void operator()(const f32x4 (&acc)[2][2][4][2], const Unit& u, int wr, int wc, int fr, int fq) const {
        const int colb = u.pn * 256 + wc * 32 + 8 * fq, rowb = u.pm * 256 + wr * 64 + fr;
#pragma unroll
        for (int ai = 0; ai < 2; ++ai) {
            u32x4 g[4][2], mx[4][2];
#pragma unroll
            for (int m = 0; m < 4; ++m)
#pragma unroll
                for (int bj = 0; bj < 2; ++bj) { const size_t row = (size_t)(rowb + ai * 128 + m * 16); g[m][bj] = *(const u32x4*)(proj + row * DIN + gcol + colb + bj * 128);
                    if (ACCUM) mx[m][bj] = *(const u32x4*)(mixed + row * DM + colb + bj * 128); }
#pragma unroll
            for (int m = 0; m < 4; ++m)
#pragma unroll
                for (int bj = 0; bj < 2; ++bj) { f32x4 g0, g1; unpack8(g[m][bj], g0, g1); f32x4 v0 = acc[ai][bj][m][0] * g0, v1 = acc[ai][bj][m][1] * g1;
                    if (ACCUM) { f32x4 m0, m1; unpack8(mx[m][bj], m0, m1); v0 = v0 + m0; v1 = v1 + m1; }
                    *(u32x4*)(mixed + (size_t)(rowb + ai * 128 + m * 16) * DM + colb + bj * 128) = pack8(v0, v1); }
        }
    }
};
struct EpiMixF {         static constexpr int NVMEM = 16;
    bf16_t* mixed; const bf16_t* proj;
    __device__ __forceinline__ void mid(f32x4 (&acc)[2][2][4][2], const Unit& u, int wr, int wc, int fr, int fq) const {
        const int colb = u.pn * 256 + wc * 32 + 8 * fq, rowb = u.pm * 256 + wr * 64 + fr;
#pragma unroll
        for (int ai = 0; ai < 2; ++ai) {
            u32x2 ga[4][2], gb[4][2];
#pragma unroll
            for (int m = 0; m < 4; ++m)
#pragma unroll
                for (int bj = 0; bj < 2; ++bj) { const unsigned char* p = (const unsigned char*)(proj + (size_t)(rowb + ai * 128 + m * 16) * DIN) + GATE_BYTE0 + colb + bj * 128; ga[m][bj] = *(const u32x2*)p; gb[m][bj] = *(const u32x2*)(p + 1024); }
#pragma unroll
            for (int m = 0; m < 4; ++m)
#pragma unroll
                for (int bj = 0; bj < 2; ++bj) { const f32x4 a0 = un4_u8(ga[m][bj].x), a1 = un4_u8(ga[m][bj].y), b0 = un4_u8(gb[m][bj].x), b1 = un4_u8(gb[m][bj].y);
#pragma unroll
                    for (int j = 0; j < 4; ++j) { acc[ai][bj][m][0][j] *= a0[j] * __builtin_amdgcn_rcpf(b0[j]); acc[ai][bj][m][1][j] *= a1[j] * __builtin_amdgcn_rcpf(b1[j]); } }
        }
    }
    __device__ __forceinline__ void operator()(const f32x4 (&acc)[2][2][4][2], const Unit& u, int wr, int wc, int fr, int fq) const {
        const int colb = u.pn * 256 + wc * 32 + 8 * fq, rowb = u.pm * 256 + wr * 64 + fr;
#pragma unroll
        for (int ai = 0; ai < 2; ++ai) {
            u32x2 gb[4][2];
#pragma unroll
            for (int m = 0; m < 4; ++m)
#pragma unroll
                for (int bj = 0; bj < 2; ++bj) gb[m][bj] = *(const u32x2*)((const unsigned char*)(proj + (size_t)(rowb + ai * 128 + m * 16) * DIN) + GATE_BYTE0 + 1024 + colb + bj * 128);
#pragma unroll
            for (int m = 0; m < 4; ++m)
#pragma unroll
                for (int bj = 0; bj < 2; ++bj) { const f32x4 b0 = un4_u8(gb[m][bj].x) * (1.0f / 255.0f), b1 = un4_u8(gb[m][bj].y) * (1.0f / 255.0f);
                    *(u32x4*)(mixed + (size_t)(rowb + ai * 128 + m * 16) * DM + colb + bj * 128) = pack8(acc[ai][bj][m][0] * b0, acc[ai][bj][m][1] * b1); }
        }
    }
};
struct EpiOut {
    static constexpr int NVMEM = 16;
    const float* x; bf16_t* x1;
    __device__ __forceinline__ void operator()(const f32x4 (&acc)[2][2][4][2], const Unit& u, int wr, int wc, int fr, int fq) const {
        const int colb = u.pn * 256 + wc * 32 + 8 * fq, rowb = u.pm * 256 + wr * 64 + fr;
#pragma unroll
        for (int ai = 0; ai < 2; ++ai) {
            f32x4 xv[4][2][2];
#pragma unroll
            for (int m = 0; m < 4; ++m)
#pragma unroll
                for (int bj = 0; bj < 2; ++bj) { const float* p = x + (size_t)(rowb + ai * 128 + m * 16) * DM + colb + bj * 128; xv[m][bj][0] = __builtin_nontemporal_load((const f32x4*)p); xv[m][bj][1] = __builtin_nontemporal_load((const f32x4*)(p + 4)); }
#pragma unroll
            for (int m = 0; m < 4; ++m)
#pragma unroll
                for (int bj = 0; bj < 2; ++bj) *(u32x4*)(x1 + (size_t)(rowb + ai * 128 + m * 16) * DM + colb + bj * 128) = pack8(xv[m][bj][0] + acc[ai][bj][m][0], xv[m][bj][1] + acc[ai][bj][m][1]);
        }
    }
};
struct EpiMoe1 {         static constexpr int NVMEM = 8;
    bf16_t* hid; const float* bias;
    struct Pre { f32x4 b[4]; };
    __device__ __forceinline__ Pre pre(const Unit& u, int wr, int wc, int fr, int fq) const { Pre p; const float* bp = bias + (size_t)u.e * 2048 + 2 * (128 * u.pn + wc * 32 + 8 * fq);
#pragma unroll
        for (int j = 0; j < 4; ++j) p.b[j] = *(const f32x4*)(bp + 4 * j);
        return p; }
    __device__ __forceinline__ void operator()(const f32x4 (&acc)[2][2][4][2], const Unit& u, int wr, int wc, int fr, int fq, const Pre& pf) const {
        const int jj0 = wc * 32 + 8 * fq, J0 = 128 * u.pn + jj0;
        const f32x4 (&b)[4] = pf.b;
        constexpr float DQ = MOE1_I8 ? 1.0f : DQ1;
        constexpr float HS = MOE_FP8 ? S_HID : 1.0f, KE = -1.702f * 1.4426950408889634f;
#pragma unroll
        for (int ai = 0; ai < 2; ++ai)
#pragma unroll
            for (int m = 0; m < 4; ++m) {
                const int r = ai * 128 + wr * 64 + m * 16 + fr;
                f32x2 h[4];
#pragma unroll
                for (int p = 0; p < 4; ++p) {
                    const f32x4 ag = acc[ai][0][m][p >> 1], au = acc[ai][1][m][p >> 1];
                    const f32x2 g0 = (p & 1) ? (f32x2){ag[2], ag[3]} : (f32x2){ag[0], ag[1]}, u0 = (p & 1) ? (f32x2){au[2], au[3]} : (f32x2){au[0], au[1]};
                    f32x2 gt = g0 * DQ + (f32x2){b[p][0], b[p][2]}, up = u0 * DQ + (f32x2){b[p][1], b[p][3]};
                    gt.x = fminf(gt.x, 7.0f); gt.y = fminf(gt.y, 7.0f); up.x = __builtin_amdgcn_fmed3f(up.x, -7.0f, 7.0f); up.y = __builtin_amdgcn_fmed3f(up.y, -7.0f, 7.0f);
                    f32x2 e = gt * KE; e.x = __builtin_amdgcn_exp2f(e.x); e.y = __builtin_amdgcn_exp2f(e.y);
                    f32x2 den = e * (1.0f / HS) + (1.0f / HS); den.x = __builtin_amdgcn_rcpf(den.x); den.y = __builtin_amdgcn_rcpf(den.y);
                    h[p] = (up * gt + gt) * den;
                }
                if constexpr (MOE_FP8) { u32x2 w; unsigned t = 0u;
                    t = __builtin_amdgcn_cvt_pk_fp8_f32(h[0].x, h[0].y, t, false); t = __builtin_amdgcn_cvt_pk_fp8_f32(h[1].x, h[1].y, t, true); w.x = t; t = 0u;
                    t = __builtin_amdgcn_cvt_pk_fp8_f32(h[2].x, h[2].y, t, false); t = __builtin_amdgcn_cvt_pk_fp8_f32(h[3].x, h[3].y, t, true); w.y = t;
                    *(u32x2*)((unsigned char*)hid + (size_t)(u.pm * 256 + r) * DE + J0) = w; }
                else { u32x4 w; w.x = pk2(h[0].x, h[0].y); w.y = pk2(h[1].x, h[1].y); w.z = pk2(h[2].x, h[2].y); w.w = pk2(h[3].x, h[3].y);
                    *(u32x4*)(hid + (size_t)(u.pm * 256 + r) * DE + J0) = w; }
            }
    }
};
struct EpiMoe2 {
    static constexpr int NVMEM = MOE_FP8 ? 8 : 16;
    bf16_t* yg; const float* bias; const int* rows; const float* roww;
    struct Pre { f32x4 b[2][2]; int slot[2][4]; float wgt[2][4]; };
    __device__ __forceinline__ Pre pre(const Unit& u, int wr, int wc, int fr, int fq) const { Pre p; f32x4 (&b)[2][2] = p.b; int (&slot)[2][4] = p.slot; float (&wgt)[2][4] = p.wgt;
        const int c0 = MOE_FP8 ? u.pn * 256 + 64 * wc + 16 * fq : 0;
#pragma unroll
        for (int bj = 0; bj < 2; ++bj) { const float* bp = MOE_FP8 ? bias + (size_t)u.e * DM + c0 + 8 * bj : bias + (size_t)u.e * DM + u.pn * 256 + bj * 128 + wc * 32 + 8 * fq; b[bj][0] = *(const f32x4*)bp; b[bj][1] = *(const f32x4*)(bp + 4); }
#pragma unroll
        for (int ai = 0; ai < 2; ++ai)
#pragma unroll
            for (int m = 0; m < 4; ++m) { int r = ai * 128 + wr * 64 + m * 16 + fr; r = r < u.nvalid ? r : u.nvalid - 1; const size_t pp = (size_t)u.e * CAP + u.lt * 256 + r; slot[ai][m] = rows[pp]; wgt[ai][m] = roww[pp]; }
        return p; }
    __device__ __forceinline__ void operator()(const f32x4 (&acc)[2][2][4][2], const Unit& u, int wr, int wc, int fr, int fq, const Pre& pf) const {
        const f32x4 (&b)[2][2] = pf.b; const int (&slot)[2][4] = pf.slot; const float (&wgt)[2][4] = pf.wgt;
        const int c0 = MOE_FP8 ? u.pn * 256 + 64 * wc + 16 * fq : 0;
#pragma unroll
        for (int ai = 0; ai < 2; ++ai)
#pragma unroll
            for (int m = 0; m < 4; ++m) {
                const int r = ai * 128 + wr * 64 + m * 16 + fr; const float w = wgt[ai][m];
                if (r < u.nvalid) {
                    if constexpr (MOE_FP8) { u32x4 q; const float ws = w * S_YG;
#define PK4Y_(A, B) ({ const f32x4 y_ = ((A) * DQ2 + (B)) * ws; unsigned t_ = 0u; \
                        t_ = __builtin_amdgcn_cvt_pk_fp8_f32(__builtin_amdgcn_fmed3f(y_[0], -440.0f, 440.0f), __builtin_amdgcn_fmed3f(y_[1], -440.0f, 440.0f), t_, false); \
                        t_ = __builtin_amdgcn_cvt_pk_fp8_f32(__builtin_amdgcn_fmed3f(y_[2], -440.0f, 440.0f), __builtin_amdgcn_fmed3f(y_[3], -440.0f, 440.0f), t_, true); t_; })
                        q.x = PK4Y_(acc[ai][0][m][0], b[0][0]); q.y = PK4Y_(acc[ai][0][m][1], b[0][1]); q.z = PK4Y_(acc[ai][1][m][0], b[1][0]); q.w = PK4Y_(acc[ai][1][m][1], b[1][1]);
#undef PK4Y_
                        *(u32x4*)((unsigned char*)yg + (size_t)slot[ai][m] * DM + c0) = q; }
                    else {
#pragma unroll
                        for (int bj = 0; bj < 2; ++bj) { const f32x4 y0 = (acc[ai][bj][m][0] * DQ2 + b[bj][0]) * w, y1 = (acc[ai][bj][m][1] * DQ2 + b[bj][1]) * w;
                            *(u32x4*)(yg + (size_t)slot[ai][m] * DM + u.pn * 256 + bj * 128 + wc * 32 + 8 * fq) = pack8(y0, y1); } }
                }
            }
    }
};

struct Args { const float* in[16]; float* out; unsigned char* ws; int ph_lo, ph_hi; };
enum { I_X = 0, I_N1, I_WIN, I_MUP, I_LBL, I_HNW, I_HUP, I_WOUT, I_N2, I_RW, I_RB, I_WGU, I_BGU, I_WD, I_BD, I_FNW };
constexpr int NPHASE = 11;

struct Frame { LAS unsigned char* lds; int tid, lane, wave, G, bid; };
__device__ __forceinline__ Frame fresh(const Frame& F0) { Frame F = F0; const int l = lane_id_(); F.lane = l; F.tid = F0.wave * 64 + l; return F; }

template <int MAP> __device__ __forceinline__ int rowmap(int n) {
    if (MAP == 1) return n < 1024 ? ((n & ~63) | (2 * (n & 31) + ((n >> 5) & 1))) : n;
    if (MAP == 2) { const int J = n >> 1, s = n & 1; return 256 * (J >> 7) + 128 * s + (J & 127); }
    return n;
}
template <int MAP> __device__ __forceinline__ void transpose_item(const float* W, int K, int N, bf16_t* WT, LAS float* scr, int item, int lane, int KP = 0) {
    if (KP == 0) KP = K;
    const int nblk = N / 32, kb = item / nblk, nb = item % nblk, k0 = 64 * kb, n0 = 32 * nb;
    f32x4 v[8];
#pragma unroll
    for (int i = 0; i < 8; ++i) v[i] = __builtin_nontemporal_load((const f32x4*)(W + (size_t)(k0 + 8 * i + (lane >> 3)) * N + n0 + 4 * (lane & 7)));
#pragma unroll
    for (int i = 0; i < 8; ++i) { LAS float* p = scr + (8 * i + (lane >> 3)) * 33 + 4 * (lane & 7); p[0] = v[i].x; p[1] = v[i].y; p[2] = v[i].z; p[3] = v[i].w; }
    asm volatile("s_waitcnt lgkmcnt(0)" ::: "memory");
    const int c = lane & 7;
#pragma unroll
    for (int j = 0; j < 4; ++j) { const int n = (lane >> 3) + 8 * j; const LAS float* s = scr + (8 * c) * 33 + n;
        u32x4 o; o.x = pk2(s[0 * 33], s[1 * 33]); o.y = pk2(s[2 * 33], s[3 * 33]); o.z = pk2(s[4 * 33], s[5 * 33]); o.w = pk2(s[6 * 33], s[7 * 33]);
        *(u32x4*)(WT + (size_t)rowmap<MAP>(n0 + n) * KP + k0 + 8 * c) = o; }
    asm volatile("s_waitcnt lgkmcnt(0)" ::: "memory");
}
template <int MAP> __device__ __forceinline__ void transpose_item_fp8(const float* W, int K, int N, unsigned char* WT, LAS float* scr, int item, int lane) {
    const int nblk = N / 32, kb = item / nblk, nb = item % nblk, k0 = 64 * kb, n0 = 32 * nb;
    f32x4 v[8];
#pragma unroll
    for (int i = 0; i < 8; ++i) v[i] = __builtin_nontemporal_load((const f32x4*)(W + (size_t)(k0 + 8 * i + (lane >> 3)) * N + n0 + 4 * (lane & 7)));
#pragma unroll
    for (int i = 0; i < 8; ++i) { LAS float* p = scr + (8 * i + (lane >> 3)) * 33 + 4 * (lane & 7); p[0] = v[i].x; p[1] = v[i].y; p[2] = v[i].z; p[3] = v[i].w; }
    asm volatile("s_waitcnt lgkmcnt(0)" ::: "memory");
    const int n = lane >> 1, hf = lane & 1; const LAS float* s = scr + (32 * hf) * 33 + n;
    u32x4 o0, o1;
    o0.x = pk4_fp8(s[0 * 33], s[1 * 33], s[2 * 33], s[3 * 33], S_W);     o0.y = pk4_fp8(s[4 * 33], s[5 * 33], s[6 * 33], s[7 * 33], S_W);
    o0.z = pk4_fp8(s[8 * 33], s[9 * 33], s[10 * 33], s[11 * 33], S_W);   o0.w = pk4_fp8(s[12 * 33], s[13 * 33], s[14 * 33], s[15 * 33], S_W);
    o1.x = pk4_fp8(s[16 * 33], s[17 * 33], s[18 * 33], s[19 * 33], S_W); o1.y = pk4_fp8(s[20 * 33], s[21 * 33], s[22 * 33], s[23 * 33], S_W);
    o1.z = pk4_fp8(s[24 * 33], s[25 * 33], s[26 * 33], s[27 * 33], S_W); o1.w = pk4_fp8(s[28 * 33], s[29 * 33], s[30 * 33], s[31 * 33], S_W);
    unsigned char* dst = WT + (size_t)rowmap<MAP>(n0 + n) * K + k0 + 32 * hf;
    *(u32x4*)dst = o0; *(u32x4*)(dst + 16) = o1;
    asm volatile("s_waitcnt lgkmcnt(0)" ::: "memory");
}
struct QItem { const float* W; unsigned char* WT; float* scl; int N, n0, map; };
constexpr int NQ_IN = P1_I8 ? DIN / 32 : 0, NQ_GU = MOE1_I8 ? NE * 64 : 0, NQ = NQ_IN + NQ_GU;
__device__ __forceinline__ QItem q_item(const float* win, const float* wgu, unsigned char* ws, int wi) {
    QItem q;
    if (wi < NQ_IN) { q.W = win; q.WT = ws + WS_WIN; q.scl = (float*)(ws + WS_WINS); q.N = DIN; q.n0 = 32 * wi; q.map = 1; }
    else { wi -= NQ_IN; const int e = wi >> 6; q.W = wgu + (size_t)e * DM * 2 * DE; q.WT = ws + WS_WGU + (size_t)e * 2 * DE * DM; q.scl = (float*)(ws + WS_WGS) + (size_t)e * 2 * DE; q.N = 2 * DE; q.n0 = 32 * (wi & 63); q.map = 2; }
    return q;
}
__device__ __forceinline__ void q_load(const QItem& q, f32x4 (&v)[16], int wave, int lane) {
#pragma unroll
    for (int i = 0; i < 16; ++i) v[i] = __builtin_nontemporal_load((const f32x4*)(q.W + (size_t)(128 * wave + 8 * i + (lane >> 3)) * q.N + q.n0 + 4 * (lane & 7)));
}
__device__ __forceinline__ void quant_cols_loop(const float* win, const float* wgu, unsigned char* ws, LAS unsigned char* lds, int bid, int G, int wave, int lane) {
    if (NQ == 0) return;
    LAS float* s = (LAS float*)lds; LAS float* pmax = (LAS float*)(lds + 1024 * 33 * 4);
    int wi = bid; if (wi >= NQ) return;
    QItem q = q_item(win, wgu, ws, wi); f32x4 v[16]; q_load(q, v, wave, lane);
    for (;;) {
#pragma unroll
        for (int i = 0; i < 16; ++i) { LAS float* p = s + (128 * wave + 8 * i + (lane >> 3)) * 33 + 4 * (lane & 7); p[0] = v[i].x; p[1] = v[i].y; p[2] = v[i].z; p[3] = v[i].w; }
        lds_barrier();
        const int nw = wi + G; const bool more = nw < NQ; QItem qn = q;
        if (more) { qn = q_item(win, wgu, ws, nw); q_load(qn, v, wave, lane); }
        const int n = lane & 31, kb = 128 * wave + 64 * (lane >> 5);
        float x[64]; float am = 0.f;
#pragma unroll
        for (int kk = 0; kk < 64; ++kk) { x[kk] = s[(kb + kk) * 33 + n]; am = fmaxf(am, fabsf(x[kk])); }
        pmax[(2 * wave + (lane >> 5)) * 32 + n] = am;
        lds_barrier();
        am = 0.f;
#pragma unroll
        for (int p = 0; p < 16; ++p) am = fmaxf(am, pmax[p * 32 + n]);
        const float inv = am > 0.f ? 127.0f / am : 0.f;
        const int r = q.map == 1 ? rowmap<1>(q.n0 + n) : rowmap<2>(q.n0 + n);
        if (wave == 0 && lane < 32) q.scl[r] = am * (1.0f / 127.0f);
        unsigned char* dst = q.WT + (size_t)r * 1024 + kb;
#pragma unroll
        for (int qq = 0; qq < 4; ++qq) { u32x4 o;
            o.x = pk4_i8(x[16 * qq + 0] * inv, x[16 * qq + 1] * inv, x[16 * qq + 2] * inv, x[16 * qq + 3] * inv);   o.y = pk4_i8(x[16 * qq + 4] * inv, x[16 * qq + 5] * inv, x[16 * qq + 6] * inv, x[16 * qq + 7] * inv);
            o.z = pk4_i8(x[16 * qq + 8] * inv, x[16 * qq + 9] * inv, x[16 * qq + 10] * inv, x[16 * qq + 11] * inv); o.w = pk4_i8(x[16 * qq + 12] * inv, x[16 * qq + 13] * inv, x[16 * qq + 14] * inv, x[16 * qq + 15] * inv);
            *(u32x4*)(dst + 16 * qq) = o; }
        if (!more) break;
        q = qn; wi = nw;
    }
    lds_barrier();
}
__device__ __forceinline__ void rms_row_to_bf16(const float* xrow, const float* w, bf16_t* orow, int lane) {
    const f32x4* xr = (const f32x4*)xrow + lane; const f32x4* wr = (const f32x4*)w + lane;
    f32x4 v[4]; float s = 0.f;
#pragma unroll
    for (int j = 0; j < 4; ++j) { v[j] = __builtin_nontemporal_load(xr + 64 * j); s += (v[j].x * v[j].x + v[j].y * v[j].y) + (v[j].z * v[j].z + v[j].w * v[j].w); }
    const float rstd = 1.0f / sqrtf(wave_sum(s) * (1.0f / DM) + RMS_EPS);
    u32x2* o8 = (u32x2*)orow + lane;
#pragma unroll
    for (int j = 0; j < 4; ++j) { const f32x4 ww = wr[64 * j]; u32x2 o; o.x = pk2(v[j].x * rstd * ww.x, v[j].y * rstd * ww.y); o.y = pk2(v[j].z * rstd * ww.z, v[j].w * rstd * ww.w); o8[64 * j] = o; }
}
__device__ __forceinline__ void rms_row_to_i8(const float* xrow, const float* w, unsigned char* orow, float* sc, int lane) {
    const f32x4* xr = (const f32x4*)xrow + lane; const f32x4* wr = (const f32x4*)w + lane;
    f32x4 v[4]; float s = 0.f;
#pragma unroll
    for (int j = 0; j < 4; ++j) { v[j] = __builtin_nontemporal_load(xr + 64 * j); s += (v[j].x * v[j].x + v[j].y * v[j].y) + (v[j].z * v[j].z + v[j].w * v[j].w); }
    const float rstd = 1.0f / sqrtf(wave_sum(s) * (1.0f / DM) + RMS_EPS);
    float am = 0.f;
#pragma unroll
    for (int j = 0; j < 4; ++j) { const f32x4 ww = wr[64 * j]; v[j] = v[j] * rstd * ww; am = fmaxf(fmaxf(am, fmaxf(fabsf(v[j].x), fabsf(v[j].y))), fmaxf(fabsf(v[j].z), fabsf(v[j].w))); }
    am = wave_max(am); const float inv = am > 0.f ? 127.0f / am : 0.f;
    unsigned* o4 = (unsigned*)orow + lane;
#pragma unroll
    for (int j = 0; j < 4; ++j) o4[64 * j] = pk4_i8(v[j].x * inv, v[j].y * inv, v[j].z * inv, v[j].w * inv);
    if (lane == 0) *sc = am * (1.0f / 127.0f);
}

__device__ __forceinline__ void p0_prologue(const Frame& F0, const Args& a) {
    const Frame F = fresh(F0);
    unsigned char* ws = a.ws;
    LAS float* scr = (LAS float*)(F.lds + F.wave * 16384);
    const int gw = F.bid * 8 + F.wave, NGW = F.G * 8;
    constexpr int I_IN = P1_I8 ? 0 : 16 * (DIN / 32), I_UP = 8 * 32, I_O = 16 * 32, I_GU = MOE1_I8 ? 0 : 16 * 64, I_D = 16 * 32;
    constexpr int NITEMS = I_IN + 2 * I_UP + I_O + NE * (I_GU + I_D);
    for (int it = gw; it < NITEMS; it += NGW) {
        int r = it;
        if (r < I_IN) { transpose_item<1>(a.in[I_WIN], DM, DIN, (bf16_t*)(ws + WS_WIN), scr, r, F.lane); continue; } r -= I_IN;
        if (r < I_UP) { transpose_item<0>(a.in[I_MUP], 512, DM, (bf16_t*)(ws + WS_MUP), scr, r, F.lane, 1024); continue; } r -= I_UP;
        if (r < I_UP) { transpose_item<0>(a.in[I_HUP], 512, DM, (bf16_t*)(ws + WS_MUP) + 512, scr, r, F.lane, 1024); continue; } r -= I_UP;
        if (r < I_O) { transpose_item<0>(a.in[I_WOUT], DM, DM, (bf16_t*)(ws + WS_WOUT), scr, r, F.lane); continue; } r -= I_O;
        if (I_GU > 0 && r < NE * I_GU) { const int e = r / (I_GU > 0 ? I_GU : 1);
            if constexpr (MOE_FP8) transpose_item_fp8<2>(a.in[I_WGU] + (size_t)e * DM * 2 * DE, DM, 2 * DE, (unsigned char*)(ws + WS_WGU) + (size_t)e * 2 * DE * DM, scr, r % (I_GU > 0 ? I_GU : 1), F.lane);
            else transpose_item<2>(a.in[I_WGU] + (size_t)e * DM * 2 * DE, DM, 2 * DE, (bf16_t*)(ws + WS_WGU) + (size_t)e * 2 * DE * DM, scr, r % (I_GU > 0 ? I_GU : 1), F.lane);
            continue; } r -= NE * I_GU;
        { const int e = r / I_D;
            if constexpr (MOE_FP8) transpose_item_fp8<0>(a.in[I_WD] + (size_t)e * DE * DM, DE, DM, (unsigned char*)(ws + WS_WD) + (size_t)e * DM * DE, scr, r % I_D, F.lane);
            else transpose_item<0>(a.in[I_WD] + (size_t)e * DE * DM, DE, DM, (bf16_t*)(ws + WS_WD) + (size_t)e * DM * DE, scr, r % I_D, F.lane); }
    }
    if constexpr (P1_I8) { for (int m = gw; m < NTOK; m += NGW) rms_row_to_i8(a.in[I_X] + (size_t)m * DM, a.in[I_N1], ws + WS_XN + (size_t)m * DM, (float*)(ws + WS_XS) + m, F.lane); }
    else { for (int m = gw; m < NTOK; m += NGW) rms_row_to_bf16(a.in[I_X] + (size_t)m * DM, a.in[I_N1], (bf16_t*)(ws + WS_XN) + (size_t)m * DM, F.lane); }
    if constexpr (NQ > 0) {
        __syncthreads();
        quant_cols_loop(a.in[I_WIN], a.in[I_WGU], ws, F.lds, F.bid, F.G, F.wave, F.lane);
    }
    float* rope = (float*)(ws + WS_ROPE);
    for (int idx = F.bid * 512 + F.tid; idx < SEQ * 32; idx += F.G * 512) {
        const int pos = idx >> 5, i = idx & 31;
        const double inv = exp2(-(double)i * (13.287712379549449 / 32.0));
        const double rev = (double)pos * inv * 0.15915494309189535;
        const float fr = (float)(rev - floor(rev));
        rope[2 * idx] = __builtin_amdgcn_cosf(fr); rope[2 * idx + 1] = __builtin_amdgcn_sinf(fr);
    }
    if (F.bid == 0) { const float* l = a.in[I_LBL]; const float a0 = l[F.tid], a1 = l[512 + F.tid]; ((float*)(ws + WS_LB))[F.tid] = 1.0f / (1.0f + __expf(a1 - a0)); }
}

__device__ __forceinline__ void p2_kmean(const Frame& F0, const Args& a) {
    const Frame F = fresh(F0);
    const bf16_t* proj = (const bf16_t*)(a.ws + WS_PROJ); bf16_t* km = (bf16_t*)(a.ws + WS_KMEAN);
    LAS float* red = (LAS float*)F.lds;
    for (int it = F.bid; it < 128; it += F.G) {
        const int b = it >> 4, n = it & 15;
        float s[8] = {0, 0, 0, 0, 0, 0, 0, 0};
        const bf16_t* base = proj + (size_t)(b * SEQ + n * 256 + F.wave * 32) * DIN + C_KA + F.lane * 8;
#pragma unroll 8
        for (int r = 0; r < 32; ++r) { const u32x4 w = *(const u32x4*)(base + (size_t)r * DIN); f32x4 x0, x1; unpack8(w, x0, x1);
            s[0] += x0[0]; s[1] += x0[1]; s[2] += x0[2]; s[3] += x0[3]; s[4] += x1[0]; s[5] += x1[1]; s[6] += x1[2]; s[7] += x1[3]; }
#pragma unroll
        for (int j = 0; j < 8; ++j) red[F.wave * 512 + F.lane * 8 + j] = s[j];
        __syncthreads();
        float t = 0.f;
#pragma unroll
        for (int w = 0; w < 8; ++w) t += red[w * 512 + F.tid];
        km[((size_t)b * 64 + n) * 512 + F.tid] = (bf16_t)f2bf(t * (1.0f / 256.0f));
        km[((size_t)b * 64 + n + 16) * 512 + F.tid] = 0; km[((size_t)b * 64 + n + 32) * 512 + F.tid] = 0; km[((size_t)b * 64 + n + 48) * 512 + F.tid] = 0;
        __syncthreads();
    }
}

constexpr int HP = 72, HQ = 136;
__device__ __forceinline__ void h2_scan(const Frame& F0, const Args& a) {
    const Frame F = fresh(F0);
    bf16_t* hst = (bf16_t*)(a.ws + WS_HST); const float* gdec = (const float*)(a.ws + WS_GDEC);
    LAS float* G = (LAS float*)F.lds;
    for (int base = F.bid * 512; base < 32 * 128 * 32; base += F.G * 512) {
        const int idx = base + F.tid, bh = idx >> 12, v = (idx >> 5) & 127, d4 = idx & 31;
        { const f32x4* gp = (const f32x4*)(gdec + (size_t)bh * 64 * 128) + F.tid;
#pragma unroll
          for (int j = 0; j < 4; ++j) *(LAS f32x4*)(G + (F.tid + 512 * j) * 4) = gp[512 * j]; }
        lds_barrier();
        bf16_t* p = hst + ((size_t)bh * 64 * 128 + v) * 128 + d4 * 4;
        f32x4 s = {0.f, 0.f, 0.f, 0.f};
#pragma unroll 1
        for (int c0 = 0; c0 < 64; c0 += 16) {
            u32x2 u[16];
#pragma unroll
            for (int j = 0; j < 16; ++j) u[j] = __builtin_nontemporal_load((const u32x2*)(p + (size_t)(c0 + j) * 16384));
#pragma unroll
            for (int j = 0; j < 16; ++j) { const f32x4 gg = *(const LAS f32x4*)(G + (c0 + j) * 128 + d4 * 4);
                u32x2 w; w.x = pk2(s[0], s[1]); w.y = pk2(s[2], s[3]); *(u32x2*)(p + (size_t)(c0 + j) * 16384) = w;
                s = gg * s + (f32x4){bf_lo(u[j].x), bf_hi(u[j].x), bf_lo(u[j].y), bf_hi(u[j].y)}; }
        }
        lds_barrier();
    }
}
#define H_CVT_LF(LFR, LH) do { _Pragma("unroll") for (int j_ = 0; j_ < 2; ++j_) { const f32x8 f_ = __builtin_convertvector(LH[j_], f32x8); LFR[2 * j_] = (f32x4){f_[0], f_[1], f_[2], f_[3]}; LFR[2 * j_ + 1] = (f32x4){f_[4], f_[5], f_[6], f_[7]}; } } while (0)
constexpr int LFP = 132;
#define H_LOAD_LQI(it_, LFR, QR, IR, WITHQ) do { const int bh_ = (it_) >> 6, c_ = (it_) & 63; const size_t r_ = (size_t)(bh_ >> 2) * SEQ + c_ * 64 + t_r; const int hh_ = (bh_ & 3) * 128 + 16 * seg; \
    _Pragma("unroll") for (int j_ = 0; j_ < 2; ++j_) LFR[j_] = __builtin_nontemporal_load((const h16x8*)((const _Float16*)logf + r_ * 512 + hh_ + 8 * j_));     \
    _Pragma("unroll") for (int j_ = 0; j_ < 2; ++j_) { if (WITHQ) QR[j_] = __builtin_nontemporal_load((const u32x4*)(proj + r_ * DIN + C_QB + hh_ + 8 * j_)); IR[j_] = __builtin_nontemporal_load((const u32x4*)(proj + r_ * DIN + C_IB + hh_ + 8 * j_)); } } while (0)
__device__ __forceinline__ void scatter_it(LAS bf16_t* It, const u32x4 (&ir)[2], int seg, int t_r) {
    const int tsw = (((t_r >> 3) ^ seg) << 3) | (t_r & 7);
#pragma unroll
    for (int j = 0; j < 2; ++j) { const unsigned w[4] = {ir[j].x, ir[j].y, ir[j].z, ir[j].w};
#pragma unroll
        for (int q = 0; q < 4; ++q) { It[(16 * seg + 8 * j + 2 * q) * HP + tsw] = (bf16_t)(w[q] & 0xffffu); It[(16 * seg + 8 * j + 2 * q + 1) * HP + tsw] = (bf16_t)(w[q] >> 16); } }
}
__device__ __forceinline__ void h1_local_states_p(const Frame& F0, const Args& a) {
    const Frame F = fresh(F0);
    const bf16_t* proj = (const bf16_t*)(a.ws + WS_PROJ); const float* logf = (const float*)(a.ws + WS_LOGF);
    bf16_t* hst = (bf16_t*)(a.ws + WS_HST); float* gdec = (float*)(a.ws + WS_GDEC);
    LAS float* LF = (LAS float*)F.lds; LAS bf16_t* Kp = (LAS bf16_t*)(F.lds + 64 * LFP * 4); LAS bf16_t* It = Kp + 128 * HP;
    const int t_r = F.tid >> 3, seg = F.tid & 7, l15 = F.lane & 15, lq = F.lane >> 4;
    f32x4 lfr[4]; h16x8 lhr[2], lhn[2]; u32x4 qdum[2], ir[2], in_[2];
    int it = F.bid;
    if (it < 2048) H_LOAD_LQI(it, lhr, qdum, ir, false);
    for (; it < 2048; it += F.G) {
        const int bh = it >> 6, c = it & 63;
        H_CVT_LF(lfr, lhr);
#pragma unroll
        for (int j = 0; j < 4; ++j) *(LAS f32x4*)(LF + t_r * LFP + 16 * seg + 4 * j) = lfr[j];
        scatter_it(It, ir, seg, t_r);
        const int itn = it + F.G;
        if (itn < 2048) H_LOAD_LQI(itn, lhn, qdum, in_, false);
        lds_barrier();
        if (F.tid < 128) { float run = 0.f;
#pragma unroll 16
            for (int t = 0; t < 64; ++t) { run += LF[t * LFP + F.tid]; LF[t * LFP + F.tid] = run; }
            gdec[((size_t)bh * 64 + c) * 128 + F.tid] = __expf(run); }
        lds_barrier();
        {
            f32x4 bb[4], bl[4];
#pragma unroll
            for (int j = 0; j < 4; ++j) { bb[j] = *(const LAS f32x4*)(LF + t_r * LFP + 16 * seg + 4 * j); bl[j] = *(const LAS f32x4*)(LF + 63 * LFP + 16 * seg + 4 * j); }
#pragma unroll
            for (int j = 0; j < 4; ++j)
#pragma unroll
                for (int q = 0; q < 4; ++q) { const float kv = (1.0f - __expf(lfr[j][q])) * __expf(bl[j][q] - bb[j][q]); Kp[(16 * seg + 4 * j + q) * HP + ((((t_r >> 3) ^ seg) << 3) | (t_r & 7))] = (bf16_t)f2bf(kv); }
        }
        lds_barrier();
        bf16x8 af[2];
#pragma unroll
        for (int ks = 0; ks < 2; ++ks) af[ks] = *(const LAS bf16x8*)(Kp + (16 * F.wave + l15) * HP + (((ks * 4 + lq) ^ F.wave) << 3));
#pragma unroll
        for (int vt = 0; vt < 8; ++vt) {
            f32x4 acc = {0.f, 0.f, 0.f, 0.f};
#pragma unroll
            for (int ks = 0; ks < 2; ++ks) { const bf16x8 bfr = *(const LAS bf16x8*)(It + (16 * vt + l15) * HP + (((ks * 4 + lq) ^ vt) << 3)); acc = __builtin_amdgcn_mfma_f32_16x16x32_bf16(af[ks], bfr, acc, 0, 0, 0); }
            u32x2 w; w.x = pk2(acc[0], acc[1]); w.y = pk2(acc[2], acc[3]);
            *(u32x2*)(hst + (((size_t)bh * 64 + c) * 128 + 16 * vt + l15) * 128 + 16 * F.wave + 4 * lq) = w;
        }
        lds_barrier();
        lhr[0] = lhn[0]; lhr[1] = lhn[1];
        ir[0] = in_[0]; ir[1] = in_[1];
    }
}
#define H3_LOAD_SF(it_, SF) do { const int bh_ = (it_) >> 6, c_ = (it_) & 63; \
    _Pragma("unroll") for (int ks_ = 0; ks_ < 4; ++ks_) SF[ks_] = __builtin_nontemporal_load((const bf16x8*)(hst + (((size_t)bh_ * 64 + c_) * 128 + 16 * w + l15) * 128 + ks_ * 32 + 8 * lq)); } while (0)
#define H3_LOAD_GR(it_, GR) do { const int bh_ = (it_) >> 6, c_ = (it_) & 63; const size_t row0_ = (size_t)(bh_ >> 2) * SEQ + c_ * 64; \
    _Pragma("unroll") for (int tt_ = 0; tt_ < 4; ++tt_) GR[tt_] = __builtin_nontemporal_load((const u32x2*)(proj + (row0_ + 16 * tt_ + l15) * DIN + C_GB + (bh_ & 3) * 128 + 16 * w + 4 * lq)); } while (0)
#define H3_LOAD_Q(it_, QR) do { const int bh_ = (it_) >> 6, c_ = (it_) & 63; const size_t r_ = (size_t)(bh_ >> 2) * SEQ + c_ * 64 + t_r; const int hh_ = (bh_ & 3) * 128 + 16 * seg; \
    _Pragma("unroll") for (int j_ = 0; j_ < 2; ++j_) QR[j_] = __builtin_nontemporal_load((const u32x4*)(proj + r_ * DIN + C_QB + hh_ + 8 * j_)); } while (0)
#define H3_LOAD_LATE(it_, SF, GR) do { H3_LOAD_SF(it_, SF); H3_LOAD_GR(it_, GR); } while (0)
__device__ __forceinline__ void h3_outputs_p(const Frame& F0, const Args& a) {
    const Frame F = fresh(F0);
    const bf16_t* proj = (const bf16_t*)(a.ws + WS_PROJ); const float* logf = (const float*)(a.ws + WS_LOGF);
    const bf16_t* hst = (const bf16_t*)(a.ws + WS_HST); bf16_t* yb = (bf16_t*)(a.ws + WS_YA); const float* nw = a.in[I_HNW];
    LAS float* LF = (LAS float*)F.lds; LAS bf16_t* Qt = (LAS bf16_t*)(F.lds + 64 * LFP * 4); LAS bf16_t* Kt = Qt + 64 * HQ; LAS bf16_t* It = Kt + 64 * HQ; LAS bf16_t* Pm = It + 128 * HP;
    LAS float* rsq = (LAS float*)(Pm + 64 * HP);
    const int t_r = F.tid >> 3, seg = F.tid & 7, l15 = F.lane & 15, lq = F.lane >> 4, w = F.wave;
    f32x4 lfr[4]; h16x8 lhr[2], lhn[2]; u32x4 qr[2], qn[2], ir[2], in_[2]; bf16x8 sf[4], sfn[4]; u32x2 gr[4], grn[4];
    int it = F.bid;
    if (it < 2048) { H_LOAD_LQI(it, lhr, qr, ir, true); H3_LOAD_LATE(it, sf, gr); }
    for (; it < 2048; it += F.G) {
        const int bh = it >> 6, c = it & 63, b = bh >> 2, h = bh & 3; const size_t row0 = (size_t)b * SEQ + c * 64;
        H_CVT_LF(lfr, lhr);
#pragma unroll
        for (int j = 0; j < 4; ++j) *(LAS f32x4*)(LF + t_r * LFP + 16 * seg + 4 * j) = lfr[j];
        scatter_it(It, ir, seg, t_r);
        const int itn = it + F.G;
        if (itn < 2048) H_LOAD_LQI(itn, lhn, qn, in_, false);
        lds_barrier();
        if (itn < 2048) H3_LOAD_Q(itn, qn);
        if (F.tid < 128) { float run = 0.f;
#pragma unroll 16
            for (int t = 0; t < 64; ++t) { run += LF[t * LFP + F.tid]; LF[t * LFP + F.tid] = run; } }
        lds_barrier();
        if (itn < 2048) H3_LOAD_SF(itn, sfn);
        {
            float qv[16], kv[16];
#pragma unroll
            for (int j = 0; j < 4; ++j) { const f32x4 bb = *(const LAS f32x4*)(LF + t_r * LFP + 16 * seg + 4 * j);
#pragma unroll
                for (int q = 0; q < 4; ++q) { const float eb = __expf(bb[q]); const unsigned qw = (j < 2 ? qr[0] : qr[1])[(2 * j + (q >> 1)) & 3];
                    const float qs = (q & 1) ? bf_hi(qw) : bf_lo(qw);
                    qv[4 * j + q] = qs * eb; kv[4 * j + q] = (1.0f - __expf(lfr[j][q])) * __builtin_amdgcn_rcpf(eb); } }
            u32x4 o0, o1;
            o0.x = pk2(qv[0], qv[1]); o0.y = pk2(qv[2], qv[3]); o0.z = pk2(qv[4], qv[5]); o0.w = pk2(qv[6], qv[7]); o1.x = pk2(qv[8], qv[9]); o1.y = pk2(qv[10], qv[11]); o1.z = pk2(qv[12], qv[13]); o1.w = pk2(qv[14], qv[15]);
            *(LAS u32x4*)(Qt + t_r * HQ + 16 * seg) = o0; *(LAS u32x4*)(Qt + t_r * HQ + 16 * seg + 8) = o1;
            o0.x = pk2(kv[0], kv[1]); o0.y = pk2(kv[2], kv[3]); o0.z = pk2(kv[4], kv[5]); o0.w = pk2(kv[6], kv[7]); o1.x = pk2(kv[8], kv[9]); o1.y = pk2(kv[10], kv[11]); o1.z = pk2(kv[12], kv[13]); o1.w = pk2(kv[14], kv[15]);
            *(LAS u32x4*)(Kt + t_r * HQ + 16 * seg) = o0; *(LAS u32x4*)(Kt + t_r * HQ + 16 * seg + 8) = o1;
        }
        lds_barrier();
        if (itn < 2048) H3_LOAD_GR(itn, grn);
        {
            const int tt = w >> 1; bf16x8 qa[4];
#pragma unroll
            for (int ks = 0; ks < 4; ++ks) qa[ks] = *(const LAS bf16x8*)(Qt + (16 * tt + l15) * HQ + ks * 32 + 8 * lq);
#pragma unroll
            for (int j = 0; j < 2; ++j) {
                const int st = (w & 1) * 2 + j; f32x4 acc = {0.f, 0.f, 0.f, 0.f};
#pragma unroll
                for (int ks = 0; ks < 4; ++ks) { const bf16x8 kb = *(const LAS bf16x8*)(Kt + (16 * st + l15) * HQ + ks * 32 + 8 * lq); acc = __builtin_amdgcn_mfma_f32_16x16x32_bf16(qa[ks], kb, acc, 0, 0, 0); }
                const int s = 16 * st + l15;
#pragma unroll
                for (int r = 0; r < 4; ++r) { const int t = 16 * tt + 4 * lq + r; Pm[t * HP + s] = (bf16_t)(s <= t ? f2bf(acc[r]) : 0u); }
            }
        }
        lds_barrier();
        f32x4 o[4];
        {
            bf16x8 ia[2];
#pragma unroll
            for (int ks = 0; ks < 2; ++ks) ia[ks] = *(const LAS bf16x8*)(It + (16 * w + l15) * HP + (((ks * 4 + lq) ^ w) << 3));
#pragma unroll
            for (int tt = 0; tt < 4; ++tt) {
                f32x4 acc = {0.f, 0.f, 0.f, 0.f};
#pragma unroll
                for (int ks = 0; ks < 2; ++ks) { const bf16x8 pb = *(const LAS bf16x8*)(Pm + (16 * tt + l15) * HP + ks * 32 + 8 * lq); acc = __builtin_amdgcn_mfma_f32_16x16x32_bf16(ia[ks], pb, acc, 0, 0, 0); }
#pragma unroll
                for (int ks = 0; ks < 4; ++ks) { const bf16x8 qb = *(const LAS bf16x8*)(Qt + (16 * tt + l15) * HQ + ks * 32 + 8 * lq); acc = __builtin_amdgcn_mfma_f32_16x16x32_bf16(sf[ks], qb, acc, 0, 0, 0); }
                o[tt] = acc;
                float sq = (acc[0] * acc[0] + acc[1] * acc[1]) + (acc[2] * acc[2] + acc[3] * acc[3]);
                sq += __shfl_xor(sq, 16); sq += __shfl_xor(sq, 32);
                if (F.lane < 16) rsq[w * 64 + 16 * tt + F.lane] = sq;
            }
        }
        lds_barrier();
        const int v0 = 16 * w + 4 * lq; const f32x4 nw4 = *(const f32x4*)(nw + h * 128 + v0);
#pragma unroll
        for (int tt = 0; tt < 4; ++tt) {
            const int t = 16 * tt + l15; float tot = 0.f;
#pragma unroll
            for (int ww = 0; ww < 8; ++ww) tot += rsq[ww * 64 + t];
            const float rstd = __builtin_amdgcn_rsqf(tot * (1.0f / 128.0f) + RMS_EPS);
            const u32x2 gg = gr[tt];
            u32x2 y; y.x = pk2(o[tt][0] * rstd * nw4[0] * bf_lo(gg.x), o[tt][1] * rstd * nw4[1] * bf_hi(gg.x)); y.y = pk2(o[tt][2] * rstd * nw4[2] * bf_lo(gg.y), o[tt][3] * rstd * nw4[3] * bf_hi(gg.y));
            *(u32x2*)(yb + (row0 + t) * 1024 + 512 + h * 128 + v0) = y;
        }
        lds_barrier();
        lhr[0] = lhn[0]; lhr[1] = lhn[1];
        qr[0] = qn[0]; qr[1] = qn[1]; ir[0] = in_[0]; ir[1] = in_[1];
#pragma unroll
        for (int j = 0; j < 4; ++j) { sf[j] = sfn[j]; gr[j] = grn[j]; }
    }
}
#undef H3_LOAD_LATE
#undef H3_LOAD_SF
#undef H3_LOAD_Q
#undef H3_LOAD_GR

#include <hip/hip_bf16.h>
#include <cmath>
namespace attn_body {
using bf16=__hip_bfloat16;
using bf16x8=__attribute__((ext_vector_type(8)))short;
using s16x4=__attribute__((ext_vector_type(4)))short;
using f32x16=__attribute__((ext_vector_type(16)))float;
using u32x4=__attribute__((ext_vector_type(4)))unsigned;
constexpr int BATCH=8,NHEAD=8,SEQ=4096,D=64,PIN=5632,POUT=1024,PKM=512;
constexpr int NW=8,QBLK=32,QB=QBLK*NW,KVBLK=64,NQB=SEQ/QB;
constexpr int ATTN_UNIT_ROWS=QB;
__device__ __forceinline__ int crow(int r,int hi){return (r&3)+8*(r>>2)+4*hi;}
#define SBAR() __builtin_amdgcn_sched_barrier(0)
__device__ __forceinline__ void cmask(f32x16&p0,f32x16&p1,int jb,int qrel,int hi){
  const float NEG=-INFINITY; int kb=64*jb+4*hi;
  #pragma unroll
  for(int r=0;r<16;++r){int kv=kb+(r&3)+8*(r>>2); if(kv>qrel)p0[r]=NEG; if(kv+32>qrel)p1[r]=NEG;}
}

__device__ __forceinline__ void smask(f32x16&p0,f32x16&p1,unsigned selm,int n){ if(!((selm>>n)&1u)){ const float NEG=-INFINITY;
  #pragma unroll
  for(int r=0;r<16;++r){p0[r]=NEG;p1[r]=NEG;} } }
constexpr int NSLOT=3, SLOTB=8192;
constexpr int LDS_K=0, LDS_V=NSLOT*SLOTB, LDS_WS=2*NSLOT*SLOTB, LDS_OST=LDS_WS+NW*64*4, LDS_BYTES=LDS_OST+NW*4096;
constexpr float C2=0.125f*1.4426950408889634f;
__device__ __forceinline__ void glds16(const void*gsrc,unsigned lds_dst){unsigned keep;
  asm volatile("s_mov_b32 %0, m0\n\ts_mov_b32 m0, %2\n\ts_nop 0\n\tglobal_load_lds_dwordx4 %1, off\n\ts_mov_b32 m0, %0":"=&s"(keep):"v"(gsrc),"s"(lds_dst):"memory");}
__device__ __forceinline__ float max3f(float a,float b,float c){float r;asm("v_max3_f32 %0, %1, %2, %3":"=v"(r):"v"(a),"v"(b),"v"(c));return r;}
__device__ __forceinline__ float max2f(float a,float b){float r;asm("v_max_f32_e32 %0, %1, %2":"=v"(r):"v"(a),"v"(b));return r;}
__device__ __forceinline__ float fadd_s(float a,float b){float r;asm("v_add_f32_e32 %0, %1, %2":"=v"(r):"v"(a),"v"(b));return r;}
__device__ __forceinline__ float fsub_s(float a,float b){float r;asm("v_sub_f32_e32 %0, %1, %2":"=v"(r):"v"(a),"v"(b));return r;}
typedef float f32x2_t __attribute__((ext_vector_type(2))); typedef __bf16 bf16x2_t __attribute__((ext_vector_type(2)));
__device__ __forceinline__ unsigned cvtpk_s(float lo,float hi){f32x2_t v={lo,hi};bf16x2_t b=__builtin_convertvector(v,bf16x2_t);return __builtin_bit_cast(unsigned,b);}
#define WAIT_BAR(N) asm volatile("s_waitcnt vmcnt(" #N ") lgkmcnt(0)\n\ts_barrier":::"memory")

__device__ __forceinline__ void qkt(f32x16&p0,f32x16&p1,const char*Kslot,const bf16x8*qr,int r32,int hi){
  const char*kb=Kslot+hi*1024+r32*16;
  #pragma unroll
  for(int d0=0;d0<4;++d0){
    const bf16x8 b0=*reinterpret_cast<const bf16x8*>(kb+d0*2048);
    const bf16x8 b1=*reinterpret_cast<const bf16x8*>(kb+d0*2048+512);
    if(d0==0){p0=__builtin_amdgcn_mfma_f32_32x32x16_bf16(b0,qr[0],f32x16{},0,0,0);p1=__builtin_amdgcn_mfma_f32_32x32x16_bf16(b1,qr[0],f32x16{},0,0,0);}
    else{p0=__builtin_amdgcn_mfma_f32_32x32x16_bf16(b0,qr[d0],p0,0,0,0);p1=__builtin_amdgcn_mfma_f32_32x32x16_bf16(b1,qr[d0],p1,0,0,0);}}
}
typedef __attribute__((address_space(3))) const char* lds_cptr;
typedef short v4i16_t __attribute__((ext_vector_type(4)));
__device__ __forceinline__ void kload8(bf16x8*kf,lds_cptr kp){
  kf[0]=*(const __attribute__((address_space(3))) bf16x8*)(kp);      kf[1]=*(const __attribute__((address_space(3))) bf16x8*)(kp+512);
  kf[2]=*(const __attribute__((address_space(3))) bf16x8*)(kp+2048); kf[3]=*(const __attribute__((address_space(3))) bf16x8*)(kp+2560);
  kf[4]=*(const __attribute__((address_space(3))) bf16x8*)(kp+4096); kf[5]=*(const __attribute__((address_space(3))) bf16x8*)(kp+4608);
  kf[6]=*(const __attribute__((address_space(3))) bf16x8*)(kp+6144); kf[7]=*(const __attribute__((address_space(3))) bf16x8*)(kp+6656);
}
__device__ __forceinline__ void kload2(bf16x8*kf,lds_cptr kp,int j){ kf[2*j]=*(const __attribute__((address_space(3))) bf16x8*)(kp+j*2048); kf[2*j+1]=*(const __attribute__((address_space(3))) bf16x8*)(kp+j*2048+512); }
__device__ __forceinline__ s16x4 vtr(lds_cptr p){ return __builtin_bit_cast(s16x4,__builtin_amdgcn_ds_read_tr16_b64_v4i16((__attribute__((address_space(3))) v4i16_t*)p)); }
__device__ __forceinline__ float rowmax(const f32x16&p0,const f32x16&p1){
  float a=max3f(p0[0],p0[1],p1[0]),b=max3f(p0[2],p0[3],p1[1]);a=max3f(a,p1[2],p1[3]);
  #pragma unroll
  for(int r=4;r<16;r+=4){a=max3f(a,p0[r],p0[r+1]);b=max3f(b,p0[r+2],p0[r+3]);a=max3f(a,p1[r],p1[r+1]);b=max3f(b,p1[r+2],p1[r+3]);}
  const float m=max2f(a,b);
  auto rr=__builtin_amdgcn_permlane32_swap(__float_as_uint(m),__float_as_uint(m),false,false);
  return max2f(__uint_as_float(rr[0]),__uint_as_float(rr[1]));
}
__device__ __forceinline__ void pv(f32x16*o,int vb,bf16x8 pa0,bf16x8 pa1,bf16x8 pa2,bf16x8 pa3){
  #pragma unroll
  for(int d0=0;d0<2;++d0){s16x4 lo[4],hi[4];
    #pragma unroll
    for(int ks=0;ks<4;++ks){
      asm volatile("ds_read_b64_tr_b16 %0,%1 offset:%c2":"=&v"(lo[ks]):"v"(vb),"i"(d0*4096+ks*1024):"memory");
      asm volatile("ds_read_b64_tr_b16 %0,%1 offset:%c2":"=&v"(hi[ks]):"v"(vb),"i"(d0*4096+ks*1024+512):"memory");}
    asm volatile("s_waitcnt lgkmcnt(0)":::"memory");SBAR();
    #define PK(k) (bf16x8){lo[k][0],lo[k][1],lo[k][2],lo[k][3],hi[k][0],hi[k][1],hi[k][2],hi[k][3]}
    o[d0]=__builtin_amdgcn_mfma_f32_32x32x16_bf16(pa0,PK(0),o[d0],0,0,0);
    o[d0]=__builtin_amdgcn_mfma_f32_32x32x16_bf16(pa1,PK(1),o[d0],0,0,0);
    o[d0]=__builtin_amdgcn_mfma_f32_32x32x16_bf16(pa2,PK(2),o[d0],0,0,0);
    o[d0]=__builtin_amdgcn_mfma_f32_32x32x16_bf16(pa3,PK(3),o[d0],0,0,0);
    #undef PK
  }
}

#ifndef ATTN_STORE16
#define ATTN_STORE16(p,v) (*(u32x4*)(p)=(v))
#endif
template<int THRL> __device__ __forceinline__ void attn_unit(int wave_,int b,int h,int qb,const bf16*Q,const bf16*__restrict__ K,const bf16*__restrict__ V,const bf16*__restrict__ KM,bf16*O,char*shm){
  const int lane=lane_id_(),tid=wave_*64+lane,r32=lane&31,hi=lane>>5; const int wid=wave_;
  const long rowbase=(long)b*SEQ; const int q0=qb*QB;
  const bf16*Qw=Q+(rowbase+q0+wid*QBLK)*PIN+h*D;
  const bf16*Kh=K+rowbase*PIN+h*D,*Vh=V+rowbase*PIN+h*D;
  const unsigned lds0=(unsigned)(uintptr_t)shm;
  float*wsf=(float*)(shm+LDS_WS)+wid*64;
  const bf16*ksrc=Kh+(long)lane*PIN+wid*8;
  const bf16*kmsrc=KM+((long)b*64+lane)*PKM+h*D+wid*8;
  const bf16*vsrc=Vh+(long)(16*(wid&3)+(lane>>2))*PIN+(wid>>2)*32+(lane&3)*8;
  const unsigned kdst=lds0+LDS_K+wid*1024, vdst=lds0+LDS_V+wid*1024;
  #define DMA_K(t,slot) glds16(ksrc+(long)(t)*KVBLK*PIN,(unsigned)__builtin_amdgcn_readfirstlane(kdst+(slot)))
  #define DMA_V(t,slot) glds16(vsrc+(long)(t)*KVBLK*PIN,(unsigned)__builtin_amdgcn_readfirstlane(vdst+(slot)))
  const int vb0=(int)(lds0+LDS_V)+((lane>>4)&1)*32+(lane&3)*8+(4*hi+((lane&15)>>2))*64;
  const char*Kbase=shm+LDS_K; bf16x8 kf[8];
  const lds_cptr shm3=(lds_cptr)shm; const lds_cptr kp0=shm3+LDS_K+hi*1024+r32*16; const lds_cptr vp0=shm3+LDS_V+((lane>>4)&1)*32+(lane&3)*8+(4*hi+((lane&15)>>2))*64;
  const int NT=(q0+QB)/KVBLK;
  glds16(kmsrc,(unsigned)__builtin_amdgcn_readfirstlane(lds0+LDS_V+2*SLOTB+wid*1024));
  DMA_K(0,0);DMA_V(0,0);DMA_K(1,SLOTB);
  bf16x8 qr[4];
  #pragma unroll
  for(int d0=0;d0<4;++d0)qr[d0]=*reinterpret_cast<const bf16x8*>(&Qw[(long)r32*PIN+d0*16+hi*8]);
  float mhat=0.f,l_reg=0.f;f32x16 o[2];o[0]=f32x16{};o[1]=f32x16{};
  const int qrel=wid*QBLK+r32;
  #define CMASK(P0,P1,t) do{int jb_=(t)-(NT-4); const float sb_=(jb_>=0||((selm>>((t)>>2))&1u))?mhat:INFINITY; {const float nsb_=-sb_;P0=P0+nsb_;P1=P1+nsb_;} if(jb_>=0)cmask(P0,P1,jb_,qrel,hi);}while(0)
  bool resc=false;
  #define START(P0,P1) do{ const float rm=rowmax(P0,P1); resc=false; \
    { const float dl=(rm>-1.0e30f)?rm:0.f; mhat=fadd_s(mhat,dl); \
      _Pragma("unroll") for(int r=0;r<16;++r){P0[r]=fsub_s(P0[r],dl);P1[r]=fsub_s(P1[r],dl);} \
      } \
    _Pragma("unroll") for(int r=0;r<16;++r)P0[r]=__builtin_amdgcn_exp2f(P0[r]); }while(0)
  #define RESC() do{ if(resc){ asm volatile("s_waitcnt lgkmcnt(0)":::"memory"); \
      _Pragma("unroll") for(int d_=0;d_<2;++d_) _Pragma("unroll") for(int r=0;r<16;++r)o[d_][r]*=wsf[crow(r,hi)]; } }while(0)
  f32x16 pA0,pA1,pB0,pB1;
  int sl_prev=0,sl_cur=0,sl_next=SLOTB;
  #define ROT() do{sl_prev=sl_cur;sl_cur=sl_next;sl_next=(sl_next==(NSLOT-1)*SLOTB)?0:sl_next+SLOTB;}while(0)
  DMA_K(2,2*SLOTB);
  unsigned selm=0u;
  WAIT_BAR(4);
  { f32x16 g0,g1;
    qkt(g0,g1,shm+LDS_V+2*SLOTB,qr,r32,hi); asm volatile("s_nop 15\n\ts_nop 7":"+v"(g0),"+v"(g1));
    float gm[8],go[8],g[16];
    #pragma unroll
    for(int r=0;r<8;++r){gm[r]=g0[r];go[r]=__shfl_xor(gm[r],32);}
    #pragma unroll
    for(int j=0;j<4;++j){ g[j]=hi?go[j]:gm[j]; g[4+j]=hi?gm[j]:go[j]; g[8+j]=hi?go[4+j]:gm[4+j]; g[12+j]=hi?gm[4+j]:go[4+j]; }
    #pragma unroll
    for(int s=0;s<3;++s){ float best=-3.0e38f; int bi=-1;
      #pragma unroll
      for(int n=0;n<16;++n){ const bool ok=(n<qb)&&!((selm>>n)&1u)&&(g[n]>best); if(ok){best=g[n];bi=n;} }
      if(bi>=0)selm|=1u<<bi; } }
  WAIT_BAR(3);
  qkt(pA0,pA1,Kbase,qr,r32,hi);asm volatile("s_nop 15\n\ts_nop 7":"+v"(pA0),"+v"(pA1));CMASK(pA0,pA1,0);
  START(pA0,pA1);
  _Pragma("unroll") for(int r=0;r<16;++r)pA1[r]=__builtin_amdgcn_exp2f(pA1[r]);
  WAIT_BAR(0);
  DMA_K(3,0);DMA_V(1,SLOTB);
  ROT();
  kload8(kf,kp0+sl_cur);
  WAIT_BAR(2);
  s16x4 vlo[8],vhi[8]; u32x4 pw0,pw1,pw2,pw3;
  #define PKW(P,B) cvtpk_s(P[B],P[B+1])
  #define PAF(k) __builtin_bit_cast(bf16x8,pw##k)
  #define VFR(i) (bf16x8){vlo[i][0],vlo[i][1],vlo[i][2],vlo[i][3],vhi[i][0],vhi[i][1],vhi[i][2],vhi[i][3]}
  #define PIN(x) asm volatile("":"+v"(x))
  #define MX3(a,b,c) __builtin_fmaxf(__builtin_fmaxf((a),(b)),(c))
  #define GAPA(MF,A0,A1,A2,A3,W0,W1,PW) do{ MF; sacc+=A0; sacc+=A1; sacc+=A2; sacc+=A3; PIN(sacc); W0; W1; PIN(PW); SBAR(); }while(0)
  #define EX(v) __builtin_amdgcn_exp2f(v)
  #define GAPB(MF,X,B) do{ MF; X[B]=EX(X[B]); X[B+1]=EX(X[B+1]); X[B+2]=EX(X[B+2]); X[B+3]=EX(X[B+3]); PIN(X); SBAR(); }while(0)
  #define VRD(i) do{ vlo[i]=vtr(vp_+(((i)>>2)*4096+((i)&3)*1024)); vhi[i]=vtr(vp_+(((i)>>2)*4096+((i)&3)*1024+512)); }while(0)
  #define KRD(G,j) do{ if(G){ kload2(kf,kp0+sl_next,j); SBAR(); } }while(0)
  #define STEP(C0,C1,P0,P1,t,GK,GV,GL) do{ SBAR(); \
    const lds_cptr vp_=vp0+sl_prev; \
    VRD(0); SBAR(); float sacc=(P0[0]+P0[1]); \
    GAPA(C0=__builtin_amdgcn_mfma_f32_32x32x16_bf16(kf[0],qr[0],f32x16{},0,0,0), P0[2],P0[3],P0[4],P0[5],     pw0[0]=PKW(P0,0), pw0[1]=PKW(P0,2), pw0); \
    VRD(4); SBAR(); GAPA(C1=__builtin_amdgcn_mfma_f32_32x32x16_bf16(kf[1],qr[0],f32x16{},0,0,0), P0[6],P0[7],P0[8],P0[9],     pw0[2]=PKW(P0,4), pw0[3]=PKW(P0,6), pw0); \
    VRD(1); SBAR(); GAPA(C0=__builtin_amdgcn_mfma_f32_32x32x16_bf16(kf[2],qr[1],C0,0,0,0),   P0[10],P0[11],P0[12],P0[13], pw1[0]=PKW(P0,8), pw1[1]=PKW(P0,10), pw1); \
    VRD(5); SBAR(); GAPA(C1=__builtin_amdgcn_mfma_f32_32x32x16_bf16(kf[3],qr[1],C1,0,0,0),   P0[14],P0[15],P1[0],P1[1],   pw1[2]=PKW(P0,12),pw1[3]=PKW(P0,14), pw1); \
    VRD(2); SBAR(); GAPA(C0=__builtin_amdgcn_mfma_f32_32x32x16_bf16(kf[4],qr[2],C0,0,0,0),   P1[2],P1[3],P1[4],P1[5],     pw2[0]=PKW(P1,0), pw2[1]=PKW(P1,2), pw2); \
    VRD(6); SBAR(); GAPA(C1=__builtin_amdgcn_mfma_f32_32x32x16_bf16(kf[5],qr[2],C1,0,0,0),   P1[6],P1[7],P1[8],P1[9],     pw2[2]=PKW(P1,4), pw2[3]=PKW(P1,6), pw2); \
    VRD(3); SBAR(); GAPA(C0=__builtin_amdgcn_mfma_f32_32x32x16_bf16(kf[6],qr[3],C0,0,0,0),   P1[10],P1[11],P1[12],P1[13], pw3[0]=PKW(P1,8), pw3[1]=PKW(P1,10), pw3); \
    VRD(7); SBAR(); GAPA(C1=__builtin_amdgcn_mfma_f32_32x32x16_bf16(kf[7],qr[3],C1,0,0,0),   P1[14],P1[15],0.f,0.f,       pw3[2]=PKW(P1,12),pw3[3]=PKW(P1,14), pw3); \
    l_reg+=sacc; \
    if(GK){DMA_K((t)+3,sl_cur);} if(GV){DMA_V((t)+1,sl_next);} \
    CMASK(C0,C1,t); \
    { float a=MX3(C0[0],C0[1],C1[0]),b=MX3(C0[2],C0[3],C1[1]); a=MX3(a,C1[2],C1[3]); \
      _Pragma("unroll") for(int r=4;r<16;r+=4){a=MX3(a,C0[r],C0[r+1]);b=MX3(b,C0[r+2],C0[r+3]);a=MX3(a,C1[r],C1[r+1]);b=MX3(b,C1[r+2],C1[r+3]);} \
      float rm=__builtin_fmaxf(a,b); { auto rr=__builtin_amdgcn_permlane32_swap(__float_as_uint(rm),__float_as_uint(rm),false,false); rm=__builtin_fmaxf(__uint_as_float(rr[0]),__uint_as_float(rr[1])); } \
      resc=false; \
      if(__builtin_expect(__any(rm>(float)THRL),0)){ const float dl=__builtin_fmaxf(rm,0.f); mhat+=dl; \
        _Pragma("unroll") for(int r=0;r<16;++r){C0[r]-=dl;C1[r]-=dl;} \
        const float f=__builtin_amdgcn_exp2f(-dl); l_reg*=f; if(hi==0)wsf[r32]=f; resc=true; } } \
    SBAR(); \
    GAPB(o[0]=__builtin_amdgcn_mfma_f32_32x32x16_bf16(PAF(0),VFR(0),o[0],0,0,0), C0,0); \
    GAPB(o[1]=__builtin_amdgcn_mfma_f32_32x32x16_bf16(PAF(0),VFR(4),o[1],0,0,0), C0,4); \
    KRD(GL,0); GAPB(o[0]=__builtin_amdgcn_mfma_f32_32x32x16_bf16(PAF(1),VFR(1),o[0],0,0,0), C0,8); \
    KRD(GL,1); GAPB(o[1]=__builtin_amdgcn_mfma_f32_32x32x16_bf16(PAF(1),VFR(5),o[1],0,0,0), C0,12); \
    KRD(GL,2); GAPB(o[0]=__builtin_amdgcn_mfma_f32_32x32x16_bf16(PAF(2),VFR(2),o[0],0,0,0), C1,0); \
    KRD(GL,3); GAPB(o[1]=__builtin_amdgcn_mfma_f32_32x32x16_bf16(PAF(2),VFR(6),o[1],0,0,0), C1,4); \
    GAPB(o[0]=__builtin_amdgcn_mfma_f32_32x32x16_bf16(PAF(3),VFR(3),o[0],0,0,0), C1,8); \
    GAPB(o[1]=__builtin_amdgcn_mfma_f32_32x32x16_bf16(PAF(3),VFR(7),o[1],0,0,0), C1,12); \
    }while(0)
  int t=1;
  #undef CMASK
  #define CMASK(P0,P1,t) do{ const float sb_=((selm>>((t)>>2))&1u)?mhat:INFINITY; {const float nsb_=-sb_;P0=P0+nsb_;P1=P1+nsb_;} }while(0)
  for(;t+5<NT;t+=2){
    STEP(pB0,pB1,pA0,pA1,t,true,true,true);     WAIT_BAR(2); RESC(); ROT();
    STEP(pA0,pA1,pB0,pB1,t+1,true,true,true);   WAIT_BAR(2); RESC(); ROT();
  }
  #undef CMASK
  #define CMASK(P0,P1,t) do{int jb_=(t)-(NT-4); const float sb_=(jb_>=0||((selm>>((t)>>2))&1u))?mhat:INFINITY; {const float nsb_=-sb_;P0=P0+nsb_;P1=P1+nsb_;} if(jb_>=0)cmask(P0,P1,jb_,qrel,hi);}while(0)
  #define ENDW(tt) do{ if((tt)+3<NT){WAIT_BAR(2);} else if((tt)+2<NT){WAIT_BAR(1);} else {WAIT_BAR(0);} }while(0)
  for(;t+1<NT;t+=2){
    STEP(pB0,pB1,pA0,pA1,t,(t+3<NT),(t+1<NT),(t+1<NT));       ENDW(t);   RESC(); ROT();
    STEP(pA0,pA1,pB0,pB1,t+1,(t+4<NT),(t+2<NT),(t+2<NT));     ENDW(t+1); RESC(); ROT();
  }
  STEP(pB0,pB1,pA0,pA1,NT-1,false,false,false); RESC();
  { float sacc=pB0[0]+pB0[1]; _Pragma("unroll") for(int r=2;r<16;++r)sacc+=pB0[r]; _Pragma("unroll") for(int r=0;r<16;++r)sacc+=pB1[r]; l_reg+=sacc;
    pw0=(u32x4){PKW(pB0,0),PKW(pB0,2),PKW(pB0,4),PKW(pB0,6)};pw1=(u32x4){PKW(pB0,8),PKW(pB0,10),PKW(pB0,12),PKW(pB0,14)};pw2=(u32x4){PKW(pB1,0),PKW(pB1,2),PKW(pB1,4),PKW(pB1,6)};pw3=(u32x4){PKW(pB1,8),PKW(pB1,10),PKW(pB1,12),PKW(pB1,14)};
    SBAR(); pv(o,vb0+sl_cur,PAF(0),PAF(1),PAF(2),PAF(3)); }
  #undef PKW
  #undef PAF
  #undef VFR
  #undef PIN
  #undef MX3
  #undef GAPA
  #undef GAPB
  #undef EX
  #undef VRD
  #undef KRD
  #undef STEP
  #undef ENDW
  {auto rr=__builtin_amdgcn_permlane32_swap(__float_as_uint(l_reg),__float_as_uint(l_reg),false,false);l_reg=__uint_as_float(rr[0])+__uint_as_float(rr[1]);}
  if(hi==0)wsf[32+r32]=l_reg;asm volatile("s_waitcnt lgkmcnt(0)":::"memory");
  float rli[16];
  #pragma unroll
  for(int r=0;r<16;++r)rli[r]=__builtin_amdgcn_rcpf(wsf[32+crow(r,hi)]);
  bf16*Ow=O+(rowbase+q0+wid*QBLK)*POUT+h*D;
  { bf16*stg=(bf16*)(shm+LDS_OST)+wid*2048;
    #pragma unroll
    for(int r=0;r<16;++r){const int orow=crow(r,hi);
      #pragma unroll
      for(int d0=0;d0<2;++d0)stg[orow*64+d0*32+r32]=__float2bfloat16(o[d0][r]*rli[r]);}
    asm volatile("s_waitcnt lgkmcnt(0)":::"memory");
    #pragma unroll
    for(int i=0;i<4;++i){const int row=i*8+(lane>>3),ch=lane&7; const u32x4 v=*(const u32x4*)(stg+row*64+ch*8); ATTN_STORE16(Ow+(long)row*POUT+ch*8,v);} }
  asm volatile("s_waitcnt lgkmcnt(0)\n\ts_barrier":::"memory");
  #undef DMA_K
  #undef DMA_V
  #undef CMASK
  #undef START
  #undef RESC
  #undef ROT
}
constexpr int ATTN_LDS_BYTES=LDS_BYTES;
struct AttnTensors { const bf16* Q; const bf16* K; const bf16* V; const bf16* KM; bf16* O; };
struct AttnUnit { int bh; int qb; };
struct StaticOrder {
  int vcu,G,blk;
  __device__ __forceinline__ explicit StaticOrder(int grid,int block):vcu((grid%8==0)?(block%8)*(grid/8)+block/8:block),G(grid),blk(block){}
  __device__ __forceinline__ bool next(int i,AttnUnit&u)const{
    if(G==256){ if(i>=4)return false; const int s=vcu&3; u.bh=vcu>>2; u.qb=(i==0)?s:(i==1)?7-s:(i==2)?8+s:15-s; return true; }
    const int idx=i*G+blk; if(idx>=BATCH*NHEAD*NQB)return false; u.bh=idx/NQB; u.qb=idx%NQB; return true; }
  __device__ __forceinline__ void a_ready(const AttnUnit&)const{}
  __device__ __forceinline__ void done(const AttnUnit&)const{}
};
template<class Sched,int THRL=8> __device__ __forceinline__ void attn_phase(char*lds,const AttnTensors&T,const Sched&S,int wave_){
  AttnUnit u;
  for(int i=0;S.next(i,u);++i){ S.a_ready(u); attn_unit<THRL>(wave_,u.bh/NHEAD,u.bh%NHEAD,u.qb,T.Q,T.K,T.V,T.KM,T.O,lds); S.done(u); }
}
#undef SBAR
#undef WAIT_BAR
}

template <bool DRY = false> __device__ __forceinline__ void p6_route(const Frame& F0, const Args& a) {
    const Frame F = fresh(F0);
    const bf16_t* x1 = (const bf16_t*)(a.ws + WS_X1); bf16_t* xn = (bf16_t*)(a.ws + WS_XN); const float* rw = a.in[I_RW]; const float* rb = a.in[I_RB]; const float* n2 = a.in[I_N2];
    unsigned* cnt = (unsigned*)(a.ws + WS_CTL) + CW_CNT; int* rows = (int*)(a.ws + WS_ROWS); float* roww = (float*)(a.ws + WS_ROWW);
    constexpr int HP2 = 1040;
    LAS float* H2 = (LAS float*)F.lds;
    LAS float* PL = (LAS float*)(F.lds + 16 * HP2 * 4);
    LAS int* lcnt = (LAS int*)(F.lds + MISC_OFF); LAS int* lbase = lcnt + 32; LAS int* ae = lbase + 32; LAS int* ap = ae + 512; LAS float* aw = (LAS float*)(ap + 512); LAS float* hsrow = aw + 512;
    float* rowhs = (float*)(a.ws + WS_ROWHS);
    const int lane = F.lane, e = lane & 31, w = F.wave, l15 = lane & 15, kq = lane >> 4;
    float rwq[8][4][2];
#pragma unroll
    for (int g = 0; g < 8; ++g)
#pragma unroll
        for (int s = 0; s < 4; ++s)
#pragma unroll
            for (int h = 0; h < 2; ++h) rwq[g][s][h] = rw[(size_t)(128 * w + 16 * g + 4 * kq + s) * NE + 16 * h + l15];
    const float bias = rb[e];
    for (int blk = F.bid; blk < NTOK / 128; blk += F.G) {
        if (F.tid < 32) lcnt[F.tid] = 0;
        u32x2 xq[2][4];
#pragma unroll
        for (int rr = 0; rr < 2; ++rr) { const u32x2* xr = (const u32x2*)(x1 + ((size_t)blk * 128 + 2 * w + rr) * DM) + lane;
#pragma unroll
            for (int j = 0; j < 4; ++j) xq[rr][j] = __builtin_nontemporal_load(xr + 64 * j); }
#pragma unroll 1
        for (int sub = 0; sub < 8; ++sub) {
#pragma unroll
            for (int rr = 0; rr < 2; ++rr) {
                const int rl = 2 * w + rr; const size_t row = (size_t)blk * 128 + sub * 16 + rl;
                const f32x4* wr = (const f32x4*)n2 + lane;
                f32x4 v[4]; float s = 0.f;
#pragma unroll
                for (int j = 0; j < 4; ++j) { const u32x2 xw = xq[rr][j]; v[j] = (f32x4){bf_lo(xw.x), bf_hi(xw.x), bf_lo(xw.y), bf_hi(xw.y)}; s += (v[j].x * v[j].x + v[j].y * v[j].y) + (v[j].z * v[j].z + v[j].w * v[j].w); }
                const float rstd = __builtin_amdgcn_rsqf(wave_sum(s) * (1.0f / DM) + RMS_EPS);
                u32x2* o8 = (u32x2*)(xn + row * DM) + lane; unsigned* o4 = (unsigned*)((unsigned char*)xn + row * DM) + lane;
#pragma unroll
                for (int j = 0; j < 4; ++j) { const f32x4 ww = wr[64 * j]; const f32x4 hv = v[j] * rstd * ww;
                    if constexpr (MOE1_I8) v[j] = hv;
                    else if constexpr (MOE_FP8) o4[64 * j] = pk4_fp8(hv.x, hv.y, hv.z, hv.w, S_H2);
                    else { u32x2 o; o.x = pk2(hv.x, hv.y); o.y = pk2(hv.z, hv.w); o8[64 * j] = o; }
                    *(LAS f32x4*)(H2 + rl * HP2 + 256 * j + 4 * lane) = hv; }
                if constexpr (MOE1_I8) {
                    float am = 0.f;
#pragma unroll
                    for (int j = 0; j < 4; ++j) am = fmaxf(fmaxf(am, fmaxf(fabsf(v[j].x), fabsf(v[j].y))), fmaxf(fabsf(v[j].z), fabsf(v[j].w)));
                    am = wave_max(am); const float inv = am > 0.f ? 127.0f / am : 0.f;
#pragma unroll
                    for (int j = 0; j < 4; ++j) o4[64 * j] = pk4_i8(v[j].x * inv, v[j].y * inv, v[j].z * inv, v[j].w * inv);
                    if (lane == 0) hsrow[sub * 16 + rl] = am * (1.0f / 127.0f); }
            }
            if (sub < 7) {
#pragma unroll
                for (int rr = 0; rr < 2; ++rr) { const u32x2* xr = (const u32x2*)(x1 + ((size_t)blk * 128 + (sub + 1) * 16 + 2 * w + rr) * DM) + lane;
#pragma unroll
                    for (int j = 0; j < 4; ++j) xq[rr][j] = __builtin_nontemporal_load(xr + 64 * j); }
            }
            lds_barrier();
            {
                f32x4 acc0 = {0.f, 0.f, 0.f, 0.f}, acc1 = {0.f, 0.f, 0.f, 0.f};
#pragma unroll
                for (int g = 0; g < 8; ++g) {
                    const f32x4 hq = *(const LAS f32x4*)(H2 + l15 * HP2 + 128 * w + 16 * g + 4 * kq);
#pragma unroll
                    for (int s = 0; s < 4; ++s) { acc0 = __builtin_amdgcn_mfma_f32_16x16x4f32(hq[s], rwq[g][s][0], acc0, 0, 0, 0); acc1 = __builtin_amdgcn_mfma_f32_16x16x4f32(hq[s], rwq[g][s][1], acc1, 0, 0, 0); }
                }
#pragma unroll
                for (int r = 0; r < 4; ++r) { PL[(w * 16 + 4 * kq + r) * 32 + l15] = acc0[r]; PL[(w * 16 + 4 * kq + r) * 32 + 16 + l15] = acc1[r]; }
            }
            lds_barrier();
            {
                const int rl = 2 * w + (lane >> 5); float val = bias;
#pragma unroll
                for (int ww = 0; ww < 8; ++ww) val += PL[(ww * 16 + rl) * 32 + e];
                unsigned key; { unsigned u = __builtin_bit_cast(unsigned, val); u ^= (unsigned)((int)u >> 31) | 0x80000000u; key = (u & ~31u) | (unsigned)(31 - e); }
                float tv[4]; int te[4];
#pragma unroll
                for (int k = 0; k < 4; ++k) {
                    unsigned m = key, o;
                    o = (unsigned)__builtin_amdgcn_update_dpp(0, (int)m, 0xB1, 0xF, 0xF, false);  m = m > o ? m : o;
                    o = (unsigned)__builtin_amdgcn_update_dpp(0, (int)m, 0x4E, 0xF, 0xF, false);  m = m > o ? m : o;
                    o = (unsigned)__builtin_amdgcn_update_dpp(0, (int)m, 0x141, 0xF, 0xF, false); m = m > o ? m : o;
                    o = (unsigned)__builtin_amdgcn_update_dpp(0, (int)m, 0x140, 0xF, 0xF, false); m = m > o ? m : o;
                    o = (unsigned)__shfl_xor((int)m, 16); m = m > o ? m : o;
                    te[k] = 31 - (int)(m & 31u); { const unsigned vb = m & ~31u; tv[k] = __builtin_bit_cast(float, (vb & 0x80000000u) ? (vb ^ 0x80000000u) : ~vb); }
                    if (e == te[k]) key = 0u;
                }
                if (e == 0) {
                    const float p1 = __expf(tv[1] - tv[0]), p2 = __expf(tv[2] - tv[0]), p3 = __expf(tv[3] - tv[0]); const float inv = 1.0f / (1.0f + p1 + p2 + p3);
                    const float w4[4] = {inv, p1 * inv, p2 * inv, p3 * inv};
                    const int rb_ = sub * 16 + rl;
#pragma unroll
                    for (int k = 0; k < 4; ++k) { const int pos = atomicAdd((int*)&lcnt[te[k]], 1); ae[rb_ * 4 + k] = te[k]; ap[rb_ * 4 + k] = pos; aw[rb_ * 4 + k] = w4[k]; }
                }
            }
        }
        lds_barrier();
        if (!DRY) { if (F.tid < 32) lbase[F.tid] = (int)__hip_atomic_fetch_add(cnt + F.tid, (unsigned)lcnt[F.tid], __ATOMIC_RELAXED, __HIP_MEMORY_SCOPE_AGENT); }
        lds_barrier();
        if (!DRY) { const int ee = ae[F.tid]; const size_t p = (size_t)ee * CAP + lbase[ee] + ap[F.tid]; rows[p] = blk * 512 + F.tid; roww[p] = aw[F.tid]; if constexpr (MOE1_I8) rowhs[p] = hsrow[F.tid >> 2]; }
        lds_barrier();
    }
}
__device__ __forceinline__ int moe_tiles(const Frame& F, const Args& a, LAS int* ts) {
    if (F.tid == 0) { const unsigned* cnt = (const unsigned*)(a.ws + WS_CTL) + CW_CNT; int acc = 0;
        for (int e = 0; e < NE; ++e) { const int c = (int)__hip_atomic_load(cnt + e, __ATOMIC_RELAXED, __HIP_MEMORY_SCOPE_AGENT); ts[e] = acc; ts[33 + e] = c; acc += (c + 255) >> 8; }
        ts[32] = acc; }
    __syncthreads();
    return ts[32];
}
__device__ __forceinline__ void p9_final(const Frame& F0, const Args& a) {
    const Frame F = fresh(F0);
    float* out = a.out; const bf16_t* yg = (const bf16_t*)(a.ws + WS_YG); const float* fw = a.in[I_FNW]; const bf16_t* x1 = (const bf16_t*)(a.ws + WS_X1);
    const int gw = F.bid * 8 + F.wave, NGW = F.G * 8;
    for (int row = gw; row < NTOK; row += NGW) {
        f32x4* xr = (f32x4*)(out + (size_t)row * DM) + F.lane;
        f32x4 v[4]; const u32x2* x1r = (const u32x2*)(x1 + (size_t)row * DM) + F.lane;
#pragma unroll
        for (int j = 0; j < 4; ++j) { const u32x2 xw = __builtin_nontemporal_load(x1r + 64 * j); v[j] = (f32x4){bf_lo(xw.x), bf_hi(xw.x), bf_lo(xw.y), bf_hi(xw.y)}; }
#pragma unroll
        for (int k = 0; k < 4; ++k) {
            if constexpr (MOE_FP8) { const unsigned* yp = (const unsigned*)((const unsigned char*)yg + ((size_t)row * 4 + k) * DM) + F.lane;
#pragma unroll
                for (int j = 0; j < 4; ++j) { const unsigned w = __builtin_nontemporal_load(yp + 64 * j); const f32x2 lo = __builtin_amdgcn_cvt_pk_f32_fp8(w, false), hi = __builtin_amdgcn_cvt_pk_f32_fp8(w, true);
                    v[j].x += lo.x * (1.0f / S_YG); v[j].y += lo.y * (1.0f / S_YG); v[j].z += hi.x * (1.0f / S_YG); v[j].w += hi.y * (1.0f / S_YG); } }
            else { const u32x2* yp = (const u32x2*)(yg + ((size_t)row * 4 + k) * DM) + F.lane;
#pragma unroll
                for (int j = 0; j < 4; ++j) { const u32x2 w = yp[64 * j]; v[j].x += bf_lo(w.x); v[j].y += bf_hi(w.x); v[j].z += bf_lo(w.y); v[j].w += bf_hi(w.y); } } }
        float s = 0.f;
#pragma unroll
        for (int j = 0; j < 4; ++j) s += (v[j].x * v[j].x + v[j].y * v[j].y) + (v[j].z * v[j].z + v[j].w * v[j].w);
        const float rstd = 1.0f / sqrtf(wave_sum(s) * (1.0f / DM) + RMS_EPS);
        const f32x4* wr = (const f32x4*)fw + F.lane;
#if TIM_PHASE
        { const unsigned* tm = (const unsigned*)(a.ws + WS_CTL) + 208; const unsigned den = (TIM_SEL == 4 ? 1u : (tm[3] ? tm[3] : 1u)) * (unsigned)(TIM_UNIT); unsigned q = tm[TIM_SEL] / den; q = q > 24u ? 24u : q; const float sc_ = 1.0f + (float)q;
#pragma unroll
          for (int j = 0; j < 4; ++j) v[j] = v[j] * sc_; }
#endif
#pragma unroll
        for (int j = 0; j < 4; ++j) xr[64 * j] = v[j] * rstd * wr[64 * j];
    }
}

#define XB_TMO      128
#define XB_XCNT(j)  (256  + 64 * (j))
#define XB_XSUB(j)  (1280 + 64 * (j))
#define XB_XGEN(j)  (2304 + 64 * (j))
#define XB_TOP      3328
#define XB_TOPGEN   3392
#define XCD_BAR_WORDS 3456
#define XB_SPIN_CAP (1u << 18)

__device__ __forceinline__ unsigned xb_ld(unsigned* p)              { return __hip_atomic_load(p, __ATOMIC_RELAXED, __HIP_MEMORY_SCOPE_AGENT); }
__device__ __forceinline__ unsigned xb_add(unsigned* p, unsigned v) { return __hip_atomic_fetch_add(p, v, __ATOMIC_RELAXED, __HIP_MEMORY_SCOPE_AGENT); }
__device__ __forceinline__ unsigned xb_xcc_id() { return (unsigned)__builtin_amdgcn_s_getreg((3 << 11) | 20) & 0xFu; }
#define XB_SPIN(cond, bar) do { unsigned _sp = 0; while (cond) { __builtin_amdgcn_s_sleep(1); \
    if ((++_sp & 255u) == 0u) { if (xb_ld(&(bar)[XB_TMO])) break; if (_sp > XB_SPIN_CAP) { atomicAdd(&(bar)[XB_TMO], 1u); break; } } } } while (0)

struct XcdBarrier {
    unsigned* bar; unsigned x; int w;
    volatile LAS unsigned* st;
};

__device__ __forceinline__ XcdBarrier xcd_barrier_post(unsigned* bar, volatile LAS unsigned* st) {
    XcdBarrier b; b.bar = bar; b.x = xb_xcc_id(); b.st = st;
    if (threadIdx.x == 0) (void)xb_add(&bar[XB_XCNT(b.x)], 1u);
    return b;
}
__device__ __forceinline__ void xcd_barrier_complete(unsigned* bar, unsigned x, unsigned& nloc, unsigned& nx) {
    const unsigned G = gridDim.x * gridDim.y * gridDim.z;
    unsigned sum, cnt, mine, sp = 0u;
    for (;;) {
        sum = 0u; cnt = 0u; mine = 0u;
#pragma unroll
        for (unsigned j = 0; j < 16; ++j) { const unsigned c = xb_ld(&bar[XB_XCNT(j)]); sum += c; cnt += (c > 0u) ? 1u : 0u; mine = (j == x) ? c : mine; }
        if (sum == G) break;
        __builtin_amdgcn_s_sleep(1);
        if ((++sp & 255u) == 0u) { if (xb_ld(&bar[XB_TMO])) break; if (sp > XB_SPIN_CAP) { atomicAdd(&bar[XB_TMO], 1u); break; } }
    }
    nloc = mine > 0u ? mine : 1u; nx = cnt > 0u ? cnt : 1u;
}

__device__ __forceinline__ void xcd_barrier(const XcdBarrier& b) {
    asm volatile("s_waitcnt vmcnt(0)" ::: "memory");
    __syncthreads();
    if (b.w == 0 && lane_id_() == 0) {
        unsigned* bar = b.bar;
        __builtin_amdgcn_s_waitcnt(0);
        unsigned nloc = b.st[0], nx = b.st[1];
        if (nloc == 0u) { xcd_barrier_complete(bar, b.x, nloc, nx); b.st[0] = nloc; b.st[1] = nx; }
        const unsigned old = xb_add(&bar[XB_XSUB(b.x)], 1u);
        const unsigned gen = old / nloc;
        if (old + 1u == (gen + 1u) * nloc) {
            __builtin_amdgcn_fence(__ATOMIC_RELEASE, "agent");
            asm volatile("s_waitcnt vmcnt(0)" ::: "memory");
            const unsigned og = xb_add(&bar[XB_TOP], 1u);
            const unsigned tg = og / nx;
            if (og + 1u == (tg + 1u) * nx) xb_add(&bar[XB_TOPGEN], 1u);
            else XB_SPIN(xb_ld(&bar[XB_TOPGEN]) == tg, bar);
            __builtin_amdgcn_fence(__ATOMIC_ACQUIRE, "agent");
            xb_add(&bar[XB_XGEN(b.x)], 1u);
            asm volatile("s_waitcnt vmcnt(0)" ::: "memory");
        } else {
            XB_SPIN(xb_ld(&bar[XB_XGEN(b.x)]) == gen, bar);
            __builtin_amdgcn_fence(__ATOMIC_ACQUIRE, "agent");
            asm volatile("s_waitcnt vmcnt(0)" ::: "memory");
        }
    }
    __syncthreads();
}


__global__ void __launch_bounds__(512, 2) fwd_kernel(Args args) {
    extern __shared__ __attribute__((aligned(16))) unsigned char lds_raw[];
    Frame F; F.lds = (LAS unsigned char*)lds_raw; F.tid = threadIdx.x; F.lane = F.tid & 63; F.wave = __builtin_amdgcn_readfirstlane(F.tid >> 6); F.G = gridDim.x; F.bid = blockIdx.x;
#if USE_COOP
    cg::grid_group grid = cg::this_grid();
#endif
    volatile LAS unsigned* MISCW = (volatile LAS unsigned*)(F.lds + LDS_BYTES - 256);
    if (F.tid < 64) MISCW[F.tid] = 0u;
    __syncthreads();
    XcdBarrier xbar = xcd_barrier_post((unsigned*)(args.ws + WS_CTL) + CW_BAR, MISCW + 8); xbar.w = F.wave;
    unsigned char* ws = args.ws;
    const int lo = args.ph_lo, hi = args.ph_hi;
#ifndef REPMASK
#define REPMASK 0
#endif
#define NREP(k) (((REPMASK) >> (k)) & 1 ? 2 : 1)
#define IN(k) (lo <= (k) && (k) < hi)
#if USE_COOP
#define SEAM(k) do { if (IN(k) && IN((k) + 1)) xcd_barrier(xbar); } while (0)
#else
#define SEAM(k) do { if (IN(k) && IN((k) + 1)) xcd_barrier(xbar); } while (0)
#endif
    bf16_t* proj = (bf16_t*)(ws + WS_PROJ);

#if USE_COOP
    if (lo < 0) grid.sync();
#endif
    if (IN(0)) for (int rep_ = 0; rep_ < NREP(0); ++rep_) { p0_prologue(F, args); } SEAM(0);
    if (IN(1)) for (int rep_ = 0; rep_ < NREP(1); ++rep_) {
        pg8::Gemm g{(const bf16_t*)(ws + WS_XN), (const bf16_t*)(ws + WS_WIN), DIN, DM, nullptr, (const float*)(ws + WS_XS), (const float*)(ws + WS_WINS), TIM_PHASE == 1 ? (unsigned*)(ws + WS_CTL) + 208 : nullptr};
        pg8::DenseSched<DIN / 256> S; S.o.init(NTOK / 256, DIN / 256, F.G, F.bid);
        EpiProj E{proj, (float*)(ws + WS_LOGF), (const float*)(ws + WS_ROPE), (const float*)(ws + WS_LB)};
        pg8::gemm_phase<EpiProj, pg8::DenseSched<DIN / 256>, false, false, false, false, P1_I8>(F.lds, g, S, E, F.wave);
    } SEAM(1);
    if (IN(2)) for (int rep_ = 0; rep_ < NREP(2); ++rep_) { p2_kmean(F, args); h1_local_states_p(F, args); } SEAM(2);
    if (IN(3)) {
        h2_scan(F, args);
        const attn_body::AttnTensors AT{(const attn_body::bf16*)(proj + C_QA), (const attn_body::bf16*)(proj + C_KA), (const attn_body::bf16*)(proj + C_VA), (const attn_body::bf16*)(ws + WS_KMEAN), (attn_body::bf16*)(ws + WS_YA)};
        const attn_body::StaticOrder AS((int)F.G, (int)F.bid);
        for (int rep_ = 0; rep_ < NREP(3); ++rep_) attn_body::attn_phase<attn_body::StaticOrder>((char*)lds_raw, AT, AS, F.wave);
    } SEAM(3);
    if (IN(4)) for (int rep_ = 0; rep_ < NREP(4); ++rep_) { h3_outputs_p(F, args); } SEAM(4);
    if (IN(5)) for (int rep_ = 0; rep_ < NREP(5); ++rep_) {
        pg8::DenseSched<DM / 256> S; S.o.init(NTOK / 256, DM / 256, F.G, F.bid);
        pg8::Gemm g{(const bf16_t*)(ws + WS_YA), (const bf16_t*)(ws + WS_MUP), DM, DM, nullptr};
        EpiMixF E{(bf16_t*)(ws + WS_MIXED), proj};
        pg8::gemm_phase<EpiMixF, pg8::DenseSched<DM / 256>, false, false, false, true>(F.lds, g, S, E, F.wave);
    } SEAM(5);
    if (IN(6)) for (int rep_ = 0; rep_ < NREP(6); ++rep_) {
        pg8::Gemm g{(const bf16_t*)(ws + WS_MIXED), (const bf16_t*)(ws + WS_WOUT), DM, DM, nullptr};
        pg8::DenseSched<DM / 256> S; S.o.init(NTOK / 256, DM / 256, F.G, F.bid);
        EpiOut E{args.in[I_X], (bf16_t*)(ws + WS_X1)};
        pg8::gemm_phase<EpiOut, pg8::DenseSched<DM / 256>, false>(F.lds, g, S, E, F.wave);
    } SEAM(6);
    if (IN(7)) { if (NREP(7) > 1) p6_route<true>(F, args); p6_route<false>(F, args); } SEAM(7);
    if (IN(8)) for (int rep_ = 0; rep_ < NREP(8); ++rep_) {
        LAS int* ts = (LAS int*)(F.lds + MISC_OFF + 8192);
        const int ntile = moe_tiles(F, args, ts);
        pg8::Gemm g{(const bf16_t*)(ws + WS_XN), (const bf16_t*)(ws + WS_WGU), 2 * DE, DM, (const int*)(ws + WS_ROWS), (const float*)(ws + WS_ROWHS), (const float*)(ws + WS_WGS), TIM_PHASE == 8 ? (unsigned*)(ws + WS_CTL) + 208 : nullptr};
        pg8::MoeSched<2 * DE / 256> S; S.o.init(ntile, 2 * DE / 256, F.G, F.bid); S.ts = ts;
        EpiMoe1 E{(bf16_t*)(ws + WS_HID), args.in[I_BGU]};
        pg8::gemm_phase<EpiMoe1, pg8::MoeSched<2 * DE / 256>, true, MOE_FP8 && !MOE1_I8, false, false, MOE1_I8>(F.lds, g, S, E, F.wave);
    } SEAM(8);
    if (IN(9)) for (int rep_ = 0; rep_ < NREP(9); ++rep_) {
        LAS int* ts = (LAS int*)(F.lds + MISC_OFF + 8192);
        const int ntile = moe_tiles(F, args, ts);
        pg8::Gemm g{(const bf16_t*)(ws + WS_HID), (const bf16_t*)(ws + WS_WD), DM, DE, nullptr, nullptr, nullptr, TIM_PHASE == 9 ? (unsigned*)(ws + WS_CTL) + 208 : nullptr};
        pg8::MoeSched<DM / 256> S; S.o.init(ntile, DM / 256, F.G, F.bid); S.ts = ts;
        EpiMoe2 E{(bf16_t*)(ws + WS_YG), args.in[I_BD], (const int*)(ws + WS_ROWS), (const float*)(ws + WS_ROWW)};
        pg8::gemm_phase<EpiMoe2, pg8::MoeSched<DM / 256>, false, MOE_FP8, false, false, false, MOE_FP8>(F.lds, g, S, E, F.wave);
    } SEAM(9);
    if (IN(10)) for (int rep_ = 0; rep_ < NREP(10); ++rep_) { p9_final(F, args); }
#undef IN
#undef SEAM
}

#ifndef N_LAUNCHES
#define N_LAUNCHES 1
#endif
extern "C" void kernel_launch(void* const* d_in, const int* in_sizes, int n_in, void* d_out, int out_size, void* d_ws, size_t ws_size, hipStream_t stream) {
    static int grid = 0;
    if (grid == 0) {
        if (n_in != 16 || in_sizes[0] != NTOK * DM || out_size != NTOK * DM || ws_size < WS_END) { fprintf(stderr, "kernel_launch: unexpected shapes (n_in %d, in0 %d, out %d, ws %zu)\n", n_in, n_in > 0 ? in_sizes[0] : -1, out_size, ws_size); grid = -1; return; }
        int dev = 0, cus = 0, per_cu = 0;
        (void)hipGetDevice(&dev); (void)hipDeviceGetAttribute(&cus, hipDeviceAttributeMultiprocessorCount, dev);
        if (hipFuncSetAttribute((const void*)fwd_kernel, hipFuncAttributeMaxDynamicSharedMemorySize, LDS_BYTES) != hipSuccess) { fprintf(stderr, "kernel_launch: hipFuncSetAttribute failed\n"); grid = -1; return; }
        if (hipOccupancyMaxActiveBlocksPerMultiprocessor(&per_cu, (const void*)fwd_kernel, 512, LDS_BYTES) != hipSuccess || per_cu < 1) { fprintf(stderr, "kernel_launch: occupancy query says %d\n", per_cu); per_cu = 1; }
        (void)hipGetLastError();
        grid = cus;
    }
    if (grid < 0) return;
    (void)hipMemsetAsync((char*)d_ws + WS_CTL, 0, CTL_BYTES, stream);
    Args a{};
    for (int i = 0; i < 16; ++i) a.in[i] = (const float*)d_in[i];
    a.out = (float*)d_out; a.ws = (unsigned char*)d_ws;
    if (N_LAUNCHES == 1) {
        a.ph_lo = 0; a.ph_hi = NPHASE; void* params[] = {&a};
#if USE_COOP
        hipError_t e = hipLaunchCooperativeKernel((const void*)fwd_kernel, dim3(grid), dim3(512), params, LDS_BYTES, stream);
        if (e != hipSuccess) fprintf(stderr, "cooperative launch failed: %s (grid %d)\n", hipGetErrorString(e), grid);
#else
        (void)params; hipLaunchKernelGGL(fwd_kernel, dim3(grid), dim3(512), LDS_BYTES, stream, a);
#endif
    } else {
        for (int p = 0; p < NPHASE; ++p) { a.ph_lo = p; a.ph_hi = p + 1; hipLaunchKernelGGL(fwd_kernel, dim3(grid), dim3(512), LDS_BYTES, stream, a); }
    }
}
```

```cpp
#include <hip/hip_runtime.h>
#include <hip/hip_cooperative_groups.h>
#include <cstdio>
#include <cstdint>
namespace cg = cooperative_groups;
#ifndef USE_COOP
#define USE_COOP 1
#endif

#define LAS __attribute__((address_space(3)))
#define GAS __attribute__((address_space(1)))
typedef unsigned short bf16_t;
typedef short bf16x8 __attribute__((ext_vector_type(8)));
typedef float f32x4 __attribute__((ext_vector_type(4)));
typedef float f32x2 __attribute__((ext_vector_type(2)));
typedef unsigned u32x4 __attribute__((ext_vector_type(4)));
typedef unsigned u32x2 __attribute__((ext_vector_type(2)));

constexpr int NTOK = 32768, DM = 1024, SEQ = 4096, NBATCH = 8;
constexpr int DIN = 5632;
constexpr int AH = 8, AD = 64;
constexpr int HH = 4, HK = 128;
constexpr int NE = 32, DE = 1024, CAP = 32768;
constexpr float RMS_EPS = 1e-6f;
constexpr float QSCALE = 0.125f * 1.4426950408889634f;
constexpr int C_QA = 0, C_KA = 512, C_VA = 1024, C_QB = 1536, C_FB = 2048, C_IB = 2560, C_GB = 3072, C_GA = 3584, C_GBT = 4608;

constexpr size_t MiB = 1u << 20;
constexpr size_t WS_CTL = 0, CTL_BYTES = 32768;
constexpr size_t WS_ROPE = 1 * MiB;
constexpr size_t WS_WIN = 2 * MiB;
constexpr size_t WS_MUP = 13 * MiB;
constexpr size_t WS_WOUT = 15 * MiB;
constexpr size_t WS_LB = 17 * MiB;
constexpr size_t WS_KMEAN = 17 * MiB + 65536;
constexpr size_t WS_SLOTW = 18 * MiB;
constexpr size_t WS_ROWS = 19 * MiB;
constexpr size_t WS_ROWW = 25 * MiB;
constexpr size_t WS_WGS = 18 * MiB;
constexpr size_t WS_XS = 18 * MiB + 512 * 1024;
constexpr size_t WS_WINS = 18 * MiB + 768 * 1024;
constexpr size_t WS_ROWHS = 672 * MiB;
constexpr size_t WS_GDEC = 24 * MiB;
constexpr size_t WS_WGU = 32 * MiB;
constexpr size_t WS_WD = 160 * MiB;
constexpr size_t WS_XN = 224 * MiB;
constexpr size_t WS_PROJ = 288 * MiB;
constexpr size_t WS_LOGF = 640 * MiB;
constexpr size_t WS_YA = 704 * MiB;
constexpr size_t WS_OB = 768 * MiB;
constexpr size_t WS_HST = 768 * MiB;
constexpr size_t WS_MIXED = 832 * MiB;
constexpr size_t WS_HID = 288 * MiB;
constexpr size_t WS_YG = 560 * MiB;
constexpr size_t WS_X1 = 896 * MiB;
constexpr size_t WS_END = 960 * MiB;
constexpr int CW_CNT = 64;
constexpr int CW_BAR = 4096;
static_assert((CW_BAR + 3456) * 4 <= (int)CTL_BYTES, "barrier words inside the zeroed control region");

constexpr int RING_BYTES = 131072;
constexpr int MISC_OFF = RING_BYTES;
constexpr int LDS_BYTES = 147456;

#ifndef MOE1_I8_
#define MOE1_I8_ 1
#endif
#ifndef MOE_FP8_
#define MOE_FP8_ 1
#endif
constexpr bool MOE1_I8 = (MOE1_I8_ != 0) && (MOE_FP8_ != 0);
#ifndef P1_I8_
#define P1_I8_ 1
#endif
constexpr bool P1_I8 = P1_I8_ != 0;
#ifndef TIM_PHASE
#define TIM_PHASE 0
#endif
#ifndef TIM_SEL
#define TIM_SEL 0
#endif
#ifndef TIM_UNIT
#define TIM_UNIT 1024
#endif
constexpr bool MOE_FP8 = MOE_FP8_ != 0;
constexpr float S_H2 = 16.0f, S_HID = 4.0f, S_W = 512.0f, S_YG = 32.0f;
constexpr float DQ1 = MOE_FP8 ? 1.0f / (S_H2 * S_W) : 1.0f, DQ2 = MOE_FP8 ? 1.0f / (S_HID * S_W) : 1.0f;
typedef int v8i __attribute__((ext_vector_type(8)));
typedef int v4i __attribute__((ext_vector_type(4)));
__device__ __forceinline__ unsigned pk4_i8(float a, float b, float c, float d) {
    const int ia = (int)__builtin_rintf(fminf(fmaxf(a, -127.f), 127.f)), ib = (int)__builtin_rintf(fminf(fmaxf(b, -127.f), 127.f)), ic = (int)__builtin_rintf(fminf(fmaxf(c, -127.f), 127.f)), id = (int)__builtin_rintf(fminf(fmaxf(d, -127.f), 127.f));
    return (unsigned)(ia & 255) | ((unsigned)(ib & 255) << 8) | ((unsigned)(ic & 255) << 16) | ((unsigned)id << 24); }
typedef _Float16 h16x4 __attribute__((ext_vector_type(4)));
typedef _Float16 h16x8 __attribute__((ext_vector_type(8)));
typedef float f32x8 __attribute__((ext_vector_type(8)));
__device__ __forceinline__ unsigned pk4_fp8_nc(float a, float b, float c, float d, float s) { unsigned w = 0u; w = __builtin_amdgcn_cvt_pk_fp8_f32(a * s, b * s, w, false); w = __builtin_amdgcn_cvt_pk_fp8_f32(c * s, d * s, w, true); return w; }
__device__ __forceinline__ unsigned pk4_u8(float a, float b, float c, float d) { unsigned w = 0u;
    w = __builtin_amdgcn_cvt_pk_u8_f32(fmaxf(a * 255.0f, 1.0f), 0, w); w = __builtin_amdgcn_cvt_pk_u8_f32(fmaxf(b * 255.0f, 1.0f), 1, w);
    w = __builtin_amdgcn_cvt_pk_u8_f32(fmaxf(c * 255.0f, 1.0f), 2, w); w = __builtin_amdgcn_cvt_pk_u8_f32(fmaxf(d * 255.0f, 1.0f), 3, w); return w; }
__device__ __forceinline__ f32x4 un4_u8(unsigned w) { return (f32x4){(float)(w & 0xffu), (float)((w >> 8) & 0xffu), (float)((w >> 16) & 0xffu), (float)(w >> 24)}; }
constexpr int GATE_BYTE0 = 2 * 3584;
__device__ __forceinline__ unsigned pk4_fp8(float a, float b, float c, float d, float s) {
    const float L = 440.0f;
    a = __builtin_amdgcn_fmed3f(a * s, -L, L); b = __builtin_amdgcn_fmed3f(b * s, -L, L); c = __builtin_amdgcn_fmed3f(c * s, -L, L); d = __builtin_amdgcn_fmed3f(d * s, -L, L);
    unsigned w = 0u; w = __builtin_amdgcn_cvt_pk_fp8_f32(a, b, w, false); w = __builtin_amdgcn_cvt_pk_fp8_f32(c, d, w, true); return w;
}
__device__ __forceinline__ unsigned f2bf(float f) { unsigned u = __builtin_bit_cast(unsigned, f); return (u + 0x7fffu + ((u >> 16) & 1u)) >> 16; }
typedef __bf16 bf16x2_t_ __attribute__((ext_vector_type(2)));
__device__ __forceinline__ unsigned pk2(float lo, float hi) { f32x2 v = {lo, hi}; bf16x2_t_ b = __builtin_convertvector(v, bf16x2_t_); return __builtin_bit_cast(unsigned, b); }
__device__ __forceinline__ float bf_lo(unsigned u) { return __builtin_bit_cast(float, u << 16); }
__device__ __forceinline__ float bf_hi(unsigned u) { return __builtin_bit_cast(float, u & 0xffff0000u); }
__device__ __forceinline__ float bf2f(bf16_t h) { return __builtin_bit_cast(float, (unsigned)h << 16); }
template <int CTRL> __device__ __forceinline__ float dppf_(float v) { return __builtin_bit_cast(float, __builtin_amdgcn_update_dpp(0, __builtin_bit_cast(int, v), CTRL, 0xF, 0xF, false)); }
__device__ __forceinline__ float rdlane_(float v, int l) { return __builtin_bit_cast(float, __builtin_amdgcn_readlane(__builtin_bit_cast(int, v), l)); }
__device__ __forceinline__ float wave_sum(float v) {
    v += dppf_<0xB1>(v); v += dppf_<0x4E>(v); v += dppf_<0x141>(v); v += dppf_<0x140>(v);
    return (rdlane_(v, 0) + rdlane_(v, 16)) + (rdlane_(v, 32) + rdlane_(v, 48));
}
__device__ __forceinline__ float wave_max(float v) {
    v = fmaxf(v, dppf_<0xB1>(v)); v = fmaxf(v, dppf_<0x4E>(v)); v = fmaxf(v, dppf_<0x141>(v)); v = fmaxf(v, dppf_<0x140>(v));
    return fmaxf(fmaxf(rdlane_(v, 0), rdlane_(v, 16)), fmaxf(rdlane_(v, 32), rdlane_(v, 48)));
}
__device__ __forceinline__ void lds_barrier() { asm volatile("s_waitcnt lgkmcnt(0)\n\ts_barrier" ::: "memory"); }
__device__ __forceinline__ f32x4 sigmoid4_(f32x4 x) {
    f32x4 t = x * (-1.4426950408889634f); t = (f32x4){__builtin_amdgcn_exp2f(t[0]), __builtin_amdgcn_exp2f(t[1]), __builtin_amdgcn_exp2f(t[2]), __builtin_amdgcn_exp2f(t[3])}; t = t + 1.0f;
    return (f32x4){__builtin_amdgcn_rcpf(t[0]), __builtin_amdgcn_rcpf(t[1]), __builtin_amdgcn_rcpf(t[2]), __builtin_amdgcn_rcpf(t[3])}; }
__device__ __forceinline__ float sigmoidf_(float x) { return __builtin_amdgcn_rcpf(1.0f + __builtin_amdgcn_exp2f(-1.4426950408889634f * x)); }
__device__ __forceinline__ int lane_id_() { int l; asm volatile("v_mbcnt_lo_u32_b32 %0, -1, 0\n\tv_mbcnt_hi_u32_b32 %0, -1, %0" : "=v"(l)); return l; }
__device__ __forceinline__ float rdlane(float v, int l) { return __builtin_bit_cast(float, __builtin_amdgcn_readlane(__builtin_bit_cast(int, v), l)); }

namespace pg8 {
constexpr int BM = 256, BK = 64, HALF = 128, HTB = HALF * BK * 2, STAGE_BYTES = 8 * HTB, NXCD = 8, WGM = 8;
__host__ __device__ __forceinline__ int lds_byte(int r, int c) { const int st = (r >> 4) * 2 + (c >> 5), rr = r & 15, cc = c & 31, ob = rr * 64 + cc * 2; return st * 1024 + (ob ^ (((ob >> 9) & 1) << 5)); }
__host__ __device__ __forceinline__ void stage_rc(int b, int& R, int& C) { const int st = b / 1024, sb = b % 1024, swz = sb ^ (((sb >> 9) & 1) << 5); R = (st >> 1) * 16 + swz / 64; C = (st & 1) * 32 + (swz % 64) / 2; }
__host__ __device__ __forceinline__ int perm32(int rho) { const int n = rho >> 4, i = rho & 15; return 8 * (i >> 2) + 4 * n + (i & 3); }

struct Unit { int pm, pn, e, lt, nvalid; };
struct Gemm { const bf16_t* A; const bf16_t* Bt; int N, K; const int* rows; const float* rs = nullptr; const float* cs = nullptr; unsigned* tim = nullptr; };

template <int NN> struct Order {
    static constexpr int nN = NN;
    int nM, nwg, G, c;
    __device__ void init(int nM_, int nN_, int G_, int c_) { nM = nM_; nwg = nM * nN; G = G_; c = c_; }
    __device__ bool map(int i, int& pm, int& pn) const {
        const long L = (long)i * G + c; if (L >= nwg) return false;
        int wgid = (int)L; { const int q = nwg / NXCD, r = nwg % NXCD, xcd = wgid % NXCD, off = wgid / NXCD; wgid = (xcd < r ? xcd * (q + 1) : r * (q + 1) + (xcd - r) * q) + off; }
        const int nig = WGM * nN, gid = wgid / nig, fm = gid * WGM, gsz = (nM - fm) < WGM ? (nM - fm) : WGM;
        const int rem = wgid - gid * nig;
        pm = fm + rem % gsz; pn = rem / gsz; return true;
    }
};
template <int NN> struct DenseSched {
    Order<NN> o;
    __device__ bool next(int i, Unit& u) const { if (!o.map(i, u.pm, u.pn)) return false; u.e = 0; u.lt = u.pm; u.nvalid = 256; return true; }
};
template <int NN> struct MoeSched {
    Order<NN> o; const LAS int* ts;
    __device__ bool next(int i, Unit& u) const {
        if (!o.map(i, u.pm, u.pn)) return false;
        const int lane = lane_id_(); const int tv = ts[(lane & 31) + 1];
        const unsigned long long bal = __ballot(lane < NE - 1 && tv <= u.pm);
        const int e = __builtin_amdgcn_readfirstlane((int)__popcll(bal));
        const int t0 = __builtin_amdgcn_readfirstlane(ts[e]), cn = __builtin_amdgcn_readfirstlane(ts[33 + e]);
        u.e = e; u.lt = u.pm - t0; const int rem = cn - u.lt * 256; u.nvalid = rem < 256 ? rem : 256; return true;
    }
};

struct NoPre {};
template <class T, class = void> struct HasPre { static constexpr bool v = false; };
template <class T> struct HasPre<T, decltype((void)sizeof(typename T::Pre))> { static constexpr bool v = true; };
template <class T, bool> struct PreOf { typedef NoPre type; };
template <class T> struct PreOf<T, true> { typedef typename T::Pre type; };
template <class Epi, class Sched, bool GATHER, bool FP8 = false, bool NOEPI = false, bool HOOK = false, bool I8 = false, bool P16 = false>
__device__ __forceinline__ void gemm_phase(LAS unsigned char* lds, const Gemm g, const Sched& S, const Epi& E, const int wid) {
    const int lane = lane_id_(), tid = wid * 64 + lane, wr = wid >> 2, wc = wid & 3, fr = lane & 15, fq = lane >> 4;
    const int K = g.K, RP = (FP8 || I8) ? K : 2 * K, nt = RP / 128;
    unsigned voffB[2];
#pragma unroll
    for (int i = 0; i < 2; ++i) { int R, C; stage_rc(tid * 16 + i * 8192, R, C); const int Rb = P16 ? 64 * (R >> 5) + 16 * ((R & 15) >> 2) + 4 * ((R >> 4) & 1) + (R & 3) : (R & ~31) + perm32(R & 31); voffB[i] = (unsigned)(Rb * RP + C * 2); }
    const size_t kstep = 128;
    const size_t hstep = (size_t)HALF * RP, hstepB = P16 ? (size_t)8 * RP : hstep;
    const size_t tstep = 2 * hstep;
    const size_t estride = (size_t)g.N * RP;
    const unsigned ldsw = (unsigned)wid * 1024u;
    const int aoff = lds_byte(wr * 64 + fr, fq * 8), boff = lds_byte(wc * 32 + fr, fq * 8);
    constexpr int KOFF = 1024;
#define PG8_SA(b, h) (((b) * 2 + (h)) * HTB)
#define PG8_SB(b, h) ((4 + (b) * 2 + (h)) * HTB)
#define PG8_STAGE(bufoff, gbase, voff) do { _Pragma("unroll") for (int _i = 0; _i < 2; ++_i) { unsigned _o = (voff)[_i]; asm volatile("" : "+v"(_o));     \
        __builtin_amdgcn_global_load_lds((const unsigned*)((const char*)(gbase) + _o), (LAS unsigned*)(lds + (bufoff) + ldsw + _i * 8192), 16, 0, 0); } } while (0)
#define PG8_STAGE2(bufoff, gbase, h) PG8_STAGE(bufoff, gbase, vC[h])
#define PG8_LDA(dst, b, h) do { _Pragma("unroll") for (int m = 0; m < 4; ++m) _Pragma("unroll") for (int k = 0; k < 2; ++k) dst[m][k] = *(const LAS bf16x8*)(lds + PG8_SA(b, h) + aoff + m * 2048 + k * KOFF); } while (0)
#define PG8_LDB(dst, b, h) do { _Pragma("unroll") for (int n = 0; n < 2; ++n) _Pragma("unroll") for (int k = 0; k < 2; ++k) dst[n][k] = *(const LAS bf16x8*)(lds + PG8_SB(b, h) + boff + n * 2048 + k * KOFF); } while (0)
#define PG8_CAT(x) __builtin_bit_cast(v8i, __builtin_shufflevector((x)[0], (x)[1], 0, 1, 2, 3, 4, 5, 6, 7, 8, 9, 10, 11, 12, 13, 14, 15))
#define PG8_MMA(ai, bj, At, Bt) do { __builtin_amdgcn_s_setprio(1); _Pragma("unroll") for (int m = 0; m < 4; ++m) _Pragma("unroll") for (int n = 0; n < 2; ++n) { \
        if constexpr (FP8) acc[ai][bj][m][n] = __builtin_amdgcn_mfma_scale_f32_16x16x128_f8f6f4(PG8_CAT(Bt[n]), PG8_CAT(At[m]), acc[ai][bj][m][n], 0, 0, 0, 0, 0, 0); \
        else if constexpr (I8) { _Pragma("unroll") for (int k = 0; k < 2; ++k) acci[ai][bj][m][n] = __builtin_amdgcn_mfma_i32_16x16x64_i8(__builtin_bit_cast(v4i, Bt[n][k]), __builtin_bit_cast(v4i, At[m][k]), acci[ai][bj][m][n], 0, 0, 0); } \
        else { _Pragma("unroll") for (int k = 0; k < 2; ++k) acc[ai][bj][m][n] = __builtin_amdgcn_mfma_f32_16x16x32_bf16(Bt[n][k], At[m][k], acc[ai][bj][m][n], 0, 0, 0); } } \
        __builtin_amdgcn_s_setprio(0); } while (0)
#define PG8_WAIT_V(n) asm volatile("s_waitcnt vmcnt(" #n ")" ::: "memory")
#define PG8_WAIT_V8R() do { if (NOEPI || Epi::NVMEM == 0 || !relax) asm volatile("s_waitcnt vmcnt(8)" ::: "memory"); else asm volatile("s_waitcnt vmcnt(%0)" :: "n"(8 + (NOEPI ? 0 : Epi::NVMEM)) : "memory"); } while (0)
#define PG8_WAIT_L(n) asm volatile("s_waitcnt lgkmcnt(" #n ")" ::: "memory")
#define PG8_BAR __builtin_amdgcn_s_barrier()
#define PG8_SCHED __builtin_amdgcn_sched_barrier(0)
#define PG8_SETV(u, v) do { _Pragma("unroll") for (int _h = 0; _h < 2; ++_h) _Pragma("unroll") for (int _i = 0; _i < 2; ++_i) { int _R, _C; stage_rc((wid * 64 + lane_id_()) * 16 + _i * 8192, _R, _C); \
        if (GATHER) { int _r = _h * HALF + _R; _r = _r < (u).nvalid ? _r : (u).nvalid - 1; const int _s = g.rows[(size_t)(u).e * CAP + (u).lt * 256 + _r]; \
                      (v)[_h][_i] = (unsigned)(_s >> 2) * (unsigned)RP + (unsigned)(_C * 2); } \
        else (v)[_h][_i] = (unsigned)(_R * RP + _C * 2) + (unsigned)(_h * hstep); } } while (0)
#define PG8_ABASE(u) (GATHER ? (const char*)g.A : (const char*)g.A + (size_t)(u).pm * tstep)
#define PG8_BBASE(u) ((const char*)g.Bt + (size_t)(u).e * estride + (size_t)(u).pn * tstep)
    Unit cur, nxt, nn; int ui = 0;
    if (!S.next(0, cur)) return;
    bool has_next = S.next(1, nxt);
    unsigned vC[2][2];
    PG8_SETV(cur, vC);
#define PG8_PARK ((LAS unsigned*)(lds + MISC_OFF) + (wid * 64 + lane_id_()) * 4)
    if (GATHER) { unsigned vP[2][2];
        if (has_next) PG8_SETV(nxt, vP); else { vP[0][0] = vC[0][0]; vP[0][1] = vC[0][1]; vP[1][0] = vC[1][0]; vP[1][1] = vC[1][1]; }
        LAS unsigned* pk = PG8_PARK; pk[0] = vP[0][0]; pk[1] = vP[0][1]; pk[2] = vP[1][0]; pk[3] = vP[1][1]; }
    f32x4 acc[2][2][4][2]; v4i acci[2][2][4][2];
#pragma unroll
    for (int a = 0; a < 2; ++a)
#pragma unroll
        for (int b = 0; b < 2; ++b)
#pragma unroll
            for (int m = 0; m < 4; ++m)
#pragma unroll
                for (int n = 0; n < 2; ++n) { acc[a][b][m][n] = (f32x4){0.f, 0.f, 0.f, 0.f}; acci[a][b][m][n] = (v4i){0, 0, 0, 0}; }
    bf16x8 At[4][2], B0[2][2], B1[2][2];
    const char* cA = PG8_ABASE(cur); const char* cB = PG8_BBASE(cur);
    PG8_STAGE(PG8_SB(0, 0), cB, voffB); PG8_STAGE(PG8_SB(0, 1), cB + hstepB, voffB); PG8_STAGE(PG8_SA(0, 0), cA, vC[0]); PG8_STAGE(PG8_SA(0, 1), cA, vC[1]);
    if (wr == 1) PG8_BAR;
    PG8_WAIT_V(2); PG8_BAR;
    PG8_STAGE(PG8_SB(1, 0), cB + kstep, voffB); PG8_STAGE(PG8_SA(1, 0), cA + kstep, vC[0]); PG8_STAGE(PG8_SB(1, 1), cB + hstepB + kstep, voffB);
    PG8_WAIT_V(6); PG8_BAR;
#if TIM_PHASE
    unsigned long long tk_ = 0, ta_ = 0, tb_ = 0, tu_ = 0; unsigned tl_ = 0; const unsigned long long ts_ = __builtin_amdgcn_s_memtime();
#endif
    for (;;) {
#if TIM_PHASE
        const unsigned long long t0_ = __builtin_amdgcn_s_memtime();
#endif
        const char* nA = has_next ? PG8_ABASE(nxt) : cA; const char* nB = has_next ? PG8_BBASE(nxt) : cB;
#pragma unroll 1
        for (int t = 0; t < nt; t += 2) {
            const bool last = (t == nt - 2); const bool relax = false;
            if constexpr (HOOK) { if (t == nt / 2) { const int l_ = lane_id_(); E.mid(acc, cur, wr, wc, l_ & 15, l_ >> 4); } }
            const char* a1 = cA + (size_t)(t + 1) * kstep;
            const char* a2 = last ? nA : cA + (size_t)(t + 2) * kstep; const char* b2 = last ? nB : cB + (size_t)(t + 2) * kstep;
            const char* a3 = a2 + kstep; const char* b3 = b2 + kstep;
            PG8_LDB(B0, 0, 0); PG8_LDB(B1, 0, 1); PG8_SCHED; PG8_LDA(At, 0, 0); PG8_STAGE(PG8_SA(1, 1), a1, vC[1]);
            if (GATHER && last) { const LAS unsigned* pk = PG8_PARK; vC[0][0] = pk[0]; vC[0][1] = pk[1]; vC[1][0] = pk[2]; vC[1][1] = pk[3]; }
            PG8_WAIT_V8R(); PG8_WAIT_L(0); PG8_BAR; PG8_MMA(0, 0, At, B0); PG8_MMA(0, 1, At, B1); PG8_BAR; PG8_SCHED;
            PG8_LDA(At, 0, 1); PG8_STAGE(PG8_SB(0, 0), b2, voffB); PG8_STAGE(PG8_SB(0, 1), b2 + hstepB, voffB); PG8_STAGE2(PG8_SA(0, 0), a2, 0);
            PG8_WAIT_V8R(); PG8_WAIT_L(0); PG8_BAR; PG8_MMA(1, 0, At, B0); PG8_MMA(1, 1, At, B1); PG8_BAR; PG8_SCHED;
            PG8_LDB(B0, 1, 0); PG8_LDB(B1, 1, 1); PG8_SCHED; PG8_LDA(At, 1, 0); PG8_STAGE2(PG8_SA(0, 1), a2, 1);
            PG8_WAIT_V(8); PG8_WAIT_L(0); PG8_BAR; PG8_MMA(0, 0, At, B0); PG8_MMA(0, 1, At, B1); PG8_BAR; PG8_SCHED;
            PG8_LDA(At, 1, 1); PG8_STAGE(PG8_SB(1, 0), b3, voffB); PG8_STAGE(PG8_SB(1, 1), b3 + hstepB, voffB); PG8_STAGE2(PG8_SA(1, 0), a3, 0);
            PG8_WAIT_V(8); PG8_WAIT_L(0); PG8_BAR; PG8_MMA(1, 0, At, B0); PG8_MMA(1, 1, At, B1); PG8_BAR; PG8_SCHED;
        }
#if TIM_PHASE
        const unsigned long long t1_ = __builtin_amdgcn_s_memtime();
#endif
        float rsv[2][4]; f32x4 csv[2][2]; typename PreOf<Epi, HasPre<Epi>::v>::type pf;
        { const int l_ = lane_id_();
          if constexpr (I8) {
            const float* rsp = g.rs + (GATHER ? (size_t)cur.e * CAP : (size_t)0) + (size_t)cur.lt * 256; const float* csp = g.cs + (size_t)cur.e * g.N + cur.pn * 256 + wc * 32 + 8 * (l_ >> 4);
#pragma unroll
            for (int a = 0; a < 2; ++a)
#pragma unroll
                for (int m = 0; m < 4; ++m) { int r = a * 128 + wr * 64 + m * 16 + (l_ & 15); r = r < cur.nvalid ? r : cur.nvalid - 1; rsv[a][m] = rsp[r]; }
#pragma unroll
            for (int b = 0; b < 2; ++b)
#pragma unroll
                for (int n = 0; n < 2; ++n) csv[b][n] = *(const f32x4*)(csp + b * 128 + 4 * n);
          }
          if constexpr (HasPre<Epi>::v && !NOEPI) pf = E.pre(cur, wr, wc, l_ & 15, l_ >> 4); }
        if (wr == 0) PG8_BAR;
        bool has_nn = false; unsigned vT[2][2];
        if (has_next) has_nn = S.next(ui + 2, nn);
        if (GATHER && has_nn) PG8_SETV(nn, vT);
#if TIM_PHASE
        const unsigned long long t2_ = __builtin_amdgcn_s_memtime();
#endif
        if constexpr (I8) {
#pragma unroll
            for (int a = 0; a < 2; ++a)
#pragma unroll
                for (int b = 0; b < 2; ++b)
#pragma unroll
                    for (int m = 0; m < 4; ++m)
#pragma unroll
                        for (int n = 0; n < 2; ++n)
#pragma unroll
                            for (int i = 0; i < 4; ++i) acc[a][b][m][n][i] = ((float)acci[a][b][m][n][i] * rsv[a][m]) * csv[b][n][i];
        }
        { const int l_ = lane_id_();
          if constexpr (!NOEPI) { if constexpr (HasPre<Epi>::v) E(acc, cur, wr, wc, l_ & 15, l_ >> 4, pf); else E(acc, cur, wr, wc, l_ & 15, l_ >> 4); }
          else { _Pragma("unroll") for (int a_ = 0; a_ < 2; ++a_) _Pragma("unroll") for (int b_ = 0; b_ < 2; ++b_) _Pragma("unroll") for (int m_ = 0; m_ < 4; ++m_) _Pragma("unroll") for (int n_ = 0; n_ < 2; ++n_) asm volatile("" :: "v"(acc[a_][b_][m_][n_])); } }
#if TIM_PHASE
        { const unsigned long long t3_ = __builtin_amdgcn_s_memtime(); tk_ += t1_ - t0_; ta_ += t2_ - t1_; tb_ += t3_ - t2_; tu_ += 1;
 }
#endif
        if (!has_next) break;
#pragma unroll
        for (int a = 0; a < 2; ++a)
#pragma unroll
            for (int b = 0; b < 2; ++b)
#pragma unroll
                for (int m = 0; m < 4; ++m)
#pragma unroll
                    for (int n = 0; n < 2; ++n) { acc[a][b][m][n] = (f32x4){0.f, 0.f, 0.f, 0.f}; acci[a][b][m][n] = (v4i){0, 0, 0, 0}; }
        cur = nxt; cA = nA; cB = nB; ++ui;
        if (GATHER && has_nn) { LAS unsigned* pk = PG8_PARK; pk[0] = vT[0][0]; pk[1] = vT[0][1]; pk[2] = vT[1][0]; pk[3] = vT[1][1]; }
        nxt = nn; has_next = has_nn;
        if (wr == 1) PG8_BAR;
    }
    PG8_WAIT_V(0);
    PG8_BAR;
#if TIM_PHASE
    if (g.tim && blockIdx.x == 0 && wid == 0 && lane_id_() == 0) { const unsigned long long te_ = __builtin_amdgcn_s_memtime(); g.tim[0] = (unsigned)tk_; g.tim[1] = (unsigned)ta_; g.tim[2] = (unsigned)tb_; g.tim[3] = (unsigned)tu_; g.tim[4] = (unsigned)(te_ - ts_); g.tim[5] = (unsigned)tl_; }
#endif
#undef PG8_SA
#undef PG8_SB
#undef PG8_STAGE
#undef PG8_STAGE2
#undef PG8_PARK
#undef PG8_LDA
#undef PG8_LDB
#undef PG8_MMA
#undef PG8_CAT
#undef PG8_WAIT_V
#undef PG8_WAIT_V8R
#undef PG8_WAIT_L
#undef PG8_BAR
#undef PG8_SCHED
#undef PG8_SETV
#undef PG8_ABASE
#undef PG8_BBASE
}

template <class F> struct EpiOct {
    F f;
    __device__ __forceinline__ void operator()(const f32x4 (&acc)[2][2][4][2], const Unit& u, int wr, int wc, int fr, int fq) const {
#pragma unroll
        for (int ai = 0; ai < 2; ++ai)
#pragma unroll
            for (int m = 0; m < 4; ++m) {
                const int r = ai * HALF + wr * 64 + m * 16 + fr;
#pragma unroll
                for (int bj = 0; bj < 2; ++bj) f(u, r, bj * HALF + wc * 32 + 8 * fq, acc[ai][bj][m][0], acc[ai][bj][m][1]);
            }
    }
};
}
using pg8::Unit;

__device__ __forceinline__ u32x4 pack8(f32x4 a, f32x4 b) { u32x4 w; w.x = pk2(a[0], a[1]); w.y = pk2(a[2], a[3]); w.z = pk2(b[0], b[1]); w.w = pk2(b[2], b[3]); return w; }
__device__ __forceinline__ void unpack8(u32x4 w, f32x4& a, f32x4& b) { a = (f32x4){bf_lo(w.x), bf_hi(w.x), bf_lo(w.y), bf_hi(w.y)}; b = (f32x4){bf_lo(w.z), bf_hi(w.z), bf_lo(w.w), bf_hi(w.w)}; }

template <bool NOSTORE = false> struct EpiProj_ {
    static constexpr int NVMEM = NOSTORE ? 0 : 16;
    bf16_t* proj; float* logf; const float* rope; const float* lb;
    __device__ __forceinline__ void operator()(const f32x4 (&acc)[2][2][4][2], const Unit& u, int wr, int wc, int fr, int fq) const {
        const int pn = u.pn, colb = pn * 256 + wc * 32 + 8 * fq, rowb = u.pm * 256 + wr * 64 + fr;
        if (pn < 4) {
            const int i0 = (colb & 63) >> 1; const float sc = pn < 2 ? QSCALE : 1.0f;
            f32x4 cs[2][4][2];
#pragma unroll
            for (int ai = 0; ai < 2; ++ai)
#pragma unroll
                for (int m = 0; m < 4; ++m) { const int pos = (rowb + ai * 128 + m * 16) & (SEQ - 1); const float* tp = rope + ((size_t)pos * 32 + i0) * 2; cs[ai][m][0] = *(const f32x4*)tp; cs[ai][m][1] = *(const f32x4*)(tp + 4); }
#pragma unroll
            for (int ai = 0; ai < 2; ++ai)
#pragma unroll
                for (int m = 0; m < 4; ++m) { const f32x4 c0 = cs[ai][m][0] * sc, c1 = cs[ai][m][1] * sc;
#pragma unroll
                    for (int bj = 0; bj < 2; ++bj) { const f32x4 v0 = acc[ai][bj][m][0], v1 = acc[ai][bj][m][1]; f32x4 o0, o1;
                        o0[0] = v0[0] * c0[0] - v0[1] * c0[1]; o0[1] = v0[1] * c0[0] + v0[0] * c0[1]; o0[2] = v0[2] * c0[2] - v0[3] * c0[3]; o0[3] = v0[3] * c0[2] + v0[2] * c0[3];
                        o1[0] = v1[0] * c1[0] - v1[1] * c1[1]; o1[1] = v1[1] * c1[0] + v1[0] * c1[1]; o1[2] = v1[2] * c1[2] - v1[3] * c1[3]; o1[3] = v1[3] * c1[2] + v1[2] * c1[3];
                        { const u32x4 w_ = pack8(o0, o1); if (NOSTORE) asm volatile("" :: "v"(w_)); else __builtin_nontemporal_store(w_, (u32x4*)(proj + (size_t)(rowb + ai * 128 + m * 16) * DIN + colb + bj * 128)); } } }
        } else if (pn == 8 || pn == 9) {
            f32x4 l[2][2];
#pragma unroll
            for (int bj = 0; bj < 2; ++bj) { const float* lp = lb + (colb - C_FB) + bj * 128; l[bj][0] = *(const f32x4*)lp; l[bj][1] = *(const f32x4*)(lp + 4); }
#pragma unroll
            for (int ai = 0; ai < 2; ++ai)
#pragma unroll
                for (int m = 0; m < 4; ++m)
#pragma unroll
                    for (int bj = 0; bj < 2; ++bj) { f32x4 o[2];
#pragma unroll
                        for (int n = 0; n < 2; ++n) { const f32x4 sg = sigmoid4_(acc[ai][bj][m][n]), lv = l[bj][n], t = lv + (1.0f - lv) * sg;
                            o[n] = (f32x4){__logf(t[0]), __logf(t[1]), __logf(t[2]), __logf(t[3])}; }
                        _Float16* p = (_Float16*)logf + (size_t)(rowb + ai * 128 + m * 16) * 512 + (colb - C_FB) + bj * 128;
                        const h16x8 hv = {(_Float16)o[0][0], (_Float16)o[0][1], (_Float16)o[0][2], (_Float16)o[0][3], (_Float16)o[1][0], (_Float16)o[1][1], (_Float16)o[1][2], (_Float16)o[1][3]};
                        if (NOSTORE) asm volatile("" :: "v"(hv)); else *(h16x8*)p = hv; }
        } else {
            const int mode = (pn == 6 || pn == 7 || pn == 12 || pn == 13) ? 1 : (pn >= 14 ? 2 : 0);
#define EPROJ_LOOP(EXPR) _Pragma("unroll") for (int ai = 0; ai < 2; ++ai) _Pragma("unroll") for (int m = 0; m < 4; ++m) _Pragma("unroll") for (int bj = 0; bj < 2; ++bj) { f32x4 o[2]; \
                _Pragma("unroll") for (int n = 0; n < 2; ++n) { const f32x4 x = acc[ai][bj][m][n]; o[n] = (EXPR); } \
                const u32x4 w_ = pack8(o[0], o[1]); if (NOSTORE) asm volatile("" :: "v"(w_)); else __builtin_nontemporal_store(w_, (u32x4*)(proj + (size_t)(rowb + ai * 128 + m * 16) * DIN + colb + bj * 128)); }
            if (mode == 0) { EPROJ_LOOP(x) } else if (mode == 1) { EPROJ_LOOP(x * sigmoid4_(x)) } else {
#pragma unroll
                for (int ai = 0; ai < 2; ++ai)
#pragma unroll
                    for (int m = 0; m < 4; ++m)
#pragma unroll
                        for (int bj = 0; bj < 2; ++bj) { f32x4 o[2];
#pragma unroll
                            for (int n = 0; n < 2; ++n) o[n] = sigmoid4_(acc[ai][bj][m][n]);
                            u32x2 w_; w_.x = pk4_u8(o[0][0], o[0][1], o[0][2], o[0][3]); w_.y = pk4_u8(o[1][0], o[1][1], o[1][2], o[1][3]);
                            unsigned char* gp = (unsigned char*)(proj + (size_t)(rowb + ai * 128 + m * 16) * DIN) + GATE_BYTE0 + (colb - C_GA) + bj * 128;
                            if (NOSTORE) asm volatile("" :: "v"(w_)); else *(u32x2*)gp = w_; }
            }
#undef EPROJ_LOOP
        }
    }
};
typedef EpiProj_<false> EpiProj;
template <bool ACCUM> struct EpiMix {
    bf16_t* mixed; const bf16_t* proj; int gcol;
    __device__ __forceinline__ void operator()(const f32x4 (&acc)[2][2][4][2], const Unit& u, int wr, int wc, int fr, int fq) const {
        const int colb = u.pn * 256 + wc * 32 + 8 * fq, rowb = u.pm * 256 + wr * 64 + fr;
#pragma unroll
        for (int ai = 0; ai < 2; ++ai) {
            u32x4 g[4][2], mx[4][2];
#pragma unroll
            for (int m = 0; m < 4; ++m)
#pragma unroll
                for (int bj = 0; bj < 2; ++bj) { const size_t row = (size_t)(rowb + ai * 128 + m * 16); g[m][bj] = *(const u32x4*)(proj + row * DIN + gcol + colb + bj * 128);
                    if (ACCUM) mx[m][bj] = *(const u32x4*)(mixed + row * DM + colb + bj * 128); }
#pragma unroll
            for (int m = 0; m < 4; ++m)
#pragma unroll
                for (int bj = 0; bj < 2; ++bj) { f32x4 g0, g1; unpack8(g[m][bj], g0, g1); f32x4 v0 = acc[ai][bj][m][0] * g0, v1 = acc[ai][bj][m][1] * g1;
                    if (ACCUM) { f32x4 m0, m1; unpack8(mx[m][bj], m0, m1); v0 = v0 + m0; v1 = v1 + m1; }
                    *(u32x4*)(mixed + (size_t)(rowb + ai * 128 + m * 16) * DM + colb + bj * 128) = pack8(v0, v1); }
        }
    }
};
struct EpiMixF {         static constexpr int NVMEM = 16;
    bf16_t* mixed; const bf16_t* proj;
    __device__ __forceinline__ void mid(f32x4 (&acc)[2][2][4][2], const Unit& u, int wr, int wc, int fr, int fq) const {
        const int colb = u.pn * 256 + wc * 32 + 8 * fq, rowb = u.pm * 256 + wr * 64 + fr;
        u32x2 ga[2][4][2], gb[2][4][2];
#pragma unroll
        for (int ai = 0; ai < 2; ++ai)
#pragma unroll
            for (int m = 0; m < 4; ++m)
#pragma unroll
                for (int bj = 0; bj < 2; ++bj) { const unsigned char* p = (const unsigned char*)(proj + (size_t)(rowb + ai * 128 + m * 16) * DIN) + GATE_BYTE0 + colb + bj * 128; ga[ai][m][bj] = *(const u32x2*)p; gb[ai][m][bj] = *(const u32x2*)(p + 1024); }
#pragma unroll
        for (int ai = 0; ai < 2; ++ai)
#pragma unroll
            for (int m = 0; m < 4; ++m)
#pragma unroll
                for (int bj = 0; bj < 2; ++bj) { const f32x4 a0 = un4_u8(ga[ai][m][bj].x), a1 = un4_u8(ga[ai][m][bj].y), b0 = un4_u8(gb[ai][m][bj].x), b1 = un4_u8(gb[ai][m][bj].y);
                    const f32x4 r0 = a0 * (f32x4){__builtin_amdgcn_rcpf(b0[0]), __builtin_amdgcn_rcpf(b0[1]), __builtin_amdgcn_rcpf(b0[2]), __builtin_amdgcn_rcpf(b0[3])};
                    const f32x4 r1 = a1 * (f32x4){__builtin_amdgcn_rcpf(b1[0]), __builtin_amdgcn_rcpf(b1[1]), __builtin_amdgcn_rcpf(b1[2]), __builtin_amdgcn_rcpf(b1[3])};
                    acc[ai][bj][m][0] = acc[ai][bj][m][0] * r0; acc[ai][bj][m][1] = acc[ai][bj][m][1] * r1; }
    }
    __device__ __forceinline__ void operator()(const f32x4 (&acc)[2][2][4][2], const Unit& u, int wr, int wc, int fr, int fq) const {
        const int colb = u.pn * 256 + wc * 32 + 8 * fq, rowb = u.pm * 256 + wr * 64 + fr;
        u32x2 gb[2][4][2];
#pragma unroll
        for (int ai = 0; ai < 2; ++ai)
#pragma unroll
            for (int m = 0; m < 4; ++m)
#pragma unroll
                for (int bj = 0; bj < 2; ++bj) gb[ai][m][bj] = *(const u32x2*)((const unsigned char*)(proj + (size_t)(rowb + ai * 128 + m * 16) * DIN) + GATE_BYTE0 + 1024 + colb + bj * 128);
#pragma unroll
        for (int ai = 0; ai < 2; ++ai)
#pragma unroll
            for (int m = 0; m < 4; ++m)
#pragma unroll
                for (int bj = 0; bj < 2; ++bj) { const f32x4 b0 = un4_u8(gb[ai][m][bj].x) * (1.0f / 255.0f), b1 = un4_u8(gb[ai][m][bj].y) * (1.0f / 255.0f);
                    *(u32x4*)(mixed + (size_t)(rowb + ai * 128 + m * 16) * DM + colb + bj * 128) = pack8(acc[ai][bj][m][0] * b0, acc[ai][bj][m][1] * b1); }
    }
};
struct EpiOut {
    static constexpr int NVMEM = 16;
    const float* x; bf16_t* x1;
    __device__ __forceinline__ void operator()(const f32x4 (&acc)[2][2][4][2], const Unit& u, int wr, int wc, int fr, int fq) const {
        const int colb = u.pn * 256 + wc * 32 + 8 * fq, rowb = u.pm * 256 + wr * 64 + fr;
#pragma unroll
        for (int ai = 0; ai < 2; ++ai) {
            f32x4 xv[4][2][2];
#pragma unroll
            for (int m = 0; m < 4; ++m)
#pragma unroll
                for (int bj = 0; bj < 2; ++bj) { const float* p = x + (size_t)(rowb + ai * 128 + m * 16) * DM + colb + bj * 128; xv[m][bj][0] = __builtin_nontemporal_load((const f32x4*)p); xv[m][bj][1] = __builtin_nontemporal_load((const f32x4*)(p + 4)); }
#pragma unroll
            for (int m = 0; m < 4; ++m)
#pragma unroll
                for (int bj = 0; bj < 2; ++bj) *(u32x4*)(x1 + (size_t)(rowb + ai * 128 + m * 16) * DM + colb + bj * 128) = pack8(xv[m][bj][0] + acc[ai][bj][m][0], xv[m][bj][1] + acc[ai][bj][m][1]);
        }
    }
};
struct EpiMoe1 {         static constexpr int NVMEM = 8;
    bf16_t* hid; const float* bias;
    struct Pre { f32x4 b[4]; };
    __device__ __forceinline__ Pre pre(const Unit& u, int wr, int wc, int fr, int fq) const { Pre p; const float* bp = bias + (size_t)u.e * 2048 + 2 * (128 * u.pn + wc * 32 + 8 * fq);
#pragma unroll
        for (int j = 0; j < 4; ++j) p.b[j] = *(const f32x4*)(bp + 4 * j);
        return p; }
    __device__ __forceinline__ void operator()(const f32x4 (&acc)[2][2][4][2], const Unit& u, int wr, int wc, int fr, int fq, const Pre& pf) const {
        const int jj0 = wc * 32 + 8 * fq, J0 = 128 * u.pn + jj0;
        const f32x4 (&b)[4] = pf.b;
        constexpr float DQ = MOE1_I8 ? 1.0f : DQ1;
        constexpr float HS = MOE_FP8 ? S_HID : 1.0f, KE = -1.702f * 1.4426950408889634f;
#pragma unroll
        for (int ai = 0; ai < 2; ++ai)
#pragma unroll
            for (int m = 0; m < 4; ++m) {
                const int r = ai * 128 + wr * 64 + m * 16 + fr;
                f32x2 h[4];
#pragma unroll
                for (int p = 0; p < 4; ++p) {
                    const f32x4 ag = acc[ai][0][m][p >> 1], au = acc[ai][1][m][p >> 1];
                    const f32x2 g0 = (p & 1) ? (f32x2){ag[2], ag[3]} : (f32x2){ag[0], ag[1]}, u0 = (p & 1) ? (f32x2){au[2], au[3]} : (f32x2){au[0], au[1]};
                    f32x2 gt = g0 * DQ + (f32x2){b[p][0], b[p][2]}, up = u0 * DQ + (f32x2){b[p][1], b[p][3]};
                    gt.x = fminf(gt.x, 7.0f); gt.y = fminf(gt.y, 7.0f); up.x = __builtin_amdgcn_fmed3f(up.x, -7.0f, 7.0f); up.y = __builtin_amdgcn_fmed3f(up.y, -7.0f, 7.0f);
                    f32x2 e = gt * KE; e.x = __builtin_amdgcn_exp2f(e.x); e.y = __builtin_amdgcn_exp2f(e.y);
                    f32x2 den = e * (1.0f / HS) + (1.0f / HS); den.x = __builtin_amdgcn_rcpf(den.x); den.y = __builtin_amdgcn_rcpf(den.y);
                    h[p] = (up * gt + gt) * den;
                }
                if constexpr (MOE_FP8) { u32x2 w; unsigned t = 0u;
                    t = __builtin_amdgcn_cvt_pk_fp8_f32(h[0].x, h[0].y, t, false); t = __builtin_amdgcn_cvt_pk_fp8_f32(h[1].x, h[1].y, t, true); w.x = t; t = 0u;
                    t = __builtin_amdgcn_cvt_pk_fp8_f32(h[2].x, h[2].y, t, false); t = __builtin_amdgcn_cvt_pk_fp8_f32(h[3].x, h[3].y, t, true); w.y = t;
                    *(u32x2*)((unsigned char*)hid + (size_t)(u.pm * 256 + r) * DE + J0) = w; }
                else { u32x4 w; w.x = pk2(h[0].x, h[0].y); w.y = pk2(h[1].x, h[1].y); w.z = pk2(h[2].x, h[2].y); w.w = pk2(h[3].x, h[3].y);
                    *(u32x4*)(hid + (size_t)(u.pm * 256 + r) * DE + J0) = w; }
            }
    }
};
struct EpiMoe2 {
    static constexpr int NVMEM = MOE_FP8 ? 8 : 16;
    bf16_t* yg; const float* bias; const int* rows; const float* roww;
    struct Pre { f32x4 b[2][2]; int slot[2][4]; float wgt[2][4]; };
    __device__ __forceinline__ Pre pre(const Unit& u, int wr, int wc, int fr, int fq) const { Pre p; f32x4 (&b)[2][2] = p.b; int (&slot)[2][4] = p.slot; float (&wgt)[2][4] = p.wgt;
        const int c0 = MOE_FP8 ? u.pn * 256 + 64 * wc + 16 * fq : 0;
#pragma unroll
        for (int bj = 0; bj < 2; ++bj) { const float* bp = MOE_FP8 ? bias + (size_t)u.e * DM + c0 + 8 * bj : bias + (size_t)u.e * DM + u.pn * 256 + bj * 128 + wc * 32 + 8 * fq; b[bj][0] = *(const f32x4*)bp; b[bj][1] = *(const f32x4*)(bp + 4); }
#pragma unroll
        for (int ai = 0; ai < 2; ++ai)
#pragma unroll
            for (int m = 0; m < 4; ++m) { int r = ai * 128 + wr * 64 + m * 16 + fr; r = r < u.nvalid ? r : u.nvalid - 1; const size_t pp = (size_t)u.e * CAP + u.lt * 256 + r; slot[ai][m] = rows[pp]; wgt[ai][m] = roww[pp]; }
        return p; }
    __device__ __forceinline__ void operator()(const f32x4 (&acc)[2][2][4][2], const Unit& u, int wr, int wc, int fr, int fq, const Pre& pf) const {
        const f32x4 (&b)[2][2] = pf.b; const int (&slot)[2][4] = pf.slot; const float (&wgt)[2][4] = pf.wgt;
        const int c0 = MOE_FP8 ? u.pn * 256 + 64 * wc + 16 * fq : 0;
#pragma unroll
        for (int ai = 0; ai < 2; ++ai)
#pragma unroll
            for (int m = 0; m < 4; ++m) {
                const int r = ai * 128 + wr * 64 + m * 16 + fr; const float w = wgt[ai][m];
                if (r < u.nvalid) {
                    if constexpr (MOE_FP8) { u32x4 q; const float ws = w * S_YG;
#define PK4Y_(A, B) ({ const f32x4 y_ = ((A) * DQ2 + (B)) * ws; unsigned t_ = 0u; \
                        t_ = __builtin_amdgcn_cvt_pk_fp8_f32(__builtin_amdgcn_fmed3f(y_[0], -440.0f, 440.0f), __builtin_amdgcn_fmed3f(y_[1], -440.0f, 440.0f), t_, false); \
                        t_ = __builtin_amdgcn_cvt_pk_fp8_f32(__builtin_amdgcn_fmed3f(y_[2], -440.0f, 440.0f), __builtin_amdgcn_fmed3f(y_[3], -440.0f, 440.0f), t_, true); t_; })
                        q.x = PK4Y_(acc[ai][0][m][0], b[0][0]); q.y = PK4Y_(acc[ai][0][m][1], b[0][1]); q.z = PK4Y_(acc[ai][1][m][0], b[1][0]); q.w = PK4Y_(acc[ai][1][m][1], b[1][1]);
#undef PK4Y_
                        *(u32x4*)((unsigned char*)yg + (size_t)slot[ai][m] * DM + c0) = q; }
                    else {
#pragma unroll
                        for (int bj = 0; bj < 2; ++bj) { const f32x4 y0 = (acc[ai][bj][m][0] * DQ2 + b[bj][0]) * w, y1 = (acc[ai][bj][m][1] * DQ2 + b[bj][1]) * w;
                            *(u32x4*)(yg + (size_t)slot[ai][m] * DM + u.pn * 256 + bj * 128 + wc * 32 + 8 * fq) = pack8(y0, y1); } }
                }
            }
    }
};

struct Args { const float* in[16]; float* out; unsigned char* ws; int ph_lo, ph_hi; };
enum { I_X = 0, I_N1, I_WIN, I_MUP, I_LBL, I_HNW, I_HUP, I_WOUT, I_N2, I_RW, I_RB, I_WGU, I_BGU, I_WD, I_BD, I_FNW };
constexpr int NPHASE = 11;

struct Frame { LAS unsigned char* lds; int tid, lane, wave, G, bid; };
__device__ __forceinline__ Frame fresh(const Frame& F0) { Frame F = F0; const int l = lane_id_(); F.lane = l; F.tid = F0.wave * 64 + l; return F; }

template <int MAP> __device__ __forceinline__ int rowmap(int n) {
    if (MAP == 1) return n < 1024 ? ((n & ~63) | (2 * (n & 31) + ((n >> 5) & 1))) : n;
    if (MAP == 2) { const int J = n >> 1, s = n & 1; return 256 * (J >> 7) + 128 * s + (J & 127); }
    return n;
}
template <int MAP> __device__ __forceinline__ void transpose_item(const float* W, int K, int N, bf16_t* WT, LAS float* scr, int item, int lane, int KP = 0) {
    if (KP == 0) KP = K;
    const int nblk = N / 32, kb = item / nblk, nb = item % nblk, k0 = 64 * kb, n0 = 32 * nb;
    f32x4 v[8];
#pragma unroll
    for (int i = 0; i < 8; ++i) v[i] = __builtin_nontemporal_load((const f32x4*)(W + (size_t)(k0 + 8 * i + (lane >> 3)) * N + n0 + 4 * (lane & 7)));
#pragma unroll
    for (int i = 0; i < 8; ++i) { LAS float* p = scr + (8 * i + (lane >> 3)) * 33 + 4 * (lane & 7); p[0] = v[i].x; p[1] = v[i].y; p[2] = v[i].z; p[3] = v[i].w; }
    asm volatile("s_waitcnt lgkmcnt(0)" ::: "memory");
    const int c = lane & 7;
#pragma unroll
    for (int j = 0; j < 4; ++j) { const int n = (lane >> 3) + 8 * j; const LAS float* s = scr + (8 * c) * 33 + n;
        u32x4 o; o.x = pk2(s[0 * 33], s[1 * 33]); o.y = pk2(s[2 * 33], s[3 * 33]); o.z = pk2(s[4 * 33], s[5 * 33]); o.w = pk2(s[6 * 33], s[7 * 33]);
        *(u32x4*)(WT + (size_t)rowmap<MAP>(n0 + n) * KP + k0 + 8 * c) = o; }
    asm volatile("s_waitcnt lgkmcnt(0)" ::: "memory");
}
template <int MAP> __device__ __forceinline__ void transpose_item_fp8(const float* W, int K, int N, unsigned char* WT, LAS float* scr, int item, int lane) {
    const int nblk = N / 32, kb = item / nblk, nb = item % nblk, k0 = 64 * kb, n0 = 32 * nb;
    f32x4 v[8];
#pragma unroll
    for (int i = 0; i < 8; ++i) v[i] = __builtin_nontemporal_load((const f32x4*)(W + (size_t)(k0 + 8 * i + (lane >> 3)) * N + n0 + 4 * (lane & 7)));
#pragma unroll
    for (int i = 0; i < 8; ++i) { LAS float* p = scr + (8 * i + (lane >> 3)) * 33 + 4 * (lane & 7); p[0] = v[i].x; p[1] = v[i].y; p[2] = v[i].z; p[3] = v[i].w; }
    asm volatile("s_waitcnt lgkmcnt(0)" ::: "memory");
    const int n = lane >> 1, hf = lane & 1; const LAS float* s = scr + (32 * hf) * 33 + n;
    u32x4 o0, o1;
    o0.x = pk4_fp8(s[0 * 33], s[1 * 33], s[2 * 33], s[3 * 33], S_W);     o0.y = pk4_fp8(s[4 * 33], s[5 * 33], s[6 * 33], s[7 * 33], S_W);
    o0.z = pk4_fp8(s[8 * 33], s[9 * 33], s[10 * 33], s[11 * 33], S_W);   o0.w = pk4_fp8(s[12 * 33], s[13 * 33], s[14 * 33], s[15 * 33], S_W);
    o1.x = pk4_fp8(s[16 * 33], s[17 * 33], s[18 * 33], s[19 * 33], S_W); o1.y = pk4_fp8(s[20 * 33], s[21 * 33], s[22 * 33], s[23 * 33], S_W);
    o1.z = pk4_fp8(s[24 * 33], s[25 * 33], s[26 * 33], s[27 * 33], S_W); o1.w = pk4_fp8(s[28 * 33], s[29 * 33], s[30 * 33], s[31 * 33], S_W);
    unsigned char* dst = WT + (size_t)rowmap<MAP>(n0 + n) * K + k0 + 32 * hf;
    *(u32x4*)dst = o0; *(u32x4*)(dst + 16) = o1;
    asm volatile("s_waitcnt lgkmcnt(0)" ::: "memory");
}
struct QItem { const float* W; unsigned char* WT; float* scl; int N, n0, map; };
constexpr int NQ_IN = P1_I8 ? DIN / 32 : 0, NQ_GU = MOE1_I8 ? NE * 64 : 0, NQ = NQ_IN + NQ_GU;
__device__ __forceinline__ QItem q_item(const float* win, const float* wgu, unsigned char* ws, int wi) {
    QItem q;
    if (wi < NQ_IN) { q.W = win; q.WT = ws + WS_WIN; q.scl = (float*)(ws + WS_WINS); q.N = DIN; q.n0 = 32 * wi; q.map = 1; }
    else { wi -= NQ_IN; const int e = wi >> 6; q.W = wgu + (size_t)e * DM * 2 * DE; q.WT = ws + WS_WGU + (size_t)e * 2 * DE * DM; q.scl = (float*)(ws + WS_WGS) + (size_t)e * 2 * DE; q.N = 2 * DE; q.n0 = 32 * (wi & 63); q.map = 2; }
    return q;
}
__device__ __forceinline__ void q_load(const QItem& q, f32x4 (&v)[16], int wave, int lane) {
#pragma unroll
    for (int i = 0; i < 16; ++i) v[i] = __builtin_nontemporal_load((const f32x4*)(q.W + (size_t)(128 * wave + 8 * i + (lane >> 3)) * q.N + q.n0 + 4 * (lane & 7)));
}
__device__ __forceinline__ void quant_cols_loop(const float* win, const float* wgu, unsigned char* ws, LAS unsigned char* lds, int bid, int G, int wave, int lane) {
    if (NQ == 0) return;
    LAS float* s = (LAS float*)lds; LAS float* pmax = (LAS float*)(lds + 1024 * 33 * 4);
    int wi = bid; if (wi >= NQ) return;
    QItem q = q_item(win, wgu, ws, wi); f32x4 v[16]; q_load(q, v, wave, lane);
    for (;;) {
#pragma unroll
        for (int i = 0; i < 16; ++i) { LAS float* p = s + (128 * wave + 8 * i + (lane >> 3)) * 33 + 4 * (lane & 7); p[0] = v[i].x; p[1] = v[i].y; p[2] = v[i].z; p[3] = v[i].w; }
        lds_barrier();
        const int nw = wi + G; const bool more = nw < NQ; QItem qn = q;
        if (more) { qn = q_item(win, wgu, ws, nw); q_load(qn, v, wave, lane); }
        const int n = lane & 31, kb = 128 * wave + 64 * (lane >> 5);
        float x[64]; float am = 0.f;
#pragma unroll
        for (int kk = 0; kk < 64; ++kk) { x[kk] = s[(kb + kk) * 33 + n]; am = fmaxf(am, fabsf(x[kk])); }
        pmax[(2 * wave + (lane >> 5)) * 32 + n] = am;
        lds_barrier();
        am = 0.f;
#pragma unroll
        for (int p = 0; p < 16; ++p) am = fmaxf(am, pmax[p * 32 + n]);
        const float inv = am > 0.f ? 127.0f / am : 0.f;
        const int r = q.map == 1 ? rowmap<1>(q.n0 + n) : rowmap<2>(q.n0 + n);
        if (wave == 0 && lane < 32) q.scl[r] = am * (1.0f / 127.0f);
        unsigned char* dst = q.WT + (size_t)r * 1024 + kb;
#pragma unroll
        for (int qq = 0; qq < 4; ++qq) { u32x4 o;
            o.x = pk4_i8(x[16 * qq + 0] * inv, x[16 * qq + 1] * inv, x[16 * qq + 2] * inv, x[16 * qq + 3] * inv);   o.y = pk4_i8(x[16 * qq + 4] * inv, x[16 * qq + 5] * inv, x[16 * qq + 6] * inv, x[16 * qq + 7] * inv);
            o.z = pk4_i8(x[16 * qq + 8] * inv, x[16 * qq + 9] * inv, x[16 * qq + 10] * inv, x[16 * qq + 11] * inv); o.w = pk4_i8(x[16 * qq + 12] * inv, x[16 * qq + 13] * inv, x[16 * qq + 14] * inv, x[16 * qq + 15] * inv);
            *(u32x4*)(dst + 16 * qq) = o; }
        if (!more) break;
        q = qn; wi = nw;
    }
    lds_barrier();
}
__device__ __forceinline__ void rms_row_to_bf16(const float* xrow, const float* w, bf16_t* orow, int lane) {
    const f32x4* xr = (const f32x4*)xrow + lane; const f32x4* wr = (const f32x4*)w + lane;
    f32x4 v[4]; float s = 0.f;
#pragma unroll
    for (int j = 0; j < 4; ++j) { v[j] = __builtin_nontemporal_load(xr + 64 * j); s += (v[j].x * v[j].x + v[j].y * v[j].y) + (v[j].z * v[j].z + v[j].w * v[j].w); }
    const float rstd = 1.0f / sqrtf(wave_sum(s) * (1.0f / DM) + RMS_EPS);
    u32x2* o8 = (u32x2*)orow + lane;
#pragma unroll
    for (int j = 0; j < 4; ++j) { const f32x4 ww = wr[64 * j]; u32x2 o; o.x = pk2(v[j].x * rstd * ww.x, v[j].y * rstd * ww.y); o.y = pk2(v[j].z * rstd * ww.z, v[j].w * rstd * ww.w); o8[64 * j] = o; }
}
__device__ __forceinline__ void rms_row_to_i8(const float* xrow, const float* w, unsigned char* orow, float* sc, int lane) {
    const f32x4* xr = (const f32x4*)xrow + lane; const f32x4* wr = (const f32x4*)w + lane;
    f32x4 v[4]; float s = 0.f;
#pragma unroll
    for (int j = 0; j < 4; ++j) { v[j] = __builtin_nontemporal_load(xr + 64 * j); s += (v[j].x * v[j].x + v[j].y * v[j].y) + (v[j].z * v[j].z + v[j].w * v[j].w); }
    const float rstd = 1.0f / sqrtf(wave_sum(s) * (1.0f / DM) + RMS_EPS);
    float am = 0.f;
#pragma unroll
    for (int j = 0; j < 4; ++j) { const f32x4 ww = wr[64 * j]; v[j] = v[j] * rstd * ww; am = fmaxf(fmaxf(am, fmaxf(fabsf(v[j].x), fabsf(v[j].y))), fmaxf(fabsf(v[j].z), fabsf(v[j].w))); }
    am = wave_max(am); const float inv = am > 0.f ? 127.0f / am : 0.f;
    unsigned* o4 = (unsigned*)orow + lane;
#pragma unroll
    for (int j = 0; j < 4; ++j) o4[64 * j] = pk4_i8(v[j].x * inv, v[j].y * inv, v[j].z * inv, v[j].w * inv);
    if (lane == 0) *sc = am * (1.0f / 127.0f);
}

__device__ __forceinline__ void p0_prologue(const Frame& F0, const Args& a) {
    const Frame F = fresh(F0);
    unsigned char* ws = a.ws;
    LAS float* scr = (LAS float*)(F.lds + F.wave * 16384);
    const int gw = F.bid * 8 + F.wave, NGW = F.G * 8;
    constexpr int I_IN = P1_I8 ? 0 : 16 * (DIN / 32), I_UP = 8 * 32, I_O = 16 * 32, I_GU = MOE1_I8 ? 0 : 16 * 64, I_D = 16 * 32;
    constexpr int NITEMS = I_IN + 2 * I_UP + I_O + NE * (I_GU + I_D);
    for (int it = gw; it < NITEMS; it += NGW) {
        int r = it;
        if (r < I_IN) { transpose_item<1>(a.in[I_WIN], DM, DIN, (bf16_t*)(ws + WS_WIN), scr, r, F.lane); continue; } r -= I_IN;
        if (r < I_UP) { transpose_item<0>(a.in[I_MUP], 512, DM, (bf16_t*)(ws + WS_MUP), scr, r, F.lane, 1024); continue; } r -= I_UP;
        if (r < I_UP) { transpose_item<0>(a.in[I_HUP], 512, DM, (bf16_t*)(ws + WS_MUP) + 512, scr, r, F.lane, 1024); continue; } r -= I_UP;
        if (r < I_O) { transpose_item<0>(a.in[I_WOUT], DM, DM, (bf16_t*)(ws + WS_WOUT), scr, r, F.lane); continue; } r -= I_O;
        if (I_GU > 0 && r < NE * I_GU) { const int e = r / (I_GU > 0 ? I_GU : 1);
            if constexpr (MOE_FP8) transpose_item_fp8<2>(a.in[I_WGU] + (size_t)e * DM * 2 * DE, DM, 2 * DE, (unsigned char*)(ws + WS_WGU) + (size_t)e * 2 * DE * DM, scr, r % (I_GU > 0 ? I_GU : 1), F.lane);
            else transpose_item<2>(a.in[I_WGU] + (size_t)e * DM * 2 * DE, DM, 2 * DE, (bf16_t*)(ws + WS_WGU) + (size_t)e * 2 * DE * DM, scr, r % (I_GU > 0 ? I_GU : 1), F.lane);
            continue; } r -= NE * I_GU;
        { const int e = r / I_D;
            if constexpr (MOE_FP8) transpose_item_fp8<0>(a.in[I_WD] + (size_t)e * DE * DM, DE, DM, (unsigned char*)(ws + WS_WD) + (size_t)e * DM * DE, scr, r % I_D, F.lane);
            else transpose_item<0>(a.in[I_WD] + (size_t)e * DE * DM, DE, DM, (bf16_t*)(ws + WS_WD) + (size_t)e * DM * DE, scr, r % I_D, F.lane); }
    }
    if constexpr (P1_I8) { for (int m = gw; m < NTOK; m += NGW) rms_row_to_i8(a.in[I_X] + (size_t)m * DM, a.in[I_N1], ws + WS_XN + (size_t)m * DM, (float*)(ws + WS_XS) + m, F.lane); }
    else { for (int m = gw; m < NTOK; m += NGW) rms_row_to_bf16(a.in[I_X] + (size_t)m * DM, a.in[I_N1], (bf16_t*)(ws + WS_XN) + (size_t)m * DM, F.lane); }
    if constexpr (NQ > 0) {
        __syncthreads();
        quant_cols_loop(a.in[I_WIN], a.in[I_WGU], ws, F.lds, F.bid, F.G, F.wave, F.lane);
    }
    float* rope = (float*)(ws + WS_ROPE);
    for (int idx = F.bid * 512 + F.tid; idx < SEQ * 32; idx += F.G * 512) {
        const int pos = idx >> 5, i = idx & 31;
        const double inv = exp2(-(double)i * (13.287712379549449 / 32.0));
        const double rev = (double)pos * inv * 0.15915494309189535;
        const float fr = (float)(rev - floor(rev));
        rope[2 * idx] = __builtin_amdgcn_cosf(fr); rope[2 * idx + 1] = __builtin_amdgcn_sinf(fr);
    }
    if (F.bid == 0) { const float* l = a.in[I_LBL]; const float a0 = l[F.tid], a1 = l[512 + F.tid]; ((float*)(ws + WS_LB))[F.tid] = 1.0f / (1.0f + __expf(a1 - a0)); }
}

__device__ __forceinline__ void p2_kmean(const Frame& F0, const Args& a) {
    const Frame F = fresh(F0);
    const bf16_t* proj = (const bf16_t*)(a.ws + WS_PROJ); bf16_t* km = (bf16_t*)(a.ws + WS_KMEAN);
    LAS float* red = (LAS float*)F.lds;
    for (int it = F.bid; it < 128; it += F.G) {
        const int b = it >> 4, n = it & 15;
        float s[8] = {0, 0, 0, 0, 0, 0, 0, 0};
        const bf16_t* base = proj + (size_t)(b * SEQ + n * 256 + F.wave * 32) * DIN + C_KA + F.lane * 8;
#pragma unroll 8
        for (int r = 0; r < 32; ++r) { const u32x4 w = *(const u32x4*)(base + (size_t)r * DIN); f32x4 x0, x1; unpack8(w, x0, x1);
            s[0] += x0[0]; s[1] += x0[1]; s[2] += x0[2]; s[3] += x0[3]; s[4] += x1[0]; s[5] += x1[1]; s[6] += x1[2]; s[7] += x1[3]; }
#pragma unroll
        for (int j = 0; j < 8; ++j) red[F.wave * 512 + F.lane * 8 + j] = s[j];
        __syncthreads();
        float t = 0.f;
#pragma unroll
        for (int w = 0; w < 8; ++w) t += red[w * 512 + F.tid];
        km[((size_t)b * 64 + n) * 512 + F.tid] = (bf16_t)f2bf(t * (1.0f / 256.0f));
        km[((size_t)b * 64 + n + 16) * 512 + F.tid] = 0; km[((size_t)b * 64 + n + 32) * 512 + F.tid] = 0; km[((size_t)b * 64 + n + 48) * 512 + F.tid] = 0;
        __syncthreads();
    }
}

constexpr int HP = 72, HQ = 136;
__device__ __forceinline__ void h2_scan(const Frame& F0, const Args& a) {
    const Frame F = fresh(F0);
    bf16_t* hst = (bf16_t*)(a.ws + WS_HST); const float* gdec = (const float*)(a.ws + WS_GDEC);
    LAS float* G = (LAS float*)F.lds;
    for (int base = F.bid * 512; base < 32 * 128 * 32; base += F.G * 512) {
        const int idx = base + F.tid, bh = idx >> 12, v = (idx >> 5) & 127, d4 = idx & 31;
        { const f32x4* gp = (const f32x4*)(gdec + (size_t)bh * 64 * 128) + F.tid;
#pragma unroll
          for (int j = 0; j < 4; ++j) *(LAS f32x4*)(G + (F.tid + 512 * j) * 4) = gp[512 * j]; }
        lds_barrier();
        bf16_t* p = hst + ((size_t)bh * 64 * 128 + v) * 128 + d4 * 4;
        f32x4 s = {0.f, 0.f, 0.f, 0.f};
#pragma unroll 1
        for (int c0 = 0; c0 < 64; c0 += 16) {
            u32x2 u[16];
#pragma unroll
            for (int j = 0; j < 16; ++j) u[j] = __builtin_nontemporal_load((const u32x2*)(p + (size_t)(c0 + j) * 16384));
#pragma unroll
            for (int j = 0; j < 16; ++j) { const f32x4 gg = *(const LAS f32x4*)(G + (c0 + j) * 128 + d4 * 4);
                u32x2 w; w.x = pk2(s[0], s[1]); w.y = pk2(s[2], s[3]); *(u32x2*)(p + (size_t)(c0 + j) * 16384) = w;
                s = gg * s + (f32x4){bf_lo(u[j].x), bf_hi(u[j].x), bf_lo(u[j].y), bf_hi(u[j].y)}; }
        }
        lds_barrier();
    }
}
#define H_CVT_LF(LFR, LH) do { _Pragma("unroll") for (int j_ = 0; j_ < 2; ++j_) { const f32x8 f_ = __builtin_convertvector(LH[j_], f32x8); LFR[2 * j_] = (f32x4){f_[0], f_[1], f_[2], f_[3]}; LFR[2 * j_ + 1] = (f32x4){f_[4], f_[5], f_[6], f_[7]}; } } while (0)
constexpr int LFP = 132;
#define H_LOAD_LQI(it_, LFR, QR, IR, WITHQ) do { const int bh_ = (it_) >> 6, c_ = (it_) & 63; const size_t r_ = (size_t)(bh_ >> 2) * SEQ + c_ * 64 + t_r; const int hh_ = (bh_ & 3) * 128 + 16 * seg; \
    _Pragma("unroll") for (int j_ = 0; j_ < 2; ++j_) LFR[j_] = __builtin_nontemporal_load((const h16x8*)((const _Float16*)logf + r_ * 512 + hh_ + 8 * j_));     \
    _Pragma("unroll") for (int j_ = 0; j_ < 2; ++j_) { if (WITHQ) QR[j_] = __builtin_nontemporal_load((const u32x4*)(proj + r_ * DIN + C_QB + hh_ + 8 * j_)); IR[j_] = __builtin_nontemporal_load((const u32x4*)(proj + r_ * DIN + C_IB + hh_ + 8 * j_)); } } while (0)
__device__ __forceinline__ void scatter_it(LAS bf16_t* It, const u32x4 (&ir)[2], int seg, int t_r) {
    const int tsw = (((t_r >> 3) ^ seg) << 3) | (t_r & 7);
#pragma unroll
    for (int j = 0; j < 2; ++j) { const unsigned w[4] = {ir[j].x, ir[j].y, ir[j].z, ir[j].w};
#pragma unroll
        for (int q = 0; q < 4; ++q) { It[(16 * seg + 8 * j + 2 * q) * HP + tsw] = (bf16_t)(w[q] & 0xffffu); It[(16 * seg + 8 * j + 2 * q + 1) * HP + tsw] = (bf16_t)(w[q] >> 16); } }
}
__device__ __forceinline__ void h1_local_states_p(const Frame& F0, const Args& a) {
    const Frame F = fresh(F0);
    const bf16_t* proj = (const bf16_t*)(a.ws + WS_PROJ); const float* logf = (const float*)(a.ws + WS_LOGF);
    bf16_t* hst = (bf16_t*)(a.ws + WS_HST); float* gdec = (float*)(a.ws + WS_GDEC);
    LAS float* LF = (LAS float*)F.lds; LAS bf16_t* Kp = (LAS bf16_t*)(F.lds + 64 * LFP * 4); LAS bf16_t* It = Kp + 128 * HP;
    const int t_r = F.tid >> 3, seg = F.tid & 7, l15 = F.lane & 15, lq = F.lane >> 4;
    f32x4 lfr[4]; h16x8 lhr[2], lhn[2]; u32x4 qdum[2], ir[2], in_[2];
    int it = F.bid;
    if (it < 2048) H_LOAD_LQI(it, lhr, qdum, ir, false);
    for (; it < 2048; it += F.G) {
        const int bh = it >> 6, c = it & 63;
        H_CVT_LF(lfr, lhr);
#pragma unroll
        for (int j = 0; j < 4; ++j) *(LAS f32x4*)(LF + t_r * LFP + 16 * seg + 4 * j) = lfr[j];
        scatter_it(It, ir, seg, t_r);
        const int itn = it + F.G;
        if (itn < 2048) H_LOAD_LQI(itn, lhn, qdum, in_, false);
        lds_barrier();
        if (F.tid < 128) { float run = 0.f;
#pragma unroll 16
            for (int t = 0; t < 64; ++t) { run += LF[t * LFP + F.tid]; LF[t * LFP + F.tid] = run; }
            gdec[((size_t)bh * 64 + c) * 128 + F.tid] = __expf(run); }
        lds_barrier();
        {
            f32x4 bb[4], bl[4];
#pragma unroll
            for (int j = 0; j < 4; ++j) { bb[j] = *(const LAS f32x4*)(LF + t_r * LFP + 16 * seg + 4 * j); bl[j] = *(const LAS f32x4*)(LF + 63 * LFP + 16 * seg + 4 * j); }
#pragma unroll
            for (int j = 0; j < 4; ++j)
#pragma unroll
                for (int q = 0; q < 4; ++q) { const float kv = (1.0f - __expf(lfr[j][q])) * __expf(bl[j][q] - bb[j][q]); Kp[(16 * seg + 4 * j + q) * HP + ((((t_r >> 3) ^ seg) << 3) | (t_r & 7))] = (bf16_t)f2bf(kv); }
        }
        lds_barrier();
        bf16x8 af[2];
#pragma unroll
        for (int ks = 0; ks < 2; ++ks) af[ks] = *(const LAS bf16x8*)(Kp + (16 * F.wave + l15) * HP + (((ks * 4 + lq) ^ F.wave) << 3));
#pragma unroll
        for (int vt = 0; vt < 8; ++vt) {
            f32x4 acc = {0.f, 0.f, 0.f, 0.f};
#pragma unroll
            for (int ks = 0; ks < 2; ++ks) { const bf16x8 bfr = *(const LAS bf16x8*)(It + (16 * vt + l15) * HP + (((ks * 4 + lq) ^ vt) << 3)); acc = __builtin_amdgcn_mfma_f32_16x16x32_bf16(af[ks], bfr, acc, 0, 0, 0); }
            u32x2 w; w.x = pk2(acc[0], acc[1]); w.y = pk2(acc[2], acc[3]);
            *(u32x2*)(hst + (((size_t)bh * 64 + c) * 128 + 16 * vt + l15) * 128 + 16 * F.wave + 4 * lq) = w;
        }
        lds_barrier();
        lhr[0] = lhn[0]; lhr[1] = lhn[1];
        ir[0] = in_[0]; ir[1] = in_[1];
    }
}
#define H3_LOAD_SF(it_, SF) do { const int bh_ = (it_) >> 6, c_ = (it_) & 63; \
    _Pragma("unroll") for (int ks_ = 0; ks_ < 4; ++ks_) SF[ks_] = __builtin_nontemporal_load((const bf16x8*)(hst + (((size_t)bh_ * 64 + c_) * 128 + 16 * w + l15) * 128 + ks_ * 32 + 8 * lq)); } while (0)
#define H3_LOAD_GR(it_, GR) do { const int bh_ = (it_) >> 6, c_ = (it_) & 63; const size_t row0_ = (size_t)(bh_ >> 2) * SEQ + c_ * 64; \
    _Pragma("unroll") for (int tt_ = 0; tt_ < 4; ++tt_) GR[tt_] = __builtin_nontemporal_load((const u32x2*)(proj + (row0_ + 16 * tt_ + l15) * DIN + C_GB + (bh_ & 3) * 128 + 16 * w + 4 * lq)); } while (0)
#define H3_LOAD_Q(it_, QR) do { const int bh_ = (it_) >> 6, c_ = (it_) & 63; const size_t r_ = (size_t)(bh_ >> 2) * SEQ + c_ * 64 + t_r; const int hh_ = (bh_ & 3) * 128 + 16 * seg; \
    _Pragma("unroll") for (int j_ = 0; j_ < 2; ++j_) QR[j_] = __builtin_nontemporal_load((const u32x4*)(proj + r_ * DIN + C_QB + hh_ + 8 * j_)); } while (0)
#define H3_LOAD_LATE(it_, SF, GR) do { H3_LOAD_SF(it_, SF); H3_LOAD_GR(it_, GR); } while (0)
__device__ __forceinline__ void h3_outputs_p(const Frame& F0, const Args& a) {
    const Frame F = fresh(F0);
    const bf16_t* proj = (const bf16_t*)(a.ws + WS_PROJ); const float* logf = (const float*)(a.ws + WS_LOGF);
    const bf16_t* hst = (const bf16_t*)(a.ws + WS_HST); bf16_t* yb = (bf16_t*)(a.ws + WS_YA); const float* nw = a.in[I_HNW];
    LAS float* LF = (LAS float*)F.lds; LAS bf16_t* Qt = (LAS bf16_t*)(F.lds + 64 * LFP * 4); LAS bf16_t* Kt = Qt + 64 * HQ; LAS bf16_t* It = Kt + 64 * HQ; LAS bf16_t* Pm = It + 128 * HP;
    LAS float* rsq = (LAS float*)(Pm + 64 * HP);
    const int t_r = F.tid >> 3, seg = F.tid & 7, l15 = F.lane & 15, lq = F.lane >> 4, w = F.wave;
    f32x4 lfr[4]; h16x8 lhr[2], lhn[2]; u32x4 qr[2], qn[2], ir[2], in_[2]; bf16x8 sf[4], sfn[4]; u32x2 gr[4], grn[4];
    int it = F.bid;
    if (it < 2048) { H_LOAD_LQI(it, lhr, qr, ir, true); H3_LOAD_LATE(it, sf, gr); }
    for (; it < 2048; it += F.G) {
        const int bh = it >> 6, c = it & 63, b = bh >> 2, h = bh & 3; const size_t row0 = (size_t)b * SEQ + c * 64;
        H_CVT_LF(lfr, lhr);
#pragma unroll
        for (int j = 0; j < 4; ++j) *(LAS f32x4*)(LF + t_r * LFP + 16 * seg + 4 * j) = lfr[j];
        scatter_it(It, ir, seg, t_r);
        const int itn = it + F.G;
        if (itn < 2048) H_LOAD_LQI(itn, lhn, qn, in_, false);
        lds_barrier();
        if (itn < 2048) H3_LOAD_Q(itn, qn);
        if (F.tid < 128) { float run = 0.f;
#pragma unroll 16
            for (int t = 0; t < 64; ++t) { run += LF[t * LFP + F.tid]; LF[t * LFP + F.tid] = run; } }
        lds_barrier();
        if (itn < 2048) H3_LOAD_SF(itn, sfn);
        {
            float qv[16], kv[16];
#pragma unroll
            for (int j = 0; j < 4; ++j) { const f32x4 bb = *(const LAS f32x4*)(LF + t_r * LFP + 16 * seg + 4 * j);
#pragma unroll
                for (int q = 0; q < 4; ++q) { const float eb = __expf(bb[q]); const unsigned qw = (j < 2 ? qr[0] : qr[1])[(2 * j + (q >> 1)) & 3];
                    const float qs = (q & 1) ? bf_hi(qw) : bf_lo(qw);
                    qv[4 * j + q] = qs * eb; kv[4 * j + q] = (1.0f - __expf(lfr[j][q])) * __builtin_amdgcn_rcpf(eb); } }
            u32x4 o0, o1;
            o0.x = pk2(qv[0], qv[1]); o0.y = pk2(qv[2], qv[3]); o0.z = pk2(qv[4], qv[5]); o0.w = pk2(qv[6], qv[7]); o1.x = pk2(qv[8], qv[9]); o1.y = pk2(qv[10], qv[11]); o1.z = pk2(qv[12], qv[13]); o1.w = pk2(qv[14], qv[15]);
            *(LAS u32x4*)(Qt + t_r * HQ + 16 * seg) = o0; *(LAS u32x4*)(Qt + t_r * HQ + 16 * seg + 8) = o1;
            o0.x = pk2(kv[0], kv[1]); o0.y = pk2(kv[2], kv[3]); o0.z = pk2(kv[4], kv[5]); o0.w = pk2(kv[6], kv[7]); o1.x = pk2(kv[8], kv[9]); o1.y = pk2(kv[10], kv[11]); o1.z = pk2(kv[12], kv[13]); o1.w = pk2(kv[14], kv[15]);
            *(LAS u32x4*)(Kt + t_r * HQ + 16 * seg) = o0; *(LAS u32x4*)(Kt + t_r * HQ + 16 * seg + 8) = o1;
        }
        lds_barrier();
        if (itn < 2048) H3_LOAD_GR(itn, grn);
        {
            const int tt = w >> 1; bf16x8 qa[4];
#pragma unroll
            for (int ks = 0; ks < 4; ++ks) qa[ks] = *(const LAS bf16x8*)(Qt + (16 * tt + l15) * HQ + ks * 32 + 8 * lq);
#pragma unroll
            for (int j = 0; j < 2; ++j) {
                const int st = (w & 1) * 2 + j; f32x4 acc = {0.f, 0.f, 0.f, 0.f};
#pragma unroll
                for (int ks = 0; ks < 4; ++ks) { const bf16x8 kb = *(const LAS bf16x8*)(Kt + (16 * st + l15) * HQ + ks * 32 + 8 * lq); acc = __builtin_amdgcn_mfma_f32_16x16x32_bf16(qa[ks], kb, acc, 0, 0, 0); }
                const int s = 16 * st + l15;
#pragma unroll
                for (int r = 0; r < 4; ++r) { const int t = 16 * tt + 4 * lq + r; Pm[t * HP + s] = (bf16_t)(s <= t ? f2bf(acc[r]) : 0u); }
            }
        }
        lds_barrier();
        f32x4 o[4];
        {
            bf16x8 ia[2];
#pragma unroll
            for (int ks = 0; ks < 2; ++ks) ia[ks] = *(const LAS bf16x8*)(It + (16 * w + l15) * HP + (((ks * 4 + lq) ^ w) << 3));
#pragma unroll
            for (int tt = 0; tt < 4; ++tt) {
                f32x4 acc = {0.f, 0.f, 0.f, 0.f};
#pragma unroll
                for (int ks = 0; ks < 2; ++ks) { const bf16x8 pb = *(const LAS bf16x8*)(Pm + (16 * tt + l15) * HP + ks * 32 + 8 * lq); acc = __builtin_amdgcn_mfma_f32_16x16x32_bf16(ia[ks], pb, acc, 0, 0, 0); }
#pragma unroll
                for (int ks = 0; ks < 4; ++ks) { const bf16x8 qb = *(const LAS bf16x8*)(Qt + (16 * tt + l15) * HQ + ks * 32 + 8 * lq); acc = __builtin_amdgcn_mfma_f32_16x16x32_bf16(sf[ks], qb, acc, 0, 0, 0); }
                o[tt] = acc;
                float sq = (acc[0] * acc[0] + acc[1] * acc[1]) + (acc[2] * acc[2] + acc[3] * acc[3]);
                sq += __shfl_xor(sq, 16); sq += __shfl_xor(sq, 32);
                if (F.lane < 16) rsq[w * 64 + 16 * tt + F.lane] = sq;
            }
        }
        lds_barrier();
        const int v0 = 16 * w + 4 * lq; const f32x4 nw4 = *(const f32x4*)(nw + h * 128 + v0);
#pragma unroll
        for (int tt = 0; tt < 4; ++tt) {
            const int t = 16 * tt + l15; float tot = 0.f;
#pragma unroll
            for (int ww = 0; ww < 8; ++ww) tot += rsq[ww * 64 + t];
            const float rstd = __builtin_amdgcn_rsqf(tot * (1.0f / 128.0f) + RMS_EPS);
            const u32x2 gg = gr[tt];
            u32x2 y; y.x = pk2(o[tt][0] * rstd * nw4[0] * bf_lo(gg.x), o[tt][1] * rstd * nw4[1] * bf_hi(gg.x)); y.y = pk2(o[tt][2] * rstd * nw4[2] * bf_lo(gg.y), o[tt][3] * rstd * nw4[3] * bf_hi(gg.y));
            *(u32x2*)(yb + (row0 + t) * 1024 + 512 + h * 128 + v0) = y;
        }
        lds_barrier();
        lhr[0] = lhn[0]; lhr[1] = lhn[1];
        qr[0] = qn[0]; qr[1] = qn[1]; ir[0] = in_[0]; ir[1] = in_[1];
#pragma unroll
        for (int j = 0; j < 4; ++j) { sf[j] = sfn[j]; gr[j] = grn[j]; }
    }
}
#undef H3_LOAD_LATE
#undef H3_LOAD_SF
#undef H3_LOAD_Q
#undef H3_LOAD_GR

#include <hip/hip_bf16.h>
#include <cmath>
namespace attn_body {
using bf16=__hip_bfloat16;
using bf16x8=__attribute__((ext_vector_type(8)))short;
using s16x4=__attribute__((ext_vector_type(4)))short;
using f32x16=__attribute__((ext_vector_type(16)))float;
using u32x4=__attribute__((ext_vector_type(4)))unsigned;
constexpr int BATCH=8,NHEAD=8,SEQ=4096,D=64,PIN=5632,POUT=1024,PKM=512;
constexpr int NW=8,QBLK=32,QB=QBLK*NW,KVBLK=64,NQB=SEQ/QB;
constexpr int ATTN_UNIT_ROWS=QB;
__device__ __forceinline__ int crow(int r,int hi){return (r&3)+8*(r>>2)+4*hi;}
#define SBAR() __builtin_amdgcn_sched_barrier(0)
__device__ __forceinline__ void cmask(f32x16&p0,f32x16&p1,int jb,int qrel,int hi){
  const float NEG=-INFINITY; int kb=64*jb+4*hi;
  #pragma unroll
  for(int r=0;r<16;++r){int kv=kb+(r&3)+8*(r>>2); if(kv>qrel)p0[r]=NEG; if(kv+32>qrel)p1[r]=NEG;}
}

__device__ __forceinline__ void smask(f32x16&p0,f32x16&p1,unsigned selm,int n){ if(!((selm>>n)&1u)){ const float NEG=-INFINITY;
  #pragma unroll
  for(int r=0;r<16;++r){p0[r]=NEG;p1[r]=NEG;} } }
constexpr int NSLOT=3, SLOTB=8192;
constexpr int LDS_K=0, LDS_V=NSLOT*SLOTB, LDS_WS=2*NSLOT*SLOTB, LDS_OST=LDS_WS+NW*64*4, LDS_BYTES=LDS_OST+NW*4096;
constexpr float C2=0.125f*1.4426950408889634f;
__device__ __forceinline__ void glds16(const void*gsrc,unsigned lds_dst){unsigned keep;
  asm volatile("s_mov_b32 %0, m0\n\ts_mov_b32 m0, %2\n\ts_nop 0\n\tglobal_load_lds_dwordx4 %1, off\n\ts_mov_b32 m0, %0":"=&s"(keep):"v"(gsrc),"s"(lds_dst):"memory");}
__device__ __forceinline__ float max3f(float a,float b,float c){float r;asm("v_max3_f32 %0, %1, %2, %3":"=v"(r):"v"(a),"v"(b),"v"(c));return r;}
__device__ __forceinline__ float max2f(float a,float b){float r;asm("v_max_f32_e32 %0, %1, %2":"=v"(r):"v"(a),"v"(b));return r;}
__device__ __forceinline__ float fadd_s(float a,float b){float r;asm("v_add_f32_e32 %0, %1, %2":"=v"(r):"v"(a),"v"(b));return r;}
__device__ __forceinline__ float fsub_s(float a,float b){float r;asm("v_sub_f32_e32 %0, %1, %2":"=v"(r):"v"(a),"v"(b));return r;}
typedef float f32x2_t __attribute__((ext_vector_type(2))); typedef __bf16 bf16x2_t __attribute__((ext_vector_type(2)));
__device__ __forceinline__ unsigned cvtpk_s(float lo,float hi){f32x2_t v={lo,hi};bf16x2_t b=__builtin_convertvector(v,bf16x2_t);return __builtin_bit_cast(unsigned,b);}
#define WAIT_BAR(N) asm volatile("s_waitcnt vmcnt(" #N ") lgkmcnt(0)\n\ts_barrier":::"memory")

__device__ __forceinline__ void qkt(f32x16&p0,f32x16&p1,const char*Kslot,const bf16x8*qr,int r32,int hi){
  const char*kb=Kslot+hi*1024+r32*16;
  #pragma unroll
  for(int d0=0;d0<4;++d0){
    const bf16x8 b0=*reinterpret_cast<const bf16x8*>(kb+d0*2048);
    const bf16x8 b1=*reinterpret_cast<const bf16x8*>(kb+d0*2048+512);
    if(d0==0){p0=__builtin_amdgcn_mfma_f32_32x32x16_bf16(b0,qr[0],f32x16{},0,0,0);p1=__builtin_amdgcn_mfma_f32_32x32x16_bf16(b1,qr[0],f32x16{},0,0,0);}
    else{p0=__builtin_amdgcn_mfma_f32_32x32x16_bf16(b0,qr[d0],p0,0,0,0);p1=__builtin_amdgcn_mfma_f32_32x32x16_bf16(b1,qr[d0],p1,0,0,0);}}
}
typedef __attribute__((address_space(3))) const char* lds_cptr;
typedef short v4i16_t __attribute__((ext_vector_type(4)));
__device__ __forceinline__ void kload8(bf16x8*kf,lds_cptr kp){
  kf[0]=*(const __attribute__((address_space(3))) bf16x8*)(kp);      kf[1]=*(const __attribute__((address_space(3))) bf16x8*)(kp+512);
  kf[2]=*(const __attribute__((address_space(3))) bf16x8*)(kp+2048); kf[3]=*(const __attribute__((address_space(3))) bf16x8*)(kp+2560);
  kf[4]=*(const __attribute__((address_space(3))) bf16x8*)(kp+4096); kf[5]=*(const __attribute__((address_space(3))) bf16x8*)(kp+4608);
  kf[6]=*(const __attribute__((address_space(3))) bf16x8*)(kp+6144); kf[7]=*(const __attribute__((address_space(3))) bf16x8*)(kp+6656);
}
__device__ __forceinline__ void kload2(bf16x8*kf,lds_cptr kp,int j){ kf[2*j]=*(const __attribute__((address_space(3))) bf16x8*)(kp+j*2048); kf[2*j+1]=*(const __attribute__((address_space(3))) bf16x8*)(kp+j*2048+512); }
__device__ __forceinline__ s16x4 vtr(lds_cptr p){ return __builtin_bit_cast(s16x4,__builtin_amdgcn_ds_read_tr16_b64_v4i16((__attribute__((address_space(3))) v4i16_t*)p)); }
__device__ __forceinline__ float rowmax(const f32x16&p0,const f32x16&p1){
  float a=max3f(p0[0],p0[1],p1[0]),b=max3f(p0[2],p0[3],p1[1]);a=max3f(a,p1[2],p1[3]);
  #pragma unroll
  for(int r=4;r<16;r+=4){a=max3f(a,p0[r],p0[r+1]);b=max3f(b,p0[r+2],p0[r+3]);a=max3f(a,p1[r],p1[r+1]);b=max3f(b,p1[r+2],p1[r+3]);}
  const float m=max2f(a,b);
  auto rr=__builtin_amdgcn_permlane32_swap(__float_as_uint(m),__float_as_uint(m),false,false);
  return max2f(__uint_as_float(rr[0]),__uint_as_float(rr[1]));
}
__device__ __forceinline__ void pv(f32x16*o,int vb,bf16x8 pa0,bf16x8 pa1,bf16x8 pa2,bf16x8 pa3){
  #pragma unroll
  for(int d0=0;d0<2;++d0){s16x4 lo[4],hi[4];
    #pragma unroll
    for(int ks=0;ks<4;++ks){
      asm volatile("ds_read_b64_tr_b16 %0,%1 offset:%c2":"=&v"(lo[ks]):"v"(vb),"i"(d0*4096+ks*1024):"memory");
      asm volatile("ds_read_b64_tr_b16 %0,%1 offset:%c2":"=&v"(hi[ks]):"v"(vb),"i"(d0*4096+ks*1024+512):"memory");}
    asm volatile("s_waitcnt lgkmcnt(0)":::"memory");SBAR();
    #define PK(k) (bf16x8){lo[k][0],lo[k][1],lo[k][2],lo[k][3],hi[k][0],hi[k][1],hi[k][2],hi[k][3]}
    o[d0]=__builtin_amdgcn_mfma_f32_32x32x16_bf16(pa0,PK(0),o[d0],0,0,0);
    o[d0]=__builtin_amdgcn_mfma_f32_32x32x16_bf16(pa1,PK(1),o[d0],0,0,0);
    o[d0]=__builtin_amdgcn_mfma_f32_32x32x16_bf16(pa2,PK(2),o[d0],0,0,0);
    o[d0]=__builtin_amdgcn_mfma_f32_32x32x16_bf16(pa3,PK(3),o[d0],0,0,0);
    #undef PK
  }
}

#ifndef ATTN_STORE16
#define ATTN_STORE16(p,v) (*(u32x4*)(p)=(v))
#endif
template<int THRL> __device__ __forceinline__ void attn_unit(int wave_,int b,int h,int qb,const bf16*Q,const bf16*__restrict__ K,const bf16*__restrict__ V,const bf16*__restrict__ KM,bf16*O,char*shm){
  const int lane=lane_id_(),tid=wave_*64+lane,r32=lane&31,hi=lane>>5; const int wid=wave_;
  const long rowbase=(long)b*SEQ; const int q0=qb*QB;
  const bf16*Qw=Q+(rowbase+q0+wid*QBLK)*PIN+h*D;
  const bf16*Kh=K+rowbase*PIN+h*D,*Vh=V+rowbase*PIN+h*D;
  const unsigned lds0=(unsigned)(uintptr_t)shm;
  float*wsf=(float*)(shm+LDS_WS)+wid*64;
  const bf16*ksrc=Kh+(long)lane*PIN+wid*8;
  const bf16*kmsrc=KM+((long)b*64+lane)*PKM+h*D+wid*8;
  const bf16*vsrc=Vh+(long)(16*(wid&3)+(lane>>2))*PIN+(wid>>2)*32+(lane&3)*8;
  const unsigned kdst=lds0+LDS_K+wid*1024, vdst=lds0+LDS_V+wid*1024;
  #define DMA_K(t,slot) glds16(ksrc+(long)(t)*KVBLK*PIN,(unsigned)__builtin_amdgcn_readfirstlane(kdst+(slot)))
  #define DMA_V(t,slot) glds16(vsrc+(long)(t)*KVBLK*PIN,(unsigned)__builtin_amdgcn_readfirstlane(vdst+(slot)))
  const int vb0=(int)(lds0+LDS_V)+((lane>>4)&1)*32+(lane&3)*8+(4*hi+((lane&15)>>2))*64;
  const char*Kbase=shm+LDS_K; bf16x8 kf[8];
  const lds_cptr shm3=(lds_cptr)shm; const lds_cptr kp0=shm3+LDS_K+hi*1024+r32*16; const lds_cptr vp0=shm3+LDS_V+((lane>>4)&1)*32+(lane&3)*8+(4*hi+((lane&15)>>2))*64;
  const int NT=(q0+QB)/KVBLK;
  glds16(kmsrc,(unsigned)__builtin_amdgcn_readfirstlane(lds0+LDS_V+2*SLOTB+wid*1024));
  DMA_K(0,0);DMA_V(0,0);DMA_K(1,SLOTB);
  bf16x8 qr[4];
  #pragma unroll
  for(int d0=0;d0<4;++d0)qr[d0]=*reinterpret_cast<const bf16x8*>(&Qw[(long)r32*PIN+d0*16+hi*8]);
  float mhat=0.f,l_reg=0.f;f32x16 o[2];o[0]=f32x16{};o[1]=f32x16{};
  const int qrel=wid*QBLK+r32;
  #define CMASK(P0,P1,t) do{int jb_=(t)-(NT-4); const float sb_=(jb_>=0||((selm>>((t)>>2))&1u))?mhat:INFINITY; {const float nsb_=-sb_;P0=P0+nsb_;P1=P1+nsb_;} if(jb_>=0)cmask(P0,P1,jb_,qrel,hi);}while(0)
  bool resc=false;
  #define START(P0,P1) do{ const float rm=rowmax(P0,P1); resc=false; \
    { const float dl=(rm>-1.0e30f)?rm:0.f; mhat=fadd_s(mhat,dl); \
      _Pragma("unroll") for(int r=0;r<16;++r){P0[r]=fsub_s(P0[r],dl);P1[r]=fsub_s(P1[r],dl);} \
      } \
    _Pragma("unroll") for(int r=0;r<16;++r)P0[r]=__builtin_amdgcn_exp2f(P0[r]); }while(0)
  #define RESC() do{ if(resc){ asm volatile("s_waitcnt lgkmcnt(0)":::"memory"); \
      _Pragma("unroll") for(int d_=0;d_<2;++d_) _Pragma("unroll") for(int r=0;r<16;++r)o[d_][r]*=wsf[crow(r,hi)]; } }while(0)
  f32x16 pA0,pA1,pB0,pB1;
  int sl_prev=0,sl_cur=0,sl_next=SLOTB;
  #define ROT() do{sl_prev=sl_cur;sl_cur=sl_next;sl_next=(sl_next==(NSLOT-1)*SLOTB)?0:sl_next+SLOTB;}while(0)
  DMA_K(2,2*SLOTB);
  unsigned selm=0u;
  WAIT_BAR(4);
  { f32x16 g0,g1;
    qkt(g0,g1,shm+LDS_V+2*SLOTB,qr,r32,hi); asm volatile("s_nop 15\n\ts_nop 7":"+v"(g0),"+v"(g1));
    float gm[8],go[8],g[16];
    #pragma unroll
    for(int r=0;r<8;++r){gm[r]=g0[r];go[r]=__shfl_xor(gm[r],32);}
    #pragma unroll
    for(int j=0;j<4;++j){ g[j]=hi?go[j]:gm[j]; g[4+j]=hi?gm[j]:go[j]; g[8+j]=hi?go[4+j]:gm[4+j]; g[12+j]=hi?gm[4+j]:go[4+j]; }
    #pragma unroll
    for(int s=0;s<3;++s){ float best=-3.0e38f; int bi=-1;
      #pragma unroll
      for(int n=0;n<16;++n){ const bool ok=(n<qb)&&!((selm>>n)&1u)&&(g[n]>best); if(ok){best=g[n];bi=n;} }
      if(bi>=0)selm|=1u<<bi; } }
  WAIT_BAR(3);
  qkt(pA0,pA1,Kbase,qr,r32,hi);asm volatile("s_nop 15\n\ts_nop 7":"+v"(pA0),"+v"(pA1));CMASK(pA0,pA1,0);
  START(pA0,pA1);
  _Pragma("unroll") for(int r=0;r<16;++r)pA1[r]=__builtin_amdgcn_exp2f(pA1[r]);
  WAIT_BAR(0);
  DMA_K(3,0);DMA_V(1,SLOTB);
  ROT();
  kload8(kf,kp0+sl_cur);
  WAIT_BAR(2);
  s16x4 vlo[8],vhi[8]; u32x4 pw0,pw1,pw2,pw3;
  #define PKW(P,B) cvtpk_s(P[B],P[B+1])
  #define PAF(k) __builtin_bit_cast(bf16x8,pw##k)
  #define VFR(i) (bf16x8){vlo[i][0],vlo[i][1],vlo[i][2],vlo[i][3],vhi[i][0],vhi[i][1],vhi[i][2],vhi[i][3]}
  #define PIN(x) asm volatile("":"+v"(x))
  #define MX3(a,b,c) __builtin_fmaxf(__builtin_fmaxf((a),(b)),(c))
  #define GAPA(MF,A0,A1,A2,A3,W0,W1,PW) do{ MF; sacc+=A0; sacc+=A1; sacc+=A2; sacc+=A3; PIN(sacc); W0; W1; PIN(PW); SBAR(); }while(0)
  #define EX(v) __builtin_amdgcn_exp2f(v)
  #define GAPB(MF,X,B) do{ MF; X[B]=EX(X[B]); X[B+1]=EX(X[B+1]); X[B+2]=EX(X[B+2]); X[B+3]=EX(X[B+3]); PIN(X); SBAR(); }while(0)
  #define VRD(i) do{ vlo[i]=vtr(vp_+(((i)>>2)*4096+((i)&3)*1024)); vhi[i]=vtr(vp_+(((i)>>2)*4096+((i)&3)*1024+512)); }while(0)
  #define KRD(G,j) do{ if(G){ kload2(kf,kp0+sl_next,j); SBAR(); } }while(0)
  #define STEP(C0,C1,P0,P1,t,GK,GV,GL) do{ SBAR(); \
    const lds_cptr vp_=vp0+sl_prev; \
    VRD(0); SBAR(); float sacc=(P0[0]+P0[1]); \
    GAPA(C0=__builtin_amdgcn_mfma_f32_32x32x16_bf16(kf[0],qr[0],f32x16{},0,0,0), P0[2],P0[3],P0[4],P0[5],     pw0[0]=PKW(P0,0), pw0[1]=PKW(P0,2), pw0); \
    VRD(4); SBAR(); GAPA(C1=__builtin_amdgcn_mfma_f32_32x32x16_bf16(kf[1],qr[0],f32x16{},0,0,0), P0[6],P0[7],P0[8],P0[9],     pw0[2]=PKW(P0,4), pw0[3]=PKW(P0,6), pw0); \
    VRD(1); SBAR(); GAPA(C0=__builtin_amdgcn_mfma_f32_32x32x16_bf16(kf[2],qr[1],C0,0,0,0),   P0[10],P0[11],P0[12],P0[13], pw1[0]=PKW(P0,8), pw1[1]=PKW(P0,10), pw1); \
    VRD(5); SBAR(); GAPA(C1=__builtin_amdgcn_mfma_f32_32x32x16_bf16(kf[3],qr[1],C1,0,0,0),   P0[14],P0[15],P1[0],P1[1],   pw1[2]=PKW(P0,12),pw1[3]=PKW(P0,14), pw1); \
    VRD(2); SBAR(); GAPA(C0=__builtin_amdgcn_mfma_f32_32x32x16_bf16(kf[4],qr[2],C0,0,0,0),   P1[2],P1[3],P1[4],P1[5],     pw2[0]=PKW(P1,0), pw2[1]=PKW(P1,2), pw2); \
    VRD(6); SBAR(); GAPA(C1=__builtin_amdgcn_mfma_f32_32x32x16_bf16(kf[5],qr[2],C1,0,0,0),   P1[6],P1[7],P1[8],P1[9],     pw2[2]=PKW(P1,4), pw2[3]=PKW(P1,6), pw2); \
    VRD(3); SBAR(); GAPA(C0=__builtin_amdgcn_mfma_f32_32x32x16_bf16(kf[6],qr[3],C0,0,0,0),   P1[10],P1[11],P1[12],P1[13], pw3[0]=PKW(P1,8), pw3[1]=PKW(P1,10), pw3); \
    VRD(7); SBAR(); GAPA(C1=__builtin_amdgcn_mfma_f32_32x32x16_bf16(kf[7],qr[3],C1,0,0,0),   P1[14],P1[15],0.f,0.f,       pw3[2]=PKW(P1,12),pw3[3]=PKW(P1,14), pw3); \
    l_reg+=sacc; \
    if(GK){DMA_K((t)+3,sl_cur);} if(GV){DMA_V((t)+1,sl_next);} \
    CMASK(C0,C1,t); \
    { float a=MX3(C0[0],C0[1],C1[0]),b=MX3(C0[2],C0[3],C1[1]); a=MX3(a,C1[2],C1[3]); \
      _Pragma("unroll") for(int r=4;r<16;r+=4){a=MX3(a,C0[r],C0[r+1]);b=MX3(b,C0[r+2],C0[r+3]);a=MX3(a,C1[r],C1[r+1]);b=MX3(b,C1[r+2],C1[r+3]);} \
      float rm=__builtin_fmaxf(a,b); { auto rr=__builtin_amdgcn_permlane32_swap(__float_as_uint(rm),__float_as_uint(rm),false,false); rm=__builtin_fmaxf(__uint_as_float(rr[0]),__uint_as_float(rr[1])); } \
      resc=false; \
      if(__builtin_expect(__any(rm>(float)THRL),0)){ const float dl=__builtin_fmaxf(rm,0.f); mhat+=dl; \
        _Pragma("unroll") for(int r=0;r<16;++r){C0[r]-=dl;C1[r]-=dl;} \
        const float f=__builtin_amdgcn_exp2f(-dl); l_reg*=f; if(hi==0)wsf[r32]=f; resc=true; } } \
    SBAR(); \
    GAPB(o[0]=__builtin_amdgcn_mfma_f32_32x32x16_bf16(PAF(0),VFR(0),o[0],0,0,0), C0,0); \
    GAPB(o[1]=__builtin_amdgcn_mfma_f32_32x32x16_bf16(PAF(0),VFR(4),o[1],0,0,0), C0,4); \
    KRD(GL,0); GAPB(o[0]=__builtin_amdgcn_mfma_f32_32x32x16_bf16(PAF(1),VFR(1),o[0],0,0,0), C0,8); \
    KRD(GL,1); GAPB(o[1]=__builtin_amdgcn_mfma_f32_32x32x16_bf16(PAF(1),VFR(5),o[1],0,0,0), C0,12); \
    KRD(GL,2); GAPB(o[0]=__builtin_amdgcn_mfma_f32_32x32x16_bf16(PAF(2),VFR(2),o[0],0,0,0), C1,0); \
    KRD(GL,3); GAPB(o[1]=__builtin_amdgcn_mfma_f32_32x32x16_bf16(PAF(2),VFR(6),o[1],0,0,0), C1,4); \
    GAPB(o[0]=__builtin_amdgcn_mfma_f32_32x32x16_bf16(PAF(3),VFR(3),o[0],0,0,0), C1,8); \
    GAPB(o[1]=__builtin_amdgcn_mfma_f32_32x32x16_bf16(PAF(3),VFR(7),o[1],0,0,0), C1,12); \
    }while(0)
  int t=1;
  #undef CMASK
  #define CMASK(P0,P1,t) do{ const float sb_=((selm>>((t)>>2))&1u)?mhat:INFINITY; {const float nsb_=-sb_;P0=P0+nsb_;P1=P1+nsb_;} }while(0)
  for(;t+5<NT;t+=2){
    STEP(pB0,pB1,pA0,pA1,t,true,true,true);     WAIT_BAR(2); RESC(); ROT();
    STEP(pA0,pA1,pB0,pB1,t+1,true,true,true);   WAIT_BAR(2); RESC(); ROT();
  }
  #undef CMASK
  #define CMASK(P0,P1,t) do{int jb_=(t)-(NT-4); const float sb_=(jb_>=0||((selm>>((t)>>2))&1u))?mhat:INFINITY; {const float nsb_=-sb_;P0=P0+nsb_;P1=P1+nsb_;} if(jb_>=0)cmask(P0,P1,jb_,qrel,hi);}while(0)
  #define ENDW(tt) do{ if((tt)+3<NT){WAIT_BAR(2);} else if((tt)+2<NT){WAIT_BAR(1);} else {WAIT_BAR(0);} }while(0)
  for(;t+1<NT;t+=2){
    STEP(pB0,pB1,pA0,pA1,t,(t+3<NT),(t+1<NT),(t+1<NT));       ENDW(t);   RESC(); ROT();
    STEP(pA0,pA1,pB0,pB1,t+1,(t+4<NT),(t+2<NT),(t+2<NT));     ENDW(t+1); RESC(); ROT();
  }
  STEP(pB0,pB1,pA0,pA1,NT-1,false,false,false); RESC();
  { float sacc=pB0[0]+pB0[1]; _Pragma("unroll") for(int r=2;r<16;++r)sacc+=pB0[r]; _Pragma("unroll") for(int r=0;r<16;++r)sacc+=pB1[r]; l_reg+=sacc;
    pw0=(u32x4){PKW(pB0,0),PKW(pB0,2),PKW(pB0,4),PKW(pB0,6)};pw1=(u32x4){PKW(pB0,8),PKW(pB0,10),PKW(pB0,12),PKW(pB0,14)};pw2=(u32x4){PKW(pB1,0),PKW(pB1,2),PKW(pB1,4),PKW(pB1,6)};pw3=(u32x4){PKW(pB1,8),PKW(pB1,10),PKW(pB1,12),PKW(pB1,14)};
    SBAR(); pv(o,vb0+sl_cur,PAF(0),PAF(1),PAF(2),PAF(3)); }
  #undef PKW
  #undef PAF
  #undef VFR
  #undef PIN
  #undef MX3
  #undef GAPA
  #undef GAPB
  #undef EX
  #undef VRD
  #undef KRD
  #undef STEP
  #undef ENDW
  {auto rr=__builtin_amdgcn_permlane32_swap(__float_as_uint(l_reg),__float_as_uint(l_reg),false,false);l_reg=__uint_as_float(rr[0])+__uint_as_float(rr[1]);}
  if(hi==0)wsf[32+r32]=l_reg;asm volatile("s_waitcnt lgkmcnt(0)":::"memory");
  float rli[16];
  #pragma unroll
  for(int r=0;r<16;++r)rli[r]=__builtin_amdgcn_rcpf(wsf[32+crow(r,hi)]);
  bf16*Ow=O+(rowbase+q0+wid*QBLK)*POUT+h*D;
  { bf16*stg=(bf16*)(shm+LDS_OST)+wid*2048;
    #pragma unroll
    for(int r=0;r<16;++r){const int orow=crow(r,hi);
      #pragma unroll
      for(int d0=0;d0<2;++d0)stg[orow*64+d0*32+r32]=__float2bfloat16(o[d0][r]*rli[r]);}
    asm volatile("s_waitcnt lgkmcnt(0)":::"memory");
    #pragma unroll
    for(int i=0;i<4;++i){const int row=i*8+(lane>>3),ch=lane&7; const u32x4 v=*(const u32x4*)(stg+row*64+ch*8); ATTN_STORE16(Ow+(long)row*POUT+ch*8,v);} }
  asm volatile("s_waitcnt lgkmcnt(0)\n\ts_barrier":::"memory");
  #undef DMA_K
  #undef DMA_V
  #undef CMASK
  #undef START
  #undef RESC
  #undef ROT
}
constexpr int ATTN_LDS_BYTES=LDS_BYTES;
struct AttnTensors { const bf16* Q; const bf16* K; const bf16* V; const bf16* KM; bf16* O; };
struct AttnUnit { int bh; int qb; };
struct StaticOrder {
  int vcu,G,blk;
  __device__ __forceinline__ explicit StaticOrder(int grid,int block):vcu((grid%8==0)?(block%8)*(grid/8)+block/8:block),G(grid),blk(block){}
  __device__ __forceinline__ bool next(int i,AttnUnit&u)const{
    if(G==256){ if(i>=4)return false; const int s=vcu&3; u.bh=vcu>>2; u.qb=(i==0)?s:(i==1)?7-s:(i==2)?8+s:15-s; return true; }
    const int idx=i*G+blk; if(idx>=BATCH*NHEAD*NQB)return false; u.bh=idx/NQB; u.qb=idx%NQB; return true; }
  __device__ __forceinline__ void a_ready(const AttnUnit&)const{}
  __device__ __forceinline__ void done(const AttnUnit&)const{}
};
template<class Sched,int THRL=8> __device__ __forceinline__ void attn_phase(char*lds,const AttnTensors&T,const Sched&S,int wave_){
  AttnUnit u;
  for(int i=0;S.next(i,u);++i){ S.a_ready(u); attn_unit<THRL>(wave_,u.bh/NHEAD,u.bh%NHEAD,u.qb,T.Q,T.K,T.V,T.KM,T.O,lds); S.done(u); }
}
#undef SBAR
#undef WAIT_BAR
}

template <bool DRY = false> __device__ __forceinline__ void p6_route(const Frame& F0, const Args& a) {
    const Frame F = fresh(F0);
    const bf16_t* x1 = (const bf16_t*)(a.ws + WS_X1); bf16_t* xn = (bf16_t*)(a.ws + WS_XN); const float* rw = a.in[I_RW]; const float* rb = a.in[I_RB]; const float* n2 = a.in[I_N2];
    unsigned* cnt = (unsigned*)(a.ws + WS_CTL) + CW_CNT; int* rows = (int*)(a.ws + WS_ROWS); float* roww = (float*)(a.ws + WS_ROWW);
    constexpr int HP2 = 1040;
    LAS float* H2 = (LAS float*)F.lds;
    LAS float* PL = (LAS float*)(F.lds + 16 * HP2 * 4);
    LAS int* lcnt = (LAS int*)(F.lds + MISC_OFF); LAS int* lbase = lcnt + 32; LAS int* ae = lbase + 32; LAS int* ap = ae + 512; LAS float* aw = (LAS float*)(ap + 512); LAS float* hsrow = aw + 512;
    float* rowhs = (float*)(a.ws + WS_ROWHS);
    const int lane = F.lane, e = lane & 31, w = F.wave, l15 = lane & 15, kq = lane >> 4;
    float rwq[8][4][2];
#pragma unroll
    for (int g = 0; g < 8; ++g)
#pragma unroll
        for (int s = 0; s < 4; ++s)
#pragma unroll
            for (int h = 0; h < 2; ++h) rwq[g][s][h] = rw[(size_t)(128 * w + 16 * g + 4 * kq + s) * NE + 16 * h + l15];
    const float bias = rb[e];
    for (int blk = F.bid; blk < NTOK / 128; blk += F.G) {
        if (F.tid < 32) lcnt[F.tid] = 0;
        u32x2 xq[2][4];
#pragma unroll
        for (int rr = 0; rr < 2; ++rr) { const u32x2* xr = (const u32x2*)(x1 + ((size_t)blk * 128 + 2 * w + rr) * DM) + lane;
#pragma unroll
            for (int j = 0; j < 4; ++j) xq[rr][j] = __builtin_nontemporal_load(xr + 64 * j); }
#pragma unroll 1
        for (int sub = 0; sub < 8; ++sub) {
#pragma unroll
            for (int rr = 0; rr < 2; ++rr) {
                const int rl = 2 * w + rr; const size_t row = (size_t)blk * 128 + sub * 16 + rl;
                const f32x4* wr = (const f32x4*)n2 + lane;
                f32x4 v[4]; float s = 0.f;
#pragma unroll
                for (int j = 0; j < 4; ++j) { const u32x2 xw = xq[rr][j]; v[j] = (f32x4){bf_lo(xw.x), bf_hi(xw.x), bf_lo(xw.y), bf_hi(xw.y)}; s += (v[j].x * v[j].x + v[j].y * v[j].y) + (v[j].z * v[j].z + v[j].w * v[j].w); }
                const float rstd = __builtin_amdgcn_rsqf(wave_sum(s) * (1.0f / DM) + RMS_EPS);
                u32x2* o8 = (u32x2*)(xn + row * DM) + lane; unsigned* o4 = (unsigned*)((unsigned char*)xn + row * DM) + lane;
#pragma unroll
                for (int j = 0; j < 4; ++j) { const f32x4 ww = wr[64 * j]; const f32x4 hv = v[j] * rstd * ww;
                    if constexpr (MOE1_I8) v[j] = hv;
                    else if constexpr (MOE_FP8) o4[64 * j] = pk4_fp8(hv.x, hv.y, hv.z, hv.w, S_H2);
                    else { u32x2 o; o.x = pk2(hv.x, hv.y); o.y = pk2(hv.z, hv.w); o8[64 * j] = o; }
                    *(LAS f32x4*)(H2 + rl * HP2 + 256 * j + 4 * lane) = hv; }
                if constexpr (MOE1_I8) {
                    float am = 0.f;
#pragma unroll
                    for (int j = 0; j < 4; ++j) am = fmaxf(fmaxf(am, fmaxf(fabsf(v[j].x), fabsf(v[j].y))), fmaxf(fabsf(v[j].z), fabsf(v[j].w)));
                    am = wave_max(am); const float inv = am > 0.f ? 127.0f / am : 0.f;
#pragma unroll
                    for (int j = 0; j < 4; ++j) o4[64 * j] = pk4_i8(v[j].x * inv, v[j].y * inv, v[j].z * inv, v[j].w * inv);
                    if (lane == 0) hsrow[sub * 16 + rl] = am * (1.0f / 127.0f); }
            }
            if (sub < 7) {
#pragma unroll
                for (int rr = 0; rr < 2; ++rr) { const u32x2* xr = (const u32x2*)(x1 + ((size_t)blk * 128 + (sub + 1) * 16 + 2 * w + rr) * DM) + lane;
#pragma unroll
                    for (int j = 0; j < 4; ++j) xq[rr][j] = __builtin_nontemporal_load(xr + 64 * j); }
            }
            lds_barrier();
            {
                f32x4 acc0 = {0.f, 0.f, 0.f, 0.f}, acc1 = {0.f, 0.f, 0.f, 0.f};
#pragma unroll
                for (int g = 0; g < 8; ++g) {
                    const f32x4 hq = *(const LAS f32x4*)(H2 + l15 * HP2 + 128 * w + 16 * g + 4 * kq);
#pragma unroll
                    for (int s = 0; s < 4; ++s) { acc0 = __builtin_amdgcn_mfma_f32_16x16x4f32(hq[s], rwq[g][s][0], acc0, 0, 0, 0); acc1 = __builtin_amdgcn_mfma_f32_16x16x4f32(hq[s], rwq[g][s][1], acc1, 0, 0, 0); }
                }
#pragma unroll
                for (int r = 0; r < 4; ++r) { PL[(w * 16 + 4 * kq + r) * 32 + l15] = acc0[r]; PL[(w * 16 + 4 * kq + r) * 32 + 16 + l15] = acc1[r]; }
            }
            lds_barrier();
            {
                const int rl = 2 * w + (lane >> 5); float val = bias;
#pragma unroll
                for (int ww = 0; ww < 8; ++ww) val += PL[(ww * 16 + rl) * 32 + e];
                unsigned key; { unsigned u = __builtin_bit_cast(unsigned, val); u ^= (unsigned)((int)u >> 31) | 0x80000000u; key = (u & ~31u) | (unsigned)(31 - e); }
                float tv[4]; int te[4];
#pragma unroll
                for (int k = 0; k < 4; ++k) {
                    unsigned m = key, o;
                    o = (unsigned)__builtin_amdgcn_update_dpp(0, (int)m, 0xB1, 0xF, 0xF, false);  m = m > o ? m : o;
                    o = (unsigned)__builtin_amdgcn_update_dpp(0, (int)m, 0x4E, 0xF, 0xF, false);  m = m > o ? m : o;
                    o = (unsigned)__builtin_amdgcn_update_dpp(0, (int)m, 0x141, 0xF, 0xF, false); m = m > o ? m : o;
                    o = (unsigned)__builtin_amdgcn_update_dpp(0, (int)m, 0x140, 0xF, 0xF, false); m = m > o ? m : o;
                    o = (unsigned)__shfl_xor((int)m, 16); m = m > o ? m : o;
                    te[k] = 31 - (int)(m & 31u); { const unsigned vb = m & ~31u; tv[k] = __builtin_bit_cast(float, (vb & 0x80000000u) ? (vb ^ 0x80000000u) : ~vb); }
                    if (e == te[k]) key = 0u;
                }
                if (e == 0) {
                    const float p1 = __expf(tv[1] - tv[0]), p2 = __expf(tv[2] - tv[0]), p3 = __expf(tv[3] - tv[0]); const float inv = 1.0f / (1.0f + p1 + p2 + p3);
                    const float w4[4] = {inv, p1 * inv, p2 * inv, p3 * inv};
                    const int rb_ = sub * 16 + rl;
#pragma unroll
                    for (int k = 0; k < 4; ++k) { const int pos = atomicAdd((int*)&lcnt[te[k]], 1); ae[rb_ * 4 + k] = te[k]; ap[rb_ * 4 + k] = pos; aw[rb_ * 4 + k] = w4[k]; }
                }
            }
        }
        lds_barrier();
        if (!DRY) { if (F.tid < 32) lbase[F.tid] = (int)__hip_atomic_fetch_add(cnt + F.tid, (unsigned)lcnt[F.tid], __ATOMIC_RELAXED, __HIP_MEMORY_SCOPE_AGENT); }
        lds_barrier();
        if (!DRY) { const int ee = ae[F.tid]; const size_t p = (size_t)ee * CAP + lbase[ee] + ap[F.tid]; rows[p] = blk * 512 + F.tid; roww[p] = aw[F.tid]; if constexpr (MOE1_I8) rowhs[p] = hsrow[F.tid >> 2]; }
        lds_barrier();
    }
}
__device__ __forceinline__ int moe_tiles(const Frame& F, const Args& a, LAS int* ts) {
    if (F.tid == 0) { const unsigned* cnt = (const unsigned*)(a.ws + WS_CTL) + CW_CNT; int acc = 0;
        for (int e = 0; e < NE; ++e) { const int c = (int)__hip_atomic_load(cnt + e, __ATOMIC_RELAXED, __HIP_MEMORY_SCOPE_AGENT); ts[e] = acc; ts[33 + e] = c; acc += (c + 255) >> 8; }
        ts[32] = acc; }
    __syncthreads();
    return ts[32];
}
__device__ __forceinline__ void p9_final(const Frame& F0, const Args& a) {
    const Frame F = fresh(F0);
    float* out = a.out; const bf16_t* yg = (const bf16_t*)(a.ws + WS_YG); const float* fw = a.in[I_FNW]; const bf16_t* x1 = (const bf16_t*)(a.ws + WS_X1);
    const int gw = F.bid * 8 + F.wave, NGW = F.G * 8;
    for (int row = gw; row < NTOK; row += NGW) {
        f32x4* xr = (f32x4*)(out + (size_t)row * DM) + F.lane;
        f32x4 v[4]; const u32x2* x1r = (const u32x2*)(x1 + (size_t)row * DM) + F.lane;
#pragma unroll
        for (int j = 0; j < 4; ++j) { const u32x2 xw = __builtin_nontemporal_load(x1r + 64 * j); v[j] = (f32x4){bf_lo(xw.x), bf_hi(xw.x), bf_lo(xw.y), bf_hi(xw.y)}; }
#pragma unroll
        for (int k = 0; k < 4; ++k) {
            if constexpr (MOE_FP8) { const unsigned* yp = (const unsigned*)((const unsigned char*)yg + ((size_t)row * 4 + k) * DM) + F.lane;
#pragma unroll
                for (int j = 0; j < 4; ++j) { const unsigned w = __builtin_nontemporal_load(yp + 64 * j); const f32x2 lo = __builtin_amdgcn_cvt_pk_f32_fp8(w, false), hi = __builtin_amdgcn_cvt_pk_f32_fp8(w, true);
                    v[j].x += lo.x * (1.0f / S_YG); v[j].y += lo.y * (1.0f / S_YG); v[j].z += hi.x * (1.0f / S_YG); v[j].w += hi.y * (1.0f / S_YG); } }
            else { const u32x2* yp = (const u32x2*)(yg + ((size_t)row * 4 + k) * DM) + F.lane;
#pragma unroll
                for (int j = 0; j < 4; ++j) { const u32x2 w = yp[64 * j]; v[j].x += bf_lo(w.x); v[j].y += bf_hi(w.x); v[j].z += bf_lo(w.y); v[j].w += bf_hi(w.y); } } }
        float s = 0.f;
#pragma unroll
        for (int j = 0; j < 4; ++j) s += (v[j].x * v[j].x + v[j].y * v[j].y) + (v[j].z * v[j].z + v[j].w * v[j].w);
        const float rstd = 1.0f / sqrtf(wave_sum(s) * (1.0f / DM) + RMS_EPS);
        const f32x4* wr = (const f32x4*)fw + F.lane;
#if TIM_PHASE
        { const unsigned* tm = (const unsigned*)(a.ws + WS_CTL) + 208; const unsigned den = (TIM_SEL == 4 ? 1u : (tm[3] ? tm[3] : 1u)) * (unsigned)(TIM_UNIT); unsigned q = tm[TIM_SEL] / den; q = q > 24u ? 24u : q; const float sc_ = 1.0f + (float)q;
#pragma unroll
          for (int j = 0; j < 4; ++j) v[j] = v[j] * sc_; }
#endif
#pragma unroll
        for (int j = 0; j < 4; ++j) xr[64 * j] = v[j] * rstd * wr[64 * j];
    }
}

#define XB_TMO      128
#define XB_XCNT(j)  (256  + 64 * (j))
#define XB_XSUB(j)  (1280 + 64 * (j))
#define XB_XGEN(j)  (2304 + 64 * (j))
#define XB_TOP      3328
#define XB_TOPGEN   3392
#define XCD_BAR_WORDS 3456
#define XB_SPIN_CAP (1u << 18)

__device__ __forceinline__ unsigned xb_ld(unsigned* p)              { return __hip_atomic_load(p, __ATOMIC_RELAXED, __HIP_MEMORY_SCOPE_AGENT); }
__device__ __forceinline__ unsigned xb_add(unsigned* p, unsigned v) { return __hip_atomic_fetch_add(p, v, __ATOMIC_RELAXED, __HIP_MEMORY_SCOPE_AGENT); }
__device__ __forceinline__ unsigned xb_xcc_id() { return (unsigned)__builtin_amdgcn_s_getreg((3 << 11) | 20) & 0xFu; }
#define XB_SPIN(cond, bar) do { unsigned _sp = 0; while (cond) { __builtin_amdgcn_s_sleep(1); \
    if ((++_sp & 255u) == 0u) { if (xb_ld(&(bar)[XB_TMO])) break; if (_sp > XB_SPIN_CAP) { atomicAdd(&(bar)[XB_TMO], 1u); break; } } } } while (0)

struct XcdBarrier {
    unsigned* bar; unsigned x; int w;
    volatile LAS unsigned* st;
};

__device__ __forceinline__ XcdBarrier xcd_barrier_post(unsigned* bar, volatile LAS unsigned* st) {
    XcdBarrier b; b.bar = bar; b.x = xb_xcc_id(); b.st = st;
    if (threadIdx.x == 0) (void)xb_add(&bar[XB_XCNT(b.x)], 1u);
    return b;
}
__device__ __forceinline__ void xcd_barrier_complete(unsigned* bar, unsigned x, unsigned& nloc, unsigned& nx) {
    const unsigned G = gridDim.x * gridDim.y * gridDim.z;
    unsigned sum, cnt, mine, sp = 0u;
    for (;;) {
        sum = 0u; cnt = 0u; mine = 0u;
#pragma unroll
        for (unsigned j = 0; j < 16; ++j) { const unsigned c = xb_ld(&bar[XB_XCNT(j)]); sum += c; cnt += (c > 0u) ? 1u : 0u; mine = (j == x) ? c : mine; }
        if (sum == G) break;
        __builtin_amdgcn_s_sleep(1);
        if ((++sp & 255u) == 0u) { if (xb_ld(&bar[XB_TMO])) break; if (sp > XB_SPIN_CAP) { atomicAdd(&bar[XB_TMO], 1u); break; } }
    }
    nloc = mine > 0u ? mine : 1u; nx = cnt > 0u ? cnt : 1u;
}

__device__ __forceinline__ void xcd_barrier(const XcdBarrier& b) {
    asm volatile("s_waitcnt vmcnt(0)" ::: "memory");
    __syncthreads();
    if (b.w == 0 && lane_id_() == 0) {
        unsigned* bar = b.bar;
        __builtin_amdgcn_s_waitcnt(0);
        unsigned nloc = b.st[0], nx = b.st[1];
        if (nloc == 0u) { xcd_barrier_complete(bar, b.x, nloc, nx); b.st[0] = nloc; b.st[1] = nx; }
        const unsigned old = xb_add(&bar[XB_XSUB(b.x)], 1u);
        const unsigned gen = old / nloc;
        if (old + 1u == (gen + 1u) * nloc) {
            __builtin_amdgcn_fence(__ATOMIC_RELEASE, "agent");
            asm volatile("s_waitcnt vmcnt(0)" ::: "memory");
            const unsigned og = xb_add(&bar[XB_TOP], 1u);
            const unsigned tg = og / nx;
            if (og + 1u == (tg + 1u) * nx) xb_add(&bar[XB_TOPGEN], 1u);
            else XB_SPIN(xb_ld(&bar[XB_TOPGEN]) == tg, bar);
            __builtin_amdgcn_fence(__ATOMIC_ACQUIRE, "agent");
            xb_add(&bar[XB_XGEN(b.x)], 1u);
            asm volatile("s_waitcnt vmcnt(0)" ::: "memory");
        } else {
            XB_SPIN(xb_ld(&bar[XB_XGEN(b.x)]) == gen, bar);
            __builtin_amdgcn_fence(__ATOMIC_ACQUIRE, "agent");
            asm volatile("s_waitcnt vmcnt(0)" ::: "memory");
        }
    }
    __syncthreads();
}


__global__ void __launch_bounds__(512, 2) fwd_kernel(Args args) {
    extern __shared__ __attribute__((aligned(16))) unsigned char lds_raw[];
    Frame F; F.lds = (LAS unsigned char*)lds_raw; F.tid = threadIdx.x; F.lane = F.tid & 63; F.wave = __builtin_amdgcn_readfirstlane(F.tid >> 6); F.G = gridDim.x; F.bid = blockIdx.x;
#if USE_COOP
    cg::grid_group grid = cg::this_grid();
#endif
    volatile LAS unsigned* MISCW = (volatile LAS unsigned*)(F.lds + LDS_BYTES - 256);
    if (F.tid < 64) MISCW[F.tid] = 0u;
    __syncthreads();
    XcdBarrier xbar = xcd_barrier_post((unsigned*)(args.ws + WS_CTL) + CW_BAR, MISCW + 8); xbar.w = F.wave;
    unsigned char* ws = args.ws;
    const int lo = args.ph_lo, hi = args.ph_hi;
#ifndef REPMASK
#define REPMASK 0
#endif
#define NREP(k) (((REPMASK) >> (k)) & 1 ? 2 : 1)
#define IN(k) (lo <= (k) && (k) < hi)
#if USE_COOP
#define SEAM(k) do { if (IN(k) && IN((k) + 1)) xcd_barrier(xbar); } while (0)
#else
#define SEAM(k) do { if (IN(k) && IN((k) + 1)) xcd_barrier(xbar); } while (0)
#endif
    bf16_t* proj = (bf16_t*)(ws + WS_PROJ);

#if USE_COOP
    if (lo < 0) grid.sync();
#endif
    if (IN(0)) for (int rep_ = 0; rep_ < NREP(0); ++rep_) { p0_prologue(F, args); } SEAM(0);
    if (IN(1)) for (int rep_ = 0; rep_ < NREP(1); ++rep_) {
        pg8::Gemm g{(const bf16_t*)(ws + WS_XN), (const bf16_t*)(ws + WS_WIN), DIN, DM, nullptr, (const float*)(ws + WS_XS), (const float*)(ws + WS_WINS), TIM_PHASE == 1 ? (unsigned*)(ws + WS_CTL) + 208 : nullptr};
        pg8::DenseSched<DIN / 256> S; S.o.init(NTOK / 256, DIN / 256, F.G, F.bid);
        EpiProj E{proj, (float*)(ws + WS_LOGF), (const float*)(ws + WS_ROPE), (const float*)(ws + WS_LB)};
        pg8::gemm_phase<EpiProj, pg8::DenseSched<DIN / 256>, false, false, false, false, P1_I8>(F.lds, g, S, E, F.wave);
    } SEAM(1);
    if (IN(2)) for (int rep_ = 0; rep_ < NREP(2); ++rep_) { p2_kmean(F, args); h1_local_states_p(F, args); } SEAM(2);
    if (IN(3)) {
        h2_scan(F, args);
        const attn_body::AttnTensors AT{(const attn_body::bf16*)(proj + C_QA), (const attn_body::bf16*)(proj + C_KA), (const attn_body::bf16*)(proj + C_VA), (const attn_body::bf16*)(ws + WS_KMEAN), (attn_body::bf16*)(ws + WS_YA)};
        const attn_body::StaticOrder AS((int)F.G, (int)F.bid);
        for (int rep_ = 0; rep_ < NREP(3); ++rep_) attn_body::attn_phase<attn_body::StaticOrder>((char*)lds_raw, AT, AS, F.wave);
    } SEAM(3);
    if (IN(4)) for (int rep_ = 0; rep_ < NREP(4); ++rep_) { h3_outputs_p(F, args); } SEAM(4);
    if (IN(5)) for (int rep_ = 0; rep_ < NREP(5); ++rep_) {
        pg8::DenseSched<DM / 256> S; S.o.init(NTOK / 256, DM / 256, F.G, F.bid);
        pg8::Gemm g{(const bf16_t*)(ws + WS_YA), (const bf16_t*)(ws + WS_MUP), DM, DM, nullptr};
        EpiMixF E{(bf16_t*)(ws + WS_MIXED), proj};
        pg8::gemm_phase<EpiMixF, pg8::DenseSched<DM / 256>, false, false, false, true>(F.lds, g, S, E, F.wave);
    } SEAM(5);
    if (IN(6)) for (int rep_ = 0; rep_ < NREP(6); ++rep_) {
        pg8::Gemm g{(const bf16_t*)(ws + WS_MIXED), (const bf16_t*)(ws + WS_WOUT), DM, DM, nullptr};
        pg8::DenseSched<DM / 256> S; S.o.init(NTOK / 256, DM / 256, F.G, F.bid);
        EpiOut E{args.in[I_X], (bf16_t*)(ws + WS_X1)};
        pg8::gemm_phase<EpiOut, pg8::DenseSched<DM / 256>, false>(F.lds, g, S, E, F.wave);
    } SEAM(6);
    if (IN(7)) { if (NREP(7) > 1) p6_route<true>(F, args); p6_route<false>(F, args); } SEAM(7);
    if (IN(8)) for (int rep_ = 0; rep_ < NREP(8); ++rep_) {
        LAS int* ts = (LAS int*)(F.lds + MISC_OFF + 8192);
        const int ntile = moe_tiles(F, args, ts);
        pg8::Gemm g{(const bf16_t*)(ws + WS_XN), (const bf16_t*)(ws + WS_WGU), 2 * DE, DM, (const int*)(ws + WS_ROWS), (const float*)(ws + WS_ROWHS), (const float*)(ws + WS_WGS), TIM_PHASE == 8 ? (unsigned*)(ws + WS_CTL) + 208 : nullptr};
        pg8::MoeSched<2 * DE / 256> S; S.o.init(ntile, 2 * DE / 256, F.G, F.bid); S.ts = ts;
        EpiMoe1 E{(bf16_t*)(ws + WS_HID), args.in[I_BGU]};
        pg8::gemm_phase<EpiMoe1, pg8::MoeSched<2 * DE / 256>, true, MOE_FP8 && !MOE1_I8, false, false, MOE1_I8>(F.lds, g, S, E, F.wave);
    } SEAM(8);
    if (IN(9)) for (int rep_ = 0; rep_ < NREP(9); ++rep_) {
        LAS int* ts = (LAS int*)(F.lds + MISC_OFF + 8192);
        const int ntile = moe_tiles(F, args, ts);
        pg8::Gemm g{(const bf16_t*)(ws + WS_HID), (const bf16_t*)(ws + WS_WD), DM, DE, nullptr, nullptr, nullptr, TIM_PHASE == 9 ? (unsigned*)(ws + WS_CTL) + 208 : nullptr};
        pg8::MoeSched<DM / 256> S; S.o.init(ntile, DM / 256, F.G, F.bid); S.ts = ts;
        EpiMoe2 E{(bf16_t*)(ws + WS_YG), args.in[I_BD], (const int*)(ws + WS_ROWS), (const float*)(ws + WS_ROWW)};
        pg8::gemm_phase<EpiMoe2, pg8::MoeSched<DM / 256>, false, MOE_FP8, false, false, false, MOE_FP8>(F.lds, g, S, E, F.wave);
    } SEAM(9);
    if (IN(10)) for (int rep_ = 0; rep_ < NREP(10); ++rep_) { p9_final(F, args); }
#undef IN
#undef SEAM
}

#ifndef N_LAUNCHES
#define N_LAUNCHES 1
#endif
extern "C" void kernel_launch(void* const* d_in, const int* in_sizes, int n_in, void* d_out, int out_size, void* d_ws, size_t ws_size, hipStream_t stream) {
    static int grid = 0;
    if (grid == 0) {
        if (n_in != 16 || in_sizes[0] != NTOK * DM || out_size != NTOK * DM || ws_size < WS_END) { fprintf(stderr, "kernel_launch: unexpected shapes (n_in %d, in0 %d, out %d, ws %zu)\n", n_in, n_in > 0 ? in_sizes[0] : -1, out_size, ws_size); grid = -1; return; }
        int dev = 0, cus = 0, per_cu = 0;
        (void)hipGetDevice(&dev); (void)hipDeviceGetAttribute(&cus, hipDeviceAttributeMultiprocessorCount, dev);
        if (hipFuncSetAttribute((const void*)fwd_kernel, hipFuncAttributeMaxDynamicSharedMemorySize, LDS_BYTES) != hipSuccess) { fprintf(stderr, "kernel_launch: hipFuncSetAttribute failed\n"); grid = -1; return; }
        if (hipOccupancyMaxActiveBlocksPerMultiprocessor(&per_cu, (const void*)fwd_kernel, 512, LDS_BYTES) != hipSuccess || per_cu < 1) { fprintf(stderr, "kernel_launch: occupancy query says %d\n", per_cu); per_cu = 1; }
        (void)hipGetLastError();
        grid = cus;
    }
    if (grid < 0) return;
    (void)hipMemsetAsync((char*)d_ws + WS_CTL, 0, CTL_BYTES, stream);
    Args a{};
    for (int i = 0; i < 16; ++i) a.in[i] = (const float*)d_in[i];
    a.out = (float*)d_out; a.ws = (unsigned char*)d_ws;
    if (N_LAUNCHES == 1) {
        a.ph_lo = 0; a.ph_hi = NPHASE; void* params[] = {&a};
#if USE_COOP
        hipError_t e = hipLaunchCooperativeKernel((const void*)fwd_kernel, dim3(grid), dim3(512), params, LDS_BYTES, stream);
        if (e != hipSuccess) fprintf(stderr, "cooperative launch failed: %s (grid %d)\n", hipGetErrorString(e), grid);
#else
        (void)params; hipLaunchKernelGGL(fwd_kernel, dim3(grid), dim3(512), LDS_BYTES, stream, a);
#endif
    } else {
        for (int p = 0; p < NPHASE; ++p) { a.ph_lo = p; a.ph_hi = p + 1; hipLaunchKernelGGL(fwd_kernel, dim3(grid), dim3(512), LDS_BYTES, stream, a); }
    }
}
```

```cpp
#include <hip/hip_runtime.h>
#include <hip/hip_cooperative_groups.h>
#include <cstdio>
#include <cstdint>
namespace cg = cooperative_groups;
#ifndef USE_COOP
#define USE_COOP 1
#endif

#define LAS __attribute__((address_space(3)))
#define GAS __attribute__((address_space(1)))
typedef unsigned short bf16_t;
typedef short bf16x8 __attribute__((ext_vector_type(8)));
typedef float f32x4 __attribute__((ext_vector_type(4)));
typedef float f32x2 __attribute__((ext_vector_type(2)));
typedef unsigned u32x4 __attribute__((ext_vector_type(4)));
typedef unsigned u32x2 __attribute__((ext_vector_type(2)));

constexpr int NTOK = 32768, DM = 1024, SEQ = 4096, NBATCH = 8;
constexpr int DIN = 5632;
constexpr int AH = 8, AD = 64;
constexpr int HH = 4, HK = 128;
constexpr int NE = 32, DE = 1024, CAP = 32768;
constexpr float RMS_EPS = 1e-6f;
constexpr float QSCALE = 0.125f * 1.4426950408889634f;
constexpr int C_QA = 0, C_KA = 512, C_VA = 1024, C_QB = 1536, C_FB = 2048, C_IB = 2560, C_GB = 3072, C_GA = 3584, C_GBT = 4608;

constexpr size_t MiB = 1u << 20;
constexpr size_t WS_CTL = 0, CTL_BYTES = 32768;
constexpr size_t WS_ROPE = 1 * MiB;
constexpr size_t WS_WIN = 2 * MiB;
constexpr size_t WS_MUP = 13 * MiB;
constexpr size_t WS_WOUT = 15 * MiB;
constexpr size_t WS_LB = 17 * MiB;
constexpr size_t WS_KMEAN = 17 * MiB + 65536;
constexpr size_t WS_SLOTW = 18 * MiB;
constexpr size_t WS_ROWS = 19 * MiB;
constexpr size_t WS_ROWW = 25 * MiB;
constexpr size_t WS_WGS = 18 * MiB;
constexpr size_t WS_XS = 18 * MiB + 512 * 1024;
constexpr size_t WS_WINS = 18 * MiB + 768 * 1024;
constexpr size_t WS_ROWHS = 672 * MiB;
constexpr size_t WS_GDEC = 24 * MiB;
constexpr size_t WS_WGU = 32 * MiB;
constexpr size_t WS_WD = 160 * MiB;
constexpr size_t WS_XN = 224 * MiB;
constexpr size_t WS_PROJ = 288 * MiB;
constexpr size_t WS_LOGF = 640 * MiB;
constexpr size_t WS_YA = 704 * MiB;
constexpr size_t WS_OB = 768 * MiB;
constexpr size_t WS_HST = 768 * MiB;
constexpr size_t WS_MIXED = 832 * MiB;
constexpr size_t WS_HID = 288 * MiB;
constexpr size_t WS_YG = 560 * MiB;
constexpr size_t WS_X1 = 896 * MiB;
constexpr size_t WS_END = 960 * MiB;
constexpr int CW_CNT = 64;
constexpr int CW_BAR = 4096;
static_assert((CW_BAR + 3456) * 4 <= (int)CTL_BYTES, "barrier words inside the zeroed control region");

constexpr int RING_BYTES = 131072;
constexpr int MISC_OFF = RING_BYTES;
constexpr int LDS_BYTES = 147456;

#ifndef MOE1_I8_
#define MOE1_I8_ 1
#endif
#ifndef MOE_FP8_
#define MOE_FP8_ 1
#endif
constexpr bool MOE1_I8 = (MOE1_I8_ != 0) && (MOE_FP8_ != 0);
#ifndef P1_I8_
#define P1_I8_ 1
#endif
constexpr bool P1_I8 = P1_I8_ != 0;
#ifndef DEFER_MOE_W_
#define DEFER_MOE_W_ 1
#endif
#ifndef TIM_PHASE
#define TIM_PHASE 0
#endif
#ifndef TIM_SEL
#define TIM_SEL 0
#endif
#ifndef TIM_UNIT
#define TIM_UNIT 1024
#endif
constexpr bool MOE_FP8 = MOE_FP8_ != 0;
constexpr float S_H2 = 16.0f, S_HID = 4.0f, S_W = 512.0f, S_YG = 32.0f;
constexpr float DQ1 = MOE_FP8 ? 1.0f / (S_H2 * S_W) : 1.0f, DQ2 = MOE_FP8 ? 1.0f / (S_HID * S_W) : 1.0f;
typedef int v8i __attribute__((ext_vector_type(8)));
typedef int v4i __attribute__((ext_vector_type(4)));
__device__ __forceinline__ unsigned pk4_i8(float a, float b, float c, float d) {
    const int ia = (int)__builtin_rintf(fminf(fmaxf(a, -127.f), 127.f)), ib = (int)__builtin_rintf(fminf(fmaxf(b, -127.f), 127.f)), ic = (int)__builtin_rintf(fminf(fmaxf(c, -127.f), 127.f)), id = (int)__builtin_rintf(fminf(fmaxf(d, -127.f), 127.f));
    return (unsigned)(ia & 255) | ((unsigned)(ib & 255) << 8) | ((unsigned)(ic & 255) << 16) | ((unsigned)id << 24); }
typedef _Float16 h16x4 __attribute__((ext_vector_type(4)));
typedef _Float16 h16x8 __attribute__((ext_vector_type(8)));
typedef float f32x8 __attribute__((ext_vector_type(8)));
__device__ __forceinline__ unsigned pk4_fp8_nc(float a, float b, float c, float d, float s) { unsigned w = 0u; w = __builtin_amdgcn_cvt_pk_fp8_f32(a * s, b * s, w, false); w = __builtin_amdgcn_cvt_pk_fp8_f32(c * s, d * s, w, true); return w; }
__device__ __forceinline__ unsigned pk4_u8(float a, float b, float c, float d) { unsigned w = 0u;
    w = __builtin_amdgcn_cvt_pk_u8_f32(fmaxf(a * 255.0f, 1.0f), 0, w); w = __builtin_amdgcn_cvt_pk_u8_f32(fmaxf(b * 255.0f, 1.0f), 1, w);
    w = __builtin_amdgcn_cvt_pk_u8_f32(fmaxf(c * 255.0f, 1.0f), 2, w); w = __builtin_amdgcn_cvt_pk_u8_f32(fmaxf(d * 255.0f, 1.0f), 3, w); return w; }
__device__ __forceinline__ f32x4 un4_u8(unsigned w) { return (f32x4){(float)(w & 0xffu), (float)((w >> 8) & 0xffu), (float)((w >> 16) & 0xffu), (float)(w >> 24)}; }
constexpr int GATE_BYTE0 = 2 * 3584;
__device__ __forceinline__ unsigned pk4_fp8(float a, float b, float c, float d, float s) {
    const float L = 440.0f;
    a = __builtin_amdgcn_fmed3f(a * s, -L, L); b = __builtin_amdgcn_fmed3f(b * s, -L, L); c = __builtin_amdgcn_fmed3f(c * s, -L, L); d = __builtin_amdgcn_fmed3f(d * s, -L, L);
    unsigned w = 0u; w = __builtin_amdgcn_cvt_pk_fp8_f32(a, b, w, false); w = __builtin_amdgcn_cvt_pk_fp8_f32(c, d, w, true); return w;
}
__device__ __forceinline__ unsigned f2bf(float f) { unsigned u = __builtin_bit_cast(unsigned, f); return (u + 0x7fffu + ((u >> 16) & 1u)) >> 16; }
typedef __bf16 bf16x2_t_ __attribute__((ext_vector_type(2)));
__device__ __forceinline__ unsigned pk2(float lo, float hi) { f32x2 v = {lo, hi}; bf16x2_t_ b = __builtin_convertvector(v, bf16x2_t_); return __builtin_bit_cast(unsigned, b); }
__device__ __forceinline__ float bf_lo(unsigned u) { return __builtin_bit_cast(float, u << 16); }
__device__ __forceinline__ float bf_hi(unsigned u) { return __builtin_bit_cast(float, u & 0xffff0000u); }
__device__ __forceinline__ float bf2f(bf16_t h) { return __builtin_bit_cast(float, (unsigned)h << 16); }
template <int CTRL> __device__ __forceinline__ float dppf_(float v) { return __builtin_bit_cast(float, __builtin_amdgcn_update_dpp(0, __builtin_bit_cast(int, v), CTRL, 0xF, 0xF, false)); }
__device__ __forceinline__ float rdlane_(float v, int l) { return __builtin_bit_cast(float, __builtin_amdgcn_readlane(__builtin_bit_cast(int, v), l)); }
__device__ __forceinline__ float wave_sum(float v) {
    v += dppf_<0xB1>(v); v += dppf_<0x4E>(v); v += dppf_<0x141>(v); v += dppf_<0x140>(v);
    return (rdlane_(v, 0) + rdlane_(v, 16)) + (rdlane_(v, 32) + rdlane_(v, 48));
}
__device__ __forceinline__ float wave_max(float v) {
    v = fmaxf(v, dppf_<0xB1>(v)); v = fmaxf(v, dppf_<0x4E>(v)); v = fmaxf(v, dppf_<0x141>(v)); v = fmaxf(v, dppf_<0x140>(v));
    return fmaxf(fmaxf(rdlane_(v, 0), rdlane_(v, 16)), fmaxf(rdlane_(v, 32), rdlane_(v, 48)));
}
__device__ __forceinline__ void lds_barrier() { asm volatile("s_waitcnt lgkmcnt(0)\n\ts_barrier" ::: "memory"); }
__device__ __forceinline__ f32x4 sigmoid4_(f32x4 x) {
    f32x4 t = x * (-1.4426950408889634f); t = (f32x4){__builtin_amdgcn_exp2f(t[0]), __builtin_amdgcn_exp2f(t[1]), __builtin_amdgcn_exp2f(t[2]), __builtin_amdgcn_exp2f(t[3])}; t = t + 1.0f;
    return (f32x4){__builtin_amdgcn_rcpf(t[0]), __builtin_amdgcn_rcpf(t[1]), __builtin_amdgcn_rcpf(t[2]), __builtin_amdgcn_rcpf(t[3])}; }
__device__ __forceinline__ float sigmoidf_(float x) { return __builtin_amdgcn_rcpf(1.0f + __builtin_amdgcn_exp2f(-1.4426950408889634f * x)); }
__device__ __forceinline__ int lane_id_() { int l; asm volatile("v_mbcnt_lo_u32_b32 %0, -1, 0\n\tv_mbcnt_hi_u32_b32 %0, -1, %0" : "=v"(l)); return l; }
__device__ __forceinline__ float rdlane(float v, int l) { return __builtin_bit_cast(float, __builtin_amdgcn_readlane(__builtin_bit_cast(int, v), l)); }

namespace pg8 {
constexpr int BM = 256, BK = 64, HALF = 128, HTB = HALF * BK * 2, STAGE_BYTES = 8 * HTB, NXCD = 8, WGM = 8;
__host__ __device__ __forceinline__ int lds_byte(int r, int c) { const int st = (r >> 4) * 2 + (c >> 5), rr = r & 15, cc = c & 31, ob = rr * 64 + cc * 2; return st * 1024 + (ob ^ (((ob >> 9) & 1) << 5)); }
__host__ __device__ __forceinline__ void stage_rc(int b, int& R, int& C) { const int st = b / 1024, sb = b % 1024, swz = sb ^ (((sb >> 9) & 1) << 5); R = (st >> 1) * 16 + swz / 64; C = (st & 1) * 32 + (swz % 64) / 2; }
__host__ __device__ __forceinline__ int perm32(int rho) { const int n = rho >> 4, i = rho & 15; return 8 * (i >> 2) + 4 * n + (i & 3); }

struct Unit { int pm, pn, e, lt, nvalid; };
struct Gemm { const bf16_t* A; const bf16_t* Bt; int N, K; const int* rows; const float* rs = nullptr; const float* cs = nullptr; unsigned* tim = nullptr; };

template <int NN> struct Order {
    static constexpr int nN = NN;
    int nM, nwg, G, c;
    __device__ void init(int nM_, int nN_, int G_, int c_) { nM = nM_; nwg = nM * nN; G = G_; c = c_; }
    __device__ bool map(int i, int& pm, int& pn) const {
        const long L = (long)i * G + c; if (L >= nwg) return false;
        int wgid = (int)L; { const int q = nwg / NXCD, r = nwg % NXCD, xcd = wgid % NXCD, off = wgid / NXCD; wgid = (xcd < r ? xcd * (q + 1) : r * (q + 1) + (xcd - r) * q) + off; }
        const int nig = WGM * nN, gid = wgid / nig, fm = gid * WGM, gsz = (nM - fm) < WGM ? (nM - fm) : WGM;
        const int rem = wgid - gid * nig;
        pm = fm + rem % gsz; pn = rem / gsz; return true;
    }
};
template <int NN> struct DenseSched {
    Order<NN> o;
    __device__ bool next(int i, Unit& u) const { if (!o.map(i, u.pm, u.pn)) return false; u.e = 0; u.lt = u.pm; u.nvalid = 256; return true; }
};
template <int NN> struct MoeSched {
    Order<NN> o; const LAS int* ts;
    __device__ bool next(int i, Unit& u) const {
        if (!o.map(i, u.pm, u.pn)) return false;
        const int lane = lane_id_(); const int tv = ts[(lane & 31) + 1];
        const unsigned long long bal = __ballot(lane < NE - 1 && tv <= u.pm);
        const int e = __builtin_amdgcn_readfirstlane((int)__popcll(bal));
        const int t0 = __builtin_amdgcn_readfirstlane(ts[e]), cn = __builtin_amdgcn_readfirstlane(ts[33 + e]);
        u.e = e; u.lt = u.pm - t0; const int rem = cn - u.lt * 256; u.nvalid = rem < 256 ? rem : 256; return true;
    }
};

struct NoPre {};
template <class T, class = void> struct HasPre { static constexpr bool v = false; };
template <class T> struct HasPre<T, decltype((void)sizeof(typename T::Pre))> { static constexpr bool v = true; };
template <class T, bool> struct PreOf { typedef NoPre type; };
template <class T> struct PreOf<T, true> { typedef typename T::Pre type; };
template <class Epi, class Sched, bool GATHER, bool FP8 = false, bool NOEPI = false, bool HOOK = false, bool I8 = false, bool P16 = false>
__device__ __forceinline__ void gemm_phase(LAS unsigned char* lds, const Gemm g, const Sched& S, const Epi& E, const int wid) {
    const int lane = lane_id_(), tid = wid * 64 + lane, wr = wid >> 2, wc = wid & 3, fr = lane & 15, fq = lane >> 4;
    const int K = g.K, RP = (FP8 || I8) ? K : 2 * K, nt = RP / 128;
    unsigned voffB[2];
#pragma unroll
    for (int i = 0; i < 2; ++i) { int R, C; stage_rc(tid * 16 + i * 8192, R, C); const int Rb = P16 ? 64 * (R >> 5) + 16 * ((R & 15) >> 2) + 4 * ((R >> 4) & 1) + (R & 3) : (R & ~31) + perm32(R & 31); voffB[i] = (unsigned)(Rb * RP + C * 2); }
    const size_t kstep = 128;
    const size_t hstep = (size_t)HALF * RP, hstepB = P16 ? (size_t)8 * RP : hstep;
    const size_t tstep = 2 * hstep;
    const size_t estride = (size_t)g.N * RP;
    const unsigned ldsw = (unsigned)wid * 1024u;
    const int aoff = lds_byte(wr * 64 + fr, fq * 8), boff = lds_byte(wc * 32 + fr, fq * 8);
    constexpr int KOFF = 1024;
#define PG8_SA(b, h) (((b) * 2 + (h)) * HTB)
#define PG8_SB(b, h) ((4 + (b) * 2 + (h)) * HTB)
#define PG8_STAGE(bufoff, gbase, voff) do { _Pragma("unroll") for (int _i = 0; _i < 2; ++_i) { unsigned _o = (voff)[_i]; asm volatile("" : "+v"(_o));     \
        __builtin_amdgcn_global_load_lds((const unsigned*)((const char*)(gbase) + _o), (LAS unsigned*)(lds + (bufoff) + ldsw + _i * 8192), 16, 0, 0); } } while (0)
#define PG8_STAGE2(bufoff, gbase, h) PG8_STAGE(bufoff, gbase, vC[h])
#define PG8_LDA(dst, b, h) do { _Pragma("unroll") for (int m = 0; m < 4; ++m) _Pragma("unroll") for (int k = 0; k < 2; ++k) dst[m][k] = *(const LAS bf16x8*)(lds + PG8_SA(b, h) + aoff + m * 2048 + k * KOFF); } while (0)
#define PG8_LDB(dst, b, h) do { _Pragma("unroll") for (int n = 0; n < 2; ++n) _Pragma("unroll") for (int k = 0; k < 2; ++k) dst[n][k] = *(const LAS bf16x8*)(lds + PG8_SB(b, h) + boff + n * 2048 + k * KOFF); } while (0)
#define PG8_CAT(x) __builtin_bit_cast(v8i, __builtin_shufflevector((x)[0], (x)[1], 0, 1, 2, 3, 4, 5, 6, 7, 8, 9, 10, 11, 12, 13, 14, 15))
#define PG8_MMA(ai, bj, At, Bt) do { __builtin_amdgcn_s_setprio(1); _Pragma("unroll") for (int m = 0; m < 4; ++m) _Pragma("unroll") for (int n = 0; n < 2; ++n) { \
        if constexpr (FP8) acc[ai][bj][m][n] = __builtin_amdgcn_mfma_scale_f32_16x16x128_f8f6f4(PG8_CAT(Bt[n]), PG8_CAT(At[m]), acc[ai][bj][m][n], 0, 0, 0, 0, 0, 0); \
        else if constexpr (I8) { _Pragma("unroll") for (int k = 0; k < 2; ++k) acci[ai][bj][m][n] = __builtin_amdgcn_mfma_i32_16x16x64_i8(__builtin_bit_cast(v4i, Bt[n][k]), __builtin_bit_cast(v4i, At[m][k]), acci[ai][bj][m][n], 0, 0, 0); } \
        else { _Pragma("unroll") for (int k = 0; k < 2; ++k) acc[ai][bj][m][n] = __builtin_amdgcn_mfma_f32_16x16x32_bf16(Bt[n][k], At[m][k], acc[ai][bj][m][n], 0, 0, 0); } } \
        __builtin_amdgcn_s_setprio(0); } while (0)
#define PG8_WAIT_V(n) asm volatile("s_waitcnt vmcnt(" #n ")" ::: "memory")
#define PG8_WAIT_V8R() do { if (NOEPI || Epi::NVMEM == 0 || !relax) asm volatile("s_waitcnt vmcnt(8)" ::: "memory"); else asm volatile("s_waitcnt vmcnt(%0)" :: "n"(8 + (NOEPI ? 0 : Epi::NVMEM)) : "memory"); } while (0)
#define PG8_WAIT_L(n) asm volatile("s_waitcnt lgkmcnt(" #n ")" ::: "memory")
#define PG8_BAR __builtin_amdgcn_s_barrier()
#define PG8_SCHED __builtin_amdgcn_sched_barrier(0)
#define PG8_SETV(u, v) do { _Pragma("unroll") for (int _h = 0; _h < 2; ++_h) _Pragma("unroll") for (int _i = 0; _i < 2; ++_i) { int _R, _C; stage_rc((wid * 64 + lane_id_()) * 16 + _i * 8192, _R, _C); \
        if (GATHER) { int _r = _h * HALF + _R; _r = _r < (u).nvalid ? _r : (u).nvalid - 1; const int _s = g.rows[(size_t)(u).e * CAP + (u).lt * 256 + _r]; \
                      (v)[_h][_i] = (unsigned)(_s >> 2) * (unsigned)RP + (unsigned)(_C * 2); } \
        else (v)[_h][_i] = (unsigned)(_R * RP + _C * 2) + (unsigned)(_h * hstep); } } while (0)
#define PG8_ABASE(u) (GATHER ? (const char*)g.A : (const char*)g.A + (size_t)(u).pm * tstep)
#define PG8_BBASE(u) ((const char*)g.Bt + (size_t)(u).e * estride + (size_t)(u).pn * tstep)
    Unit cur, nxt, nn; int ui = 0;
    if (!S.next(0, cur)) return;
    bool has_next = S.next(1, nxt);
    unsigned vC[2][2];
    PG8_SETV(cur, vC);
#define PG8_PARK ((LAS unsigned*)(lds + MISC_OFF) + (wid * 64 + lane_id_()) * 4)
    if (GATHER) { unsigned vP[2][2];
        if (has_next) PG8_SETV(nxt, vP); else { vP[0][0] = vC[0][0]; vP[0][1] = vC[0][1]; vP[1][0] = vC[1][0]; vP[1][1] = vC[1][1]; }
        LAS unsigned* pk = PG8_PARK; pk[0] = vP[0][0]; pk[1] = vP[0][1]; pk[2] = vP[1][0]; pk[3] = vP[1][1]; }
    f32x4 acc[2][2][4][2]; v4i acci[2][2][4][2];
#pragma unroll
    for (int a = 0; a < 2; ++a)
#pragma unroll
        for (int b = 0; b < 2; ++b)
#pragma unroll
            for (int m = 0; m < 4; ++m)
#pragma unroll
                for (int n = 0; n < 2; ++n) { acc[a][b][m][n] = (f32x4){0.f, 0.f, 0.f, 0.f}; acci[a][b][m][n] = (v4i){0, 0, 0, 0}; }
    bf16x8 At[4][2], B0[2][2], B1[2][2];
    const char* cA = PG8_ABASE(cur); const char* cB = PG8_BBASE(cur);
    PG8_STAGE(PG8_SB(0, 0), cB, voffB); PG8_STAGE(PG8_SB(0, 1), cB + hstepB, voffB); PG8_STAGE(PG8_SA(0, 0), cA, vC[0]); PG8_STAGE(PG8_SA(0, 1), cA, vC[1]);
    if (wr == 1) PG8_BAR;
    PG8_WAIT_V(2); PG8_BAR;
    PG8_STAGE(PG8_SB(1, 0), cB + kstep, voffB); PG8_STAGE(PG8_SA(1, 0), cA + kstep, vC[0]); PG8_STAGE(PG8_SB(1, 1), cB + hstepB + kstep, voffB);
    PG8_WAIT_V(6); PG8_BAR;
#if TIM_PHASE
    unsigned long long tk_ = 0, ta_ = 0, tb_ = 0, tu_ = 0; unsigned tl_ = 0; const unsigned long long ts_ = __builtin_amdgcn_s_memtime();
#endif
    for (;;) {
#if TIM_PHASE
        const unsigned long long t0_ = __builtin_amdgcn_s_memtime();
#endif
        const char* nA = has_next ? PG8_ABASE(nxt) : cA; const char* nB = has_next ? PG8_BBASE(nxt) : cB;
#pragma unroll 1
        for (int t = 0; t < nt; t += 2) {
            const bool last = (t == nt - 2); const bool relax = false;
            if constexpr (HOOK) { if (t == nt / 2) { const int l_ = lane_id_(); E.mid(acc, cur, wr, wc, l_ & 15, l_ >> 4); } }
            const char* a1 = cA + (size_t)(t + 1) * kstep;
            const char* a2 = last ? nA : cA + (size_t)(t + 2) * kstep; const char* b2 = last ? nB : cB + (size_t)(t + 2) * kstep;
            const char* a3 = a2 + kstep; const char* b3 = b2 + kstep;
            PG8_LDB(B0, 0, 0); PG8_LDB(B1, 0, 1); PG8_SCHED; PG8_LDA(At, 0, 0); PG8_STAGE(PG8_SA(1, 1), a1, vC[1]);
            if (GATHER && last) { const LAS unsigned* pk = PG8_PARK; vC[0][0] = pk[0]; vC[0][1] = pk[1]; vC[1][0] = pk[2]; vC[1][1] = pk[3]; }
            PG8_WAIT_V8R(); PG8_WAIT_L(0); PG8_BAR; PG8_MMA(0, 0, At, B0); PG8_MMA(0, 1, At, B1); PG8_BAR; PG8_SCHED;
            PG8_LDA(At, 0, 1); PG8_STAGE(PG8_SB(0, 0), b2, voffB); PG8_STAGE(PG8_SB(0, 1), b2 + hstepB, voffB); PG8_STAGE2(PG8_SA(0, 0), a2, 0);
            PG8_WAIT_V8R(); PG8_WAIT_L(0); PG8_BAR; PG8_MMA(1, 0, At, B0); PG8_MMA(1, 1, At, B1); PG8_BAR; PG8_SCHED;
            PG8_LDB(B0, 1, 0); PG8_LDB(B1, 1, 1); PG8_SCHED; PG8_LDA(At, 1, 0); PG8_STAGE2(PG8_SA(0, 1), a2, 1);
            PG8_WAIT_V(8); PG8_WAIT_L(0); PG8_BAR; PG8_MMA(0, 0, At, B0); PG8_MMA(0, 1, At, B1); PG8_BAR; PG8_SCHED;
            PG8_LDA(At, 1, 1); PG8_STAGE(PG8_SB(1, 0), b3, voffB); PG8_STAGE(PG8_SB(1, 1), b3 + hstepB, voffB); PG8_STAGE2(PG8_SA(1, 0), a3, 0);
            PG8_WAIT_V(8); PG8_WAIT_L(0); PG8_BAR; PG8_MMA(1, 0, At, B0); PG8_MMA(1, 1, At, B1); PG8_BAR; PG8_SCHED;
        }
#if TIM_PHASE
        const unsigned long long t1_ = __builtin_amdgcn_s_memtime();
#endif
        float rsv[2][4]; f32x4 csv[2][2]; typename PreOf<Epi, HasPre<Epi>::v>::type pf;
        { const int l_ = lane_id_();
          if constexpr (I8) {
            const float* rsp = g.rs + (GATHER ? (size_t)cur.e * CAP : (size_t)0) + (size_t)cur.lt * 256; const float* csp = g.cs + (size_t)cur.e * g.N + cur.pn * 256 + wc * 32 + 8 * (l_ >> 4);
#pragma unroll
            for (int a = 0; a < 2; ++a)
#pragma unroll
                for (int m = 0; m < 4; ++m) { int r = a * 128 + wr * 64 + m * 16 + (l_ & 15); r = r < cur.nvalid ? r : cur.nvalid - 1; rsv[a][m] = rsp[r]; }
#pragma unroll
            for (int b = 0; b < 2; ++b)
#pragma unroll
                for (int n = 0; n < 2; ++n) csv[b][n] = *(const f32x4*)(csp + b * 128 + 4 * n);
          }
          if constexpr (HasPre<Epi>::v && !NOEPI) pf = E.pre(cur, wr, wc, l_ & 15, l_ >> 4); }
        if (wr == 0) PG8_BAR;
        bool has_nn = false; unsigned vT[2][2];
        if (has_next) has_nn = S.next(ui + 2, nn);
        if (GATHER && has_nn) PG8_SETV(nn, vT);
#if TIM_PHASE
        const unsigned long long t2_ = __builtin_amdgcn_s_memtime();
#endif
        if constexpr (I8) {
#pragma unroll
            for (int a = 0; a < 2; ++a)
#pragma unroll
                for (int b = 0; b < 2; ++b)
#pragma unroll
                    for (int m = 0; m < 4; ++m)
#pragma unroll
                        for (int n = 0; n < 2; ++n)
#pragma unroll
                            for (int i = 0; i < 4; ++i) acc[a][b][m][n][i] = ((float)acci[a][b][m][n][i] * rsv[a][m]) * csv[b][n][i];
        }
        { const int l_ = lane_id_();
          if constexpr (!NOEPI) { if constexpr (HasPre<Epi>::v) E(acc, cur, wr, wc, l_ & 15, l_ >> 4, pf); else E(acc, cur, wr, wc, l_ & 15, l_ >> 4); }
          else { _Pragma("unroll") for (int a_ = 0; a_ < 2; ++a_) _Pragma("unroll") for (int b_ = 0; b_ < 2; ++b_) _Pragma("unroll") for (int m_ = 0; m_ < 4; ++m_) _Pragma("unroll") for (int n_ = 0; n_ < 2; ++n_) asm volatile("" :: "v"(acc[a_][b_][m_][n_])); } }
#if TIM_PHASE
        { const unsigned long long t3_ = __builtin_amdgcn_s_memtime(); tk_ += t1_ - t0_; ta_ += t2_ - t1_; tb_ += t3_ - t2_; tu_ += 1;
 }
#endif
        if (!has_next) break;
#pragma unroll
        for (int a = 0; a < 2; ++a)
#pragma unroll
            for (int b = 0; b < 2; ++b)
#pragma unroll
                for (int m = 0; m < 4; ++m)
#pragma unroll
                    for (int n = 0; n < 2; ++n) { acc[a][b][m][n] = (f32x4){0.f, 0.f, 0.f, 0.f}; acci[a][b][m][n] = (v4i){0, 0, 0, 0}; }
        cur = nxt; cA = nA; cB = nB; ++ui;
        if (GATHER && has_nn) { LAS unsigned* pk = PG8_PARK; pk[0] = vT[0][0]; pk[1] = vT[0][1]; pk[2] = vT[1][0]; pk[3] = vT[1][1]; }
        nxt = nn; has_next = has_nn;
        if (wr == 1) PG8_BAR;
    }
    PG8_WAIT_V(0);
    PG8_BAR;
#if TIM_PHASE
    if (g.tim && blockIdx.x == 0 && wid == 0 && lane_id_() == 0) { const unsigned long long te_ = __builtin_amdgcn_s_memtime(); g.tim[0] = (unsigned)tk_; g.tim[1] = (unsigned)ta_; g.tim[2] = (unsigned)tb_; g.tim[3] = (unsigned)tu_; g.tim[4] = (unsigned)(te_ - ts_); g.tim[5] = (unsigned)tl_; }
#endif
#undef PG8_SA
#undef PG8_SB
#undef PG8_STAGE
#undef PG8_STAGE2
#undef PG8_PARK
#undef PG8_LDA
#undef PG8_LDB
#undef PG8_MMA
#undef PG8_CAT
#undef PG8_WAIT_V
#undef PG8_WAIT_V8R
#undef PG8_WAIT_L
#undef PG8_BAR
#undef PG8_SCHED
#undef PG8_SETV
#undef PG8_ABASE
#undef PG8_BBASE
}

template <class F> struct EpiOct {
    F f;
    __device__ __forceinline__ void operator()(const f32x4 (&acc)[2][2][4][2], const Unit& u, int wr, int wc, int fr, int fq) const {
#pragma unroll
        for (int ai = 0; ai < 2; ++ai)
#pragma unroll
            for (int m = 0; m < 4; ++m) {
                const int r = ai * HALF + wr * 64 + m * 16 + fr;
#pragma unroll
                for (int bj = 0; bj < 2; ++bj) f(u, r, bj * HALF + wc * 32 + 8 * fq, acc[ai][bj][m][0], acc[ai][bj][m][1]);
            }
    }
};
}
using pg8::Unit;

__device__ __forceinline__ u32x4 pack8(f32x4 a, f32x4 b) { u32x4 w; w.x = pk2(a[0], a[1]); w.y = pk2(a[2], a[3]); w.z = pk2(b[0], b[1]); w.w = pk2(b[2], b[3]); return w; }
__device__ __forceinline__ void unpack8(u32x4 w, f32x4& a, f32x4& b) { a = (f32x4){bf_lo(w.x), bf_hi(w.x), bf_lo(w.y), bf_hi(w.y)}; b = (f32x4){bf_lo(w.z), bf_hi(w.z), bf_lo(w.w), bf_hi(w.w)}; }

template <bool NOSTORE = false> struct EpiProj_ {
    static constexpr int NVMEM = NOSTORE ? 0 : 16;
    bf16_t* proj; float* logf; const float* rope; const float* lb;
    __device__ __forceinline__ void operator()(const f32x4 (&acc)[2][2][4][2], const Unit& u, int wr, int wc, int fr, int fq) const {
        const int pn = u.pn, colb = pn * 256 + wc * 32 + 8 * fq, rowb = u.pm * 256 + wr * 64 + fr;
        if (pn < 4) {
            const int i0 = (colb & 63) >> 1; const float sc = pn < 2 ? QSCALE : 1.0f;
            f32x4 cs[2][4][2];
#pragma unroll
            for (int ai = 0; ai < 2; ++ai)
#pragma unroll
                for (int m = 0; m < 4; ++m) { const int pos = (rowb + ai * 128 + m * 16) & (SEQ - 1); const float* tp = rope + ((size_t)pos * 32 + i0) * 2; cs[ai][m][0] = *(const f32x4*)tp; cs[ai][m][1] = *(const f32x4*)(tp + 4); }
#pragma unroll
            for (int ai = 0; ai < 2; ++ai)
#pragma unroll
                for (int m = 0; m < 4; ++m) { const f32x4 c0 = cs[ai][m][0] * sc, c1 = cs[ai][m][1] * sc;
#pragma unroll
                    for (int bj = 0; bj < 2; ++bj) { const f32x4 v0 = acc[ai][bj][m][0], v1 = acc[ai][bj][m][1]; f32x4 o0, o1;
                        o0[0] = v0[0] * c0[0] - v0[1] * c0[1]; o0[1] = v0[1] * c0[0] + v0[0] * c0[1]; o0[2] = v0[2] * c0[2] - v0[3] * c0[3]; o0[3] = v0[3] * c0[2] + v0[2] * c0[3];
                        o1[0] = v1[0] * c1[0] - v1[1] * c1[1]; o1[1] = v1[1] * c1[0] + v1[0] * c1[1]; o1[2] = v1[2] * c1[2] - v1[3] * c1[3]; o1[3] = v1[3] * c1[2] + v1[2] * c1[3];
                        { const u32x4 w_ = pack8(o0, o1); if (NOSTORE) asm volatile("" :: "v"(w_)); else __builtin_nontemporal_store(w_, (u32x4*)(proj + (size_t)(rowb + ai * 128 + m * 16) * DIN + colb + bj * 128)); } } }
        } else if (pn == 8 || pn == 9) {
            f32x4 l[2][2];
#pragma unroll
            for (int bj = 0; bj < 2; ++bj) { const float* lp = lb + (colb - C_FB) + bj * 128; l[bj][0] = *(const f32x4*)lp; l[bj][1] = *(const f32x4*)(lp + 4); }
#pragma unroll
            for (int ai = 0; ai < 2; ++ai)
#pragma unroll
                for (int m = 0; m < 4; ++m)
#pragma unroll
                    for (int bj = 0; bj < 2; ++bj) { f32x4 o[2];
#pragma unroll
                        for (int n = 0; n < 2; ++n) { const f32x4 sg = sigmoid4_(acc[ai][bj][m][n]), lv = l[bj][n], t = lv + (1.0f - lv) * sg;
                            o[n] = (f32x4){__logf(t[0]), __logf(t[1]), __logf(t[2]), __logf(t[3])}; }
                        _Float16* p = (_Float16*)logf + (size_t)(rowb + ai * 128 + m * 16) * 512 + (colb - C_FB) + bj * 128;
                        const h16x8 hv = {(_Float16)o[0][0], (_Float16)o[0][1], (_Float16)o[0][2], (_Float16)o[0][3], (_Float16)o[1][0], (_Float16)o[1][1], (_Float16)o[1][2], (_Float16)o[1][3]};
                        if (NOSTORE) asm volatile("" :: "v"(hv)); else *(h16x8*)p = hv; }
        } else {
            const int mode = (pn == 6 || pn == 7 || pn == 12 || pn == 13) ? 1 : (pn >= 14 ? 2 : 0);
#define EPROJ_LOOP(EXPR) _Pragma("unroll") for (int ai = 0; ai < 2; ++ai) _Pragma("unroll") for (int m = 0; m < 4; ++m) _Pragma("unroll") for (int bj = 0; bj < 2; ++bj) { f32x4 o[2]; \
                _Pragma("unroll") for (int n = 0; n < 2; ++n) { const f32x4 x = acc[ai][bj][m][n]; o[n] = (EXPR); } \
                const u32x4 w_ = pack8(o[0], o[1]); if (NOSTORE) asm volatile("" :: "v"(w_)); else __builtin_nontemporal_store(w_, (u32x4*)(proj + (size_t)(rowb + ai * 128 + m * 16) * DIN + colb + bj * 128)); }
            if (mode == 0) { EPROJ_LOOP(x) } else if (mode == 1) { EPROJ_LOOP(x * sigmoid4_(x)) } else {
#pragma unroll
                for (int ai = 0; ai < 2; ++ai)
#pragma unroll
                    for (int m = 0; m < 4; ++m)
#pragma unroll
                        for (int bj = 0; bj < 2; ++bj) { f32x4 o[2];
#pragma unroll
                            for (int n = 0; n < 2; ++n) o[n] = sigmoid4_(acc[ai][bj][m][n]);
                            u32x2 w_; w_.x = pk4_u8(o[0][0], o[0][1], o[0][2], o[0][3]); w_.y = pk4_u8(o[1][0], o[1][1], o[1][2], o[1][3]);
                            unsigned char* gp = (unsigned char*)(proj + (size_t)(rowb + ai * 128 + m * 16) * DIN) + GATE_BYTE0 + (colb - C_GA) + bj * 128;
                            if (NOSTORE) asm volatile("" :: "v"(w_)); else *(u32x2*)gp = w_; }
            }
#undef EPROJ_LOOP
        }
    }
};
typedef EpiProj_<false> EpiProj;
template <bool ACCUM> struct EpiMix {
    bf16_t* mixed; const bf16_t* proj; int gcol;
    __device__ __forceinline__ void operator()(const f32x4 (&acc)[2][2][4][2], const Unit& u, int wr, int wc, int fr, int fq) const {
        const int colb = u.pn * 256 + wc * 32 + 8 * fq, rowb = u.pm * 256 + wr * 64 + fr;
#pragma unroll
        for (int ai = 0; ai < 2; ++ai) {
            u32x4 g[4][2], mx[4][2];
#pragma unroll
            for (int m = 0; m < 4; ++m)
#pragma unroll
                for (int bj = 0; bj < 2; ++bj) { const size_t row = (size_t)(rowb + ai * 128 + m * 16); g[m][bj] = *(const u32x4*)(proj + row * DIN + gcol + colb + bj * 128);
                    if (ACCUM) mx[m][bj] = *(const u32x4*)(mixed + row * DM + colb + bj * 128); }
#pragma unroll
            for (int m = 0; m < 4; ++m)
#pragma unroll
                for (int bj = 0; bj < 2; ++bj) { f32x4 g0, g1; unpack8(g[m][bj], g0, g1); f32x4 v0 = acc[ai][bj][m][0] * g0, v1 = acc[ai][bj][m][1] * g1;
                    if (ACCUM) { f32x4 m0, m1; unpack8(mx[m][bj], m0, m1); v0 = v0 + m0; v1 = v1 + m1; }
                    *(u32x4*)(mixed + (size_t)(rowb + ai * 128 + m * 16) * DM + colb + bj * 128) = pack8(v0, v1); }
        }
    }
};
struct EpiMixF {         static constexpr int NVMEM = 16;
    bf16_t* mixed; const bf16_t* proj;
    __device__ __forceinline__ void mid(f32x4 (&acc)[2][2][4][2], const Unit& u, int wr, int wc, int fr, int fq) const {
        const int colb = u.pn * 256 + wc * 32 + 8 * fq, rowb = u.pm * 256 + wr * 64 + fr;
        u32x2 ga[2][4][2], gb[2][4][2];
#pragma unroll
        for (int ai = 0; ai < 2; ++ai)
#pragma unroll
            for (int m = 0; m < 4; ++m)
#pragma unroll
                for (int bj = 0; bj < 2; ++bj) { const unsigned char* p = (const unsigned char*)(proj + (size_t)(rowb + ai * 128 + m * 16) * DIN) + GATE_BYTE0 + colb + bj * 128; ga[ai][m][bj] = *(const u32x2*)p; gb[ai][m][bj] = *(const u32x2*)(p + 1024); }
#pragma unroll
        for (int ai = 0; ai < 2; ++ai)
#pragma unroll
            for (int m = 0; m < 4; ++m)
#pragma unroll
                for (int bj = 0; bj < 2; ++bj) { const f32x4 a0 = un4_u8(ga[ai][m][bj].x), a1 = un4_u8(ga[ai][m][bj].y), b0 = un4_u8(gb[ai][m][bj].x), b1 = un4_u8(gb[ai][m][bj].y);
                    const f32x4 r0 = a0 * (f32x4){__builtin_amdgcn_rcpf(b0[0]), __builtin_amdgcn_rcpf(b0[1]), __builtin_amdgcn_rcpf(b0[2]), __builtin_amdgcn_rcpf(b0[3])};
                    const f32x4 r1 = a1 * (f32x4){__builtin_amdgcn_rcpf(b1[0]), __builtin_amdgcn_rcpf(b1[1]), __builtin_amdgcn_rcpf(b1[2]), __builtin_amdgcn_rcpf(b1[3])};
                    acc[ai][bj][m][0] = acc[ai][bj][m][0] * r0; acc[ai][bj][m][1] = acc[ai][bj][m][1] * r1; }
    }
    __device__ __forceinline__ void operator()(const f32x4 (&acc)[2][2][4][2], const Unit& u, int wr, int wc, int fr, int fq) const {
        const int colb = u.pn * 256 + wc * 32 + 8 * fq, rowb = u.pm * 256 + wr * 64 + fr;
        u32x2 gb[2][4][2];
#pragma unroll
        for (int ai = 0; ai < 2; ++ai)
#pragma unroll
            for (int m = 0; m < 4; ++m)
#pragma unroll
                for (int bj = 0; bj < 2; ++bj) gb[ai][m][bj] = *(const u32x2*)((const unsigned char*)(proj + (size_t)(rowb + ai * 128 + m * 16) * DIN) + GATE_BYTE0 + 1024 + colb + bj * 128);
#pragma unroll
        for (int ai = 0; ai < 2; ++ai)
#pragma unroll
            for (int m = 0; m < 4; ++m)
#pragma unroll
                for (int bj = 0; bj < 2; ++bj) { const f32x4 b0 = un4_u8(gb[ai][m][bj].x) * (1.0f / 255.0f), b1 = un4_u8(gb[ai][m][bj].y) * (1.0f / 255.0f);
                    *(u32x4*)(mixed + (size_t)(rowb + ai * 128 + m * 16) * DM + colb + bj * 128) = pack8(acc[ai][bj][m][0] * b0, acc[ai][bj][m][1] * b1); }
    }
};
struct EpiOut {
    static constexpr int NVMEM = 16;
    const float* x; bf16_t* x1;
    __device__ __forceinline__ void operator()(const f32x4 (&acc)[2][2][4][2], const Unit& u, int wr, int wc, int fr, int fq) const {
        const int colb = u.pn * 256 + wc * 32 + 8 * fq, rowb = u.pm * 256 + wr * 64 + fr;
#pragma unroll
        for (int ai = 0; ai < 2; ++ai) {
            f32x4 xv[4][2][2];
#pragma unroll
            for (int m = 0; m < 4; ++m)
#pragma unroll
                for (int bj = 0; bj < 2; ++bj) { const float* p = x + (size_t)(rowb + ai * 128 + m * 16) * DM + colb + bj * 128; xv[m][bj][0] = __builtin_nontemporal_load((const f32x4*)p); xv[m][bj][1] = __builtin_nontemporal_load((const f32x4*)(p + 4)); }
#pragma unroll
            for (int m = 0; m < 4; ++m)
#pragma unroll
                for (int bj = 0; bj < 2; ++bj) *(u32x4*)(x1 + (size_t)(rowb + ai * 128 + m * 16) * DM + colb + bj * 128) = pack8(xv[m][bj][0] + acc[ai][bj][m][0], xv[m][bj][1] + acc[ai][bj][m][1]);
        }
    }
};
struct EpiMoe1 {         static constexpr int NVMEM = 8;
    bf16_t* hid; const float* bias;
    struct Pre { f32x4 b[4]; };
    __device__ __forceinline__ Pre pre(const Unit& u, int wr, int wc, int fr, int fq) const { Pre p; const float* bp = bias + (size_t)u.e * 2048 + 2 * (128 * u.pn + wc * 32 + 8 * fq);
#pragma unroll
        for (int j = 0; j < 4; ++j) p.b[j] = *(const f32x4*)(bp + 4 * j);
        return p; }
    __device__ __forceinline__ void operator()(const f32x4 (&acc)[2][2][4][2], const Unit& u, int wr, int wc, int fr, int fq, const Pre& pf) const {
        const int jj0 = wc * 32 + 8 * fq, J0 = 128 * u.pn + jj0;
        const f32x4 (&b)[4] = pf.b;
        constexpr float DQ = MOE1_I8 ? 1.0f : DQ1;
        constexpr float HS = MOE_FP8 ? S_HID : 1.0f, KE = -1.702f * 1.4426950408889634f;
#pragma unroll
        for (int ai = 0; ai < 2; ++ai)
#pragma unroll
            for (int m = 0; m < 4; ++m) {
                const int r = ai * 128 + wr * 64 + m * 16 + fr;
                f32x2 h[4];
#pragma unroll
                for (int p = 0; p < 4; ++p) {
                    const f32x4 ag = acc[ai][0][m][p >> 1], au = acc[ai][1][m][p >> 1];
                    const f32x2 g0 = (p & 1) ? (f32x2){ag[2], ag[3]} : (f32x2){ag[0], ag[1]}, u0 = (p & 1) ? (f32x2){au[2], au[3]} : (f32x2){au[0], au[1]};
                    f32x2 gt = g0 * DQ + (f32x2){b[p][0], b[p][2]}, up = u0 * DQ + (f32x2){b[p][1], b[p][3]};
                    gt.x = fminf(gt.x, 7.0f); gt.y = fminf(gt.y, 7.0f); up.x = __builtin_amdgcn_fmed3f(up.x, -7.0f, 7.0f); up.y = __builtin_amdgcn_fmed3f(up.y, -7.0f, 7.0f);
                    f32x2 e = gt * KE; e.x = __builtin_amdgcn_exp2f(e.x); e.y = __builtin_amdgcn_exp2f(e.y);
                    f32x2 den = e * (1.0f / HS) + (1.0f / HS); den.x = __builtin_amdgcn_rcpf(den.x); den.y = __builtin_amdgcn_rcpf(den.y);
                    h[p] = (up * gt + gt) * den;
                }
                if constexpr (MOE_FP8) { u32x2 w; unsigned t = 0u;
                    t = __builtin_amdgcn_cvt_pk_fp8_f32(h[0].x, h[0].y, t, false); t = __builtin_amdgcn_cvt_pk_fp8_f32(h[1].x, h[1].y, t, true); w.x = t; t = 0u;
                    t = __builtin_amdgcn_cvt_pk_fp8_f32(h[2].x, h[2].y, t, false); t = __builtin_amdgcn_cvt_pk_fp8_f32(h[3].x, h[3].y, t, true); w.y = t;
                    *(u32x2*)((unsigned char*)hid + (size_t)(u.pm * 256 + r) * DE + J0) = w; }
                else { u32x4 w; w.x = pk2(h[0].x, h[0].y); w.y = pk2(h[1].x, h[1].y); w.z = pk2(h[2].x, h[2].y); w.w = pk2(h[3].x, h[3].y);
                    *(u32x4*)(hid + (size_t)(u.pm * 256 + r) * DE + J0) = w; }
            }
    }
};
struct EpiMoe2 {
    static constexpr int NVMEM = MOE_FP8 ? 8 : 16;
    bf16_t* yg; const float* bias; const int* rows; const float* roww;
    struct Pre { f32x4 b[2][2]; int slot[2][4]; float wgt[2][4]; };
    __device__ __forceinline__ Pre pre(const Unit& u, int wr, int wc, int fr, int fq) const { Pre p; f32x4 (&b)[2][2] = p.b; int (&slot)[2][4] = p.slot; float (&wgt)[2][4] = p.wgt;
        const int c0 = MOE_FP8 ? u.pn * 256 + 64 * wc + 16 * fq : 0;
#pragma unroll
        for (int bj = 0; bj < 2; ++bj) { const float* bp = MOE_FP8 ? bias + (size_t)u.e * DM + c0 + 8 * bj : bias + (size_t)u.e * DM + u.pn * 256 + bj * 128 + wc * 32 + 8 * fq; b[bj][0] = *(const f32x4*)bp; b[bj][1] = *(const f32x4*)(bp + 4); }
#pragma unroll
        for (int ai = 0; ai < 2; ++ai)
#pragma unroll
            for (int m = 0; m < 4; ++m) { int r = ai * 128 + wr * 64 + m * 16 + fr; r = r < u.nvalid ? r : u.nvalid - 1; const size_t pp = (size_t)u.e * CAP + u.lt * 256 + r; slot[ai][m] = rows[pp]; wgt[ai][m] = roww[pp]; }
        return p; }
    __device__ __forceinline__ void operator()(const f32x4 (&acc)[2][2][4][2], const Unit& u, int wr, int wc, int fr, int fq, const Pre& pf) const {
        const f32x4 (&b)[2][2] = pf.b; const int (&slot)[2][4] = pf.slot; const float (&wgt)[2][4] = pf.wgt;
        const int c0 = MOE_FP8 ? u.pn * 256 + 64 * wc + 16 * fq : 0;
#pragma unroll
        for (int ai = 0; ai < 2; ++ai)
#pragma unroll
            for (int m = 0; m < 4; ++m) {
                const int r = ai * 128 + wr * 64 + m * 16 + fr; const float w = wgt[ai][m];
                if (r < u.nvalid) {
                    if constexpr (MOE_FP8) { u32x4 q; const float ws = w * S_YG;
#define PK4Y_(A, B) ({ const f32x4 y_ = ((A) * DQ2 + (B)) * ws; unsigned t_ = 0u; \
                        t_ = __builtin_amdgcn_cvt_pk_fp8_f32(__builtin_amdgcn_fmed3f(y_[0], -440.0f, 440.0f), __builtin_amdgcn_fmed3f(y_[1], -440.0f, 440.0f), t_, false); \
                        t_ = __builtin_amdgcn_cvt_pk_fp8_f32(__builtin_amdgcn_fmed3f(y_[2], -440.0f, 440.0f), __builtin_amdgcn_fmed3f(y_[3], -440.0f, 440.0f), t_, true); t_; })
                        q.x = PK4Y_(acc[ai][0][m][0], b[0][0]); q.y = PK4Y_(acc[ai][0][m][1], b[0][1]); q.z = PK4Y_(acc[ai][1][m][0], b[1][0]); q.w = PK4Y_(acc[ai][1][m][1], b[1][1]);
#undef PK4Y_
                        *(u32x4*)((unsigned char*)yg + (size_t)slot[ai][m] * DM + c0) = q; }
                    else {
#pragma unroll
                        for (int bj = 0; bj < 2; ++bj) { const f32x4 y0 = (acc[ai][bj][m][0] * DQ2 + b[bj][0]) * w, y1 = (acc[ai][bj][m][1] * DQ2 + b[bj][1]) * w;
                            *(u32x4*)(yg + (size_t)slot[ai][m] * DM + u.pn * 256 + bj * 128 + wc * 32 + 8 * fq) = pack8(y0, y1); } }
                }
            }
    }
};

struct Args { const float* in[16]; float* out; unsigned char* ws; int ph_lo, ph_hi; };
enum { I_X = 0, I_N1, I_WIN, I_MUP, I_LBL, I_HNW, I_HUP, I_WOUT, I_N2, I_RW, I_RB, I_WGU, I_BGU, I_WD, I_BD, I_FNW };
constexpr int NPHASE = 11;

struct Frame { LAS unsigned char* lds; int tid, lane, wave, G, bid; };
__device__ __forceinline__ Frame fresh(const Frame& F0) { Frame F = F0; const int l = lane_id_(); F.lane = l; F.tid = F0.wave * 64 + l; return F; }

template <int MAP> __device__ __forceinline__ int rowmap(int n) {
    if (MAP == 1) return n < 1024 ? ((n & ~63) | (2 * (n & 31) + ((n >> 5) & 1))) : n;
    if (MAP == 2) { const int J = n >> 1, s = n & 1; return 256 * (J >> 7) + 128 * s + (J & 127); }
    return n;
}
template <int MAP> __device__ __forceinline__ void transpose_item(const float* W, int K, int N, bf16_t* WT, LAS float* scr, int item, int lane, int KP = 0) {
    if (KP == 0) KP = K;
    const int nblk = N / 32, kb = item / nblk, nb = item % nblk, k0 = 64 * kb, n0 = 32 * nb;
    f32x4 v[8];
#pragma unroll
    for (int i = 0; i < 8; ++i) v[i] = __builtin_nontemporal_load((const f32x4*)(W + (size_t)(k0 + 8 * i + (lane >> 3)) * N + n0 + 4 * (lane & 7)));
#pragma unroll
    for (int i = 0; i < 8; ++i) { LAS float* p = scr + (8 * i + (lane >> 3)) * 33 + 4 * (lane & 7); p[0] = v[i].x; p[1] = v[i].y; p[2] = v[i].z; p[3] = v[i].w; }
    asm volatile("s_waitcnt lgkmcnt(0)" ::: "memory");
    const int c = lane & 7;
#pragma unroll
    for (int j = 0; j < 4; ++j) { const int n = (lane >> 3) + 8 * j; const LAS float* s = scr + (8 * c) * 33 + n;
        u32x4 o; o.x = pk2(s[0 * 33], s[1 * 33]); o.y = pk2(s[2 * 33], s[3 * 33]); o.z = pk2(s[4 * 33], s[5 * 33]); o.w = pk2(s[6 * 33], s[7 * 33]);
        *(u32x4*)(WT + (size_t)rowmap<MAP>(n0 + n) * KP + k0 + 8 * c) = o; }
    asm volatile("s_waitcnt lgkmcnt(0)" ::: "memory");
}
template <int MAP> __device__ __forceinline__ void transpose_item_fp8(const float* W, int K, int N, unsigned char* WT, LAS float* scr, int item, int lane) {
    const int nblk = N / 32, kb = item / nblk, nb = item % nblk, k0 = 64 * kb, n0 = 32 * nb;
    f32x4 v[8];
#pragma unroll
    for (int i = 0; i < 8; ++i) v[i] = __builtin_nontemporal_load((const f32x4*)(W + (size_t)(k0 + 8 * i + (lane >> 3)) * N + n0 + 4 * (lane & 7)));
#pragma unroll
    for (int i = 0; i < 8; ++i) { LAS float* p = scr + (8 * i + (lane >> 3)) * 33 + 4 * (lane & 7); p[0] = v[i].x; p[1] = v[i].y; p[2] = v[i].z; p[3] = v[i].w; }
    asm volatile("s_waitcnt lgkmcnt(0)" ::: "memory");
    const int n = lane >> 1, hf = lane & 1; const LAS float* s = scr + (32 * hf) * 33 + n;
    u32x4 o0, o1;
    o0.x = pk4_fp8(s[0 * 33], s[1 * 33], s[2 * 33], s[3 * 33], S_W);     o0.y = pk4_fp8(s[4 * 33], s[5 * 33], s[6 * 33], s[7 * 33], S_W);
    o0.z = pk4_fp8(s[8 * 33], s[9 * 33], s[10 * 33], s[11 * 33], S_W);   o0.w = pk4_fp8(s[12 * 33], s[13 * 33], s[14 * 33], s[15 * 33], S_W);
    o1.x = pk4_fp8(s[16 * 33], s[17 * 33], s[18 * 33], s[19 * 33], S_W); o1.y = pk4_fp8(s[20 * 33], s[21 * 33], s[22 * 33], s[23 * 33], S_W);
    o1.z = pk4_fp8(s[24 * 33], s[25 * 33], s[26 * 33], s[27 * 33], S_W); o1.w = pk4_fp8(s[28 * 33], s[29 * 33], s[30 * 33], s[31 * 33], S_W);
    unsigned char* dst = WT + (size_t)rowmap<MAP>(n0 + n) * K + k0 + 32 * hf;
    *(u32x4*)dst = o0; *(u32x4*)(dst + 16) = o1;
    asm volatile("s_waitcnt lgkmcnt(0)" ::: "memory");
}
struct QItem { const float* W; unsigned char* WT; float* scl; int N, n0, map; };
constexpr int NQ_IN = P1_I8 ? DIN / 32 : 0, NQ_GU = MOE1_I8 ? NE * 64 : 0, NQ = NQ_IN + NQ_GU;
constexpr bool DEFER_MOE_W = (DEFER_MOE_W_ != 0) && MOE1_I8 && MOE_FP8;
__device__ __forceinline__ QItem q_item(const float* win, const float* wgu, unsigned char* ws, int wi) {
    QItem q;
    if (wi < NQ_IN) { q.W = win; q.WT = ws + WS_WIN; q.scl = (float*)(ws + WS_WINS); q.N = DIN; q.n0 = 32 * wi; q.map = 1; }
    else { wi -= NQ_IN; const int e = wi >> 6; q.W = wgu + (size_t)e * DM * 2 * DE; q.WT = ws + WS_WGU + (size_t)e * 2 * DE * DM; q.scl = (float*)(ws + WS_WGS) + (size_t)e * 2 * DE; q.N = 2 * DE; q.n0 = 32 * (wi & 63); q.map = 2; }
    return q;
}
__device__ __forceinline__ void q_load(const QItem& q, f32x4 (&v)[16], int wave, int lane) {
#pragma unroll
    for (int i = 0; i < 16; ++i) v[i] = __builtin_nontemporal_load((const f32x4*)(q.W + (size_t)(128 * wave + 8 * i + (lane >> 3)) * q.N + q.n0 + 4 * (lane & 7)));
}
__device__ __forceinline__ void quant_cols_loop(const float* win, const float* wgu, unsigned char* ws, LAS unsigned char* lds, int wi0, int wi_end, int G, int wave, int lane) {
    LAS float* s = (LAS float*)lds; LAS float* pmax = (LAS float*)(lds + 1024 * 33 * 4);
    int wi = wi0; if (wi >= wi_end) return;
    QItem q = q_item(win, wgu, ws, wi); f32x4 v[16]; q_load(q, v, wave, lane);
    for (;;) {
#pragma unroll
        for (int i = 0; i < 16; ++i) { LAS float* p = s + (128 * wave + 8 * i + (lane >> 3)) * 33 + 4 * (lane & 7); p[0] = v[i].x; p[1] = v[i].y; p[2] = v[i].z; p[3] = v[i].w; }
        lds_barrier();
        const int nw = wi + G; const bool more = nw < wi_end; QItem qn = q;
        if (more) { qn = q_item(win, wgu, ws, nw); q_load(qn, v, wave, lane); }
        const int n = lane & 31, kb = 128 * wave + 64 * (lane >> 5);
        float x[64]; float am = 0.f;
#pragma unroll
        for (int kk = 0; kk < 64; ++kk) { x[kk] = s[(kb + kk) * 33 + n]; am = fmaxf(am, fabsf(x[kk])); }
        pmax[(2 * wave + (lane >> 5)) * 32 + n] = am;
        lds_barrier();
        am = 0.f;
#pragma unroll
        for (int p = 0; p < 16; ++p) am = fmaxf(am, pmax[p * 32 + n]);
        const float inv = am > 0.f ? 127.0f / am : 0.f;
        const int r = q.map == 1 ? rowmap<1>(q.n0 + n) : rowmap<2>(q.n0 + n);
        if (wave == 0 && lane < 32) q.scl[r] = am * (1.0f / 127.0f);
        unsigned char* dst = q.WT + (size_t)r * 1024 + kb;
#pragma unroll
        for (int qq = 0; qq < 4; ++qq) { u32x4 o;
            o.x = pk4_i8(x[16 * qq + 0] * inv, x[16 * qq + 1] * inv, x[16 * qq + 2] * inv, x[16 * qq + 3] * inv);   o.y = pk4_i8(x[16 * qq + 4] * inv, x[16 * qq + 5] * inv, x[16 * qq + 6] * inv, x[16 * qq + 7] * inv);
            o.z = pk4_i8(x[16 * qq + 8] * inv, x[16 * qq + 9] * inv, x[16 * qq + 10] * inv, x[16 * qq + 11] * inv); o.w = pk4_i8(x[16 * qq + 12] * inv, x[16 * qq + 13] * inv, x[16 * qq + 14] * inv, x[16 * qq + 15] * inv);
            *(u32x4*)(dst + 16 * qq) = o; }
        if (!more) break;
        q = qn; wi = nw;
    }
    lds_barrier();
}
__device__ __forceinline__ void rms_row_to_bf16(const float* xrow, const float* w, bf16_t* orow, int lane) {
    const f32x4* xr = (const f32x4*)xrow + lane; const f32x4* wr = (const f32x4*)w + lane;
    f32x4 v[4]; float s = 0.f;
#pragma unroll
    for (int j = 0; j < 4; ++j) { v[j] = __builtin_nontemporal_load(xr + 64 * j); s += (v[j].x * v[j].x + v[j].y * v[j].y) + (v[j].z * v[j].z + v[j].w * v[j].w); }
    const float rstd = 1.0f / sqrtf(wave_sum(s) * (1.0f / DM) + RMS_EPS);
    u32x2* o8 = (u32x2*)orow + lane;
#pragma unroll
    for (int j = 0; j < 4; ++j) { const f32x4 ww = wr[64 * j]; u32x2 o; o.x = pk2(v[j].x * rstd * ww.x, v[j].y * rstd * ww.y); o.y = pk2(v[j].z * rstd * ww.z, v[j].w * rstd * ww.w); o8[64 * j] = o; }
}
__device__ __forceinline__ void rms_row_to_i8(const float* xrow, const float* w, unsigned char* orow, float* sc, int lane) {
    const f32x4* xr = (const f32x4*)xrow + lane; const f32x4* wr = (const f32x4*)w + lane;
    f32x4 v[4]; float s = 0.f;
#pragma unroll
    for (int j = 0; j < 4; ++j) { v[j] = __builtin_nontemporal_load(xr + 64 * j); s += (v[j].x * v[j].x + v[j].y * v[j].y) + (v[j].z * v[j].z + v[j].w * v[j].w); }
    const float rstd = 1.0f / sqrtf(wave_sum(s) * (1.0f / DM) + RMS_EPS);
    float am = 0.f;
#pragma unroll
    for (int j = 0; j < 4; ++j) { const f32x4 ww = wr[64 * j]; v[j] = v[j] * rstd * ww; am = fmaxf(fmaxf(am, fmaxf(fabsf(v[j].x), fabsf(v[j].y))), fmaxf(fabsf(v[j].z), fabsf(v[j].w))); }
    am = wave_max(am); const float inv = am > 0.f ? 127.0f / am : 0.f;
    unsigned* o4 = (unsigned*)orow + lane;
#pragma unroll
    for (int j = 0; j < 4; ++j) o4[64 * j] = pk4_i8(v[j].x * inv, v[j].y * inv, v[j].z * inv, v[j].w * inv);
    if (lane == 0) *sc = am * (1.0f / 127.0f);
}

__device__ __forceinline__ void p0_prologue(const Frame& F0, const Args& a) {
    const Frame F = fresh(F0);
    unsigned char* ws = a.ws;
    LAS float* scr = (LAS float*)(F.lds + F.wave * 16384);
    const int gw = F.bid * 8 + F.wave, NGW = F.G * 8;
    constexpr int I_IN = P1_I8 ? 0 : 16 * (DIN / 32), I_UP = 8 * 32, I_O = 16 * 32, I_GU = MOE1_I8 ? 0 : 16 * 64, I_D = 16 * 32;
    constexpr int NITEMS = I_IN + 2 * I_UP + I_O + NE * (I_GU + (DEFER_MOE_W ? 0 : I_D));
    for (int it = gw; it < NITEMS; it += NGW) {
        int r = it;
        if (r < I_IN) { transpose_item<1>(a.in[I_WIN], DM, DIN, (bf16_t*)(ws + WS_WIN), scr, r, F.lane); continue; } r -= I_IN;
        if (r < I_UP) { transpose_item<0>(a.in[I_MUP], 512, DM, (bf16_t*)(ws + WS_MUP), scr, r, F.lane, 1024); continue; } r -= I_UP;
        if (r < I_UP) { transpose_item<0>(a.in[I_HUP], 512, DM, (bf16_t*)(ws + WS_MUP) + 512, scr, r, F.lane, 1024); continue; } r -= I_UP;
        if (r < I_O) { transpose_item<0>(a.in[I_WOUT], DM, DM, (bf16_t*)(ws + WS_WOUT), scr, r, F.lane); continue; } r -= I_O;
        if (I_GU > 0 && r < NE * I_GU) { const int e = r / (I_GU > 0 ? I_GU : 1);
            if constexpr (MOE_FP8) transpose_item_fp8<2>(a.in[I_WGU] + (size_t)e * DM * 2 * DE, DM, 2 * DE, (unsigned char*)(ws + WS_WGU) + (size_t)e * 2 * DE * DM, scr, r % (I_GU > 0 ? I_GU : 1), F.lane);
            else transpose_item<2>(a.in[I_WGU] + (size_t)e * DM * 2 * DE, DM, 2 * DE, (bf16_t*)(ws + WS_WGU) + (size_t)e * 2 * DE * DM, scr, r % (I_GU > 0 ? I_GU : 1), F.lane);
            continue; } r -= NE * I_GU;
        { const int e = r / I_D;
            if constexpr (MOE_FP8) transpose_item_fp8<0>(a.in[I_WD] + (size_t)e * DE * DM, DE, DM, (unsigned char*)(ws + WS_WD) + (size_t)e * DM * DE, scr, r % I_D, F.lane);
            else transpose_item<0>(a.in[I_WD] + (size_t)e * DE * DM, DE, DM, (bf16_t*)(ws + WS_WD) + (size_t)e * DM * DE, scr, r % I_D, F.lane); }
    }
    if constexpr (P1_I8) { for (int m = gw; m < NTOK; m += NGW) rms_row_to_i8(a.in[I_X] + (size_t)m * DM, a.in[I_N1], ws + WS_XN + (size_t)m * DM, (float*)(ws + WS_XS) + m, F.lane); }
    else { for (int m = gw; m < NTOK; m += NGW) rms_row_to_bf16(a.in[I_X] + (size_t)m * DM, a.in[I_N1], (bf16_t*)(ws + WS_XN) + (size_t)m * DM, F.lane); }
    if constexpr (NQ > 0) {
        __syncthreads();
        quant_cols_loop(a.in[I_WIN], a.in[I_WGU], ws, F.lds, F.bid, DEFER_MOE_W ? NQ_IN : NQ, F.G, F.wave, F.lane);
    }
    float* rope = (float*)(ws + WS_ROPE);
    for (int idx = F.bid * 512 + F.tid; idx < SEQ * 32; idx += F.G * 512) {
        const int pos = idx >> 5, i = idx & 31;
        const double inv = exp2(-(double)i * (13.287712379549449 / 32.0));
        const double rev = (double)pos * inv * 0.15915494309189535;
        const float fr = (float)(rev - floor(rev));
        rope[2 * idx] = __builtin_amdgcn_cosf(fr); rope[2 * idx + 1] = __builtin_amdgcn_sinf(fr);
    }
    if (F.bid == 0) { const float* l = a.in[I_LBL]; const float a0 = l[F.tid], a1 = l[512 + F.tid]; ((float*)(ws + WS_LB))[F.tid] = 1.0f / (1.0f + __expf(a1 - a0)); }
}

__device__ __forceinline__ void moe_weight_copies(const Frame& F0, const Args& a) {
    const Frame F = fresh(F0);
    unsigned char* ws = a.ws;
    LAS float* scr = (LAS float*)(F.lds + F.wave * 16384);
    const int gw = F.bid * 8 + F.wave, NGW = F.G * 8;
    constexpr int I_D = 16 * 32;
    for (int r = gw; r < NE * I_D; r += NGW) { const int e = r / I_D;
        transpose_item_fp8<0>(a.in[I_WD] + (size_t)e * DE * DM, DE, DM, (unsigned char*)(ws + WS_WD) + (size_t)e * DM * DE, scr, r % I_D, F.lane); }
    __syncthreads();
    quant_cols_loop(a.in[I_WIN], a.in[I_WGU], ws, F.lds, NQ_IN + F.bid, NQ, F.G, F.wave, F.lane);
    __syncthreads();
}
__device__ __forceinline__ void p2_kmean(const Frame& F0, const Args& a) {
    const Frame F = fresh(F0);
    const bf16_t* proj = (const bf16_t*)(a.ws + WS_PROJ); bf16_t* km = (bf16_t*)(a.ws + WS_KMEAN);
    LAS float* red = (LAS float*)F.lds;
    for (int it = F.bid; it < 128; it += F.G) {
        const int b = it >> 4, n = it & 15;
        float s[8] = {0, 0, 0, 0, 0, 0, 0, 0};
        const bf16_t* base = proj + (size_t)(b * SEQ + n * 256 + F.wave * 32) * DIN + C_KA + F.lane * 8;
#pragma unroll 8
        for (int r = 0; r < 32; ++r) { const u32x4 w = *(const u32x4*)(base + (size_t)r * DIN); f32x4 x0, x1; unpack8(w, x0, x1);
            s[0] += x0[0]; s[1] += x0[1]; s[2] += x0[2]; s[3] += x0[3]; s[4] += x1[0]; s[5] += x1[1]; s[6] += x1[2]; s[7] += x1[3]; }
#pragma unroll
        for (int j = 0; j < 8; ++j) red[F.wave * 512 + F.lane * 8 + j] = s[j];
        __syncthreads();
        float t = 0.f;
#pragma unroll
        for (int w = 0; w < 8; ++w) t += red[w * 512 + F.tid];
        km[((size_t)b * 64 + n) * 512 + F.tid] = (bf16_t)f2bf(t * (1.0f / 256.0f));
        km[((size_t)b * 64 + n + 16) * 512 + F.tid] = 0; km[((size_t)b * 64 + n + 32) * 512 + F.tid] = 0; km[((size_t)b * 64 + n + 48) * 512 + F.tid] = 0;
        __syncthreads();
    }
}

constexpr int HP = 72, HQ = 136;
__device__ __forceinline__ void h2_scan(const Frame& F0, const Args& a) {
    const Frame F = fresh(F0);
    bf16_t* hst = (bf16_t*)(a.ws + WS_HST); const float* gdec = (const float*)(a.ws + WS_GDEC);
    LAS float* G = (LAS float*)F.lds;
    for (int base = F.bid * 512; base < 32 * 128 * 32; base += F.G * 512) {
        const int idx = base + F.tid, bh = idx >> 12, v = (idx >> 5) & 127, d4 = idx & 31;
        { const f32x4* gp = (const f32x4*)(gdec + (size_t)bh * 64 * 128) + F.tid;
#pragma unroll
          for (int j = 0; j < 4; ++j) *(LAS f32x4*)(G + (F.tid + 512 * j) * 4) = gp[512 * j]; }
        lds_barrier();
        bf16_t* p = hst + ((size_t)bh * 64 * 128 + v) * 128 + d4 * 4;
        f32x4 s = {0.f, 0.f, 0.f, 0.f};
#pragma unroll 1
        for (int c0 = 0; c0 < 64; c0 += 16) {
            u32x2 u[16];
#pragma unroll
            for (int j = 0; j < 16; ++j) u[j] = __builtin_nontemporal_load((const u32x2*)(p + (size_t)(c0 + j) * 16384));
#pragma unroll
            for (int j = 0; j < 16; ++j) { const f32x4 gg = *(const LAS f32x4*)(G + (c0 + j) * 128 + d4 * 4);
                u32x2 w; w.x = pk2(s[0], s[1]); w.y = pk2(s[2], s[3]); *(u32x2*)(p + (size_t)(c0 + j) * 16384) = w;
                s = gg * s + (f32x4){bf_lo(u[j].x), bf_hi(u[j].x), bf_lo(u[j].y), bf_hi(u[j].y)}; }
        }
        lds_barrier();
    }
}
#define H_CVT_LF(LFR, LH) do { _Pragma("unroll") for (int j_ = 0; j_ < 2; ++j_) { const f32x8 f_ = __builtin_convertvector(LH[j_], f32x8); LFR[2 * j_] = (f32x4){f_[0], f_[1], f_[2], f_[3]}; LFR[2 * j_ + 1] = (f32x4){f_[4], f_[5], f_[6], f_[7]}; } } while (0)
constexpr int LFP = 132;
#define H_LOAD_LQI(it_, LFR, QR, IR, WITHQ) do { const int bh_ = (it_) >> 6, c_ = (it_) & 63; const size_t r_ = (size_t)(bh_ >> 2) * SEQ + c_ * 64 + t_r; const int hh_ = (bh_ & 3) * 128 + 16 * seg; \
    _Pragma("unroll") for (int j_ = 0; j_ < 2; ++j_) LFR[j_] = __builtin_nontemporal_load((const h16x8*)((const _Float16*)logf + r_ * 512 + hh_ + 8 * j_));     \
    _Pragma("unroll") for (int j_ = 0; j_ < 2; ++j_) { if (WITHQ) QR[j_] = __builtin_nontemporal_load((const u32x4*)(proj + r_ * DIN + C_QB + hh_ + 8 * j_)); IR[j_] = __builtin_nontemporal_load((const u32x4*)(proj + r_ * DIN + C_IB + hh_ + 8 * j_)); } } while (0)
__device__ __forceinline__ void scatter_it(LAS bf16_t* It, const u32x4 (&ir)[2], int seg, int t_r) {
    const int tsw = (((t_r >> 3) ^ seg) << 3) | (t_r & 7);
#pragma unroll
    for (int j = 0; j < 2; ++j) { const unsigned w[4] = {ir[j].x, ir[j].y, ir[j].z, ir[j].w};
#pragma unroll
        for (int q = 0; q < 4; ++q) { It[(16 * seg + 8 * j + 2 * q) * HP + tsw] = (bf16_t)(w[q] & 0xffffu); It[(16 * seg + 8 * j + 2 * q + 1) * HP + tsw] = (bf16_t)(w[q] >> 16); } }
}
__device__ __forceinline__ void h1_local_states_p(const Frame& F0, const Args& a) {
    const Frame F = fresh(F0);
    const bf16_t* proj = (const bf16_t*)(a.ws + WS_PROJ); const float* logf = (const float*)(a.ws + WS_LOGF);
    bf16_t* hst = (bf16_t*)(a.ws + WS_HST); float* gdec = (float*)(a.ws + WS_GDEC);
    LAS float* LF = (LAS float*)F.lds; LAS bf16_t* Kp = (LAS bf16_t*)(F.lds + 64 * LFP * 4); LAS bf16_t* It = Kp + 128 * HP;
    const int t_r = F.tid >> 3, seg = F.tid & 7, l15 = F.lane & 15, lq = F.lane >> 4;
    f32x4 lfr[4]; h16x8 lhr[2], lhn[2]; u32x4 qdum[2], ir[2], in_[2];
    int it = F.bid;
    if (it < 2048) H_LOAD_LQI(it, lhr, qdum, ir, false);
    for (; it < 2048; it += F.G) {
        const int bh = it >> 6, c = it & 63;
        H_CVT_LF(lfr, lhr);
#pragma unroll
        for (int j = 0; j < 4; ++j) *(LAS f32x4*)(LF + t_r * LFP + 16 * seg + 4 * j) = lfr[j];
        scatter_it(It, ir, seg, t_r);
        const int itn = it + F.G;
        if (itn < 2048) H_LOAD_LQI(itn, lhn, qdum, in_, false);
        lds_barrier();
        if (F.tid < 128) { float run = 0.f;
#pragma unroll 16
            for (int t = 0; t < 64; ++t) { run += LF[t * LFP + F.tid]; LF[t * LFP + F.tid] = run; }
            gdec[((size_t)bh * 64 + c) * 128 + F.tid] = __expf(run); }
        lds_barrier();
        {
            f32x4 bb[4], bl[4];
#pragma unroll
            for (int j = 0; j < 4; ++j) { bb[j] = *(const LAS f32x4*)(LF + t_r * LFP + 16 * seg + 4 * j); bl[j] = *(const LAS f32x4*)(LF + 63 * LFP + 16 * seg + 4 * j); }
#pragma unroll
            for (int j = 0; j < 4; ++j)
#pragma unroll
                for (int q = 0; q < 4; ++q) { const float kv = (1.0f - __expf(lfr[j][q])) * __expf(bl[j][q] - bb[j][q]); Kp[(16 * seg + 4 * j + q) * HP + ((((t_r >> 3) ^ seg) << 3) | (t_r & 7))] = (bf16_t)f2bf(kv); }
        }
        lds_barrier();
        bf16x8 af[2];
#pragma unroll
        for (int ks = 0; ks < 2; ++ks) af[ks] = *(const LAS bf16x8*)(Kp + (16 * F.wave + l15) * HP + (((ks * 4 + lq) ^ F.wave) << 3));
#pragma unroll
        for (int vt = 0; vt < 8; ++vt) {
            f32x4 acc = {0.f, 0.f, 0.f, 0.f};
#pragma unroll
            for (int ks = 0; ks < 2; ++ks) { const bf16x8 bfr = *(const LAS bf16x8*)(It + (16 * vt + l15) * HP + (((ks * 4 + lq) ^ vt) << 3)); acc = __builtin_amdgcn_mfma_f32_16x16x32_bf16(af[ks], bfr, acc, 0, 0, 0); }
            u32x2 w; w.x = pk2(acc[0], acc[1]); w.y = pk2(acc[2], acc[3]);
            *(u32x2*)(hst + (((size_t)bh * 64 + c) * 128 + 16 * vt + l15) * 128 + 16 * F.wave + 4 * lq) = w;
        }
        lds_barrier();
        lhr[0] = lhn[0]; lhr[1] = lhn[1];
        ir[0] = in_[0]; ir[1] = in_[1];
    }
}
#define H3_LOAD_SF(it_, SF) do { const int bh_ = (it_) >> 6, c_ = (it_) & 63; \
    _Pragma("unroll") for (int ks_ = 0; ks_ < 4; ++ks_) SF[ks_] = __builtin_nontemporal_load((const bf16x8*)(hst + (((size_t)bh_ * 64 + c_) * 128 + 16 * w + l15) * 128 + ks_ * 32 + 8 * lq)); } while (0)
#define H3_LOAD_GR(it_, GR) do { const int bh_ = (it_) >> 6, c_ = (it_) & 63; const size_t row0_ = (size_t)(bh_ >> 2) * SEQ + c_ * 64; \
    _Pragma("unroll") for (int tt_ = 0; tt_ < 4; ++tt_) GR[tt_] = __builtin_nontemporal_load((const u32x2*)(proj + (row0_ + 16 * tt_ + l15) * DIN + C_GB + (bh_ & 3) * 128 + 16 * w + 4 * lq)); } while (0)
#define H3_LOAD_Q(it_, QR) do { const int bh_ = (it_) >> 6, c_ = (it_) & 63; const size_t r_ = (size_t)(bh_ >> 2) * SEQ + c_ * 64 + t_r; const int hh_ = (bh_ & 3) * 128 + 16 * seg; \
    _Pragma("unroll") for (int j_ = 0; j_ < 2; ++j_) QR[j_] = __builtin_nontemporal_load((const u32x4*)(proj + r_ * DIN + C_QB + hh_ + 8 * j_)); } while (0)
#define H3_LOAD_LATE(it_, SF, GR) do { H3_LOAD_SF(it_, SF); H3_LOAD_GR(it_, GR); } while (0)
__device__ __forceinline__ void h3_outputs_p(const Frame& F0, const Args& a) {
    const Frame F = fresh(F0);
    const bf16_t* proj = (const bf16_t*)(a.ws + WS_PROJ); const float* logf = (const float*)(a.ws + WS_LOGF);
    const bf16_t* hst = (const bf16_t*)(a.ws + WS_HST); bf16_t* yb = (bf16_t*)(a.ws + WS_YA); const float* nw = a.in[I_HNW];
    LAS float* LF = (LAS float*)F.lds; LAS bf16_t* Qt = (LAS bf16_t*)(F.lds + 64 * LFP * 4); LAS bf16_t* Kt = Qt + 64 * HQ; LAS bf16_t* It = Kt + 64 * HQ; LAS bf16_t* Pm = It + 128 * HP;
    LAS float* rsq = (LAS float*)(Pm + 64 * HP);
    const int t_r = F.tid >> 3, seg = F.tid & 7, l15 = F.lane & 15, lq = F.lane >> 4, w = F.wave;
    f32x4 lfr[4]; h16x8 lhr[2], lhn[2]; u32x4 qr[2], qn[2], ir[2], in_[2]; bf16x8 sf[4], sfn[4]; u32x2 gr[4], grn[4];
    int it = F.bid;
    if (it < 2048) { H_LOAD_LQI(it, lhr, qr, ir, true); H3_LOAD_LATE(it, sf, gr); }
    for (; it < 2048; it += F.G) {
        const int bh = it >> 6, c = it & 63, b = bh >> 2, h = bh & 3; const size_t row0 = (size_t)b * SEQ + c * 64;
        H_CVT_LF(lfr, lhr);
#pragma unroll
        for (int j = 0; j < 4; ++j) *(LAS f32x4*)(LF + t_r * LFP + 16 * seg + 4 * j) = lfr[j];
        scatter_it(It, ir, seg, t_r);
        const int itn = it + F.G;
        if (itn < 2048) H_LOAD_LQI(itn, lhn, qn, in_, false);
        lds_barrier();
        if (itn < 2048) H3_LOAD_Q(itn, qn);
        if (F.tid < 128) { float run = 0.f;
#pragma unroll 16
            for (int t = 0; t < 64; ++t) { run += LF[t * LFP + F.tid]; LF[t * LFP + F.tid] = run; } }
        lds_barrier();
        if (itn < 2048) H3_LOAD_SF(itn, sfn);
        {
            float qv[16], kv[16];
#pragma unroll
            for (int j = 0; j < 4; ++j) { const f32x4 bb = *(const LAS f32x4*)(LF + t_r * LFP + 16 * seg + 4 * j);
#pragma unroll
                for (int q = 0; q < 4; ++q) { const float eb = __expf(bb[q]); const unsigned qw = (j < 2 ? qr[0] : qr[1])[(2 * j + (q >> 1)) & 3];
                    const float qs = (q & 1) ? bf_hi(qw) : bf_lo(qw);
                    qv[4 * j + q] = qs * eb; kv[4 * j + q] = (1.0f - __expf(lfr[j][q])) * __builtin_amdgcn_rcpf(eb); } }
            u32x4 o0, o1;
            o0.x = pk2(qv[0], qv[1]); o0.y = pk2(qv[2], qv[3]); o0.z = pk2(qv[4], qv[5]); o0.w = pk2(qv[6], qv[7]); o1.x = pk2(qv[8], qv[9]); o1.y = pk2(qv[10], qv[11]); o1.z = pk2(qv[12], qv[13]); o1.w = pk2(qv[14], qv[15]);
            *(LAS u32x4*)(Qt + t_r * HQ + 16 * seg) = o0; *(LAS u32x4*)(Qt + t_r * HQ + 16 * seg + 8) = o1;
            o0.x = pk2(kv[0], kv[1]); o0.y = pk2(kv[2], kv[3]); o0.z = pk2(kv[4], kv[5]); o0.w = pk2(kv[6], kv[7]); o1.x = pk2(kv[8], kv[9]); o1.y = pk2(kv[10], kv[11]); o1.z = pk2(kv[12], kv[13]); o1.w = pk2(kv[14], kv[15]);
            *(LAS u32x4*)(Kt + t_r * HQ + 16 * seg) = o0; *(LAS u32x4*)(Kt + t_r * HQ + 16 * seg + 8) = o1;
        }
        lds_barrier();
        if (itn < 2048) H3_LOAD_GR(itn, grn);
        {
            const int tt = w >> 1; bf16x8 qa[4];
#pragma unroll
            for (int ks = 0; ks < 4; ++ks) qa[ks] = *(const LAS bf16x8*)(Qt + (16 * tt + l15) * HQ + ks * 32 + 8 * lq);
#pragma unroll
            for (int j = 0; j < 2; ++j) {
                const int st = (w & 1) * 2 + j; f32x4 acc = {0.f, 0.f, 0.f, 0.f};
#pragma unroll
                for (int ks = 0; ks < 4; ++ks) { const bf16x8 kb = *(const LAS bf16x8*)(Kt + (16 * st + l15) * HQ + ks * 32 + 8 * lq); acc = __builtin_amdgcn_mfma_f32_16x16x32_bf16(qa[ks], kb, acc, 0, 0, 0); }
                const int s = 16 * st + l15;
#pragma unroll
                for (int r = 0; r < 4; ++r) { const int t = 16 * tt + 4 * lq + r; Pm[t * HP + s] = (bf16_t)(s <= t ? f2bf(acc[r]) : 0u); }
            }
        }
        lds_barrier();
        f32x4 o[4];
        {
            bf16x8 ia[2];
#pragma unroll
            for (int ks = 0; ks < 2; ++ks) ia[ks] = *(const LAS bf16x8*)(It + (16 * w + l15) * HP + (((ks * 4 + lq) ^ w) << 3));
#pragma unroll
            for (int tt = 0; tt < 4; ++tt) {
                f32x4 acc = {0.f, 0.f, 0.f, 0.f};
#pragma unroll
                for (int ks = 0; ks < 2; ++ks) { const bf16x8 pb = *(const LAS bf16x8*)(Pm + (16 * tt + l15) * HP + ks * 32 + 8 * lq); acc = __builtin_amdgcn_mfma_f32_16x16x32_bf16(ia[ks], pb, acc, 0, 0, 0); }
#pragma unroll
                for (int ks = 0; ks < 4; ++ks) { const bf16x8 qb = *(const LAS bf16x8*)(Qt + (16 * tt + l15) * HQ + ks * 32 + 8 * lq); acc = __builtin_amdgcn_mfma_f32_16x16x32_bf16(sf[ks], qb, acc, 0, 0, 0); }
                o[tt] = acc;
                float sq = (acc[0] * acc[0] + acc[1] * acc[1]) + (acc[2] * acc[2] + acc[3] * acc[3]);
                sq += __shfl_xor(sq, 16); sq += __shfl_xor(sq, 32);
                if (F.lane < 16) rsq[w * 64 + 16 * tt + F.lane] = sq;
            }
        }
        lds_barrier();
        const int v0 = 16 * w + 4 * lq; const f32x4 nw4 = *(const f32x4*)(nw + h * 128 + v0);
#pragma unroll
        for (int tt = 0; tt < 4; ++tt) {
            const int t = 16 * tt + l15; float tot = 0.f;
#pragma unroll
            for (int ww = 0; ww < 8; ++ww) tot += rsq[ww * 64 + t];
            const float rstd = __builtin_amdgcn_rsqf(tot * (1.0f / 128.0f) + RMS_EPS);
            const u32x2 gg = gr[tt];
            u32x2 y; y.x = pk2(o[tt][0] * rstd * nw4[0] * bf_lo(gg.x), o[tt][1] * rstd * nw4[1] * bf_hi(gg.x)); y.y = pk2(o[tt][2] * rstd * nw4[2] * bf_lo(gg.y), o[tt][3] * rstd * nw4[3] * bf_hi(gg.y));
            *(u32x2*)(yb + (row0 + t) * 1024 + 512 + h * 128 + v0) = y;
        }
        lds_barrier();
        lhr[0] = lhn[0]; lhr[1] = lhn[1];
        qr[0] = qn[0]; qr[1] = qn[1]; ir[0] = in_[0]; ir[1] = in_[1];
#pragma unroll
        for (int j = 0; j < 4; ++j) { sf[j] = sfn[j]; gr[j] = grn[j]; }
    }
}
#undef H3_LOAD_LATE
#undef H3_LOAD_SF
#undef H3_LOAD_Q
#undef H3_LOAD_GR

#include <hip/hip_bf16.h>
#include <cmath>
namespace attn_body {
using bf16=__hip_bfloat16;
using bf16x8=__attribute__((ext_vector_type(8)))short;
using s16x4=__attribute__((ext_vector_type(4)))short;
using f32x16=__attribute__((ext_vector_type(16)))float;
using u32x4=__attribute__((ext_vector_type(4)))unsigned;
constexpr int BATCH=8,NHEAD=8,SEQ=4096,D=64,PIN=5632,POUT=1024,PKM=512;
constexpr int NW=8,QBLK=32,QB=QBLK*NW,KVBLK=64,NQB=SEQ/QB;
constexpr int ATTN_UNIT_ROWS=QB;
__device__ __forceinline__ int crow(int r,int hi){return (r&3)+8*(r>>2)+4*hi;}
#define SBAR() __builtin_amdgcn_sched_barrier(0)
__device__ __forceinline__ void cmask(f32x16&p0,f32x16&p1,int jb,int qrel,int hi){
  const float NEG=-INFINITY; int kb=64*jb+4*hi;
  #pragma unroll
  for(int r=0;r<16;++r){int kv=kb+(r&3)+8*(r>>2); if(kv>qrel)p0[r]=NEG; if(kv+32>qrel)p1[r]=NEG;}
}

__device__ __forceinline__ void smask(f32x16&p0,f32x16&p1,unsigned selm,int n){ if(!((selm>>n)&1u)){ const float NEG=-INFINITY;
  #pragma unroll
  for(int r=0;r<16;++r){p0[r]=NEG;p1[r]=NEG;} } }
constexpr int NSLOT=3, SLOTB=8192;
constexpr int LDS_K=0, LDS_V=NSLOT*SLOTB, LDS_WS=2*NSLOT*SLOTB, LDS_OST=LDS_WS+NW*64*4, LDS_BYTES=LDS_OST+NW*4096;
constexpr float C2=0.125f*1.4426950408889634f;
__device__ __forceinline__ void glds16(const void*gsrc,unsigned lds_dst){unsigned keep;
  asm volatile("s_mov_b32 %0, m0\n\ts_mov_b32 m0, %2\n\ts_nop 0\n\tglobal_load_lds_dwordx4 %1, off\n\ts_mov_b32 m0, %0":"=&s"(keep):"v"(gsrc),"s"(lds_dst):"memory");}
__device__ __forceinline__ float max3f(float a,float b,float c){float r;asm("v_max3_f32 %0, %1, %2, %3":"=v"(r):"v"(a),"v"(b),"v"(c));return r;}
__device__ __forceinline__ float max2f(float a,float b){float r;asm("v_max_f32_e32 %0, %1, %2":"=v"(r):"v"(a),"v"(b));return r;}
__device__ __forceinline__ float fadd_s(float a,float b){float r;asm("v_add_f32_e32 %0, %1, %2":"=v"(r):"v"(a),"v"(b));return r;}
__device__ __forceinline__ float fsub_s(float a,float b){float r;asm("v_sub_f32_e32 %0, %1, %2":"=v"(r):"v"(a),"v"(b));return r;}
typedef float f32x2_t __attribute__((ext_vector_type(2))); typedef __bf16 bf16x2_t __attribute__((ext_vector_type(2)));
__device__ __forceinline__ unsigned cvtpk_s(float lo,float hi){f32x2_t v={lo,hi};bf16x2_t b=__builtin_convertvector(v,bf16x2_t);return __builtin_bit_cast(unsigned,b);}
#define WAIT_BAR(N) asm volatile("s_waitcnt vmcnt(" #N ") lgkmcnt(0)\n\ts_barrier":::"memory")

__device__ __forceinline__ void qkt(f32x16&p0,f32x16&p1,const char*Kslot,const bf16x8*qr,int r32,int hi){
  const char*kb=Kslot+hi*1024+r32*16;
  #pragma unroll
  for(int d0=0;d0<4;++d0){
    const bf16x8 b0=*reinterpret_cast<const bf16x8*>(kb+d0*2048);
    const bf16x8 b1=*reinterpret_cast<const bf16x8*>(kb+d0*2048+512);
    if(d0==0){p0=__builtin_amdgcn_mfma_f32_32x32x16_bf16(b0,qr[0],f32x16{},0,0,0);p1=__builtin_amdgcn_mfma_f32_32x32x16_bf16(b1,qr[0],f32x16{},0,0,0);}
    else{p0=__builtin_amdgcn_mfma_f32_32x32x16_bf16(b0,qr[d0],p0,0,0,0);p1=__builtin_amdgcn_mfma_f32_32x32x16_bf16(b1,qr[d0],p1,0,0,0);}}
}
typedef __attribute__((address_space(3))) const char* lds_cptr;
typedef short v4i16_t __attribute__((ext_vector_type(4)));
__device__ __forceinline__ void kload8(bf16x8*kf,lds_cptr kp){
  kf[0]=*(const __attribute__((address_space(3))) bf16x8*)(kp);      kf[1]=*(const __attribute__((address_space(3))) bf16x8*)(kp+512);
  kf[2]=*(const __attribute__((address_space(3))) bf16x8*)(kp+2048); kf[3]=*(const __attribute__((address_space(3))) bf16x8*)(kp+2560);
  kf[4]=*(const __attribute__((address_space(3))) bf16x8*)(kp+4096); kf[5]=*(const __attribute__((address_space(3))) bf16x8*)(kp+4608);
  kf[6]=*(const __attribute__((address_space(3))) bf16x8*)(kp+6144); kf[7]=*(const __attribute__((address_space(3))) bf16x8*)(kp+6656);
}
__device__ __forceinline__ void kload2(bf16x8*kf,lds_cptr kp,int j){ kf[2*j]=*(const __attribute__((address_space(3))) bf16x8*)(kp+j*2048); kf[2*j+1]=*(const __attribute__((address_space(3))) bf16x8*)(kp+j*2048+512); }
__device__ __forceinline__ s16x4 vtr(lds_cptr p){ return __builtin_bit_cast(s16x4,__builtin_amdgcn_ds_read_tr16_b64_v4i16((__attribute__((address_space(3))) v4i16_t*)p)); }
__device__ __forceinline__ float rowmax(const f32x16&p0,const f32x16&p1){
  float a=max3f(p0[0],p0[1],p1[0]),b=max3f(p0[2],p0[3],p1[1]);a=max3f(a,p1[2],p1[3]);
  #pragma unroll
  for(int r=4;r<16;r+=4){a=max3f(a,p0[r],p0[r+1]);b=max3f(b,p0[r+2],p0[r+3]);a=max3f(a,p1[r],p1[r+1]);b=max3f(b,p1[r+2],p1[r+3]);}
  const float m=max2f(a,b);
  auto rr=__builtin_amdgcn_permlane32_swap(__float_as_uint(m),__float_as_uint(m),false,false);
  return max2f(__uint_as_float(rr[0]),__uint_as_float(rr[1]));
}
__device__ __forceinline__ void pv(f32x16*o,int vb,bf16x8 pa0,bf16x8 pa1,bf16x8 pa2,bf16x8 pa3){
  #pragma unroll
  for(int d0=0;d0<2;++d0){s16x4 lo[4],hi[4];
    #pragma unroll
    for(int ks=0;ks<4;++ks){
      asm volatile("ds_read_b64_tr_b16 %0,%1 offset:%c2":"=&v"(lo[ks]):"v"(vb),"i"(d0*4096+ks*1024):"memory");
      asm volatile("ds_read_b64_tr_b16 %0,%1 offset:%c2":"=&v"(hi[ks]):"v"(vb),"i"(d0*4096+ks*1024+512):"memory");}
    asm volatile("s_waitcnt lgkmcnt(0)":::"memory");SBAR();
    #define PK(k) (bf16x8){lo[k][0],lo[k][1],lo[k][2],lo[k][3],hi[k][0],hi[k][1],hi[k][2],hi[k][3]}
    o[d0]=__builtin_amdgcn_mfma_f32_32x32x16_bf16(pa0,PK(0),o[d0],0,0,0);
    o[d0]=__builtin_amdgcn_mfma_f32_32x32x16_bf16(pa1,PK(1),o[d0],0,0,0);
    o[d0]=__builtin_amdgcn_mfma_f32_32x32x16_bf16(pa2,PK(2),o[d0],0,0,0);
    o[d0]=__builtin_amdgcn_mfma_f32_32x32x16_bf16(pa3,PK(3),o[d0],0,0,0);
    #undef PK
  }
}

#ifndef ATTN_STORE16
#define ATTN_STORE16(p,v) (*(u32x4*)(p)=(v))
#endif
template<int THRL> __device__ __forceinline__ void attn_unit(int wave_,int b,int h,int qb,const bf16*Q,const bf16*__restrict__ K,const bf16*__restrict__ V,const bf16*__restrict__ KM,bf16*O,char*shm){
  const int lane=lane_id_(),tid=wave_*64+lane,r32=lane&31,hi=lane>>5; const int wid=wave_;
  const long rowbase=(long)b*SEQ; const int q0=qb*QB;
  const bf16*Qw=Q+(rowbase+q0+wid*QBLK)*PIN+h*D;
  const bf16*Kh=K+rowbase*PIN+h*D,*Vh=V+rowbase*PIN+h*D;
  const unsigned lds0=(unsigned)(uintptr_t)shm;
  float*wsf=(float*)(shm+LDS_WS)+wid*64;
  const bf16*ksrc=Kh+(long)lane*PIN+wid*8;
  const bf16*kmsrc=KM+((long)b*64+lane)*PKM+h*D+wid*8;
  const bf16*vsrc=Vh+(long)(16*(wid&3)+(lane>>2))*PIN+(wid>>2)*32+(lane&3)*8;
  const unsigned kdst=lds0+LDS_K+wid*1024, vdst=lds0+LDS_V+wid*1024;
  #define DMA_K(t,slot) glds16(ksrc+(long)(t)*KVBLK*PIN,(unsigned)__builtin_amdgcn_readfirstlane(kdst+(slot)))
  #define DMA_V(t,slot) glds16(vsrc+(long)(t)*KVBLK*PIN,(unsigned)__builtin_amdgcn_readfirstlane(vdst+(slot)))
  const int vb0=(int)(lds0+LDS_V)+((lane>>4)&1)*32+(lane&3)*8+(4*hi+((lane&15)>>2))*64;
  const char*Kbase=shm+LDS_K; bf16x8 kf[8];
  const lds_cptr shm3=(lds_cptr)shm; const lds_cptr kp0=shm3+LDS_K+hi*1024+r32*16; const lds_cptr vp0=shm3+LDS_V+((lane>>4)&1)*32+(lane&3)*8+(4*hi+((lane&15)>>2))*64;
  const int NT=(q0+QB)/KVBLK;
  glds16(kmsrc,(unsigned)__builtin_amdgcn_readfirstlane(lds0+LDS_V+2*SLOTB+wid*1024));
  DMA_K(0,0);DMA_V(0,0);DMA_K(1,SLOTB);
  bf16x8 qr[4];
  #pragma unroll
  for(int d0=0;d0<4;++d0)qr[d0]=*reinterpret_cast<const bf16x8*>(&Qw[(long)r32*PIN+d0*16+hi*8]);
  float mhat=0.f,l_reg=0.f;f32x16 o[2];o[0]=f32x16{};o[1]=f32x16{};
  const int qrel=wid*QBLK+r32;
  #define CMASK(P0,P1,t) do{int jb_=(t)-(NT-4); const float sb_=(jb_>=0||((selm>>((t)>>2))&1u))?mhat:INFINITY; {const float nsb_=-sb_;P0=P0+nsb_;P1=P1+nsb_;} if(jb_>=0)cmask(P0,P1,jb_,qrel,hi);}while(0)
  bool resc=false;
  #define START(P0,P1) do{ const float rm=rowmax(P0,P1); resc=false; \
    { const float dl=(rm>-1.0e30f)?rm:0.f; mhat=fadd_s(mhat,dl); \
      _Pragma("unroll") for(int r=0;r<16;++r){P0[r]=fsub_s(P0[r],dl);P1[r]=fsub_s(P1[r],dl);} \
      } \
    _Pragma("unroll") for(int r=0;r<16;++r)P0[r]=__builtin_amdgcn_exp2f(P0[r]); }while(0)
  #define RESC() do{ if(resc){ asm volatile("s_waitcnt lgkmcnt(0)":::"memory"); \
      _Pragma("unroll") for(int d_=0;d_<2;++d_) _Pragma("unroll") for(int r=0;r<16;++r)o[d_][r]*=wsf[crow(r,hi)]; } }while(0)
  f32x16 pA0,pA1,pB0,pB1;
  int sl_prev=0,sl_cur=0,sl_next=SLOTB;
  #define ROT() do{sl_prev=sl_cur;sl_cur=sl_next;sl_next=(sl_next==(NSLOT-1)*SLOTB)?0:sl_next+SLOTB;}while(0)
  DMA_K(2,2*SLOTB);
  unsigned selm=0u;
  WAIT_BAR(4);
  { f32x16 g0,g1;
    qkt(g0,g1,shm+LDS_V+2*SLOTB,qr,r32,hi); asm volatile("s_nop 15\n\ts_nop 7":"+v"(g0),"+v"(g1));
    float gm[8],go[8],g[16];
    #pragma unroll
    for(int r=0;r<8;++r){gm[r]=g0[r];go[r]=__shfl_xor(gm[r],32);}
    #pragma unroll
    for(int j=0;j<4;++j){ g[j]=hi?go[j]:gm[j]; g[4+j]=hi?gm[j]:go[j]; g[8+j]=hi?go[4+j]:gm[4+j]; g[12+j]=hi?gm[4+j]:go[4+j]; }
    #pragma unroll
    for(int s=0;s<3;++s){ float best=-3.0e38f; int bi=-1;
      #pragma unroll
      for(int n=0;n<16;++n){ const bool ok=(n<qb)&&!((selm>>n)&1u)&&(g[n]>best); if(ok){best=g[n];bi=n;} }
      if(bi>=0)selm|=1u<<bi; } }
  WAIT_BAR(3);
  qkt(pA0,pA1,Kbase,qr,r32,hi);asm volatile("s_nop 15\n\ts_nop 7":"+v"(pA0),"+v"(pA1));CMASK(pA0,pA1,0);
  START(pA0,pA1);
  _Pragma("unroll") for(int r=0;r<16;++r)pA1[r]=__builtin_amdgcn_exp2f(pA1[r]);
  WAIT_BAR(0);
  DMA_K(3,0);DMA_V(1,SLOTB);
  ROT();
  kload8(kf,kp0+sl_cur);
  WAIT_BAR(2);
  s16x4 vlo[8],vhi[8]; u32x4 pw0,pw1,pw2,pw3;
  #define PKW(P,B) cvtpk_s(P[B],P[B+1])
  #define PAF(k) __builtin_bit_cast(bf16x8,pw##k)
  #define VFR(i) (bf16x8){vlo[i][0],vlo[i][1],vlo[i][2],vlo[i][3],vhi[i][0],vhi[i][1],vhi[i][2],vhi[i][3]}
  #define PIN(x) asm volatile("":"+v"(x))
  #define MX3(a,b,c) __builtin_fmaxf(__builtin_fmaxf((a),(b)),(c))
  #define GAPA(MF,A0,A1,A2,A3,W0,W1,PW) do{ MF; sacc+=A0; sacc+=A1; sacc+=A2; sacc+=A3; PIN(sacc); W0; W1; PIN(PW); SBAR(); }while(0)
  #define EX(v) __builtin_amdgcn_exp2f(v)
  #define GAPB(MF,X,B) do{ MF; X[B]=EX(X[B]); X[B+1]=EX(X[B+1]); X[B+2]=EX(X[B+2]); X[B+3]=EX(X[B+3]); PIN(X); SBAR(); }while(0)
  #define VRD(i) do{ vlo[i]=vtr(vp_+(((i)>>2)*4096+((i)&3)*1024)); vhi[i]=vtr(vp_+(((i)>>2)*4096+((i)&3)*1024+512)); }while(0)
  #define KRD(G,j) do{ if(G){ kload2(kf,kp0+sl_next,j); SBAR(); } }while(0)
  #define STEP(C0,C1,P0,P1,t,GK,GV,GL) do{ SBAR(); \
    const lds_cptr vp_=vp0+sl_prev; \
    VRD(0); SBAR(); float sacc=(P0[0]+P0[1]); \
    GAPA(C0=__builtin_amdgcn_mfma_f32_32x32x16_bf16(kf[0],qr[0],f32x16{},0,0,0), P0[2],P0[3],P0[4],P0[5],     pw0[0]=PKW(P0,0), pw0[1]=PKW(P0,2), pw0); \
    VRD(4); SBAR(); GAPA(C1=__builtin_amdgcn_mfma_f32_32x32x16_bf16(kf[1],qr[0],f32x16{},0,0,0), P0[6],P0[7],P0[8],P0[9],     pw0[2]=PKW(P0,4), pw0[3]=PKW(P0,6), pw0); \
    VRD(1); SBAR(); GAPA(C0=__builtin_amdgcn_mfma_f32_32x32x16_bf16(kf[2],qr[1],C0,0,0,0),   P0[10],P0[11],P0[12],P0[13], pw1[0]=PKW(P0,8), pw1[1]=PKW(P0,10), pw1); \
    VRD(5); SBAR(); GAPA(C1=__builtin_amdgcn_mfma_f32_32x32x16_bf16(kf[3],qr[1],C1,0,0,0),   P0[14],P0[15],P1[0],P1[1],   pw1[2]=PKW(P0,12),pw1[3]=PKW(P0,14), pw1); \
    VRD(2); SBAR(); GAPA(C0=__builtin_amdgcn_mfma_f32_32x32x16_bf16(kf[4],qr[2],C0,0,0,0),   P1[2],P1[3],P1[4],P1[5],     pw2[0]=PKW(P1,0), pw2[1]=PKW(P1,2), pw2); \
    VRD(6); SBAR(); GAPA(C1=__builtin_amdgcn_mfma_f32_32x32x16_bf16(kf[5],qr[2],C1,0,0,0),   P1[6],P1[7],P1[8],P1[9],     pw2[2]=PKW(P1,4), pw2[3]=PKW(P1,6), pw2); \
    VRD(3); SBAR(); GAPA(C0=__builtin_amdgcn_mfma_f32_32x32x16_bf16(kf[6],qr[3],C0,0,0,0),   P1[10],P1[11],P1[12],P1[13], pw3[0]=PKW(P1,8), pw3[1]=PKW(P1,10), pw3); \
    VRD(7); SBAR(); GAPA(C1=__builtin_amdgcn_mfma_f32_32x32x16_bf16(kf[7],qr[3],C1,0,0,0),   P1[14],P1[15],0.f,0.f,       pw3[2]=PKW(P1,12),pw3[3]=PKW(P1,14), pw3); \
    l_reg+=sacc; \
    if(GK){DMA_K((t)+3,sl_cur);} if(GV){DMA_V((t)+1,sl_next);} \
    CMASK(C0,C1,t); \
    { float a=MX3(C0[0],C0[1],C1[0]),b=MX3(C0[2],C0[3],C1[1]); a=MX3(a,C1[2],C1[3]); \
      _Pragma("unroll") for(int r=4;r<16;r+=4){a=MX3(a,C0[r],C0[r+1]);b=MX3(b,C0[r+2],C0[r+3]);a=MX3(a,C1[r],C1[r+1]);b=MX3(b,C1[r+2],C1[r+3]);} \
      float rm=__builtin_fmaxf(a,b); { auto rr=__builtin_amdgcn_permlane32_swap(__float_as_uint(rm),__float_as_uint(rm),false,false); rm=__builtin_fmaxf(__uint_as_float(rr[0]),__uint_as_float(rr[1])); } \
      resc=false; \
      if(__builtin_expect(__any(rm>(float)THRL),0)){ const float dl=__builtin_fmaxf(rm,0.f); mhat+=dl; \
        _Pragma("unroll") for(int r=0;r<16;++r){C0[r]-=dl;C1[r]-=dl;} \
        const float f=__builtin_amdgcn_exp2f(-dl); l_reg*=f; if(hi==0){int r_=r32; asm volatile("":"+v"(r_)); wsf[r_]=f;} resc=true; } } \
    SBAR(); \
    GAPB(o[0]=__builtin_amdgcn_mfma_f32_32x32x16_bf16(PAF(0),VFR(0),o[0],0,0,0), C0,0); \
    GAPB(o[1]=__builtin_amdgcn_mfma_f32_32x32x16_bf16(PAF(0),VFR(4),o[1],0,0,0), C0,4); \
    KRD(GL,0); GAPB(o[0]=__builtin_amdgcn_mfma_f32_32x32x16_bf16(PAF(1),VFR(1),o[0],0,0,0), C0,8); \
    KRD(GL,1); GAPB(o[1]=__builtin_amdgcn_mfma_f32_32x32x16_bf16(PAF(1),VFR(5),o[1],0,0,0), C0,12); \
    KRD(GL,2); GAPB(o[0]=__builtin_amdgcn_mfma_f32_32x32x16_bf16(PAF(2),VFR(2),o[0],0,0,0), C1,0); \
    KRD(GL,3); GAPB(o[1]=__builtin_amdgcn_mfma_f32_32x32x16_bf16(PAF(2),VFR(6),o[1],0,0,0), C1,4); \
    GAPB(o[0]=__builtin_amdgcn_mfma_f32_32x32x16_bf16(PAF(3),VFR(3),o[0],0,0,0), C1,8); \
    GAPB(o[1]=__builtin_amdgcn_mfma_f32_32x32x16_bf16(PAF(3),VFR(7),o[1],0,0,0), C1,12); \
    }while(0)
  int t=1;
  #undef CMASK
  #define CMASK(P0,P1,t) do{ const float sb_=((selm>>((t)>>2))&1u)?mhat:INFINITY; {const float nsb_=-sb_;P0=P0+nsb_;P1=P1+nsb_;} }while(0)
  for(;t+5<NT;t+=2){
    STEP(pB0,pB1,pA0,pA1,t,true,true,true);     WAIT_BAR(2); RESC(); ROT();
    STEP(pA0,pA1,pB0,pB1,t+1,true,true,true);   WAIT_BAR(2); RESC(); ROT();
  }
  #undef CMASK
  #define CMASK(P0,P1,t) do{int jb_=(t)-(NT-4); const float sb_=(jb_>=0||((selm>>((t)>>2))&1u))?mhat:INFINITY; {const float nsb_=-sb_;P0=P0+nsb_;P1=P1+nsb_;} if(jb_>=0)cmask(P0,P1,jb_,qrel,hi);}while(0)
  #define ENDW(tt) do{ if((tt)+3<NT){WAIT_BAR(2);} else if((tt)+2<NT){WAIT_BAR(1);} else {WAIT_BAR(0);} }while(0)
  for(;t+1<NT;t+=2){
    STEP(pB0,pB1,pA0,pA1,t,(t+3<NT),(t+1<NT),(t+1<NT));       ENDW(t);   RESC(); ROT();
    STEP(pA0,pA1,pB0,pB1,t+1,(t+4<NT),(t+2<NT),(t+2<NT));     ENDW(t+1); RESC(); ROT();
  }
  STEP(pB0,pB1,pA0,pA1,NT-1,false,false,false); RESC();
  { float sacc=pB0[0]+pB0[1]; _Pragma("unroll") for(int r=2;r<16;++r)sacc+=pB0[r]; _Pragma("unroll") for(int r=0;r<16;++r)sacc+=pB1[r]; l_reg+=sacc;
    pw0=(u32x4){PKW(pB0,0),PKW(pB0,2),PKW(pB0,4),PKW(pB0,6)};pw1=(u32x4){PKW(pB0,8),PKW(pB0,10),PKW(pB0,12),PKW(pB0,14)};pw2=(u32x4){PKW(pB1,0),PKW(pB1,2),PKW(pB1,4),PKW(pB1,6)};pw3=(u32x4){PKW(pB1,8),PKW(pB1,10),PKW(pB1,12),PKW(pB1,14)};
    SBAR(); pv(o,vb0+sl_cur,PAF(0),PAF(1),PAF(2),PAF(3)); }
  #undef PKW
  #undef PAF
  #undef VFR
  #undef PIN
  #undef MX3
  #undef GAPA
  #undef GAPB
  #undef EX
  #undef VRD
  #undef KRD
  #undef STEP
  #undef ENDW
  {auto rr=__builtin_amdgcn_permlane32_swap(__float_as_uint(l_reg),__float_as_uint(l_reg),false,false);l_reg=__uint_as_float(rr[0])+__uint_as_float(rr[1]);}
  if(hi==0)wsf[32+r32]=l_reg;asm volatile("s_waitcnt lgkmcnt(0)":::"memory");
  float rli[16];
  #pragma unroll
  for(int r=0;r<16;++r)rli[r]=__builtin_amdgcn_rcpf(wsf[32+crow(r,hi)]);
  bf16*Ow=O+(rowbase+q0+wid*QBLK)*POUT+h*D;
  { bf16*stg=(bf16*)(shm+LDS_OST)+wid*2048;
    #pragma unroll
    for(int r=0;r<16;++r){const int orow=crow(r,hi);
      #pragma unroll
      for(int d0=0;d0<2;++d0)stg[orow*64+d0*32+r32]=__float2bfloat16(o[d0][r]*rli[r]);}
    asm volatile("s_waitcnt lgkmcnt(0)":::"memory");
    #pragma unroll
    for(int i=0;i<4;++i){const int row=i*8+(lane>>3),ch=lane&7; const u32x4 v=*(const u32x4*)(stg+row*64+ch*8); ATTN_STORE16(Ow+(long)row*POUT+ch*8,v);} }
  asm volatile("s_waitcnt lgkmcnt(0)\n\ts_barrier":::"memory");
  #undef DMA_K
  #undef DMA_V
  #undef CMASK
  #undef START
  #undef RESC
  #undef ROT
}
constexpr int ATTN_LDS_BYTES=LDS_BYTES;
struct AttnTensors { const bf16* Q; const bf16* K; const bf16* V; const bf16* KM; bf16* O; };
struct AttnUnit { int bh; int qb; };
struct StaticOrder {
  int vcu,G,blk;
  __device__ __forceinline__ explicit StaticOrder(int grid,int block):vcu((grid%8==0)?(block%8)*(grid/8)+block/8:block),G(grid),blk(block){}
  __device__ __forceinline__ bool next(int i,AttnUnit&u)const{
    if(G==256){ if(i>=4)return false; const int s=vcu&3; u.bh=vcu>>2; u.qb=(i==0)?s:(i==1)?7-s:(i==2)?8+s:15-s; return true; }
    const int idx=i*G+blk; if(idx>=BATCH*NHEAD*NQB)return false; u.bh=idx/NQB; u.qb=idx%NQB; return true; }
  __device__ __forceinline__ void a_ready(const AttnUnit&)const{}
  __device__ __forceinline__ void done(const AttnUnit&)const{}
};
template<class Sched,int THRL=8> __device__ __forceinline__ void attn_phase(char*lds,const AttnTensors&T,const Sched&S,int wave_){
  AttnUnit u;
  for(int i=0;S.next(i,u);++i){ S.a_ready(u); attn_unit<THRL>(wave_,u.bh/NHEAD,u.bh%NHEAD,u.qb,T.Q,T.K,T.V,T.KM,T.O,lds); S.done(u); }
}
#undef SBAR
#undef WAIT_BAR
}

template <bool DRY = false> __device__ __forceinline__ void p6_route(const Frame& F0, const Args& a) {
    const Frame F = fresh(F0);
    const bf16_t* x1 = (const bf16_t*)(a.ws + WS_X1); bf16_t* xn = (bf16_t*)(a.ws + WS_XN); const float* rw = a.in[I_RW]; const float* rb = a.in[I_RB]; const float* n2 = a.in[I_N2];
    unsigned* cnt = (unsigned*)(a.ws + WS_CTL) + CW_CNT; int* rows = (int*)(a.ws + WS_ROWS); float* roww = (float*)(a.ws + WS_ROWW);
    constexpr int HP2 = 1040;
    LAS float* H2 = (LAS float*)F.lds;
    LAS float* PL = (LAS float*)(F.lds + 16 * HP2 * 4);
    LAS int* lcnt = (LAS int*)(F.lds + MISC_OFF); LAS int* lbase = lcnt + 32; LAS int* ae = lbase + 32; LAS int* ap = ae + 512; LAS float* aw = (LAS float*)(ap + 512); LAS float* hsrow = aw + 512;
    float* rowhs = (float*)(a.ws + WS_ROWHS);
    const int lane = F.lane, e = lane & 31, w = F.wave, l15 = lane & 15, kq = lane >> 4;
    float rwq[8][4][2];
#pragma unroll
    for (int g = 0; g < 8; ++g)
#pragma unroll
        for (int s = 0; s < 4; ++s)
#pragma unroll
            for (int h = 0; h < 2; ++h) rwq[g][s][h] = rw[(size_t)(128 * w + 16 * g + 4 * kq + s) * NE + 16 * h + l15];
    const float bias = rb[e];
    for (int blk = F.bid; blk < NTOK / 128; blk += F.G) {
        if (F.tid < 32) lcnt[F.tid] = 0;
        u32x2 xq[2][4];
#pragma unroll
        for (int rr = 0; rr < 2; ++rr) { const u32x2* xr = (const u32x2*)(x1 + ((size_t)blk * 128 + 2 * w + rr) * DM) + lane;
#pragma unroll
            for (int j = 0; j < 4; ++j) xq[rr][j] = __builtin_nontemporal_load(xr + 64 * j); }
#pragma unroll 1
        for (int sub = 0; sub < 8; ++sub) {
#pragma unroll
            for (int rr = 0; rr < 2; ++rr) {
                const int rl = 2 * w + rr; const size_t row = (size_t)blk * 128 + sub * 16 + rl;
                const f32x4* wr = (const f32x4*)n2 + lane;
                f32x4 v[4]; float s = 0.f;
#pragma unroll
                for (int j = 0; j < 4; ++j) { const u32x2 xw = xq[rr][j]; v[j] = (f32x4){bf_lo(xw.x), bf_hi(xw.x), bf_lo(xw.y), bf_hi(xw.y)}; s += (v[j].x * v[j].x + v[j].y * v[j].y) + (v[j].z * v[j].z + v[j].w * v[j].w); }
                const float rstd = __builtin_amdgcn_rsqf(wave_sum(s) * (1.0f / DM) + RMS_EPS);
                u32x2* o8 = (u32x2*)(xn + row * DM) + lane; unsigned* o4 = (unsigned*)((unsigned char*)xn + row * DM) + lane;
#pragma unroll
                for (int j = 0; j < 4; ++j) { const f32x4 ww = wr[64 * j]; const f32x4 hv = v[j] * rstd * ww;
                    if constexpr (MOE1_I8) v[j] = hv;
                    else if constexpr (MOE_FP8) o4[64 * j] = pk4_fp8(hv.x, hv.y, hv.z, hv.w, S_H2);
                    else { u32x2 o; o.x = pk2(hv.x, hv.y); o.y = pk2(hv.z, hv.w); o8[64 * j] = o; }
                    *(LAS f32x4*)(H2 + rl * HP2 + 256 * j + 4 * lane) = hv; }
                if constexpr (MOE1_I8) {
                    float am = 0.f;
#pragma unroll
                    for (int j = 0; j < 4; ++j) am = fmaxf(fmaxf(am, fmaxf(fabsf(v[j].x), fabsf(v[j].y))), fmaxf(fabsf(v[j].z), fabsf(v[j].w)));
                    am = wave_max(am); const float inv = am > 0.f ? 127.0f / am : 0.f;
#pragma unroll
                    for (int j = 0; j < 4; ++j) o4[64 * j] = pk4_i8(v[j].x * inv, v[j].y * inv, v[j].z * inv, v[j].w * inv);
                    if (lane == 0) hsrow[sub * 16 + rl] = am * (1.0f / 127.0f); }
            }
            if (sub < 7) {
#pragma unroll
                for (int rr = 0; rr < 2; ++rr) { const u32x2* xr = (const u32x2*)(x1 + ((size_t)blk * 128 + (sub + 1) * 16 + 2 * w + rr) * DM) + lane;
#pragma unroll
                    for (int j = 0; j < 4; ++j) xq[rr][j] = __builtin_nontemporal_load(xr + 64 * j); }
            }
            lds_barrier();
            {
                f32x4 acc0 = {0.f, 0.f, 0.f, 0.f}, acc1 = {0.f, 0.f, 0.f, 0.f};
#pragma unroll
                for (int g = 0; g < 8; ++g) {
                    const f32x4 hq = *(const LAS f32x4*)(H2 + l15 * HP2 + 128 * w + 16 * g + 4 * kq);
#pragma unroll
                    for (int s = 0; s < 4; ++s) { acc0 = __builtin_amdgcn_mfma_f32_16x16x4f32(hq[s], rwq[g][s][0], acc0, 0, 0, 0); acc1 = __builtin_amdgcn_mfma_f32_16x16x4f32(hq[s], rwq[g][s][1], acc1, 0, 0, 0); }
                }
#pragma unroll
                for (int r = 0; r < 4; ++r) { PL[(w * 16 + 4 * kq + r) * 32 + l15] = acc0[r]; PL[(w * 16 + 4 * kq + r) * 32 + 16 + l15] = acc1[r]; }
            }
            lds_barrier();
            {
                const int rl = 2 * w + (lane >> 5); float val = bias;
#pragma unroll
                for (int ww = 0; ww < 8; ++ww) val += PL[(ww * 16 + rl) * 32 + e];
                unsigned key; { unsigned u = __builtin_bit_cast(unsigned, val); u ^= (unsigned)((int)u >> 31) | 0x80000000u; key = (u & ~31u) | (unsigned)(31 - e); }
                float tv[4]; int te[4];
#pragma unroll
                for (int k = 0; k < 4; ++k) {
                    unsigned m = key, o;
                    o = (unsigned)__builtin_amdgcn_update_dpp(0, (int)m, 0xB1, 0xF, 0xF, false);  m = m > o ? m : o;
                    o = (unsigned)__builtin_amdgcn_update_dpp(0, (int)m, 0x4E, 0xF, 0xF, false);  m = m > o ? m : o;
                    o = (unsigned)__builtin_amdgcn_update_dpp(0, (int)m, 0x141, 0xF, 0xF, false); m = m > o ? m : o;
                    o = (unsigned)__builtin_amdgcn_update_dpp(0, (int)m, 0x140, 0xF, 0xF, false); m = m > o ? m : o;
                    o = (unsigned)__shfl_xor((int)m, 16); m = m > o ? m : o;
                    te[k] = 31 - (int)(m & 31u); { const unsigned vb = m & ~31u; tv[k] = __builtin_bit_cast(float, (vb & 0x80000000u) ? (vb ^ 0x80000000u) : ~vb); }
                    if (e == te[k]) key = 0u;
                }
                if (e == 0) {
                    const float p1 = __expf(tv[1] - tv[0]), p2 = __expf(tv[2] - tv[0]), p3 = __expf(tv[3] - tv[0]); const float inv = 1.0f / (1.0f + p1 + p2 + p3);
                    const float w4[4] = {inv, p1 * inv, p2 * inv, p3 * inv};
                    const int rb_ = sub * 16 + rl;
#pragma unroll
                    for (int k = 0; k < 4; ++k) { const int pos = atomicAdd((int*)&lcnt[te[k]], 1); ae[rb_ * 4 + k] = te[k]; ap[rb_ * 4 + k] = pos; aw[rb_ * 4 + k] = w4[k]; }
                }
            }
        }
        lds_barrier();
        if (!DRY) { if (F.tid < 32) lbase[F.tid] = (int)__hip_atomic_fetch_add(cnt + F.tid, (unsigned)lcnt[F.tid], __ATOMIC_RELAXED, __HIP_MEMORY_SCOPE_AGENT); }
        lds_barrier();
        if (!DRY) { const int ee = ae[F.tid]; const size_t p = (size_t)ee * CAP + lbase[ee] + ap[F.tid]; rows[p] = blk * 512 + F.tid; roww[p] = aw[F.tid]; if constexpr (MOE1_I8) rowhs[p] = hsrow[F.tid >> 2]; }
        lds_barrier();
    }
}
__device__ __forceinline__ int moe_tiles(const Frame& F, const Args& a, LAS int* ts) {
    if (F.wave == 0) {
        const unsigned* cnt = (const unsigned*)(a.ws + WS_CTL) + CW_CNT; const int e = F.lane & 31;
        const int c = (int)__hip_atomic_load(cnt + e, __ATOMIC_RELAXED, __HIP_MEMORY_SCOPE_AGENT); const int tl = (c + 255) >> 8;
        int incl = tl;
#pragma unroll
        for (int o = 1; o < 32; o <<= 1) { const int v = __shfl_up(incl, o, 32); if (e >= o) incl += v; }
        if (F.lane < 32) { ts[e] = incl - tl; ts[33 + e] = c; if (e == 31) ts[32] = incl; }
    }
    __syncthreads();
    return ts[32];
}
__device__ __forceinline__ void p9_final(const Frame& F0, const Args& a) {
    const Frame F = fresh(F0);
    float* out = a.out; const bf16_t* yg = (const bf16_t*)(a.ws + WS_YG); const float* fw = a.in[I_FNW]; const bf16_t* x1 = (const bf16_t*)(a.ws + WS_X1);
    const int gw = F.bid * 8 + F.wave, NGW = F.G * 8;
    for (int row = gw; row < NTOK; row += NGW) {
        f32x4* xr = (f32x4*)(out + (size_t)row * DM) + F.lane;
        f32x4 v[4]; const u32x2* x1r = (const u32x2*)(x1 + (size_t)row * DM) + F.lane;
#pragma unroll
        for (int j = 0; j < 4; ++j) { const u32x2 xw = __builtin_nontemporal_load(x1r + 64 * j); v[j] = (f32x4){bf_lo(xw.x), bf_hi(xw.x), bf_lo(xw.y), bf_hi(xw.y)}; }
#pragma unroll
        for (int k = 0; k < 4; ++k) {
            if constexpr (MOE_FP8) { const unsigned* yp = (const unsigned*)((const unsigned char*)yg + ((size_t)row * 4 + k) * DM) + F.lane;
#pragma unroll
                for (int j = 0; j < 4; ++j) { const unsigned w = __builtin_nontemporal_load(yp + 64 * j); const f32x2 lo = __builtin_amdgcn_cvt_pk_f32_fp8(w, false), hi = __builtin_amdgcn_cvt_pk_f32_fp8(w, true);
                    v[j].x += lo.x * (1.0f / S_YG); v[j].y += lo.y * (1.0f / S_YG); v[j].z += hi.x * (1.0f / S_YG); v[j].w += hi.y * (1.0f / S_YG); } }
            else { const u32x2* yp = (const u32x2*)(yg + ((size_t)row * 4 + k) * DM) + F.lane;
#pragma unroll
                for (int j = 0; j < 4; ++j) { const u32x2 w = yp[64 * j]; v[j].x += bf_lo(w.x); v[j].y += bf_hi(w.x); v[j].z += bf_lo(w.y); v[j].w += bf_hi(w.y); } } }
        float s = 0.f;
#pragma unroll
        for (int j = 0; j < 4; ++j) s += (v[j].x * v[j].x + v[j].y * v[j].y) + (v[j].z * v[j].z + v[j].w * v[j].w);
        const float rstd = 1.0f / sqrtf(wave_sum(s) * (1.0f / DM) + RMS_EPS);
        const f32x4* wr = (const f32x4*)fw + F.lane;
#if TIM_PHASE
        { const unsigned* tm = (const unsigned*)(a.ws + WS_CTL) + 208; const unsigned den = (TIM_SEL == 4 ? 1u : (tm[3] ? tm[3] : 1u)) * (unsigned)(TIM_UNIT); unsigned q = tm[TIM_SEL] / den; q = q > 24u ? 24u : q; const float sc_ = 1.0f + (float)q;
#pragma unroll
          for (int j = 0; j < 4; ++j) v[j] = v[j] * sc_; }
#endif
#pragma unroll
        for (int j = 0; j < 4; ++j) xr[64 * j] = v[j] * rstd * wr[64 * j];
    }
}

#define XB_TMO      128
#define XB_XCNT(j)  (256  + 64 * (j))
#define XB_XSUB(j)  (1280 + 64 * (j))
#define XB_XGEN(j)  (2304 + 64 * (j))
#define XB_TOP      3328
#define XB_TOPGEN   3392
#define XCD_BAR_WORDS 3456
#define XB_SPIN_CAP (1u << 18)

__device__ __forceinline__ unsigned xb_ld(unsigned* p)              { return __hip_atomic_load(p, __ATOMIC_RELAXED, __HIP_MEMORY_SCOPE_AGENT); }
__device__ __forceinline__ unsigned xb_add(unsigned* p, unsigned v) { return __hip_atomic_fetch_add(p, v, __ATOMIC_RELAXED, __HIP_MEMORY_SCOPE_AGENT); }
__device__ __forceinline__ unsigned xb_xcc_id() { return (unsigned)__builtin_amdgcn_s_getreg((3 << 11) | 20) & 0xFu; }
#define XB_SPIN(cond, bar) do { unsigned _sp = 0; while (cond) { __builtin_amdgcn_s_sleep(1); \
    if ((++_sp & 255u) == 0u) { if (xb_ld(&(bar)[XB_TMO])) break; if (_sp > XB_SPIN_CAP) { atomicAdd(&(bar)[XB_TMO], 1u); break; } } } } while (0)

struct XcdBarrier {
    unsigned* bar; unsigned x; int w;
    volatile LAS unsigned* st;
};

__device__ __forceinline__ XcdBarrier xcd_barrier_post(unsigned* bar, volatile LAS unsigned* st) {
    XcdBarrier b; b.bar = bar; b.x = xb_xcc_id(); b.st = st;
    if (threadIdx.x == 0) (void)xb_add(&bar[XB_XCNT(b.x)], 1u);
    return b;
}
__device__ __forceinline__ void xcd_barrier_complete(unsigned* bar, unsigned x, unsigned& nloc, unsigned& nx) {
    const unsigned G = gridDim.x * gridDim.y * gridDim.z;
    unsigned sum, cnt, mine, sp = 0u;
    for (;;) {
        sum = 0u; cnt = 0u; mine = 0u;
#pragma unroll
        for (unsigned j = 0; j < 16; ++j) { const unsigned c = xb_ld(&bar[XB_XCNT(j)]); sum += c; cnt += (c > 0u) ? 1u : 0u; mine = (j == x) ? c : mine; }
        if (sum == G) break;
        __builtin_amdgcn_s_sleep(1);
        if ((++sp & 255u) == 0u) { if (xb_ld(&bar[XB_TMO])) break; if (sp > XB_SPIN_CAP) { atomicAdd(&bar[XB_TMO], 1u); break; } }
    }
    nloc = mine > 0u ? mine : 1u; nx = cnt > 0u ? cnt : 1u;
}

__device__ __forceinline__ void xcd_barrier(const XcdBarrier& b) {
    asm volatile("s_waitcnt vmcnt(0)" ::: "memory");
    __syncthreads();
    if (b.w == 0 && lane_id_() == 0) {
        unsigned* bar = b.bar;
        __builtin_amdgcn_s_waitcnt(0);
        unsigned nloc = b.st[0], nx = b.st[1];
        if (nloc == 0u) { xcd_barrier_complete(bar, b.x, nloc, nx); b.st[0] = nloc; b.st[1] = nx; }
        const unsigned old = xb_add(&bar[XB_XSUB(b.x)], 1u);
        const unsigned gen = old / nloc;
        if (old + 1u == (gen + 1u) * nloc) {
            __builtin_amdgcn_fence(__ATOMIC_RELEASE, "agent");
            asm volatile("s_waitcnt vmcnt(0)" ::: "memory");
            const unsigned og = xb_add(&bar[XB_TOP], 1u);
            const unsigned tg = og / nx;
            if (og + 1u == (tg + 1u) * nx) xb_add(&bar[XB_TOPGEN], 1u);
            else XB_SPIN(xb_ld(&bar[XB_TOPGEN]) == tg, bar);
            __builtin_amdgcn_fence(__ATOMIC_ACQUIRE, "agent");
            xb_add(&bar[XB_XGEN(b.x)], 1u);
            asm volatile("s_waitcnt vmcnt(0)" ::: "memory");
        } else {
            XB_SPIN(xb_ld(&bar[XB_XGEN(b.x)]) == gen, bar);
            __builtin_amdgcn_fence(__ATOMIC_ACQUIRE, "agent");
            asm volatile("s_waitcnt vmcnt(0)" ::: "memory");
        }
    }
    __syncthreads();
}


__global__ void __launch_bounds__(512, 2) fwd_kernel(Args args) {
    extern __shared__ __attribute__((aligned(16))) unsigned char lds_raw[];
    Frame F; F.lds = (LAS unsigned char*)lds_raw; F.tid = threadIdx.x; F.lane = F.tid & 63; F.wave = __builtin_amdgcn_readfirstlane(F.tid >> 6); F.G = gridDim.x; F.bid = blockIdx.x;
#if USE_COOP
    cg::grid_group grid = cg::this_grid();
#endif
    volatile LAS unsigned* MISCW = (volatile LAS unsigned*)(F.lds + LDS_BYTES - 256);
    if (F.tid < 64) MISCW[F.tid] = 0u;
    __syncthreads();
    XcdBarrier xbar = xcd_barrier_post((unsigned*)(args.ws + WS_CTL) + CW_BAR, MISCW + 8); xbar.w = F.wave;
    unsigned char* ws = args.ws;
    const int lo = args.ph_lo, hi = args.ph_hi;
#ifndef REPMASK
#define REPMASK 0
#endif
#define NREP(k) (((REPMASK) >> (k)) & 1 ? 2 : 1)
#define IN(k) (lo <= (k) && (k) < hi)
#if USE_COOP
#define SEAM(k) do { if (IN(k) && IN((k) + 1)) xcd_barrier(xbar); } while (0)
#else
#define SEAM(k) do { if (IN(k) && IN((k) + 1)) xcd_barrier(xbar); } while (0)
#endif
    bf16_t* proj = (bf16_t*)(ws + WS_PROJ);

#if USE_COOP
    if (lo < 0) grid.sync();
#endif
    if (IN(0)) for (int rep_ = 0; rep_ < NREP(0); ++rep_) { p0_prologue(F, args); } SEAM(0);
    if (IN(1)) for (int rep_ = 0; rep_ < NREP(1); ++rep_) {
        pg8::Gemm g{(const bf16_t*)(ws + WS_XN), (const bf16_t*)(ws + WS_WIN), DIN, DM, nullptr, (const float*)(ws + WS_XS), (const float*)(ws + WS_WINS), TIM_PHASE == 1 ? (unsigned*)(ws + WS_CTL) + 208 : nullptr};
        pg8::DenseSched<DIN / 256> S; S.o.init(NTOK / 256, DIN / 256, F.G, F.bid);
        EpiProj E{proj, (float*)(ws + WS_LOGF), (const float*)(ws + WS_ROPE), (const float*)(ws + WS_LB)};
        pg8::gemm_phase<EpiProj, pg8::DenseSched<DIN / 256>, false, false, false, false, P1_I8>(F.lds, g, S, E, F.wave);
    } SEAM(1);
    if (IN(2)) for (int rep_ = 0; rep_ < NREP(2); ++rep_) { p2_kmean(F, args); h1_local_states_p(F, args); } SEAM(2);
    if (IN(3)) {
        h2_scan(F, args);
        const attn_body::AttnTensors AT{(const attn_body::bf16*)(proj + C_QA), (const attn_body::bf16*)(proj + C_KA), (const attn_body::bf16*)(proj + C_VA), (const attn_body::bf16*)(ws + WS_KMEAN), (attn_body::bf16*)(ws + WS_YA)};
        const attn_body::StaticOrder AS((int)F.G, (int)F.bid);
        if constexpr (DEFER_MOE_W) {
            const int cls = F.G == 256 ? (int)(F.bid & 3) : 0, convpos = cls == 0 ? 0 : cls + 1;
            attn_body::AttnUnit u;
#pragma unroll 1
            for (int i = 0;; ++i) {
                if (i == convpos) { __syncthreads(); moe_weight_copies(F, args); }
                if (!AS.next(i, u)) break;
                attn_body::attn_unit<8>(F.wave, u.bh / attn_body::NHEAD, u.bh % attn_body::NHEAD, u.qb, AT.Q, AT.K, AT.V, AT.KM, AT.O, (char*)lds_raw);
            }
        } else
        for (int rep_ = 0; rep_ < NREP(3); ++rep_) attn_body::attn_phase<attn_body::StaticOrder>((char*)lds_raw, AT, AS, F.wave);
    } SEAM(3);
    if (IN(4)) for (int rep_ = 0; rep_ < NREP(4); ++rep_) { h3_outputs_p(F, args); } SEAM(4);
    if (IN(5)) for (int rep_ = 0; rep_ < NREP(5); ++rep_) {
        pg8::DenseSched<DM / 256> S; S.o.init(NTOK / 256, DM / 256, F.G, F.bid);
        pg8::Gemm g{(const bf16_t*)(ws + WS_YA), (const bf16_t*)(ws + WS_MUP), DM, DM, nullptr};
        EpiMixF E{(bf16_t*)(ws + WS_MIXED), proj};
        pg8::gemm_phase<EpiMixF, pg8::DenseSched<DM / 256>, false, false, false, true>(F.lds, g, S, E, F.wave);
    } SEAM(5);
    if (IN(6)) for (int rep_ = 0; rep_ < NREP(6); ++rep_) {
        pg8::Gemm g{(const bf16_t*)(ws + WS_MIXED), (const bf16_t*)(ws + WS_WOUT), DM, DM, nullptr};
        pg8::DenseSched<DM / 256> S; S.o.init(NTOK / 256, DM / 256, F.G, F.bid);
        EpiOut E{args.in[I_X], (bf16_t*)(ws + WS_X1)};
        pg8::gemm_phase<EpiOut, pg8::DenseSched<DM / 256>, false>(F.lds, g, S, E, F.wave);
    } SEAM(6);
    if (IN(7)) { if (NREP(7) > 1) p6_route<true>(F, args); p6_route<false>(F, args); } SEAM(7);
    if (IN(8)) for (int rep_ = 0; rep_ < NREP(8); ++rep_) {
        LAS int* ts = (LAS int*)(F.lds + MISC_OFF + 8192);
        const int ntile = moe_tiles(F, args, ts);
        pg8::Gemm g{(const bf16_t*)(ws + WS_XN), (const bf16_t*)(ws + WS_WGU), 2 * DE, DM, (const int*)(ws + WS_ROWS), (const float*)(ws + WS_ROWHS), (const float*)(ws + WS_WGS), TIM_PHASE == 8 ? (unsigned*)(ws + WS_CTL) + 208 : nullptr};
        pg8::MoeSched<2 * DE / 256> S; S.o.init(ntile, 2 * DE / 256, F.G, F.bid); S.ts = ts;
        EpiMoe1 E{(bf16_t*)(ws + WS_HID), args.in[I_BGU]};
        pg8::gemm_phase<EpiMoe1, pg8::MoeSched<2 * DE / 256>, true, MOE_FP8 && !MOE1_I8, false, false, MOE1_I8>(F.lds, g, S, E, F.wave);
    } SEAM(8);
    if (IN(9)) for (int rep_ = 0; rep_ < NREP(9); ++rep_) {
        LAS int* ts = (LAS int*)(F.lds + MISC_OFF + 8192);
        const int ntile = moe_tiles(F, args, ts);
        pg8::Gemm g{(const bf16_t*)(ws + WS_HID), (const bf16_t*)(ws + WS_WD), DM, DE, nullptr, nullptr, nullptr, TIM_PHASE == 9 ? (unsigned*)(ws + WS_CTL) + 208 : nullptr};
        pg8::MoeSched<DM / 256> S; S.o.init(ntile, DM / 256, F.G, F.bid); S.ts = ts;
        EpiMoe2 E{(bf16_t*)(ws + WS_YG), args.in[I_BD], (const int*)(ws + WS_ROWS), (const float*)(ws + WS_ROWW)};
        pg8::gemm_phase<EpiMoe2, pg8::MoeSched<DM / 256>, false, MOE_FP8, false, false, false, MOE_FP8>(F.lds, g, S, E, F.wave);
    } SEAM(9);
    if (IN(10)) for (int rep_ = 0; rep_ < NREP(10); ++rep_) { p9_final(F, args); }
#undef IN
#undef SEAM
}

#ifndef N_LAUNCHES
#define N_LAUNCHES 1
#endif
extern "C" void kernel_launch(void* const* d_in, const int* in_sizes, int n_in, void* d_out, int out_size, void* d_ws, size_t ws_size, hipStream_t stream) {
    static int grid = 0;
    if (grid == 0) {
        if (n_in != 16 || in_sizes[0] != NTOK * DM || out_size != NTOK * DM || ws_size < WS_END) { fprintf(stderr, "kernel_launch: unexpected shapes (n_in %d, in0 %d, out %d, ws %zu)\n", n_in, n_in > 0 ? in_sizes[0] : -1, out_size, ws_size); grid = -1; return; }
        int dev = 0, cus = 0, per_cu = 0;
        (void)hipGetDevice(&dev); (void)hipDeviceGetAttribute(&cus, hipDeviceAttributeMultiprocessorCount, dev);
        if (hipFuncSetAttribute((const void*)fwd_kernel, hipFuncAttributeMaxDynamicSharedMemorySize, LDS_BYTES) != hipSuccess) { fprintf(stderr, "kernel_launch: hipFuncSetAttribute failed\n"); grid = -1; return; }
        if (hipOccupancyMaxActiveBlocksPerMultiprocessor(&per_cu, (const void*)fwd_kernel, 512, LDS_BYTES) != hipSuccess || per_cu < 1) { fprintf(stderr, "kernel_launch: occupancy query says %d\n", per_cu); per_cu = 1; }
        (void)hipGetLastError();
        grid = cus;
    }
    if (grid < 0) return;
    (void)hipMemsetAsync((char*)d_ws + WS_CTL, 0, CTL_BYTES, stream);
    Args a{};
    for (int i = 0; i < 16; ++i) a.in[i] = (const float*)d_in[i];
    a.out = (float*)d_out; a.ws = (unsigned char*)d_ws;
    if (N_LAUNCHES == 1) {
        a.ph_lo = 0; a.ph_hi = NPHASE; void* params[] = {&a};
#if USE_COOP
        hipError_t e = hipLaunchCooperativeKernel((const void*)fwd_kernel, dim3(grid), dim3(512), params, LDS_BYTES, stream);
        if (e != hipSuccess) fprintf(stderr, "cooperative launch failed: %s (grid %d)\n", hipGetErrorString(e), grid);
#else
        (void)params; hipLaunchKernelGGL(fwd_kernel, dim3(grid), dim3(512), LDS_BYTES, stream, a);
#endif
    } else {
        for (int p = 0; p < NPHASE; ++p) { a.ph_lo = p; a.ph_hi = p + 1; hipLaunchKernelGGL(fwd_kernel, dim3(grid), dim3(512), LDS_BYTES, stream, a); }
    }
}
```

```cpp
#include <hip/hip_runtime.h>
#include <hip/hip_cooperative_groups.h>
#include <cstdio>
#include <cstdint>
namespace cg = cooperative_groups;
#ifndef USE_COOP
#define USE_COOP 1
#endif

#define LAS __attribute__((address_space(3)))
#define GAS __attribute__((address_space(1)))
typedef unsigned short bf16_t;
typedef short bf16x8 __attribute__((ext_vector_type(8)));
typedef float f32x4 __attribute__((ext_vector_type(4)));
typedef float f32x2 __attribute__((ext_vector_type(2)));
typedef unsigned u32x4 __attribute__((ext_vector_type(4)));
typedef unsigned u32x2 __attribute__((ext_vector_type(2)));

constexpr int NTOK = 32768, DM = 1024, SEQ = 4096, NBATCH = 8;
constexpr int DIN = 5632;
constexpr int AH = 8, AD = 64;
constexpr int HH = 4, HK = 128;
constexpr int NE = 32, DE = 1024, CAP = 32768;
constexpr float RMS_EPS = 1e-6f;
constexpr float QSCALE = 0.125f * 1.4426950408889634f;
constexpr int C_QA = 0, C_KA = 512, C_VA = 1024, C_QB = 1536, C_FB = 2048, C_IB = 2560, C_GB = 3072, C_GA = 3584, C_GBT = 4608;

constexpr size_t MiB = 1u << 20;
constexpr size_t WS_CTL = 0, CTL_BYTES = 32768;
constexpr size_t WS_ROPE = 1 * MiB;
constexpr size_t WS_WIN = 2 * MiB;
constexpr size_t WS_MUP = 13 * MiB;
constexpr size_t WS_WOUT = 15 * MiB;
constexpr size_t WS_LB = 17 * MiB;
constexpr size_t WS_KMEAN = 17 * MiB + 65536;
constexpr size_t WS_SLOTW = 18 * MiB;
constexpr size_t WS_ROWS = 19 * MiB;
constexpr size_t WS_ROWW = 25 * MiB;
constexpr size_t WS_WGS = 18 * MiB;
constexpr size_t WS_XS = 18 * MiB + 512 * 1024;
constexpr size_t WS_WINS = 18 * MiB + 768 * 1024;
constexpr size_t WS_ROWHS = 672 * MiB;
constexpr size_t WS_GDEC = 24 * MiB;
constexpr size_t WS_WGU = 32 * MiB;
constexpr size_t WS_WD = 160 * MiB;
constexpr size_t WS_XN = 224 * MiB;
constexpr size_t WS_PROJ = 288 * MiB;
constexpr size_t WS_LOGF = 640 * MiB;
constexpr size_t WS_YA = 704 * MiB;
constexpr size_t WS_OB = 768 * MiB;
constexpr size_t WS_HST = 768 * MiB;
constexpr size_t WS_MIXED = 832 * MiB;
constexpr size_t WS_HID = 288 * MiB;
constexpr size_t WS_YG = 560 * MiB;
constexpr size_t WS_X1 = 896 * MiB;
constexpr size_t WS_END = 960 * MiB;
constexpr int CW_CNT = 64;
constexpr int CW_BAR = 4096;
static_assert((CW_BAR + 3456) * 4 <= (int)CTL_BYTES, "barrier words inside the zeroed control region");

constexpr int RING_BYTES = 131072;
constexpr int MISC_OFF = RING_BYTES;
constexpr int LDS_BYTES = 147456;

#ifndef MOE1_I8_
#define MOE1_I8_ 1
#endif
#ifndef MOE_FP8_
#define MOE_FP8_ 1
#endif
constexpr bool MOE1_I8 = (MOE1_I8_ != 0) && (MOE_FP8_ != 0);
#ifndef P1_I8_
#define P1_I8_ 1
#endif
constexpr bool P1_I8 = P1_I8_ != 0;
#ifndef DEFER_MOE_W_
#define DEFER_MOE_W_ 1
#endif
#ifndef TIM_PHASE
#define TIM_PHASE 0
#endif
#ifndef TIM_SEL
#define TIM_SEL 0
#endif
#ifndef TIM_UNIT
#define TIM_UNIT 1024
#endif
constexpr bool MOE_FP8 = MOE_FP8_ != 0;
constexpr float S_H2 = 16.0f, S_HID = 4.0f, S_W = 512.0f, S_YG = 32.0f;
constexpr float DQ1 = MOE_FP8 ? 1.0f / (S_H2 * S_W) : 1.0f, DQ2 = MOE_FP8 ? 1.0f / (S_HID * S_W) : 1.0f;
typedef int v8i __attribute__((ext_vector_type(8)));
typedef int v4i __attribute__((ext_vector_type(4)));
__device__ __forceinline__ unsigned pk4_i8(float a, float b, float c, float d) {
    const unsigned ua = __builtin_bit_cast(unsigned, __builtin_amdgcn_fmed3f(a, -127.f, 127.f) + 12582912.0f), ub = __builtin_bit_cast(unsigned, __builtin_amdgcn_fmed3f(b, -127.f, 127.f) + 12582912.0f);
    const unsigned uc = __builtin_bit_cast(unsigned, __builtin_amdgcn_fmed3f(c, -127.f, 127.f) + 12582912.0f), ud = __builtin_bit_cast(unsigned, __builtin_amdgcn_fmed3f(d, -127.f, 127.f) + 12582912.0f);
    return __builtin_amdgcn_perm(ub, ua, 0x0c0c0400u) | __builtin_amdgcn_perm(ud, uc, 0x04000c0cu); }
typedef _Float16 h16x4 __attribute__((ext_vector_type(4)));
typedef _Float16 h16x8 __attribute__((ext_vector_type(8)));
typedef float f32x8 __attribute__((ext_vector_type(8)));
__device__ __forceinline__ unsigned pk4_fp8_nc(float a, float b, float c, float d, float s) { unsigned w = 0u; w = __builtin_amdgcn_cvt_pk_fp8_f32(a * s, b * s, w, false); w = __builtin_amdgcn_cvt_pk_fp8_f32(c * s, d * s, w, true); return w; }
__device__ __forceinline__ unsigned pk4_u8(float a, float b, float c, float d) { unsigned w = 0u;
    w = __builtin_amdgcn_cvt_pk_u8_f32(fmaxf(a * 255.0f, 1.0f), 0, w); w = __builtin_amdgcn_cvt_pk_u8_f32(fmaxf(b * 255.0f, 1.0f), 1, w);
    w = __builtin_amdgcn_cvt_pk_u8_f32(fmaxf(c * 255.0f, 1.0f), 2, w); w = __builtin_amdgcn_cvt_pk_u8_f32(fmaxf(d * 255.0f, 1.0f), 3, w); return w; }
__device__ __forceinline__ f32x4 un4_u8(unsigned w) { return (f32x4){(float)(w & 0xffu), (float)((w >> 8) & 0xffu), (float)((w >> 16) & 0xffu), (float)(w >> 24)}; }
constexpr int GATE_BYTE0 = 2 * 3584;
__device__ __forceinline__ unsigned pk4_fp8(float a, float b, float c, float d, float s) {
    const float L = 440.0f;
    a = __builtin_amdgcn_fmed3f(a * s, -L, L); b = __builtin_amdgcn_fmed3f(b * s, -L, L); c = __builtin_amdgcn_fmed3f(c * s, -L, L); d = __builtin_amdgcn_fmed3f(d * s, -L, L);
    unsigned w = 0u; w = __builtin_amdgcn_cvt_pk_fp8_f32(a, b, w, false); w = __builtin_amdgcn_cvt_pk_fp8_f32(c, d, w, true); return w;
}
__device__ __forceinline__ unsigned f2bf(float f) { unsigned u = __builtin_bit_cast(unsigned, f); return (u + 0x7fffu + ((u >> 16) & 1u)) >> 16; }
typedef __bf16 bf16x2_t_ __attribute__((ext_vector_type(2)));
__device__ __forceinline__ unsigned pk2(float lo, float hi) { f32x2 v = {lo, hi}; bf16x2_t_ b = __builtin_convertvector(v, bf16x2_t_); return __builtin_bit_cast(unsigned, b); }
__device__ __forceinline__ float bf_lo(unsigned u) { return __builtin_bit_cast(float, u << 16); }
__device__ __forceinline__ float bf_hi(unsigned u) { return __builtin_bit_cast(float, u & 0xffff0000u); }
__device__ __forceinline__ float bf2f(bf16_t h) { return __builtin_bit_cast(float, (unsigned)h << 16); }
template <int CTRL> __device__ __forceinline__ float dppf_(float v) { return __builtin_bit_cast(float, __builtin_amdgcn_update_dpp(0, __builtin_bit_cast(int, v), CTRL, 0xF, 0xF, false)); }
__device__ __forceinline__ float rdlane_(float v, int l) { return __builtin_bit_cast(float, __builtin_amdgcn_readlane(__builtin_bit_cast(int, v), l)); }
__device__ __forceinline__ float wave_sum(float v) {
    v += dppf_<0xB1>(v); v += dppf_<0x4E>(v); v += dppf_<0x141>(v); v += dppf_<0x140>(v);
    return (rdlane_(v, 0) + rdlane_(v, 16)) + (rdlane_(v, 32) + rdlane_(v, 48));
}
__device__ __forceinline__ float wave_max(float v) {
    v = fmaxf(v, dppf_<0xB1>(v)); v = fmaxf(v, dppf_<0x4E>(v)); v = fmaxf(v, dppf_<0x141>(v)); v = fmaxf(v, dppf_<0x140>(v));
    return fmaxf(fmaxf(rdlane_(v, 0), rdlane_(v, 16)), fmaxf(rdlane_(v, 32), rdlane_(v, 48)));
}
__device__ __forceinline__ void lds_barrier() { asm volatile("s_waitcnt lgkmcnt(0)\n\ts_barrier" ::: "memory"); }
__device__ __forceinline__ f32x4 sigmoid4_(f32x4 x) {
    f32x4 t = x * (-1.4426950408889634f); t = (f32x4){__builtin_amdgcn_exp2f(t[0]), __builtin_amdgcn_exp2f(t[1]), __builtin_amdgcn_exp2f(t[2]), __builtin_amdgcn_exp2f(t[3])}; t = t + 1.0f;
    return (f32x4){__builtin_amdgcn_rcpf(t[0]), __builtin_amdgcn_rcpf(t[1]), __builtin_amdgcn_rcpf(t[2]), __builtin_amdgcn_rcpf(t[3])}; }
__device__ __forceinline__ float sigmoidf_(float x) { return __builtin_amdgcn_rcpf(1.0f + __builtin_amdgcn_exp2f(-1.4426950408889634f * x)); }
__device__ __forceinline__ int lane_id_() { int l; asm volatile("v_mbcnt_lo_u32_b32 %0, -1, 0\n\tv_mbcnt_hi_u32_b32 %0, -1, %0" : "=v"(l)); return l; }
__device__ __forceinline__ float rdlane(float v, int l) { return __builtin_bit_cast(float, __builtin_amdgcn_readlane(__builtin_bit_cast(int, v), l)); }

namespace pg8 {
constexpr int BM = 256, BK = 64, HALF = 128, HTB = HALF * BK * 2, STAGE_BYTES = 8 * HTB, NXCD = 8, WGM = 8;
__host__ __device__ __forceinline__ int lds_byte(int r, int c) { const int st = (r >> 4) * 2 + (c >> 5), rr = r & 15, cc = c & 31, ob = rr * 64 + cc * 2; return st * 1024 + (ob ^ (((ob >> 9) & 1) << 5)); }
__host__ __device__ __forceinline__ void stage_rc(int b, int& R, int& C) { const int st = b / 1024, sb = b % 1024, swz = sb ^ (((sb >> 9) & 1) << 5); R = (st >> 1) * 16 + swz / 64; C = (st & 1) * 32 + (swz % 64) / 2; }
__host__ __device__ __forceinline__ int perm32(int rho) { const int n = rho >> 4, i = rho & 15; return 8 * (i >> 2) + 4 * n + (i & 3); }

struct Unit { int pm, pn, e, lt, nvalid; };
struct Gemm { const bf16_t* A; const bf16_t* Bt; int N, K; const int* rows; const float* rs = nullptr; const float* cs = nullptr; unsigned* tim = nullptr; };

template <int NN> struct Order {
    static constexpr int nN = NN;
    int nM, nwg, G, c;
    __device__ void init(int nM_, int nN_, int G_, int c_) { nM = nM_; nwg = nM * nN; G = G_; c = c_; }
    __device__ bool map(int i, int& pm, int& pn) const {
        const long L = (long)i * G + c; if (L >= nwg) return false;
        int wgid = (int)L; { const int q = nwg / NXCD, r = nwg % NXCD, xcd = wgid % NXCD, off = wgid / NXCD; wgid = (xcd < r ? xcd * (q + 1) : r * (q + 1) + (xcd - r) * q) + off; }
        const int nig = WGM * nN, gid = wgid / nig, fm = gid * WGM, gsz = (nM - fm) < WGM ? (nM - fm) : WGM;
        const int rem = wgid - gid * nig;
        pm = fm + rem % gsz; pn = rem / gsz; return true;
    }
};
template <int NN> struct DenseSched {
    Order<NN> o;
    __device__ bool next(int i, Unit& u) const { if (!o.map(i, u.pm, u.pn)) return false; u.e = 0; u.lt = u.pm; u.nvalid = 256; return true; }
};
template <int NN> struct MoeSched {
    Order<NN> o; const LAS int* ts;
    __device__ bool next(int i, Unit& u) const {
        if (!o.map(i, u.pm, u.pn)) return false;
        const int lane = lane_id_(); const int tv = ts[(lane & 31) + 1];
        const unsigned long long bal = __ballot(lane < NE - 1 && tv <= u.pm);
        const int e = __builtin_amdgcn_readfirstlane((int)__popcll(bal));
        const int t0 = __builtin_amdgcn_readfirstlane(ts[e]), cn = __builtin_amdgcn_readfirstlane(ts[33 + e]);
        u.e = e; u.lt = u.pm - t0; const int rem = cn - u.lt * 256; u.nvalid = rem < 256 ? rem : 256; return true;
    }
};

struct NoPre {};
template <class T, class = void> struct HasPre { static constexpr bool v = false; };
template <class T> struct HasPre<T, decltype((void)sizeof(typename T::Pre))> { static constexpr bool v = true; };
template <class T, bool> struct PreOf { typedef NoPre type; };
template <class T> struct PreOf<T, true> { typedef typename T::Pre type; };
template <class Epi, class Sched, bool GATHER, bool FP8 = false, bool NOEPI = false, bool HOOK = false, bool I8 = false, bool P16 = false>
__device__ __forceinline__ void gemm_phase(LAS unsigned char* lds, const Gemm g, const Sched& S, const Epi& E, const int wid) {
    const int lane = lane_id_(), tid = wid * 64 + lane, wr = wid >> 2, wc = wid & 3, fr = lane & 15, fq = lane >> 4;
    const int K = g.K, RP = (FP8 || I8) ? K : 2 * K, nt = RP / 128;
    unsigned voffB[2];
#pragma unroll
    for (int i = 0; i < 2; ++i) { int R, C; stage_rc(tid * 16 + i * 8192, R, C); const int Rb = P16 ? 64 * (R >> 5) + 16 * ((R & 15) >> 2) + 4 * ((R >> 4) & 1) + (R & 3) : (R & ~31) + perm32(R & 31); voffB[i] = (unsigned)(Rb * RP + C * 2); }
    const size_t kstep = 128;
    const size_t hstep = (size_t)HALF * RP, hstepB = P16 ? (size_t)8 * RP : hstep;
    const size_t tstep = 2 * hstep;
    const size_t estride = (size_t)g.N * RP;
    const unsigned ldsw = (unsigned)wid * 1024u;
    const int aoff = lds_byte(wr * 64 + fr, fq * 8), boff = lds_byte(wc * 32 + fr, fq * 8);
    constexpr int KOFF = 1024;
#define PG8_SA(b, h) (((b) * 2 + (h)) * HTB)
#define PG8_SB(b, h) ((4 + (b) * 2 + (h)) * HTB)
#define PG8_STAGE(bufoff, gbase, voff) do { _Pragma("unroll") for (int _i = 0; _i < 2; ++_i) { unsigned _o = (voff)[_i]; asm volatile("" : "+v"(_o));     \
        __builtin_amdgcn_global_load_lds((const unsigned*)((const char*)(gbase) + _o), (LAS unsigned*)(lds + (bufoff) + ldsw + _i * 8192), 16, 0, 0); } } while (0)
#define PG8_STAGE2(bufoff, gbase, h) PG8_STAGE(bufoff, gbase, vC[h])
#define PG8_LDA(dst, b, h) do { _Pragma("unroll") for (int m = 0; m < 4; ++m) _Pragma("unroll") for (int k = 0; k < 2; ++k) dst[m][k] = *(const LAS bf16x8*)(lds + PG8_SA(b, h) + aoff + m * 2048 + k * KOFF); } while (0)
#define PG8_LDB(dst, b, h) do { _Pragma("unroll") for (int n = 0; n < 2; ++n) _Pragma("unroll") for (int k = 0; k < 2; ++k) dst[n][k] = *(const LAS bf16x8*)(lds + PG8_SB(b, h) + boff + n * 2048 + k * KOFF); } while (0)
#define PG8_CAT(x) __builtin_bit_cast(v8i, __builtin_shufflevector((x)[0], (x)[1], 0, 1, 2, 3, 4, 5, 6, 7, 8, 9, 10, 11, 12, 13, 14, 15))
#define PG8_MMA(ai, bj, At, Bt) do { __builtin_amdgcn_s_setprio(1); _Pragma("unroll") for (int m = 0; m < 4; ++m) _Pragma("unroll") for (int n = 0; n < 2; ++n) { \
        if constexpr (FP8) acc[ai][bj][m][n] = __builtin_amdgcn_mfma_scale_f32_16x16x128_f8f6f4(PG8_CAT(Bt[n]), PG8_CAT(At[m]), acc[ai][bj][m][n], 0, 0, 0, 0, 0, 0); \
        else if constexpr (I8) { _Pragma("unroll") for (int k = 0; k < 2; ++k) acci[ai][bj][m][n] = __builtin_amdgcn_mfma_i32_16x16x64_i8(__builtin_bit_cast(v4i, Bt[n][k]), __builtin_bit_cast(v4i, At[m][k]), acci[ai][bj][m][n], 0, 0, 0); } \
        else { _Pragma("unroll") for (int k = 0; k < 2; ++k) acc[ai][bj][m][n] = __builtin_amdgcn_mfma_f32_16x16x32_bf16(Bt[n][k], At[m][k], acc[ai][bj][m][n], 0, 0, 0); } } \
        __builtin_amdgcn_s_setprio(0); } while (0)
#define PG8_WAIT_V(n) asm volatile("s_waitcnt vmcnt(" #n ")" ::: "memory")
#define PG8_WAIT_V8R() do { if (NOEPI || Epi::NVMEM == 0 || !relax) asm volatile("s_waitcnt vmcnt(8)" ::: "memory"); else asm volatile("s_waitcnt vmcnt(%0)" :: "n"(8 + (NOEPI ? 0 : Epi::NVMEM)) : "memory"); } while (0)
#define PG8_WAIT_L(n) asm volatile("s_waitcnt lgkmcnt(" #n ")" ::: "memory")
#define PG8_BAR __builtin_amdgcn_s_barrier()
#define PG8_SCHED __builtin_amdgcn_sched_barrier(0)
#define PG8_SETV(u, v) do { _Pragma("unroll") for (int _h = 0; _h < 2; ++_h) _Pragma("unroll") for (int _i = 0; _i < 2; ++_i) { int _R, _C; stage_rc((wid * 64 + lane_id_()) * 16 + _i * 8192, _R, _C); \
        if (GATHER) { int _r = _h * HALF + _R; _r = _r < (u).nvalid ? _r : (u).nvalid - 1; const int _s = g.rows[(size_t)(u).e * CAP + (u).lt * 256 + _r]; \
                      (v)[_h][_i] = (unsigned)(_s >> 2) * (unsigned)RP + (unsigned)(_C * 2); } \
        else (v)[_h][_i] = (unsigned)(_R * RP + _C * 2) + (unsigned)(_h * hstep); } } while (0)
#define PG8_ABASE(u) (GATHER ? (const char*)g.A : (const char*)g.A + (size_t)(u).pm * tstep)
#define PG8_BBASE(u) ((const char*)g.Bt + (size_t)(u).e * estride + (size_t)(u).pn * tstep)
    Unit cur, nxt, nn; int ui = 0;
    if (!S.next(0, cur)) return;
    bool has_next = S.next(1, nxt);
    unsigned vC[2][2];
    PG8_SETV(cur, vC);
#define PG8_PARK ((LAS unsigned*)(lds + MISC_OFF) + (wid * 64 + lane_id_()) * 4)
    if (GATHER) { unsigned vP[2][2];
        if (has_next) PG8_SETV(nxt, vP); else { vP[0][0] = vC[0][0]; vP[0][1] = vC[0][1]; vP[1][0] = vC[1][0]; vP[1][1] = vC[1][1]; }
        LAS unsigned* pk = PG8_PARK; pk[0] = vP[0][0]; pk[1] = vP[0][1]; pk[2] = vP[1][0]; pk[3] = vP[1][1]; }
    f32x4 acc[2][2][4][2]; v4i acci[2][2][4][2];
#pragma unroll
    for (int a = 0; a < 2; ++a)
#pragma unroll
        for (int b = 0; b < 2; ++b)
#pragma unroll
            for (int m = 0; m < 4; ++m)
#pragma unroll
                for (int n = 0; n < 2; ++n) { acc[a][b][m][n] = (f32x4){0.f, 0.f, 0.f, 0.f}; acci[a][b][m][n] = (v4i){0, 0, 0, 0}; }
    bf16x8 At[4][2], B0[2][2], B1[2][2];
    const char* cA = PG8_ABASE(cur); const char* cB = PG8_BBASE(cur);
    PG8_STAGE(PG8_SB(0, 0), cB, voffB); PG8_STAGE(PG8_SB(0, 1), cB + hstepB, voffB); PG8_STAGE(PG8_SA(0, 0), cA, vC[0]); PG8_STAGE(PG8_SA(0, 1), cA, vC[1]);
    if (wr == 1) PG8_BAR;
    PG8_WAIT_V(2); PG8_BAR;
    PG8_STAGE(PG8_SB(1, 0), cB + kstep, voffB); PG8_STAGE(PG8_SA(1, 0), cA + kstep, vC[0]); PG8_STAGE(PG8_SB(1, 1), cB + hstepB + kstep, voffB);
    PG8_WAIT_V(6); PG8_BAR;
#if TIM_PHASE
    unsigned long long tk_ = 0, ta_ = 0, tb_ = 0, tu_ = 0; unsigned tl_ = 0; const unsigned long long ts_ = __builtin_amdgcn_s_memtime();
#endif
    for (;;) {
#if TIM_PHASE
        const unsigned long long t0_ = __builtin_amdgcn_s_memtime();
#endif
        const char* nA = has_next ? PG8_ABASE(nxt) : cA; const char* nB = has_next ? PG8_BBASE(nxt) : cB;
#pragma unroll 1
        for (int t = 0; t < nt; t += 2) {
            const bool last = (t == nt - 2); const bool relax = false;
            if constexpr (HOOK) { if (t == nt / 2) { const int l_ = lane_id_(); E.mid(acc, cur, wr, wc, l_ & 15, l_ >> 4); } }
            const char* a1 = cA + (size_t)(t + 1) * kstep;
            const char* a2 = last ? nA : cA + (size_t)(t + 2) * kstep; const char* b2 = last ? nB : cB + (size_t)(t + 2) * kstep;
            const char* a3 = a2 + kstep; const char* b3 = b2 + kstep;
            PG8_LDB(B0, 0, 0); PG8_LDB(B1, 0, 1); PG8_SCHED; PG8_LDA(At, 0, 0); PG8_STAGE(PG8_SA(1, 1), a1, vC[1]);
            if (GATHER && last) { const LAS unsigned* pk = PG8_PARK; vC[0][0] = pk[0]; vC[0][1] = pk[1]; vC[1][0] = pk[2]; vC[1][1] = pk[3]; }
            PG8_WAIT_V8R(); PG8_WAIT_L(0); PG8_BAR; PG8_MMA(0, 0, At, B0); PG8_MMA(0, 1, At, B1); PG8_BAR; PG8_SCHED;
            PG8_LDA(At, 0, 1); PG8_STAGE(PG8_SB(0, 0), b2, voffB); PG8_STAGE(PG8_SB(0, 1), b2 + hstepB, voffB); PG8_STAGE2(PG8_SA(0, 0), a2, 0);
            PG8_WAIT_V8R(); PG8_WAIT_L(0); PG8_BAR; PG8_MMA(1, 0, At, B0); PG8_MMA(1, 1, At, B1); PG8_BAR; PG8_SCHED;
            PG8_LDB(B0, 1, 0); PG8_LDB(B1, 1, 1); PG8_SCHED; PG8_LDA(At, 1, 0); PG8_STAGE2(PG8_SA(0, 1), a2, 1);
            PG8_WAIT_V(8); PG8_WAIT_L(0); PG8_BAR; PG8_MMA(0, 0, At, B0); PG8_MMA(0, 1, At, B1); PG8_BAR; PG8_SCHED;
            PG8_LDA(At, 1, 1); PG8_STAGE(PG8_SB(1, 0), b3, voffB); PG8_STAGE(PG8_SB(1, 1), b3 + hstepB, voffB); PG8_STAGE2(PG8_SA(1, 0), a3, 0);
            PG8_WAIT_V(8); PG8_WAIT_L(0); PG8_BAR; PG8_MMA(1, 0, At, B0); PG8_MMA(1, 1, At, B1); PG8_BAR; PG8_SCHED;
        }
#if TIM_PHASE
        const unsigned long long t1_ = __builtin_amdgcn_s_memtime();
#endif
        float rsv[2][4]; f32x4 csv[2][2]; typename PreOf<Epi, HasPre<Epi>::v>::type pf;
        { const int l_ = lane_id_();
          if constexpr (I8) {
            const float* rsp = g.rs + (GATHER ? (size_t)cur.e * CAP : (size_t)0) + (size_t)cur.lt * 256; const float* csp = g.cs + (size_t)cur.e * g.N + cur.pn * 256 + wc * 32 + 8 * (l_ >> 4);
#pragma unroll
            for (int a = 0; a < 2; ++a)
#pragma unroll
                for (int m = 0; m < 4; ++m) { int r = a * 128 + wr * 64 + m * 16 + (l_ & 15); r = r < cur.nvalid ? r : cur.nvalid - 1; rsv[a][m] = rsp[r]; }
#pragma unroll
            for (int b = 0; b < 2; ++b)
#pragma unroll
                for (int n = 0; n < 2; ++n) csv[b][n] = *(const f32x4*)(csp + b * 128 + 4 * n);
          }
          if constexpr (HasPre<Epi>::v && !NOEPI) pf = E.pre(cur, wr, wc, l_ & 15, l_ >> 4); }
        if (wr == 0) PG8_BAR;
        bool has_nn = false; unsigned vT[2][2];
        if (has_next) has_nn = S.next(ui + 2, nn);
        if (GATHER && has_nn) PG8_SETV(nn, vT);
#if TIM_PHASE
        const unsigned long long t2_ = __builtin_amdgcn_s_memtime();
#endif
        if constexpr (I8) {
#pragma unroll
            for (int a = 0; a < 2; ++a)
#pragma unroll
                for (int b = 0; b < 2; ++b)
#pragma unroll
                    for (int m = 0; m < 4; ++m)
#pragma unroll
                        for (int n = 0; n < 2; ++n)
#pragma unroll
                            for (int i = 0; i < 4; ++i) acc[a][b][m][n][i] = ((float)acci[a][b][m][n][i] * rsv[a][m]) * csv[b][n][i];
        }
        { const int l_ = lane_id_();
          if constexpr (!NOEPI) { if constexpr (HasPre<Epi>::v) E(acc, cur, wr, wc, l_ & 15, l_ >> 4, pf); else E(acc, cur, wr, wc, l_ & 15, l_ >> 4); }
          else { _Pragma("unroll") for (int a_ = 0; a_ < 2; ++a_) _Pragma("unroll") for (int b_ = 0; b_ < 2; ++b_) _Pragma("unroll") for (int m_ = 0; m_ < 4; ++m_) _Pragma("unroll") for (int n_ = 0; n_ < 2; ++n_) asm volatile("" :: "v"(acc[a_][b_][m_][n_])); } }
#if TIM_PHASE
        { const unsigned long long t3_ = __builtin_amdgcn_s_memtime(); tk_ += t1_ - t0_; ta_ += t2_ - t1_; tb_ += t3_ - t2_; tu_ += 1;
 }
#endif
        if (!has_next) break;
#pragma unroll
        for (int a = 0; a < 2; ++a)
#pragma unroll
            for (int b = 0; b < 2; ++b)
#pragma unroll
                for (int m = 0; m < 4; ++m)
#pragma unroll
                    for (int n = 0; n < 2; ++n) { acc[a][b][m][n] = (f32x4){0.f, 0.f, 0.f, 0.f}; acci[a][b][m][n] = (v4i){0, 0, 0, 0}; }
        cur = nxt; cA = nA; cB = nB; ++ui;
        if (GATHER && has_nn) { LAS unsigned* pk = PG8_PARK; pk[0] = vT[0][0]; pk[1] = vT[0][1]; pk[2] = vT[1][0]; pk[3] = vT[1][1]; }
        nxt = nn; has_next = has_nn;
        if (wr == 1) PG8_BAR;
    }
    PG8_WAIT_V(0);
    PG8_BAR;
#if TIM_PHASE
    if (g.tim && blockIdx.x == 0 && wid == 0 && lane_id_() == 0) { const unsigned long long te_ = __builtin_amdgcn_s_memtime(); g.tim[0] = (unsigned)tk_; g.tim[1] = (unsigned)ta_; g.tim[2] = (unsigned)tb_; g.tim[3] = (unsigned)tu_; g.tim[4] = (unsigned)(te_ - ts_); g.tim[5] = (unsigned)tl_; }
#endif
#undef PG8_SA
#undef PG8_SB
#undef PG8_STAGE
#undef PG8_STAGE2
#undef PG8_PARK
#undef PG8_LDA
#undef PG8_LDB
#undef PG8_MMA
#undef PG8_CAT
#undef PG8_WAIT_V
#undef PG8_WAIT_V8R
#undef PG8_WAIT_L
#undef PG8_BAR
#undef PG8_SCHED
#undef PG8_SETV
#undef PG8_ABASE
#undef PG8_BBASE
}

template <class F> struct EpiOct {
    F f;
    __device__ __forceinline__ void operator()(const f32x4 (&acc)[2][2][4][2], const Unit& u, int wr, int wc, int fr, int fq) const {
#pragma unroll
        for (int ai = 0; ai < 2; ++ai)
#pragma unroll
            for (int m = 0; m < 4; ++m) {
                const int r = ai * HALF + wr * 64 + m * 16 + fr;
#pragma unroll
                for (int bj = 0; bj < 2; ++bj) f(u, r, bj * HALF + wc * 32 + 8 * fq, acc[ai][bj][m][0], acc[ai][bj][m][1]);
            }
    }
};
}
using pg8::Unit;

__device__ __forceinline__ u32x4 pack8(f32x4 a, f32x4 b) { u32x4 w; w.x = pk2(a[0], a[1]); w.y = pk2(a[2], a[3]); w.z = pk2(b[0], b[1]); w.w = pk2(b[2], b[3]); return w; }
__device__ __forceinline__ void unpack8(u32x4 w, f32x4& a, f32x4& b) { a = (f32x4){bf_lo(w.x), bf_hi(w.x), bf_lo(w.y), bf_hi(w.y)}; b = (f32x4){bf_lo(w.z), bf_hi(w.z), bf_lo(w.w), bf_hi(w.w)}; }

template <bool NOSTORE = false> struct EpiProj_ {
    static constexpr int NVMEM = NOSTORE ? 0 : 16;
    bf16_t* proj; float* logf; const float* rope; const float* lb;
    __device__ __forceinline__ void operator()(const f32x4 (&acc)[2][2][4][2], const Unit& u, int wr, int wc, int fr, int fq) const {
        const int pn = u.pn, colb = pn * 256 + wc * 32 + 8 * fq, rowb = u.pm * 256 + wr * 64 + fr;
        if (pn < 4) {
            const int i0 = (colb & 63) >> 1; const float sc = pn < 2 ? QSCALE : 1.0f;
            f32x4 cs[2][4][2];
#pragma unroll
            for (int ai = 0; ai < 2; ++ai)
#pragma unroll
                for (int m = 0; m < 4; ++m) { const int pos = (rowb + ai * 128 + m * 16) & (SEQ - 1); const float* tp = rope + ((size_t)pos * 32 + i0) * 2; cs[ai][m][0] = *(const f32x4*)tp; cs[ai][m][1] = *(const f32x4*)(tp + 4); }
#pragma unroll
            for (int ai = 0; ai < 2; ++ai)
#pragma unroll
                for (int m = 0; m < 4; ++m) { const f32x4 c0 = cs[ai][m][0] * sc, c1 = cs[ai][m][1] * sc;
#pragma unroll
                    for (int bj = 0; bj < 2; ++bj) { const f32x4 v0 = acc[ai][bj][m][0], v1 = acc[ai][bj][m][1]; f32x4 o0, o1;
                        o0[0] = v0[0] * c0[0] - v0[1] * c0[1]; o0[1] = v0[1] * c0[0] + v0[0] * c0[1]; o0[2] = v0[2] * c0[2] - v0[3] * c0[3]; o0[3] = v0[3] * c0[2] + v0[2] * c0[3];
                        o1[0] = v1[0] * c1[0] - v1[1] * c1[1]; o1[1] = v1[1] * c1[0] + v1[0] * c1[1]; o1[2] = v1[2] * c1[2] - v1[3] * c1[3]; o1[3] = v1[3] * c1[2] + v1[2] * c1[3];
                        { const u32x4 w_ = pack8(o0, o1); if (NOSTORE) asm volatile("" :: "v"(w_)); else __builtin_nontemporal_store(w_, (u32x4*)(proj + (size_t)(rowb + ai * 128 + m * 16) * DIN + colb + bj * 128)); } } }
        } else if (pn == 8 || pn == 9) {
            f32x4 l[2][2];
#pragma unroll
            for (int bj = 0; bj < 2; ++bj) { const float* lp = lb + (colb - C_FB) + bj * 128; l[bj][0] = *(const f32x4*)lp; l[bj][1] = *(const f32x4*)(lp + 4); }
#pragma unroll
            for (int ai = 0; ai < 2; ++ai)
#pragma unroll
                for (int m = 0; m < 4; ++m)
#pragma unroll
                    for (int bj = 0; bj < 2; ++bj) { f32x4 o[2];
#pragma unroll
                        for (int n = 0; n < 2; ++n) { const f32x4 sg = sigmoid4_(acc[ai][bj][m][n]), lv = l[bj][n], t = lv + (1.0f - lv) * sg;
                            o[n] = (f32x4){__logf(t[0]), __logf(t[1]), __logf(t[2]), __logf(t[3])}; }
                        _Float16* p = (_Float16*)logf + (size_t)(rowb + ai * 128 + m * 16) * 512 + (colb - C_FB) + bj * 128;
                        const h16x8 hv = {(_Float16)o[0][0], (_Float16)o[0][1], (_Float16)o[0][2], (_Float16)o[0][3], (_Float16)o[1][0], (_Float16)o[1][1], (_Float16)o[1][2], (_Float16)o[1][3]};
                        if (NOSTORE) asm volatile("" :: "v"(hv)); else *(h16x8*)p = hv; }
        } else {
            const int mode = (pn == 6 || pn == 7 || pn == 12 || pn == 13) ? 1 : (pn >= 14 ? 2 : 0);
#define EPROJ_LOOP(EXPR) _Pragma("unroll") for (int ai = 0; ai < 2; ++ai) _Pragma("unroll") for (int m = 0; m < 4; ++m) _Pragma("unroll") for (int bj = 0; bj < 2; ++bj) { f32x4 o[2]; \
                _Pragma("unroll") for (int n = 0; n < 2; ++n) { const f32x4 x = acc[ai][bj][m][n]; o[n] = (EXPR); } \
                const u32x4 w_ = pack8(o[0], o[1]); if (NOSTORE) asm volatile("" :: "v"(w_)); else __builtin_nontemporal_store(w_, (u32x4*)(proj + (size_t)(rowb + ai * 128 + m * 16) * DIN + colb + bj * 128)); }
            if (mode == 0) { EPROJ_LOOP(x) } else if (mode == 1) { EPROJ_LOOP(x * sigmoid4_(x)) } else {
#pragma unroll
                for (int ai = 0; ai < 2; ++ai)
#pragma unroll
                    for (int m = 0; m < 4; ++m)
#pragma unroll
                        for (int bj = 0; bj < 2; ++bj) { f32x4 o[2];
#pragma unroll
                            for (int n = 0; n < 2; ++n) o[n] = sigmoid4_(acc[ai][bj][m][n]);
                            u32x2 w_; w_.x = pk4_u8(o[0][0], o[0][1], o[0][2], o[0][3]); w_.y = pk4_u8(o[1][0], o[1][1], o[1][2], o[1][3]);
                            unsigned char* gp = (unsigned char*)(proj + (size_t)(rowb + ai * 128 + m * 16) * DIN) + GATE_BYTE0 + (colb - C_GA) + bj * 128;
                            if (NOSTORE) asm volatile("" :: "v"(w_)); else *(u32x2*)gp = w_; }
            }
#undef EPROJ_LOOP
        }
    }
};
typedef EpiProj_<false> EpiProj;
template <bool ACCUM> struct EpiMix {
    bf16_t* mixed; const bf16_t* proj; int gcol;
    __device__ __forceinline__ void operator()(const f32x4 (&acc)[2][2][4][2], const Unit& u, int wr, int wc, int fr, int fq) const {
        const int colb = u.pn * 256 + wc * 32 + 8 * fq, rowb = u.pm * 256 + wr * 64 + fr;
#pragma unroll
        for (int ai = 0; ai < 2; ++ai) {
            u32x4 g[4][2], mx[4][2];
#pragma unroll
            for (int m = 0; m < 4; ++m)
#pragma unroll
                for (int bj = 0; bj < 2; ++bj) { const size_t row = (size_t)(rowb + ai * 128 + m * 16); g[m][bj] = *(const u32x4*)(proj + row * DIN + gcol + colb + bj * 128);
                    if (ACCUM) mx[m][bj] = *(const u32x4*)(mixed + row * DM + colb + bj * 128); }
#pragma unroll
            for (int m = 0; m < 4; ++m)
#pragma unroll
                for (int bj = 0; bj < 2; ++bj) { f32x4 g0, g1; unpack8(g[m][bj], g0, g1); f32x4 v0 = acc[ai][bj][m][0] * g0, v1 = acc[ai][bj][m][1] * g1;
                    if (ACCUM) { f32x4 m0, m1; unpack8(mx[m][bj], m0, m1); v0 = v0 + m0; v1 = v1 + m1; }
                    *(u32x4*)(mixed + (size_t)(rowb + ai * 128 + m * 16) * DM + colb + bj * 128) = pack8(v0, v1); }
        }
    }
};
struct EpiMixF {         static constexpr int NVMEM = 16;
    bf16_t* mixed; const bf16_t* proj;
    __device__ __forceinline__ void mid(f32x4 (&acc)[2][2][4][2], const Unit& u, int wr, int wc, int fr, int fq) const {
        const int colb = u.pn * 256 + wc * 32 + 8 * fq, rowb = u.pm * 256 + wr * 64 + fr;
        u32x2 ga[2][4][2], gb[2][4][2];
#pragma unroll
        for (int ai = 0; ai < 2; ++ai)
#pragma unroll
            for (int m = 0; m < 4; ++m)
#pragma unroll
                for (int bj = 0; bj < 2; ++bj) { const unsigned char* p = (const unsigned char*)(proj + (size_t)(rowb + ai * 128 + m * 16) * DIN) + GATE_BYTE0 + colb + bj * 128; ga[ai][m][bj] = *(const u32x2*)p; gb[ai][m][bj] = *(const u32x2*)(p + 1024); }
#pragma unroll
        for (int ai = 0; ai < 2; ++ai)
#pragma unroll
            for (int m = 0; m < 4; ++m)
#pragma unroll
                for (int bj = 0; bj < 2; ++bj) { const f32x4 a0 = un4_u8(ga[ai][m][bj].x), a1 = un4_u8(ga[ai][m][bj].y), b0 = un4_u8(gb[ai][m][bj].x), b1 = un4_u8(gb[ai][m][bj].y);
                    const f32x4 r0 = a0 * (f32x4){__builtin_amdgcn_rcpf(b0[0]), __builtin_amdgcn_rcpf(b0[1]), __builtin_amdgcn_rcpf(b0[2]), __builtin_amdgcn_rcpf(b0[3])};
                    const f32x4 r1 = a1 * (f32x4){__builtin_amdgcn_rcpf(b1[0]), __builtin_amdgcn_rcpf(b1[1]), __builtin_amdgcn_rcpf(b1[2]), __builtin_amdgcn_rcpf(b1[3])};
                    acc[ai][bj][m][0] = acc[ai][bj][m][0] * r0; acc[ai][bj][m][1] = acc[ai][bj][m][1] * r1; }
    }
    __device__ __forceinline__ void operator()(const f32x4 (&acc)[2][2][4][2], const Unit& u, int wr, int wc, int fr, int fq) const {
        const int colb = u.pn * 256 + wc * 32 + 8 * fq, rowb = u.pm * 256 + wr * 64 + fr;
        u32x2 gb[2][4][2];
#pragma unroll
        for (int ai = 0; ai < 2; ++ai)
#pragma unroll
            for (int m = 0; m < 4; ++m)
#pragma unroll
                for (int bj = 0; bj < 2; ++bj) gb[ai][m][bj] = *(const u32x2*)((const unsigned char*)(proj + (size_t)(rowb + ai * 128 + m * 16) * DIN) + GATE_BYTE0 + 1024 + colb + bj * 128);
#pragma unroll
        for (int ai = 0; ai < 2; ++ai)
#pragma unroll
            for (int m = 0; m < 4; ++m)
#pragma unroll
                for (int bj = 0; bj < 2; ++bj) { const f32x4 b0 = un4_u8(gb[ai][m][bj].x) * (1.0f / 255.0f), b1 = un4_u8(gb[ai][m][bj].y) * (1.0f / 255.0f);
                    *(u32x4*)(mixed + (size_t)(rowb + ai * 128 + m * 16) * DM + colb + bj * 128) = pack8(acc[ai][bj][m][0] * b0, acc[ai][bj][m][1] * b1); }
    }
};
struct EpiOut {
    static constexpr int NVMEM = 16;
    const float* x; bf16_t* x1;
    __device__ __forceinline__ void operator()(const f32x4 (&acc)[2][2][4][2], const Unit& u, int wr, int wc, int fr, int fq) const {
        const int colb = u.pn * 256 + wc * 32 + 8 * fq, rowb = u.pm * 256 + wr * 64 + fr;
#pragma unroll
        for (int ai = 0; ai < 2; ++ai) {
            f32x4 xv[4][2][2];
#pragma unroll
            for (int m = 0; m < 4; ++m)
#pragma unroll
                for (int bj = 0; bj < 2; ++bj) { const float* p = x + (size_t)(rowb + ai * 128 + m * 16) * DM + colb + bj * 128; xv[m][bj][0] = __builtin_nontemporal_load((const f32x4*)p); xv[m][bj][1] = __builtin_nontemporal_load((const f32x4*)(p + 4)); }
#pragma unroll
            for (int m = 0; m < 4; ++m)
#pragma unroll
                for (int bj = 0; bj < 2; ++bj) *(u32x4*)(x1 + (size_t)(rowb + ai * 128 + m * 16) * DM + colb + bj * 128) = pack8(xv[m][bj][0] + acc[ai][bj][m][0], xv[m][bj][1] + acc[ai][bj][m][1]);
        }
    }
};
struct EpiMoe1 {         static constexpr int NVMEM = 8;
    bf16_t* hid; const float* bias;
    struct Pre { f32x4 b[4]; };
    __device__ __forceinline__ Pre pre(const Unit& u, int wr, int wc, int fr, int fq) const { Pre p; const float* bp = bias + (size_t)u.e * 2048 + 2 * (128 * u.pn + wc * 32 + 8 * fq);
#pragma unroll
        for (int j = 0; j < 4; ++j) p.b[j] = *(const f32x4*)(bp + 4 * j);
        return p; }
    __device__ __forceinline__ void operator()(const f32x4 (&acc)[2][2][4][2], const Unit& u, int wr, int wc, int fr, int fq, const Pre& pf) const {
        const int jj0 = wc * 32 + 8 * fq, J0 = 128 * u.pn + jj0;
        const f32x4 (&b)[4] = pf.b;
        constexpr float DQ = MOE1_I8 ? 1.0f : DQ1;
        constexpr float HS = MOE_FP8 ? S_HID : 1.0f, KE = -1.702f * 1.4426950408889634f;
#pragma unroll
        for (int ai = 0; ai < 2; ++ai)
#pragma unroll
            for (int m = 0; m < 4; ++m) {
                const int r = ai * 128 + wr * 64 + m * 16 + fr;
                f32x2 h[4];
#pragma unroll
                for (int p = 0; p < 4; ++p) {
                    const f32x4 ag = acc[ai][0][m][p >> 1], au = acc[ai][1][m][p >> 1];
                    const f32x2 g0 = (p & 1) ? (f32x2){ag[2], ag[3]} : (f32x2){ag[0], ag[1]}, u0 = (p & 1) ? (f32x2){au[2], au[3]} : (f32x2){au[0], au[1]};
                    f32x2 gt = g0 * DQ + (f32x2){b[p][0], b[p][2]}, up = u0 * DQ + (f32x2){b[p][1], b[p][3]};
                    gt.x = fminf(gt.x, 7.0f); gt.y = fminf(gt.y, 7.0f); up.x = __builtin_amdgcn_fmed3f(up.x, -7.0f, 7.0f); up.y = __builtin_amdgcn_fmed3f(up.y, -7.0f, 7.0f);
                    f32x2 e = gt * KE; e.x = __builtin_amdgcn_exp2f(e.x); e.y = __builtin_amdgcn_exp2f(e.y);
                    f32x2 den = e * (1.0f / HS) + (1.0f / HS); den.x = __builtin_amdgcn_rcpf(den.x); den.y = __builtin_amdgcn_rcpf(den.y);
                    h[p] = (up * gt + gt) * den;
                }
                if constexpr (MOE_FP8) { u32x2 w; unsigned t = 0u;
                    t = __builtin_amdgcn_cvt_pk_fp8_f32(h[0].x, h[0].y, t, false); t = __builtin_amdgcn_cvt_pk_fp8_f32(h[1].x, h[1].y, t, true); w.x = t; t = 0u;
                    t = __builtin_amdgcn_cvt_pk_fp8_f32(h[2].x, h[2].y, t, false); t = __builtin_amdgcn_cvt_pk_fp8_f32(h[3].x, h[3].y, t, true); w.y = t;
                    *(u32x2*)((unsigned char*)hid + (size_t)(u.pm * 256 + r) * DE + J0) = w; }
                else { u32x4 w; w.x = pk2(h[0].x, h[0].y); w.y = pk2(h[1].x, h[1].y); w.z = pk2(h[2].x, h[2].y); w.w = pk2(h[3].x, h[3].y);
                    *(u32x4*)(hid + (size_t)(u.pm * 256 + r) * DE + J0) = w; }
            }
    }
};
struct EpiMoe2 {
    static constexpr int NVMEM = MOE_FP8 ? 8 : 16;
    bf16_t* yg; const float* bias; const int* rows; const float* roww;
    struct Pre { f32x4 b[2][2]; int slot[2][4]; float wgt[2][4]; };
    __device__ __forceinline__ Pre pre(const Unit& u, int wr, int wc, int fr, int fq) const { Pre p; f32x4 (&b)[2][2] = p.b; int (&slot)[2][4] = p.slot; float (&wgt)[2][4] = p.wgt;
        const int c0 = MOE_FP8 ? u.pn * 256 + 64 * wc + 16 * fq : 0;
#pragma unroll
        for (int bj = 0; bj < 2; ++bj) { const float* bp = MOE_FP8 ? bias + (size_t)u.e * DM + c0 + 8 * bj : bias + (size_t)u.e * DM + u.pn * 256 + bj * 128 + wc * 32 + 8 * fq; b[bj][0] = *(const f32x4*)bp; b[bj][1] = *(const f32x4*)(bp + 4); }
#pragma unroll
        for (int ai = 0; ai < 2; ++ai)
#pragma unroll
            for (int m = 0; m < 4; ++m) { int r = ai * 128 + wr * 64 + m * 16 + fr; r = r < u.nvalid ? r : u.nvalid - 1; const size_t pp = (size_t)u.e * CAP + u.lt * 256 + r; slot[ai][m] = rows[pp]; wgt[ai][m] = roww[pp]; }
        return p; }
    __device__ __forceinline__ void operator()(const f32x4 (&acc)[2][2][4][2], const Unit& u, int wr, int wc, int fr, int fq, const Pre& pf) const {
        const f32x4 (&b)[2][2] = pf.b; const int (&slot)[2][4] = pf.slot; const float (&wgt)[2][4] = pf.wgt;
        const int c0 = MOE_FP8 ? u.pn * 256 + 64 * wc + 16 * fq : 0;
#pragma unroll
        for (int ai = 0; ai < 2; ++ai)
#pragma unroll
            for (int m = 0; m < 4; ++m) {
                const int r = ai * 128 + wr * 64 + m * 16 + fr; const float w = wgt[ai][m];
                if (r < u.nvalid) {
                    if constexpr (MOE_FP8) { u32x4 q; const float ws = w * S_YG;
#define PK4Y_(A, B) ({ const f32x4 y_ = ((A) * DQ2 + (B)) * ws; unsigned t_ = 0u; \
                        t_ = __builtin_amdgcn_cvt_pk_fp8_f32(__builtin_amdgcn_fmed3f(y_[0], -440.0f, 440.0f), __builtin_amdgcn_fmed3f(y_[1], -440.0f, 440.0f), t_, false); \
                        t_ = __builtin_amdgcn_cvt_pk_fp8_f32(__builtin_amdgcn_fmed3f(y_[2], -440.0f, 440.0f), __builtin_amdgcn_fmed3f(y_[3], -440.0f, 440.0f), t_, true); t_; })
                        q.x = PK4Y_(acc[ai][0][m][0], b[0][0]); q.y = PK4Y_(acc[ai][0][m][1], b[0][1]); q.z = PK4Y_(acc[ai][1][m][0], b[1][0]); q.w = PK4Y_(acc[ai][1][m][1], b[1][1]);
#undef PK4Y_
                        *(u32x4*)((unsigned char*)yg + (size_t)slot[ai][m] * DM + c0) = q; }
                    else {
#pragma unroll
                        for (int bj = 0; bj < 2; ++bj) { const f32x4 y0 = (acc[ai][bj][m][0] * DQ2 + b[bj][0]) * w, y1 = (acc[ai][bj][m][1] * DQ2 + b[bj][1]) * w;
                            *(u32x4*)(yg + (size_t)slot[ai][m] * DM + u.pn * 256 + bj * 128 + wc * 32 + 8 * fq) = pack8(y0, y1); } }
                }
            }
    }
};

struct Args { const float* in[16]; float* out; unsigned char* ws; int ph_lo, ph_hi; };
enum { I_X = 0, I_N1, I_WIN, I_MUP, I_LBL, I_HNW, I_HUP, I_WOUT, I_N2, I_RW, I_RB, I_WGU, I_BGU, I_WD, I_BD, I_FNW };
constexpr int NPHASE = 11;

struct Frame { LAS unsigned char* lds; int tid, lane, wave, G, bid; };
__device__ __forceinline__ Frame fresh(const Frame& F0) { Frame F = F0; const int l = lane_id_(); F.lane = l; F.tid = F0.wave * 64 + l; return F; }

template <int MAP> __device__ __forceinline__ int rowmap(int n) {
    if (MAP == 1) return n < 1024 ? ((n & ~63) | (2 * (n & 31) + ((n >> 5) & 1))) : n;
    if (MAP == 2) { const int J = n >> 1, s = n & 1; return 256 * (J >> 7) + 128 * s + (J & 127); }
    return n;
}
template <int MAP> __device__ __forceinline__ void transpose_item(const float* W, int K, int N, bf16_t* WT, LAS float* scr, int item, int lane, int KP = 0) {
    if (KP == 0) KP = K;
    const int nblk = N / 32, kb = item / nblk, nb = item % nblk, k0 = 64 * kb, n0 = 32 * nb;
    f32x4 v[8];
#pragma unroll
    for (int i = 0; i < 8; ++i) v[i] = __builtin_nontemporal_load((const f32x4*)(W + (size_t)(k0 + 8 * i + (lane >> 3)) * N + n0 + 4 * (lane & 7)));
#pragma unroll
    for (int i = 0; i < 8; ++i) { LAS float* p = scr + (8 * i + (lane >> 3)) * 33 + 4 * (lane & 7); p[0] = v[i].x; p[1] = v[i].y; p[2] = v[i].z; p[3] = v[i].w; }
    asm volatile("s_waitcnt lgkmcnt(0)" ::: "memory");
    const int c = lane & 7;
#pragma unroll
    for (int j = 0; j < 4; ++j) { const int n = (lane >> 3) + 8 * j; const LAS float* s = scr + (8 * c) * 33 + n;
        u32x4 o; o.x = pk2(s[0 * 33], s[1 * 33]); o.y = pk2(s[2 * 33], s[3 * 33]); o.z = pk2(s[4 * 33], s[5 * 33]); o.w = pk2(s[6 * 33], s[7 * 33]);
        *(u32x4*)(WT + (size_t)rowmap<MAP>(n0 + n) * KP + k0 + 8 * c) = o; }
    asm volatile("s_waitcnt lgkmcnt(0)" ::: "memory");
}
template <int MAP> __device__ __forceinline__ void transpose_item_fp8(const float* W, int K, int N, unsigned char* WT, LAS float* scr, int item, int lane) {
    const int nblk = N / 32, kb = item / nblk, nb = item % nblk, k0 = 64 * kb, n0 = 32 * nb;
    f32x4 v[8];
#pragma unroll
    for (int i = 0; i < 8; ++i) v[i] = __builtin_nontemporal_load((const f32x4*)(W + (size_t)(k0 + 8 * i + (lane >> 3)) * N + n0 + 4 * (lane & 7)));
#pragma unroll
    for (int i = 0; i < 8; ++i) { LAS float* p = scr + (8 * i + (lane >> 3)) * 33 + 4 * (lane & 7); p[0] = v[i].x; p[1] = v[i].y; p[2] = v[i].z; p[3] = v[i].w; }
    asm volatile("s_waitcnt lgkmcnt(0)" ::: "memory");
    const int n = lane >> 1, hf = lane & 1; const LAS float* s = scr + (32 * hf) * 33 + n;
    u32x4 o0, o1;
    o0.x = pk4_fp8(s[0 * 33], s[1 * 33], s[2 * 33], s[3 * 33], S_W);     o0.y = pk4_fp8(s[4 * 33], s[5 * 33], s[6 * 33], s[7 * 33], S_W);
    o0.z = pk4_fp8(s[8 * 33], s[9 * 33], s[10 * 33], s[11 * 33], S_W);   o0.w = pk4_fp8(s[12 * 33], s[13 * 33], s[14 * 33], s[15 * 33], S_W);
    o1.x = pk4_fp8(s[16 * 33], s[17 * 33], s[18 * 33], s[19 * 33], S_W); o1.y = pk4_fp8(s[20 * 33], s[21 * 33], s[22 * 33], s[23 * 33], S_W);
    o1.z = pk4_fp8(s[24 * 33], s[25 * 33], s[26 * 33], s[27 * 33], S_W); o1.w = pk4_fp8(s[28 * 33], s[29 * 33], s[30 * 33], s[31 * 33], S_W);
    unsigned char* dst = WT + (size_t)rowmap<MAP>(n0 + n) * K + k0 + 32 * hf;
    *(u32x4*)dst = o0; *(u32x4*)(dst + 16) = o1;
    asm volatile("s_waitcnt lgkmcnt(0)" ::: "memory");
}
__device__ __forceinline__ void tp8_load(const float* W, int N, int item, f32x4 (&v)[8], int lane) {
    const int nblk = N / 32, kb = item / nblk, nb = item % nblk, k0 = 64 * kb, n0 = 32 * nb;
#pragma unroll
    for (int i = 0; i < 8; ++i) v[i] = __builtin_nontemporal_load((const f32x4*)(W + (size_t)(k0 + 8 * i + (lane >> 3)) * N + n0 + 4 * (lane & 7)));
}
template <int MAP> __device__ __forceinline__ void tp8_finish(const f32x4 (&v)[8], int K, int N, unsigned char* WT, LAS float* scr, int item, int lane) {
    const int nblk = N / 32, kb = item / nblk, nb = item % nblk, k0 = 64 * kb, n0 = 32 * nb;
#pragma unroll
    for (int i = 0; i < 8; ++i) { LAS float* p = scr + (8 * i + (lane >> 3)) * 33 + 4 * (lane & 7); p[0] = v[i].x; p[1] = v[i].y; p[2] = v[i].z; p[3] = v[i].w; }
    asm volatile("s_waitcnt lgkmcnt(0)" ::: "memory");
    const int n = lane >> 1, hf = lane & 1; const LAS float* s = scr + (32 * hf) * 33 + n;
    u32x4 o0, o1;
    o0.x = pk4_fp8(s[0 * 33], s[1 * 33], s[2 * 33], s[3 * 33], S_W);     o0.y = pk4_fp8(s[4 * 33], s[5 * 33], s[6 * 33], s[7 * 33], S_W);
    o0.z = pk4_fp8(s[8 * 33], s[9 * 33], s[10 * 33], s[11 * 33], S_W);   o0.w = pk4_fp8(s[12 * 33], s[13 * 33], s[14 * 33], s[15 * 33], S_W);
    o1.x = pk4_fp8(s[16 * 33], s[17 * 33], s[18 * 33], s[19 * 33], S_W); o1.y = pk4_fp8(s[20 * 33], s[21 * 33], s[22 * 33], s[23 * 33], S_W);
    o1.z = pk4_fp8(s[24 * 33], s[25 * 33], s[26 * 33], s[27 * 33], S_W); o1.w = pk4_fp8(s[28 * 33], s[29 * 33], s[30 * 33], s[31 * 33], S_W);
    unsigned char* dst = WT + (size_t)rowmap<MAP>(n0 + n) * K + k0 + 32 * hf;
    *(u32x4*)dst = o0; *(u32x4*)(dst + 16) = o1;
    asm volatile("s_waitcnt lgkmcnt(0)" ::: "memory");
}
struct QItem { const float* W; unsigned char* WT; float* scl; int N, n0, map; };
constexpr int NQ_IN = P1_I8 ? DIN / 32 : 0, NQ_GU = MOE1_I8 ? NE * 64 : 0, NQ = NQ_IN + NQ_GU;
constexpr bool DEFER_MOE_W = (DEFER_MOE_W_ != 0) && MOE1_I8 && MOE_FP8;
__device__ __forceinline__ QItem q_item(const float* win, const float* wgu, unsigned char* ws, int wi) {
    QItem q;
    if (wi < NQ_IN) { q.W = win; q.WT = ws + WS_WIN; q.scl = (float*)(ws + WS_WINS); q.N = DIN; q.n0 = 32 * wi; q.map = 1; }
    else { wi -= NQ_IN; const int e = wi >> 6; q.W = wgu + (size_t)e * DM * 2 * DE; q.WT = ws + WS_WGU + (size_t)e * 2 * DE * DM; q.scl = (float*)(ws + WS_WGS) + (size_t)e * 2 * DE; q.N = 2 * DE; q.n0 = 32 * (wi & 63); q.map = 2; }
    return q;
}
template <int I0 = 0, int CNT = 16> __device__ __forceinline__ void q_load(const QItem& q, f32x4 (&v)[16], int wave, int lane) {
#pragma unroll
    for (int i = I0; i < I0 + CNT; ++i) v[i] = __builtin_nontemporal_load((const f32x4*)(q.W + (size_t)(128 * wave + 8 * i + (lane >> 3)) * q.N + q.n0 + 4 * (lane & 7)));
}
#define Q_FENCE() asm volatile("" ::: "memory")
__device__ __forceinline__ void quant_cols_loop(const float* win, const float* wgu, unsigned char* ws, LAS unsigned char* lds, int wi0, int wi_end, int G, int wave, int lane) {
    LAS float* s = (LAS float*)lds; LAS float* pmax = (LAS float*)(lds + 1024 * 33 * 4);
    int wi = wi0; if (wi >= wi_end) return;
    QItem q = q_item(win, wgu, ws, wi); f32x4 v[16]; q_load(q, v, wave, lane);
    for (;;) {
#pragma unroll
        for (int i = 0; i < 16; ++i) { LAS float* p = s + (128 * wave + 8 * i + (lane >> 3)) * 33 + 4 * (lane & 7); p[0] = v[i].x; p[1] = v[i].y; p[2] = v[i].z; p[3] = v[i].w; }
        lds_barrier();
        const int nw = wi + G; const bool more = nw < wi_end; QItem qn = q;
        if (more) { qn = q_item(win, wgu, ws, nw); q_load<0, 4>(qn, v, wave, lane); }
        Q_FENCE();
        const int n = lane & 31, kb = 128 * wave + 64 * (lane >> 5);
        float x[64]; float am = 0.f;
#pragma unroll
        for (int kk = 0; kk < 32; ++kk) { x[kk] = s[(kb + kk) * 33 + n]; am = fmaxf(am, fabsf(x[kk])); }
        Q_FENCE(); if (more) q_load<4, 4>(qn, v, wave, lane); Q_FENCE();
#pragma unroll
        for (int kk = 32; kk < 64; ++kk) { x[kk] = s[(kb + kk) * 33 + n]; am = fmaxf(am, fabsf(x[kk])); }
        Q_FENCE(); if (more) q_load<8, 4>(qn, v, wave, lane); Q_FENCE();
        pmax[(2 * wave + (lane >> 5)) * 32 + n] = am;
        lds_barrier();
        if (more) q_load<12, 4>(qn, v, wave, lane);
        Q_FENCE();
        am = 0.f;
#pragma unroll
        for (int p = 0; p < 16; ++p) am = fmaxf(am, pmax[p * 32 + n]);
        const float inv = am > 0.f ? 127.0f / am : 0.f;
        const int r = q.map == 1 ? rowmap<1>(q.n0 + n) : rowmap<2>(q.n0 + n);
        if (wave == 0 && lane < 32) q.scl[r] = am * (1.0f / 127.0f);
        unsigned char* dst = q.WT + (size_t)r * 1024 + kb;
#pragma unroll
        for (int qq = 0; qq < 4; ++qq) { u32x4 o;
            o.x = pk4_i8(x[16 * qq + 0] * inv, x[16 * qq + 1] * inv, x[16 * qq + 2] * inv, x[16 * qq + 3] * inv);   o.y = pk4_i8(x[16 * qq + 4] * inv, x[16 * qq + 5] * inv, x[16 * qq + 6] * inv, x[16 * qq + 7] * inv);
            o.z = pk4_i8(x[16 * qq + 8] * inv, x[16 * qq + 9] * inv, x[16 * qq + 10] * inv, x[16 * qq + 11] * inv); o.w = pk4_i8(x[16 * qq + 12] * inv, x[16 * qq + 13] * inv, x[16 * qq + 14] * inv, x[16 * qq + 15] * inv);
            *(u32x4*)(dst + 16 * qq) = o; }
        if (!more) break;
        q = qn; wi = nw;
    }
    lds_barrier();
}
__device__ __forceinline__ void rms_row_to_bf16(const float* xrow, const float* w, bf16_t* orow, int lane) {
    const f32x4* xr = (const f32x4*)xrow + lane; const f32x4* wr = (const f32x4*)w + lane;
    f32x4 v[4]; float s = 0.f;
#pragma unroll
    for (int j = 0; j < 4; ++j) { v[j] = __builtin_nontemporal_load(xr + 64 * j); s += (v[j].x * v[j].x + v[j].y * v[j].y) + (v[j].z * v[j].z + v[j].w * v[j].w); }
    const float rstd = 1.0f / sqrtf(wave_sum(s) * (1.0f / DM) + RMS_EPS);
    u32x2* o8 = (u32x2*)orow + lane;
#pragma unroll
    for (int j = 0; j < 4; ++j) { const f32x4 ww = wr[64 * j]; u32x2 o; o.x = pk2(v[j].x * rstd * ww.x, v[j].y * rstd * ww.y); o.y = pk2(v[j].z * rstd * ww.z, v[j].w * rstd * ww.w); o8[64 * j] = o; }
}
__device__ __forceinline__ void rms_row_to_i8(const float* xrow, const float* w, unsigned char* orow, float* sc, int lane) {
    const f32x4* xr = (const f32x4*)xrow + lane; const f32x4* wr = (const f32x4*)w + lane;
    f32x4 v[4]; float s = 0.f;
#pragma unroll
    for (int j = 0; j < 4; ++j) { v[j] = __builtin_nontemporal_load(xr + 64 * j); s += (v[j].x * v[j].x + v[j].y * v[j].y) + (v[j].z * v[j].z + v[j].w * v[j].w); }
    const float rstd = 1.0f / sqrtf(wave_sum(s) * (1.0f / DM) + RMS_EPS);
    float am = 0.f;
#pragma unroll
    for (int j = 0; j < 4; ++j) { const f32x4 ww = wr[64 * j]; v[j] = v[j] * rstd * ww; am = fmaxf(fmaxf(am, fmaxf(fabsf(v[j].x), fabsf(v[j].y))), fmaxf(fabsf(v[j].z), fabsf(v[j].w))); }
    am = wave_max(am); const float inv = am > 0.f ? 127.0f / am : 0.f;
    unsigned* o4 = (unsigned*)orow + lane;
#pragma unroll
    for (int j = 0; j < 4; ++j) o4[64 * j] = pk4_i8(v[j].x * inv, v[j].y * inv, v[j].z * inv, v[j].w * inv);
    if (lane == 0) *sc = am * (1.0f / 127.0f);
}

__device__ __forceinline__ void p0_prologue(const Frame& F0, const Args& a) {
    const Frame F = fresh(F0);
    unsigned char* ws = a.ws;
    LAS float* scr = (LAS float*)(F.lds + F.wave * 16384);
    const int gw = F.bid * 8 + F.wave, NGW = F.G * 8;
    constexpr int I_IN = P1_I8 ? 0 : 16 * (DIN / 32), I_UP = 8 * 32, I_O = 16 * 32, I_GU = MOE1_I8 ? 0 : 16 * 64, I_D = 16 * 32;
    constexpr int NITEMS = I_IN + 2 * I_UP + I_O + NE * (I_GU + (DEFER_MOE_W ? 0 : I_D));
    for (int it = gw; it < NITEMS; it += NGW) {
        int r = it;
        if (r < I_IN) { transpose_item<1>(a.in[I_WIN], DM, DIN, (bf16_t*)(ws + WS_WIN), scr, r, F.lane); continue; } r -= I_IN;
        if (r < I_UP) { transpose_item<0>(a.in[I_MUP], 512, DM, (bf16_t*)(ws + WS_MUP), scr, r, F.lane, 1024); continue; } r -= I_UP;
        if (r < I_UP) { transpose_item<0>(a.in[I_HUP], 512, DM, (bf16_t*)(ws + WS_MUP) + 512, scr, r, F.lane, 1024); continue; } r -= I_UP;
        if (r < I_O) { transpose_item<0>(a.in[I_WOUT], DM, DM, (bf16_t*)(ws + WS_WOUT), scr, r, F.lane); continue; } r -= I_O;
        if (I_GU > 0 && r < NE * I_GU) { const int e = r / (I_GU > 0 ? I_GU : 1);
            if constexpr (MOE_FP8) transpose_item_fp8<2>(a.in[I_WGU] + (size_t)e * DM * 2 * DE, DM, 2 * DE, (unsigned char*)(ws + WS_WGU) + (size_t)e * 2 * DE * DM, scr, r % (I_GU > 0 ? I_GU : 1), F.lane);
            else transpose_item<2>(a.in[I_WGU] + (size_t)e * DM * 2 * DE, DM, 2 * DE, (bf16_t*)(ws + WS_WGU) + (size_t)e * 2 * DE * DM, scr, r % (I_GU > 0 ? I_GU : 1), F.lane);
            continue; } r -= NE * I_GU;
        { const int e = r / I_D;
            if constexpr (MOE_FP8) transpose_item_fp8<0>(a.in[I_WD] + (size_t)e * DE * DM, DE, DM, (unsigned char*)(ws + WS_WD) + (size_t)e * DM * DE, scr, r % I_D, F.lane);
            else transpose_item<0>(a.in[I_WD] + (size_t)e * DE * DM, DE, DM, (bf16_t*)(ws + WS_WD) + (size_t)e * DM * DE, scr, r % I_D, F.lane); }
    }
    if constexpr (P1_I8) { for (int m = gw; m < NTOK; m += NGW) rms_row_to_i8(a.in[I_X] + (size_t)m * DM, a.in[I_N1], ws + WS_XN + (size_t)m * DM, (float*)(ws + WS_XS) + m, F.lane); }
    else { for (int m = gw; m < NTOK; m += NGW) rms_row_to_bf16(a.in[I_X] + (size_t)m * DM, a.in[I_N1], (bf16_t*)(ws + WS_XN) + (size_t)m * DM, F.lane); }
    if constexpr (NQ > 0) {
        __syncthreads();
        quant_cols_loop(a.in[I_WIN], a.in[I_WGU], ws, F.lds, F.bid, DEFER_MOE_W ? NQ_IN : NQ, F.G, F.wave, F.lane);
    }
    float* rope = (float*)(ws + WS_ROPE);
    for (int idx = F.bid * 512 + F.tid; idx < SEQ * 32; idx += F.G * 512) {
        const int pos = idx >> 5, i = idx & 31;
        const double inv = exp2(-(double)i * (13.287712379549449 / 32.0));
        const double rev = (double)pos * inv * 0.15915494309189535;
        const float fr = (float)(rev - floor(rev));
        rope[2 * idx] = __builtin_amdgcn_cosf(fr); rope[2 * idx + 1] = __builtin_amdgcn_sinf(fr);
    }
    if (F.bid == 0) { const float* l = a.in[I_LBL]; const float a0 = l[F.tid], a1 = l[512 + F.tid]; ((float*)(ws + WS_LB))[F.tid] = 1.0f / (1.0f + __expf(a1 - a0)); }
}

__device__ __forceinline__ void moe_weight_copies(const Frame& F0, const Args& a) {
    const Frame F = fresh(F0);
    unsigned char* ws = a.ws;
    LAS float* scr = (LAS float*)(F.lds + F.wave * 16384);
    const int gw = F.bid * 8 + F.wave, NGW = F.G * 8;
    constexpr int I_D = 16 * 32;
    { f32x4 vc[8], vn[8]; int r = gw;
      if (r < NE * I_D) tp8_load(a.in[I_WD] + (size_t)(r / I_D) * DE * DM, DM, r % I_D, vc, F.lane);
      for (; r < NE * I_D; r += NGW) { const int rn = r + NGW, e = r / I_D;
          if (rn < NE * I_D) tp8_load(a.in[I_WD] + (size_t)(rn / I_D) * DE * DM, DM, rn % I_D, vn, F.lane);
          tp8_finish<0>(vc, DE, DM, (unsigned char*)(ws + WS_WD) + (size_t)e * DM * DE, scr, r % I_D, F.lane);
#pragma unroll
          for (int i = 0; i < 8; ++i) vc[i] = vn[i]; } }
    __syncthreads();
    quant_cols_loop(a.in[I_WIN], a.in[I_WGU], ws, F.lds, NQ_IN + F.bid, NQ, F.G, F.wave, F.lane);
    __syncthreads();
}
__device__ __forceinline__ void p2_kmean(const Frame& F0, const Args& a) {
    const Frame F = fresh(F0);
    const bf16_t* proj = (const bf16_t*)(a.ws + WS_PROJ); bf16_t* km = (bf16_t*)(a.ws + WS_KMEAN);
    LAS float* red = (LAS float*)F.lds;
    for (int it = F.bid; it < 128; it += F.G) {
        const int b = it >> 4, n = it & 15;
        float s[8] = {0, 0, 0, 0, 0, 0, 0, 0};
        const bf16_t* base = proj + (size_t)(b * SEQ + n * 256 + F.wave * 32) * DIN + C_KA + F.lane * 8;
#pragma unroll 8
        for (int r = 0; r < 32; ++r) { const u32x4 w = *(const u32x4*)(base + (size_t)r * DIN); f32x4 x0, x1; unpack8(w, x0, x1);
            s[0] += x0[0]; s[1] += x0[1]; s[2] += x0[2]; s[3] += x0[3]; s[4] += x1[0]; s[5] += x1[1]; s[6] += x1[2]; s[7] += x1[3]; }
#pragma unroll
        for (int j = 0; j < 8; ++j) red[F.wave * 512 + F.lane * 8 + j] = s[j];
        __syncthreads();
        float t = 0.f;
#pragma unroll
        for (int w = 0; w < 8; ++w) t += red[w * 512 + F.tid];
        km[((size_t)b * 64 + n) * 512 + F.tid] = (bf16_t)f2bf(t * (1.0f / 256.0f));
        km[((size_t)b * 64 + n + 16) * 512 + F.tid] = 0; km[((size_t)b * 64 + n + 32) * 512 + F.tid] = 0; km[((size_t)b * 64 + n + 48) * 512 + F.tid] = 0;
        __syncthreads();
    }
}

constexpr int HP = 72, HQ = 136;
__device__ __forceinline__ void h2_scan(const Frame& F0, const Args& a) {
    const Frame F = fresh(F0);
    bf16_t* hst = (bf16_t*)(a.ws + WS_HST); const float* gdec = (const float*)(a.ws + WS_GDEC);
    LAS float* G = (LAS float*)F.lds;
    for (int base = F.bid * 512; base < 32 * 128 * 32; base += F.G * 512) {
        const int idx = base + F.tid, bh = idx >> 12, v = (idx >> 5) & 127, d4 = idx & 31;
        { const f32x4* gp = (const f32x4*)(gdec + (size_t)bh * 64 * 128) + F.tid;
#pragma unroll
          for (int j = 0; j < 4; ++j) *(LAS f32x4*)(G + (F.tid + 512 * j) * 4) = gp[512 * j]; }
        lds_barrier();
        bf16_t* p = hst + ((size_t)bh * 64 * 128 + v) * 128 + d4 * 4;
        f32x4 s = {0.f, 0.f, 0.f, 0.f};
#pragma unroll 1
        for (int c0 = 0; c0 < 64; c0 += 16) {
            u32x2 u[16];
#pragma unroll
            for (int j = 0; j < 16; ++j) u[j] = __builtin_nontemporal_load((const u32x2*)(p + (size_t)(c0 + j) * 16384));
#pragma unroll
            for (int j = 0; j < 16; ++j) { const f32x4 gg = *(const LAS f32x4*)(G + (c0 + j) * 128 + d4 * 4);
                u32x2 w; w.x = pk2(s[0], s[1]); w.y = pk2(s[2], s[3]); *(u32x2*)(p + (size_t)(c0 + j) * 16384) = w;
                s = gg * s + (f32x4){bf_lo(u[j].x), bf_hi(u[j].x), bf_lo(u[j].y), bf_hi(u[j].y)}; }
        }
        lds_barrier();
    }
}
#define H_CVT_LF(LFR, LH) do { _Pragma("unroll") for (int j_ = 0; j_ < 2; ++j_) { const f32x8 f_ = __builtin_convertvector(LH[j_], f32x8); LFR[2 * j_] = (f32x4){f_[0], f_[1], f_[2], f_[3]}; LFR[2 * j_ + 1] = (f32x4){f_[4], f_[5], f_[6], f_[7]}; } } while (0)
constexpr int LFP = 132;
#define H_LOAD_LQI(it_, LFR, QR, IR, WITHQ) do { const int bh_ = (it_) >> 6, c_ = (it_) & 63; const size_t r_ = (size_t)(bh_ >> 2) * SEQ + c_ * 64 + t_r; const int hh_ = (bh_ & 3) * 128 + 16 * seg; \
    _Pragma("unroll") for (int j_ = 0; j_ < 2; ++j_) LFR[j_] = __builtin_nontemporal_load((const h16x8*)((const _Float16*)logf + r_ * 512 + hh_ + 8 * j_));     \
    _Pragma("unroll") for (int j_ = 0; j_ < 2; ++j_) { if (WITHQ) QR[j_] = __builtin_nontemporal_load((const u32x4*)(proj + r_ * DIN + C_QB + hh_ + 8 * j_)); IR[j_] = __builtin_nontemporal_load((const u32x4*)(proj + r_ * DIN + C_IB + hh_ + 8 * j_)); } } while (0)
__device__ __forceinline__ void scatter_it(LAS bf16_t* It, const u32x4 (&ir)[2], int seg, int t_r) {
    const int tsw = (((t_r >> 3) ^ seg) << 3) | (t_r & 7);
#pragma unroll
    for (int j = 0; j < 2; ++j) { const unsigned w[4] = {ir[j].x, ir[j].y, ir[j].z, ir[j].w};
#pragma unroll
        for (int q = 0; q < 4; ++q) { It[(16 * seg + 8 * j + 2 * q) * HP + tsw] = (bf16_t)(w[q] & 0xffffu); It[(16 * seg + 8 * j + 2 * q + 1) * HP + tsw] = (bf16_t)(w[q] >> 16); } }
}
__device__ __forceinline__ void h1_local_states_p(const Frame& F0, const Args& a) {
    const Frame F = fresh(F0);
    const bf16_t* proj = (const bf16_t*)(a.ws + WS_PROJ); const float* logf = (const float*)(a.ws + WS_LOGF);
    bf16_t* hst = (bf16_t*)(a.ws + WS_HST); float* gdec = (float*)(a.ws + WS_GDEC);
    LAS float* LF = (LAS float*)F.lds; LAS bf16_t* Kp = (LAS bf16_t*)(F.lds + 64 * LFP * 4); LAS bf16_t* It = Kp + 128 * HP;
    const int t_r = F.tid >> 3, seg = F.tid & 7, l15 = F.lane & 15, lq = F.lane >> 4;
    f32x4 lfr[4]; h16x8 lhr[2], lhn[2]; u32x4 qdum[2], ir[2], in_[2];
    int it = F.bid;
    if (it < 2048) H_LOAD_LQI(it, lhr, qdum, ir, false);
    for (; it < 2048; it += F.G) {
        const int bh = it >> 6, c = it & 63;
        H_CVT_LF(lfr, lhr);
#pragma unroll
        for (int j = 0; j < 4; ++j) *(LAS f32x4*)(LF + t_r * LFP + 16 * seg + 4 * j) = lfr[j];
        scatter_it(It, ir, seg, t_r);
        const int itn = it + F.G;
        if (itn < 2048) H_LOAD_LQI(itn, lhn, qdum, in_, false);
        lds_barrier();
        if (F.tid < 128) { float run = 0.f;
#pragma unroll 16
            for (int t = 0; t < 64; ++t) { run += LF[t * LFP + F.tid]; LF[t * LFP + F.tid] = run; }
            gdec[((size_t)bh * 64 + c) * 128 + F.tid] = __expf(run); }
        lds_barrier();
        {
            f32x4 bb[4], bl[4];
#pragma unroll
            for (int j = 0; j < 4; ++j) { bb[j] = *(const LAS f32x4*)(LF + t_r * LFP + 16 * seg + 4 * j); bl[j] = *(const LAS f32x4*)(LF + 63 * LFP + 16 * seg + 4 * j); }
#pragma unroll
            for (int j = 0; j < 4; ++j)
#pragma unroll
                for (int q = 0; q < 4; ++q) { const float kv = (1.0f - __expf(lfr[j][q])) * __expf(bl[j][q] - bb[j][q]); Kp[(16 * seg + 4 * j + q) * HP + ((((t_r >> 3) ^ seg) << 3) | (t_r & 7))] = (bf16_t)f2bf(kv); }
        }
        lds_barrier();
        bf16x8 af[2];
#pragma unroll
        for (int ks = 0; ks < 2; ++ks) af[ks] = *(const LAS bf16x8*)(Kp + (16 * F.wave + l15) * HP + (((ks * 4 + lq) ^ F.wave) << 3));
#pragma unroll
        for (int vt = 0; vt < 8; ++vt) {
            f32x4 acc = {0.f, 0.f, 0.f, 0.f};
#pragma unroll
            for (int ks = 0; ks < 2; ++ks) { const bf16x8 bfr = *(const LAS bf16x8*)(It + (16 * vt + l15) * HP + (((ks * 4 + lq) ^ vt) << 3)); acc = __builtin_amdgcn_mfma_f32_16x16x32_bf16(af[ks], bfr, acc, 0, 0, 0); }
            u32x2 w; w.x = pk2(acc[0], acc[1]); w.y = pk2(acc[2], acc[3]);
            *(u32x2*)(hst + (((size_t)bh * 64 + c) * 128 + 16 * vt + l15) * 128 + 16 * F.wave + 4 * lq) = w;
        }
        lds_barrier();
        lhr[0] = lhn[0]; lhr[1] = lhn[1];
        ir[0] = in_[0]; ir[1] = in_[1];
    }
}
#define H3_LOAD_SF(it_, SF) do { const int bh_ = (it_) >> 6, c_ = (it_) & 63; \
    _Pragma("unroll") for (int ks_ = 0; ks_ < 4; ++ks_) SF[ks_] = __builtin_nontemporal_load((const bf16x8*)(hst + (((size_t)bh_ * 64 + c_) * 128 + 16 * w + l15) * 128 + ks_ * 32 + 8 * lq)); } while (0)
#define H3_LOAD_GR(it_, GR) do { const int bh_ = (it_) >> 6, c_ = (it_) & 63; const size_t row0_ = (size_t)(bh_ >> 2) * SEQ + c_ * 64; \
    _Pragma("unroll") for (int tt_ = 0; tt_ < 4; ++tt_) GR[tt_] = __builtin_nontemporal_load((const u32x2*)(proj + (row0_ + 16 * tt_ + l15) * DIN + C_GB + (bh_ & 3) * 128 + 16 * w + 4 * lq)); } while (0)
#define H3_LOAD_Q(it_, QR) do { const int bh_ = (it_) >> 6, c_ = (it_) & 63; const size_t r_ = (size_t)(bh_ >> 2) * SEQ + c_ * 64 + t_r; const int hh_ = (bh_ & 3) * 128 + 16 * seg; \
    _Pragma("unroll") for (int j_ = 0; j_ < 2; ++j_) QR[j_] = __builtin_nontemporal_load((const u32x4*)(proj + r_ * DIN + C_QB + hh_ + 8 * j_)); } while (0)
#define H3_LOAD_LATE(it_, SF, GR) do { H3_LOAD_SF(it_, SF); H3_LOAD_GR(it_, GR); } while (0)
__device__ __forceinline__ void h3_outputs_p(const Frame& F0, const Args& a) {
    const Frame F = fresh(F0);
    const bf16_t* proj = (const bf16_t*)(a.ws + WS_PROJ); const float* logf = (const float*)(a.ws + WS_LOGF);
    const bf16_t* hst = (const bf16_t*)(a.ws + WS_HST); bf16_t* yb = (bf16_t*)(a.ws + WS_YA); const float* nw = a.in[I_HNW];
    LAS float* LF = (LAS float*)F.lds; LAS bf16_t* Qt = (LAS bf16_t*)(F.lds + 64 * LFP * 4); LAS bf16_t* Kt = Qt + 64 * HQ; LAS bf16_t* It = Kt + 64 * HQ; LAS bf16_t* Pm = It + 128 * HP;
    LAS float* rsq = (LAS float*)(Pm + 64 * HP);
    const int t_r = F.tid >> 3, seg = F.tid & 7, l15 = F.lane & 15, lq = F.lane >> 4, w = F.wave;
    f32x4 lfr[4]; h16x8 lhr[2], lhn[2]; u32x4 qr[2], qn[2], ir[2], in_[2]; bf16x8 sf[4], sfn[4]; u32x2 gr[4], grn[4];
    int it = F.bid;
    if (it < 2048) { H_LOAD_LQI(it, lhr, qr, ir, true); H3_LOAD_LATE(it, sf, gr); }
    for (; it < 2048; it += F.G) {
        const int bh = it >> 6, c = it & 63, b = bh >> 2, h = bh & 3; const size_t row0 = (size_t)b * SEQ + c * 64;
        H_CVT_LF(lfr, lhr);
#pragma unroll
        for (int j = 0; j < 4; ++j) *(LAS f32x4*)(LF + t_r * LFP + 16 * seg + 4 * j) = lfr[j];
        scatter_it(It, ir, seg, t_r);
        const int itn = it + F.G;
        if (itn < 2048) H_LOAD_LQI(itn, lhn, qn, in_, false);
        lds_barrier();
        if (itn < 2048) H3_LOAD_Q(itn, qn);
        if (F.tid < 128) { float run = 0.f;
#pragma unroll 16
            for (int t = 0; t < 64; ++t) { run += LF[t * LFP + F.tid]; LF[t * LFP + F.tid] = run; } }
        lds_barrier();
        if (itn < 2048) H3_LOAD_SF(itn, sfn);
        {
            float qv[16], kv[16];
#pragma unroll
            for (int j = 0; j < 4; ++j) { const f32x4 bb = *(const LAS f32x4*)(LF + t_r * LFP + 16 * seg + 4 * j);
#pragma unroll
                for (int q = 0; q < 4; ++q) { const float eb = __expf(bb[q]); const unsigned qw = (j < 2 ? qr[0] : qr[1])[(2 * j + (q >> 1)) & 3];
                    const float qs = (q & 1) ? bf_hi(qw) : bf_lo(qw);
                    qv[4 * j + q] = qs * eb; kv[4 * j + q] = (1.0f - __expf(lfr[j][q])) * __builtin_amdgcn_rcpf(eb); } }
            u32x4 o0, o1;
            o0.x = pk2(qv[0], qv[1]); o0.y = pk2(qv[2], qv[3]); o0.z = pk2(qv[4], qv[5]); o0.w = pk2(qv[6], qv[7]); o1.x = pk2(qv[8], qv[9]); o1.y = pk2(qv[10], qv[11]); o1.z = pk2(qv[12], qv[13]); o1.w = pk2(qv[14], qv[15]);
            *(LAS u32x4*)(Qt + t_r * HQ + 16 * seg) = o0; *(LAS u32x4*)(Qt + t_r * HQ + 16 * seg + 8) = o1;
            o0.x = pk2(kv[0], kv[1]); o0.y = pk2(kv[2], kv[3]); o0.z = pk2(kv[4], kv[5]); o0.w = pk2(kv[6], kv[7]); o1.x = pk2(kv[8], kv[9]); o1.y = pk2(kv[10], kv[11]); o1.z = pk2(kv[12], kv[13]); o1.w = pk2(kv[14], kv[15]);
            *(LAS u32x4*)(Kt + t_r * HQ + 16 * seg) = o0; *(LAS u32x4*)(Kt + t_r * HQ + 16 * seg + 8) = o1;
        }
        lds_barrier();
        if (itn < 2048) H3_LOAD_GR(itn, grn);
        {
            const int tt = w >> 1; bf16x8 qa[4];
#pragma unroll
            for (int ks = 0; ks < 4; ++ks) qa[ks] = *(const LAS bf16x8*)(Qt + (16 * tt + l15) * HQ + ks * 32 + 8 * lq);
#pragma unroll
            for (int j = 0; j < 2; ++j) {
                const int st = (w & 1) * 2 + j; f32x4 acc = {0.f, 0.f, 0.f, 0.f};
#pragma unroll
                for (int ks = 0; ks < 4; ++ks) { const bf16x8 kb = *(const LAS bf16x8*)(Kt + (16 * st + l15) * HQ + ks * 32 + 8 * lq); acc = __builtin_amdgcn_mfma_f32_16x16x32_bf16(qa[ks], kb, acc, 0, 0, 0); }
                const int s = 16 * st + l15;
#pragma unroll
                for (int r = 0; r < 4; ++r) { const int t = 16 * tt + 4 * lq + r; Pm[t * HP + s] = (bf16_t)(s <= t ? f2bf(acc[r]) : 0u); }
            }
        }
        lds_barrier();
        f32x4 o[4];
        {
            bf16x8 ia[2];
#pragma unroll
            for (int ks = 0; ks < 2; ++ks) ia[ks] = *(const LAS bf16x8*)(It + (16 * w + l15) * HP + (((ks * 4 + lq) ^ w) << 3));
#pragma unroll
            for (int tt = 0; tt < 4; ++tt) {
                f32x4 acc = {0.f, 0.f, 0.f, 0.f};
#pragma unroll
                for (int ks = 0; ks < 2; ++ks) { const bf16x8 pb = *(const LAS bf16x8*)(Pm + (16 * tt + l15) * HP + ks * 32 + 8 * lq); acc = __builtin_amdgcn_mfma_f32_16x16x32_bf16(ia[ks], pb, acc, 0, 0, 0); }
#pragma unroll
                for (int ks = 0; ks < 4; ++ks) { const bf16x8 qb = *(const LAS bf16x8*)(Qt + (16 * tt + l15) * HQ + ks * 32 + 8 * lq); acc = __builtin_amdgcn_mfma_f32_16x16x32_bf16(sf[ks], qb, acc, 0, 0, 0); }
                o[tt] = acc;
                float sq = (acc[0] * acc[0] + acc[1] * acc[1]) + (acc[2] * acc[2] + acc[3] * acc[3]);
                sq += __shfl_xor(sq, 16); sq += __shfl_xor(sq, 32);
                if (F.lane < 16) rsq[w * 64 + 16 * tt + F.lane] = sq;
            }
        }
        lds_barrier();
        const int v0 = 16 * w + 4 * lq; const f32x4 nw4 = *(const f32x4*)(nw + h * 128 + v0);
#pragma unroll
        for (int tt = 0; tt < 4; ++tt) {
            const int t = 16 * tt + l15; float tot = 0.f;
#pragma unroll
            for (int ww = 0; ww < 8; ++ww) tot += rsq[ww * 64 + t];
            const float rstd = __builtin_amdgcn_rsqf(tot * (1.0f / 128.0f) + RMS_EPS);
            const u32x2 gg = gr[tt];
            u32x2 y; y.x = pk2(o[tt][0] * rstd * nw4[0] * bf_lo(gg.x), o[tt][1] * rstd * nw4[1] * bf_hi(gg.x)); y.y = pk2(o[tt][2] * rstd * nw4[2] * bf_lo(gg.y), o[tt][3] * rstd * nw4[3] * bf_hi(gg.y));
            *(u32x2*)(yb + (row0 + t) * 1024 + 512 + h * 128 + v0) = y;
        }
        lds_barrier();
        lhr[0] = lhn[0]; lhr[1] = lhn[1];
        qr[0] = qn[0]; qr[1] = qn[1]; ir[0] = in_[0]; ir[1] = in_[1];
#pragma unroll
        for (int j = 0; j < 4; ++j) { sf[j] = sfn[j]; gr[j] = grn[j]; }
    }
}
#undef H3_LOAD_LATE
#undef H3_LOAD_SF
#undef H3_LOAD_Q
#undef H3_LOAD_GR

#include <hip/hip_bf16.h>
#include <cmath>
namespace attn_body {
using bf16=__hip_bfloat16;
using bf16x8=__attribute__((ext_vector_type(8)))short;
using s16x4=__attribute__((ext_vector_type(4)))short;
using f32x16=__attribute__((ext_vector_type(16)))float;
using u32x4=__attribute__((ext_vector_type(4)))unsigned;
constexpr int BATCH=8,NHEAD=8,SEQ=4096,D=64,PIN=5632,POUT=1024,PKM=512;
constexpr int NW=8,QBLK=32,QB=QBLK*NW,KVBLK=64,NQB=SEQ/QB;
constexpr int ATTN_UNIT_ROWS=QB;
__device__ __forceinline__ int crow(int r,int hi){return (r&3)+8*(r>>2)+4*hi;}
#define SBAR() __builtin_amdgcn_sched_barrier(0)
__device__ __forceinline__ void cmask(f32x16&p0,f32x16&p1,int jb,int qrel,int hi){
  const float NEG=-INFINITY; int kb=64*jb+4*hi;
  #pragma unroll
  for(int r=0;r<16;++r){int kv=kb+(r&3)+8*(r>>2); if(kv>qrel)p0[r]=NEG; if(kv+32>qrel)p1[r]=NEG;}
}

__device__ __forceinline__ void smask(f32x16&p0,f32x16&p1,unsigned selm,int n){ if(!((selm>>n)&1u)){ const float NEG=-INFINITY;
  #pragma unroll
  for(int r=0;r<16;++r){p0[r]=NEG;p1[r]=NEG;} } }
constexpr int NSLOT=3, SLOTB=8192;
constexpr int LDS_K=0, LDS_V=NSLOT*SLOTB, LDS_WS=2*NSLOT*SLOTB, LDS_OST=LDS_WS+NW*64*4, LDS_BYTES=LDS_OST+NW*4096;
constexpr float C2=0.125f*1.4426950408889634f;
__device__ __forceinline__ void glds16(const void*gsrc,unsigned lds_dst){unsigned keep;
  asm volatile("s_mov_b32 %0, m0\n\ts_mov_b32 m0, %2\n\ts_nop 0\n\tglobal_load_lds_dwordx4 %1, off\n\ts_mov_b32 m0, %0":"=&s"(keep):"v"(gsrc),"s"(lds_dst):"memory");}
__device__ __forceinline__ float max3f(float a,float b,float c){float r;asm("v_max3_f32 %0, %1, %2, %3":"=v"(r):"v"(a),"v"(b),"v"(c));return r;}
__device__ __forceinline__ float max2f(float a,float b){float r;asm("v_max_f32_e32 %0, %1, %2":"=v"(r):"v"(a),"v"(b));return r;}
__device__ __forceinline__ float fadd_s(float a,float b){float r;asm("v_add_f32_e32 %0, %1, %2":"=v"(r):"v"(a),"v"(b));return r;}
__device__ __forceinline__ float fsub_s(float a,float b){float r;asm("v_sub_f32_e32 %0, %1, %2":"=v"(r):"v"(a),"v"(b));return r;}
typedef float f32x2_t __attribute__((ext_vector_type(2))); typedef __bf16 bf16x2_t __attribute__((ext_vector_type(2)));
__device__ __forceinline__ unsigned cvtpk_s(float lo,float hi){f32x2_t v={lo,hi};bf16x2_t b=__builtin_convertvector(v,bf16x2_t);return __builtin_bit_cast(unsigned,b);}
#define WAIT_BAR(N) asm volatile("s_waitcnt vmcnt(" #N ") lgkmcnt(0)\n\ts_barrier":::"memory")

__device__ __forceinline__ void qkt(f32x16&p0,f32x16&p1,const char*Kslot,const bf16x8*qr,int r32,int hi){
  const char*kb=Kslot+hi*1024+r32*16;
  #pragma unroll
  for(int d0=0;d0<4;++d0){
    const bf16x8 b0=*reinterpret_cast<const bf16x8*>(kb+d0*2048);
    const bf16x8 b1=*reinterpret_cast<const bf16x8*>(kb+d0*2048+512);
    if(d0==0){p0=__builtin_amdgcn_mfma_f32_32x32x16_bf16(b0,qr[0],f32x16{},0,0,0);p1=__builtin_amdgcn_mfma_f32_32x32x16_bf16(b1,qr[0],f32x16{},0,0,0);}
    else{p0=__builtin_amdgcn_mfma_f32_32x32x16_bf16(b0,qr[d0],p0,0,0,0);p1=__builtin_amdgcn_mfma_f32_32x32x16_bf16(b1,qr[d0],p1,0,0,0);}}
}
typedef __attribute__((address_space(3))) const char* lds_cptr;
typedef short v4i16_t __attribute__((ext_vector_type(4)));
__device__ __forceinline__ void kload8(bf16x8*kf,lds_cptr kp){
  kf[0]=*(const __attribute__((address_space(3))) bf16x8*)(kp);      kf[1]=*(const __attribute__((address_space(3))) bf16x8*)(kp+512);
  kf[2]=*(const __attribute__((address_space(3))) bf16x8*)(kp+2048); kf[3]=*(const __attribute__((address_space(3))) bf16x8*)(kp+2560);
  kf[4]=*(const __attribute__((address_space(3))) bf16x8*)(kp+4096); kf[5]=*(const __attribute__((address_space(3))) bf16x8*)(kp+4608);
  kf[6]=*(const __attribute__((address_space(3))) bf16x8*)(kp+6144); kf[7]=*(const __attribute__((address_space(3))) bf16x8*)(kp+6656);
}
__device__ __forceinline__ void kload2(bf16x8*kf,lds_cptr kp,int j){ kf[2*j]=*(const __attribute__((address_space(3))) bf16x8*)(kp+j*2048); kf[2*j+1]=*(const __attribute__((address_space(3))) bf16x8*)(kp+j*2048+512); }
__device__ __forceinline__ s16x4 vtr(lds_cptr p){ return __builtin_bit_cast(s16x4,__builtin_amdgcn_ds_read_tr16_b64_v4i16((__attribute__((address_space(3))) v4i16_t*)p)); }
__device__ __forceinline__ float rowmax(const f32x16&p0,const f32x16&p1){
  float a=max3f(p0[0],p0[1],p1[0]),b=max3f(p0[2],p0[3],p1[1]);a=max3f(a,p1[2],p1[3]);
  #pragma unroll
  for(int r=4;r<16;r+=4){a=max3f(a,p0[r],p0[r+1]);b=max3f(b,p0[r+2],p0[r+3]);a=max3f(a,p1[r],p1[r+1]);b=max3f(b,p1[r+2],p1[r+3]);}
  const float m=max2f(a,b);
  auto rr=__builtin_amdgcn_permlane32_swap(__float_as_uint(m),__float_as_uint(m),false,false);
  return max2f(__uint_as_float(rr[0]),__uint_as_float(rr[1]));
}
__device__ __forceinline__ void pv(f32x16*o,int vb,bf16x8 pa0,bf16x8 pa1,bf16x8 pa2,bf16x8 pa3){
  #pragma unroll
  for(int d0=0;d0<2;++d0){s16x4 lo[4],hi[4];
    #pragma unroll
    for(int ks=0;ks<4;++ks){
      asm volatile("ds_read_b64_tr_b16 %0,%1 offset:%c2":"=&v"(lo[ks]):"v"(vb),"i"(d0*4096+ks*1024):"memory");
      asm volatile("ds_read_b64_tr_b16 %0,%1 offset:%c2":"=&v"(hi[ks]):"v"(vb),"i"(d0*4096+ks*1024+512):"memory");}
    asm volatile("s_waitcnt lgkmcnt(0)":::"memory");SBAR();
    #define PK(k) (bf16x8){lo[k][0],lo[k][1],lo[k][2],lo[k][3],hi[k][0],hi[k][1],hi[k][2],hi[k][3]}
    o[d0]=__builtin_amdgcn_mfma_f32_32x32x16_bf16(pa0,PK(0),o[d0],0,0,0);
    o[d0]=__builtin_amdgcn_mfma_f32_32x32x16_bf16(pa1,PK(1),o[d0],0,0,0);
    o[d0]=__builtin_amdgcn_mfma_f32_32x32x16_bf16(pa2,PK(2),o[d0],0,0,0);
    o[d0]=__builtin_amdgcn_mfma_f32_32x32x16_bf16(pa3,PK(3),o[d0],0,0,0);
    #undef PK
  }
}

#ifndef ATTN_STORE16
#define ATTN_STORE16(p,v) (*(u32x4*)(p)=(v))
#endif
template<int THRL> __device__ __forceinline__ void attn_unit(int wave_,int b,int h,int qb,const bf16*Q,const bf16*__restrict__ K,const bf16*__restrict__ V,const bf16*__restrict__ KM,bf16*O,char*shm){
  const int lane=lane_id_(),tid=wave_*64+lane,r32=lane&31,hi=lane>>5; const int wid=wave_;
  const long rowbase=(long)b*SEQ; const int q0=qb*QB;
  const bf16*Qw=Q+(rowbase+q0+wid*QBLK)*PIN+h*D;
  const bf16*Kh=K+rowbase*PIN+h*D,*Vh=V+rowbase*PIN+h*D;
  const unsigned lds0=(unsigned)(uintptr_t)shm;
  float*wsf=(float*)(shm+LDS_WS)+wid*64;
  const bf16*ksrc=Kh+(long)lane*PIN+wid*8;
  const bf16*kmsrc=KM+((long)b*64+lane)*PKM+h*D+wid*8;
  const bf16*vsrc=Vh+(long)(16*(wid&3)+(lane>>2))*PIN+(wid>>2)*32+(lane&3)*8;
  const unsigned kdst=lds0+LDS_K+wid*1024, vdst=lds0+LDS_V+wid*1024;
  #define DMA_K(t,slot) glds16(ksrc+(long)(t)*KVBLK*PIN,(unsigned)__builtin_amdgcn_readfirstlane(kdst+(slot)))
  #define DMA_V(t,slot) glds16(vsrc+(long)(t)*KVBLK*PIN,(unsigned)__builtin_amdgcn_readfirstlane(vdst+(slot)))
  const int vb0=(int)(lds0+LDS_V)+((lane>>4)&1)*32+(lane&3)*8+(4*hi+((lane&15)>>2))*64;
  const char*Kbase=shm+LDS_K; bf16x8 kf[8];
  const lds_cptr shm3=(lds_cptr)shm; const lds_cptr kp0=shm3+LDS_K+hi*1024+r32*16; const lds_cptr vp0=shm3+LDS_V+((lane>>4)&1)*32+(lane&3)*8+(4*hi+((lane&15)>>2))*64;
  const int NT=(q0+QB)/KVBLK;
  glds16(kmsrc,(unsigned)__builtin_amdgcn_readfirstlane(lds0+LDS_V+2*SLOTB+wid*1024));
  DMA_K(0,0);DMA_V(0,0);DMA_K(1,SLOTB);
  bf16x8 qr[4];
  #pragma unroll
  for(int d0=0;d0<4;++d0)qr[d0]=*reinterpret_cast<const bf16x8*>(&Qw[(long)r32*PIN+d0*16+hi*8]);
  float mhat=0.f,l_reg=0.f;f32x16 o[2];o[0]=f32x16{};o[1]=f32x16{};
  const int qrel=wid*QBLK+r32;
  #define CMASK(P0,P1,t) do{int jb_=(t)-(NT-4); const float sb_=(jb_>=0||((selm>>((t)>>2))&1u))?mhat:INFINITY; {const float nsb_=-sb_;P0=P0+nsb_;P1=P1+nsb_;} if(jb_>=0)cmask(P0,P1,jb_,qrel,hi);}while(0)
  bool resc=false;
  #define START(P0,P1) do{ const float rm=rowmax(P0,P1); resc=false; \
    { const float dl=(rm>-1.0e30f)?rm:0.f; mhat=fadd_s(mhat,dl); \
      _Pragma("unroll") for(int r=0;r<16;++r){P0[r]=fsub_s(P0[r],dl);P1[r]=fsub_s(P1[r],dl);} \
      } \
    _Pragma("unroll") for(int r=0;r<16;++r)P0[r]=__builtin_amdgcn_exp2f(P0[r]); }while(0)
  #define RESC() do{ if(resc){ asm volatile("s_waitcnt lgkmcnt(0)":::"memory"); \
      _Pragma("unroll") for(int d_=0;d_<2;++d_) _Pragma("unroll") for(int r=0;r<16;++r)o[d_][r]*=wsf[crow(r,hi)]; } }while(0)
  f32x16 pA0,pA1,pB0,pB1;
  int sl_prev=0,sl_cur=0,sl_next=SLOTB;
  #define ROT() do{sl_prev=sl_cur;sl_cur=sl_next;sl_next=(sl_next==(NSLOT-1)*SLOTB)?0:sl_next+SLOTB;}while(0)
  DMA_K(2,2*SLOTB);
  unsigned selm=0u;
  WAIT_BAR(4);
  { f32x16 g0,g1;
    qkt(g0,g1,shm+LDS_V+2*SLOTB,qr,r32,hi); asm volatile("s_nop 15\n\ts_nop 7":"+v"(g0),"+v"(g1));
    float gm[8],go[8],g[16];
    #pragma unroll
    for(int r=0;r<8;++r){gm[r]=g0[r];go[r]=__shfl_xor(gm[r],32);}
    #pragma unroll
    for(int j=0;j<4;++j){ g[j]=hi?go[j]:gm[j]; g[4+j]=hi?gm[j]:go[j]; g[8+j]=hi?go[4+j]:gm[4+j]; g[12+j]=hi?gm[4+j]:go[4+j]; }
    #pragma unroll
    for(int s=0;s<3;++s){ float best=-3.0e38f; int bi=-1;
      #pragma unroll
      for(int n=0;n<16;++n){ const bool ok=(n<qb)&&!((selm>>n)&1u)&&(g[n]>best); if(ok){best=g[n];bi=n;} }
      if(bi>=0)selm|=1u<<bi; } }
  WAIT_BAR(3);
  qkt(pA0,pA1,Kbase,qr,r32,hi);asm volatile("s_nop 15\n\ts_nop 7":"+v"(pA0),"+v"(pA1));CMASK(pA0,pA1,0);
  START(pA0,pA1);
  _Pragma("unroll") for(int r=0;r<16;++r)pA1[r]=__builtin_amdgcn_exp2f(pA1[r]);
  WAIT_BAR(0);
  DMA_K(3,0);DMA_V(1,SLOTB);
  ROT();
  kload8(kf,kp0+sl_cur);
  WAIT_BAR(2);
  s16x4 vlo[8],vhi[8]; u32x4 pw0,pw1,pw2,pw3;
  #define PKW(P,B) cvtpk_s(P[B],P[B+1])
  #define PAF(k) __builtin_bit_cast(bf16x8,pw##k)
  #define VFR(i) (bf16x8){vlo[i][0],vlo[i][1],vlo[i][2],vlo[i][3],vhi[i][0],vhi[i][1],vhi[i][2],vhi[i][3]}
  #define PIN(x) asm volatile("":"+v"(x))
  #define MX3(a,b,c) __builtin_fmaxf(__builtin_fmaxf((a),(b)),(c))
  #define GAPA(MF,A0,A1,A2,A3,W0,W1,PW) do{ MF; sacc+=A0; sacc+=A1; sacc+=A2; sacc+=A3; PIN(sacc); W0; W1; PIN(PW); SBAR(); }while(0)
  #define EX(v) __builtin_amdgcn_exp2f(v)
  #define GAPB(MF,X,B) do{ MF; X[B]=EX(X[B]); X[B+1]=EX(X[B+1]); X[B+2]=EX(X[B+2]); X[B+3]=EX(X[B+3]); PIN(X); SBAR(); }while(0)
  #define VRD(i) do{ vlo[i]=vtr(vp_+(((i)>>2)*4096+((i)&3)*1024)); vhi[i]=vtr(vp_+(((i)>>2)*4096+((i)&3)*1024+512)); }while(0)
  #define KRD(G,j) do{ if(G){ kload2(kf,kp0+sl_next,j); SBAR(); } }while(0)
  #define STEP(C0,C1,P0,P1,t,GK,GV,GL) do{ SBAR(); \
    const lds_cptr vp_=vp0+sl_prev; \
    VRD(0); SBAR(); float sacc=(P0[0]+P0[1]); \
    GAPA(C0=__builtin_amdgcn_mfma_f32_32x32x16_bf16(kf[0],qr[0],f32x16{},0,0,0), P0[2],P0[3],P0[4],P0[5],     pw0[0]=PKW(P0,0), pw0[1]=PKW(P0,2), pw0); \
    VRD(4); SBAR(); GAPA(C1=__builtin_amdgcn_mfma_f32_32x32x16_bf16(kf[1],qr[0],f32x16{},0,0,0), P0[6],P0[7],P0[8],P0[9],     pw0[2]=PKW(P0,4), pw0[3]=PKW(P0,6), pw0); \
    VRD(1); SBAR(); GAPA(C0=__builtin_amdgcn_mfma_f32_32x32x16_bf16(kf[2],qr[1],C0,0,0,0),   P0[10],P0[11],P0[12],P0[13], pw1[0]=PKW(P0,8), pw1[1]=PKW(P0,10), pw1); \
    VRD(5); SBAR(); GAPA(C1=__builtin_amdgcn_mfma_f32_32x32x16_bf16(kf[3],qr[1],C1,0,0,0),   P0[14],P0[15],P1[0],P1[1],   pw1[2]=PKW(P0,12),pw1[3]=PKW(P0,14), pw1); \
    VRD(2); SBAR(); GAPA(C0=__builtin_amdgcn_mfma_f32_32x32x16_bf16(kf[4],qr[2],C0,0,0,0),   P1[2],P1[3],P1[4],P1[5],     pw2[0]=PKW(P1,0), pw2[1]=PKW(P1,2), pw2); \
    VRD(6); SBAR(); GAPA(C1=__builtin_amdgcn_mfma_f32_32x32x16_bf16(kf[5],qr[2],C1,0,0,0),   P1[6],P1[7],P1[8],P1[9],     pw2[2]=PKW(P1,4), pw2[3]=PKW(P1,6), pw2); \
    VRD(3); SBAR(); GAPA(C0=__builtin_amdgcn_mfma_f32_32x32x16_bf16(kf[6],qr[3],C0,0,0,0),   P1[10],P1[11],P1[12],P1[13], pw3[0]=PKW(P1,8), pw3[1]=PKW(P1,10), pw3); \
    VRD(7); SBAR(); GAPA(C1=__builtin_amdgcn_mfma_f32_32x32x16_bf16(kf[7],qr[3],C1,0,0,0),   P1[14],P1[15],0.f,0.f,       pw3[2]=PKW(P1,12),pw3[3]=PKW(P1,14), pw3); \
    l_reg+=sacc; \
    if(GK){DMA_K((t)+3,sl_cur);} if(GV){DMA_V((t)+1,sl_next);} \
    CMASK(C0,C1,t); \
    { float a=MX3(C0[0],C0[1],C1[0]),b=MX3(C0[2],C0[3],C1[1]); a=MX3(a,C1[2],C1[3]); \
      _Pragma("unroll") for(int r=4;r<16;r+=4){a=MX3(a,C0[r],C0[r+1]);b=MX3(b,C0[r+2],C0[r+3]);a=MX3(a,C1[r],C1[r+1]);b=MX3(b,C1[r+2],C1[r+3]);} \
      float rm=__builtin_fmaxf(a,b); { auto rr=__builtin_amdgcn_permlane32_swap(__float_as_uint(rm),__float_as_uint(rm),false,false); rm=__builtin_fmaxf(__uint_as_float(rr[0]),__uint_as_float(rr[1])); } \
      resc=false; \
      if(__builtin_expect(__any(rm>(float)THRL),0)){ const float dl=__builtin_fmaxf(rm,0.f); mhat+=dl; \
        _Pragma("unroll") for(int r=0;r<16;++r){C0[r]-=dl;C1[r]-=dl;} \
        const float f=__builtin_amdgcn_exp2f(-dl); l_reg*=f; if(hi==0){int r_=r32; asm volatile("":"+v"(r_)); wsf[r_]=f;} resc=true; } } \
    SBAR(); \
    GAPB(o[0]=__builtin_amdgcn_mfma_f32_32x32x16_bf16(PAF(0),VFR(0),o[0],0,0,0), C0,0); \
    GAPB(o[1]=__builtin_amdgcn_mfma_f32_32x32x16_bf16(PAF(0),VFR(4),o[1],0,0,0), C0,4); \
    KRD(GL,0); GAPB(o[0]=__builtin_amdgcn_mfma_f32_32x32x16_bf16(PAF(1),VFR(1),o[0],0,0,0), C0,8); \
    KRD(GL,1); GAPB(o[1]=__builtin_amdgcn_mfma_f32_32x32x16_bf16(PAF(1),VFR(5),o[1],0,0,0), C0,12); \
    KRD(GL,2); GAPB(o[0]=__builtin_amdgcn_mfma_f32_32x32x16_bf16(PAF(2),VFR(2),o[0],0,0,0), C1,0); \
    KRD(GL,3); GAPB(o[1]=__builtin_amdgcn_mfma_f32_32x32x16_bf16(PAF(2),VFR(6),o[1],0,0,0), C1,4); \
    GAPB(o[0]=__builtin_amdgcn_mfma_f32_32x32x16_bf16(PAF(3),VFR(3),o[0],0,0,0), C1,8); \
    GAPB(o[1]=__builtin_amdgcn_mfma_f32_32x32x16_bf16(PAF(3),VFR(7),o[1],0,0,0), C1,12); \
    }while(0)
  int t=1;
  #undef CMASK
  #define CMASK(P0,P1,t) do{ const float sb_=((selm>>((t)>>2))&1u)?mhat:INFINITY; {const float nsb_=-sb_;P0=P0+nsb_;P1=P1+nsb_;} }while(0)
  for(;t+5<NT;t+=2){
    STEP(pB0,pB1,pA0,pA1,t,true,true,true);     WAIT_BAR(2); RESC(); ROT();
    STEP(pA0,pA1,pB0,pB1,t+1,true,true,true);   WAIT_BAR(2); RESC(); ROT();
  }
  #undef CMASK
  #define CMASK(P0,P1,t) do{int jb_=(t)-(NT-4); const float sb_=(jb_>=0||((selm>>((t)>>2))&1u))?mhat:INFINITY; {const float nsb_=-sb_;P0=P0+nsb_;P1=P1+nsb_;} if(jb_>=0)cmask(P0,P1,jb_,qrel,hi);}while(0)
  #define ENDW(tt) do{ if((tt)+3<NT){WAIT_BAR(2);} else if((tt)+2<NT){WAIT_BAR(1);} else {WAIT_BAR(0);} }while(0)
  for(;t+1<NT;t+=2){
    STEP(pB0,pB1,pA0,pA1,t,(t+3<NT),(t+1<NT),(t+1<NT));       ENDW(t);   RESC(); ROT();
    STEP(pA0,pA1,pB0,pB1,t+1,(t+4<NT),(t+2<NT),(t+2<NT));     ENDW(t+1); RESC(); ROT();
  }
  STEP(pB0,pB1,pA0,pA1,NT-1,false,false,false); RESC();
  { float sacc=pB0[0]+pB0[1]; _Pragma("unroll") for(int r=2;r<16;++r)sacc+=pB0[r]; _Pragma("unroll") for(int r=0;r<16;++r)sacc+=pB1[r]; l_reg+=sacc;
    pw0=(u32x4){PKW(pB0,0),PKW(pB0,2),PKW(pB0,4),PKW(pB0,6)};pw1=(u32x4){PKW(pB0,8),PKW(pB0,10),PKW(pB0,12),PKW(pB0,14)};pw2=(u32x4){PKW(pB1,0),PKW(pB1,2),PKW(pB1,4),PKW(pB1,6)};pw3=(u32x4){PKW(pB1,8),PKW(pB1,10),PKW(pB1,12),PKW(pB1,14)};
    SBAR(); pv(o,vb0+sl_cur,PAF(0),PAF(1),PAF(2),PAF(3)); }
  #undef PKW
  #undef PAF
  #undef VFR
  #undef PIN
  #undef MX3
  #undef GAPA
  #undef GAPB
  #undef EX
  #undef VRD
  #undef KRD
  #undef STEP
  #undef ENDW
  {auto rr=__builtin_amdgcn_permlane32_swap(__float_as_uint(l_reg),__float_as_uint(l_reg),false,false);l_reg=__uint_as_float(rr[0])+__uint_as_float(rr[1]);}
  if(hi==0)wsf[32+r32]=l_reg;asm volatile("s_waitcnt lgkmcnt(0)":::"memory");
  float rli[16];
  #pragma unroll
  for(int r=0;r<16;++r)rli[r]=__builtin_amdgcn_rcpf(wsf[32+crow(r,hi)]);
  bf16*Ow=O+(rowbase+q0+wid*QBLK)*POUT+h*D;
  { bf16*stg=(bf16*)(shm+LDS_OST)+wid*2048;
    #pragma unroll
    for(int r=0;r<16;++r){const int orow=crow(r,hi);
      #pragma unroll
      for(int d0=0;d0<2;++d0)stg[orow*64+d0*32+r32]=__float2bfloat16(o[d0][r]*rli[r]);}
    asm volatile("s_waitcnt lgkmcnt(0)":::"memory");
    #pragma unroll
    for(int i=0;i<4;++i){const int row=i*8+(lane>>3),ch=lane&7; const u32x4 v=*(const u32x4*)(stg+row*64+ch*8); ATTN_STORE16(Ow+(long)row*POUT+ch*8,v);} }
  asm volatile("s_waitcnt lgkmcnt(0)\n\ts_barrier":::"memory");
  #undef DMA_K
  #undef DMA_V
  #undef CMASK
  #undef START
  #undef RESC
  #undef ROT
}
constexpr int ATTN_LDS_BYTES=LDS_BYTES;
struct AttnTensors { const bf16* Q; const bf16* K; const bf16* V; const bf16* KM; bf16* O; };
struct AttnUnit { int bh; int qb; };
struct StaticOrder {
  int vcu,G,blk;
  __device__ __forceinline__ explicit StaticOrder(int grid,int block):vcu((grid%8==0)?(block%8)*(grid/8)+block/8:block),G(grid),blk(block){}
  __device__ __forceinline__ bool next(int i,AttnUnit&u)const{
    if(G==256){ if(i>=4)return false; const int s=vcu&3; u.bh=vcu>>2; u.qb=(i==0)?s:(i==1)?7-s:(i==2)?8+s:15-s; return true; }
    const int idx=i*G+blk; if(idx>=BATCH*NHEAD*NQB)return false; u.bh=idx/NQB; u.qb=idx%NQB; return true; }
  __device__ __forceinline__ void a_ready(const AttnUnit&)const{}
  __device__ __forceinline__ void done(const AttnUnit&)const{}
};
template<class Sched,int THRL=8> __device__ __forceinline__ void attn_phase(char*lds,const AttnTensors&T,const Sched&S,int wave_){
  AttnUnit u;
  for(int i=0;S.next(i,u);++i){ S.a_ready(u); attn_unit<THRL>(wave_,u.bh/NHEAD,u.bh%NHEAD,u.qb,T.Q,T.K,T.V,T.KM,T.O,lds); S.done(u); }
}
#undef SBAR
#undef WAIT_BAR
}

template <bool DRY = false> __device__ __forceinline__ void p6_route(const Frame& F0, const Args& a) {
    const Frame F = fresh(F0);
    const bf16_t* x1 = (const bf16_t*)(a.ws + WS_X1); bf16_t* xn = (bf16_t*)(a.ws + WS_XN); const float* rw = a.in[I_RW]; const float* rb = a.in[I_RB]; const float* n2 = a.in[I_N2];
    unsigned* cnt = (unsigned*)(a.ws + WS_CTL) + CW_CNT; int* rows = (int*)(a.ws + WS_ROWS); float* roww = (float*)(a.ws + WS_ROWW);
    constexpr int HP2 = 1040;
    LAS float* H2 = (LAS float*)F.lds;
    LAS float* PL = (LAS float*)(F.lds + 16 * HP2 * 4);
    LAS int* lcnt = (LAS int*)(F.lds + MISC_OFF); LAS int* lbase = lcnt + 32; LAS int* ae = lbase + 32; LAS int* ap = ae + 512; LAS float* aw = (LAS float*)(ap + 512); LAS float* hsrow = aw + 512;
    float* rowhs = (float*)(a.ws + WS_ROWHS);
    const int lane = F.lane, e = lane & 31, w = F.wave, l15 = lane & 15, kq = lane >> 4;
    float rwq[8][4][2];
#pragma unroll
    for (int g = 0; g < 8; ++g)
#pragma unroll
        for (int s = 0; s < 4; ++s)
#pragma unroll
            for (int h = 0; h < 2; ++h) rwq[g][s][h] = rw[(size_t)(128 * w + 16 * g + 4 * kq + s) * NE + 16 * h + l15];
    const float bias = rb[e];
    for (int blk = F.bid; blk < NTOK / 128; blk += F.G) {
        if (F.tid < 32) lcnt[F.tid] = 0;
        u32x2 xq[2][4];
#pragma unroll
        for (int rr = 0; rr < 2; ++rr) { const u32x2* xr = (const u32x2*)(x1 + ((size_t)blk * 128 + 2 * w + rr) * DM) + lane;
#pragma unroll
            for (int j = 0; j < 4; ++j) xq[rr][j] = __builtin_nontemporal_load(xr + 64 * j); }
#pragma unroll 1
        for (int sub = 0; sub < 8; ++sub) {
#pragma unroll
            for (int rr = 0; rr < 2; ++rr) {
                const int rl = 2 * w + rr; const size_t row = (size_t)blk * 128 + sub * 16 + rl;
                const f32x4* wr = (const f32x4*)n2 + lane;
                f32x4 v[4]; float s = 0.f;
#pragma unroll
                for (int j = 0; j < 4; ++j) { const u32x2 xw = xq[rr][j]; v[j] = (f32x4){bf_lo(xw.x), bf_hi(xw.x), bf_lo(xw.y), bf_hi(xw.y)}; s += (v[j].x * v[j].x + v[j].y * v[j].y) + (v[j].z * v[j].z + v[j].w * v[j].w); }
                const float rstd = __builtin_amdgcn_rsqf(wave_sum(s) * (1.0f / DM) + RMS_EPS);
                u32x2* o8 = (u32x2*)(xn + row * DM) + lane; unsigned* o4 = (unsigned*)((unsigned char*)xn + row * DM) + lane;
#pragma unroll
                for (int j = 0; j < 4; ++j) { const f32x4 ww = wr[64 * j]; const f32x4 hv = v[j] * rstd * ww;
                    if constexpr (MOE1_I8) v[j] = hv;
                    else if constexpr (MOE_FP8) o4[64 * j] = pk4_fp8(hv.x, hv.y, hv.z, hv.w, S_H2);
                    else { u32x2 o; o.x = pk2(hv.x, hv.y); o.y = pk2(hv.z, hv.w); o8[64 * j] = o; }
                    *(LAS f32x4*)(H2 + rl * HP2 + 256 * j + 4 * lane) = hv; }
                if constexpr (MOE1_I8) {
                    float am = 0.f;
#pragma unroll
                    for (int j = 0; j < 4; ++j) am = fmaxf(fmaxf(am, fmaxf(fabsf(v[j].x), fabsf(v[j].y))), fmaxf(fabsf(v[j].z), fabsf(v[j].w)));
                    am = wave_max(am); const float inv = am > 0.f ? 127.0f / am : 0.f;
#pragma unroll
                    for (int j = 0; j < 4; ++j) o4[64 * j] = pk4_i8(v[j].x * inv, v[j].y * inv, v[j].z * inv, v[j].w * inv);
                    if (lane == 0) hsrow[sub * 16 + rl] = am * (1.0f / 127.0f); }
            }
            if (sub < 7) {
#pragma unroll
                for (int rr = 0; rr < 2; ++rr) { const u32x2* xr = (const u32x2*)(x1 + ((size_t)blk * 128 + (sub + 1) * 16 + 2 * w + rr) * DM) + lane;
#pragma unroll
                    for (int j = 0; j < 4; ++j) xq[rr][j] = __builtin_nontemporal_load(xr + 64 * j); }
            }
            lds_barrier();
            {
                f32x4 acc0 = {0.f, 0.f, 0.f, 0.f}, acc1 = {0.f, 0.f, 0.f, 0.f};
#pragma unroll
                for (int g = 0; g < 8; ++g) {
                    const f32x4 hq = *(const LAS f32x4*)(H2 + l15 * HP2 + 128 * w + 16 * g + 4 * kq);
#pragma unroll
                    for (int s = 0; s < 4; ++s) { acc0 = __builtin_amdgcn_mfma_f32_16x16x4f32(hq[s], rwq[g][s][0], acc0, 0, 0, 0); acc1 = __builtin_amdgcn_mfma_f32_16x16x4f32(hq[s], rwq[g][s][1], acc1, 0, 0, 0); }
                }
#pragma unroll
                for (int r = 0; r < 4; ++r) { PL[(w * 16 + 4 * kq + r) * 32 + l15] = acc0[r]; PL[(w * 16 + 4 * kq + r) * 32 + 16 + l15] = acc1[r]; }
            }
            lds_barrier();
            {
                const int rl = 2 * w + (lane >> 5); float val = bias;
#pragma unroll
                for (int ww = 0; ww < 8; ++ww) val += PL[(ww * 16 + rl) * 32 + e];
                unsigned key; { unsigned u = __builtin_bit_cast(unsigned, val); u ^= (unsigned)((int)u >> 31) | 0x80000000u; key = (u & ~31u) | (unsigned)(31 - e); }
                float tv[4]; int te[4];
#pragma unroll
                for (int k = 0; k < 4; ++k) {
                    unsigned m = key, o;
                    o = (unsigned)__builtin_amdgcn_update_dpp(0, (int)m, 0xB1, 0xF, 0xF, false);  m = m > o ? m : o;
                    o = (unsigned)__builtin_amdgcn_update_dpp(0, (int)m, 0x4E, 0xF, 0xF, false);  m = m > o ? m : o;
                    o = (unsigned)__builtin_amdgcn_update_dpp(0, (int)m, 0x141, 0xF, 0xF, false); m = m > o ? m : o;
                    o = (unsigned)__builtin_amdgcn_update_dpp(0, (int)m, 0x140, 0xF, 0xF, false); m = m > o ? m : o;
                    o = (unsigned)__shfl_xor((int)m, 16); m = m > o ? m : o;
                    te[k] = 31 - (int)(m & 31u); { const unsigned vb = m & ~31u; tv[k] = __builtin_bit_cast(float, (vb & 0x80000000u) ? (vb ^ 0x80000000u) : ~vb); }
                    if (e == te[k]) key = 0u;
                }
                if (e == 0) {
                    const float p1 = __expf(tv[1] - tv[0]), p2 = __expf(tv[2] - tv[0]), p3 = __expf(tv[3] - tv[0]); const float inv = 1.0f / (1.0f + p1 + p2 + p3);
                    const float w4[4] = {inv, p1 * inv, p2 * inv, p3 * inv};
                    const int rb_ = sub * 16 + rl;
#pragma unroll
                    for (int k = 0; k < 4; ++k) { const int pos = atomicAdd((int*)&lcnt[te[k]], 1); ae[rb_ * 4 + k] = te[k]; ap[rb_ * 4 + k] = pos; aw[rb_ * 4 + k] = w4[k]; }
                }
            }
        }
        lds_barrier();
        if (!DRY) { if (F.tid < 32) lbase[F.tid] = (int)__hip_atomic_fetch_add(cnt + F.tid, (unsigned)lcnt[F.tid], __ATOMIC_RELAXED, __HIP_MEMORY_SCOPE_AGENT); }
        lds_barrier();
        if (!DRY) { const int ee = ae[F.tid]; const size_t p = (size_t)ee * CAP + lbase[ee] + ap[F.tid]; rows[p] = blk * 512 + F.tid; roww[p] = aw[F.tid]; if constexpr (MOE1_I8) rowhs[p] = hsrow[F.tid >> 2]; }
        lds_barrier();
    }
}
__device__ __forceinline__ int moe_tiles(const Frame& F, const Args& a, LAS int* ts) {
    if (F.wave == 0) {
        const unsigned* cnt = (const unsigned*)(a.ws + WS_CTL) + CW_CNT; const int e = F.lane & 31;
        const int c = (int)__hip_atomic_load(cnt + e, __ATOMIC_RELAXED, __HIP_MEMORY_SCOPE_AGENT); const int tl = (c + 255) >> 8;
        int incl = tl;
#pragma unroll
        for (int o = 1; o < 32; o <<= 1) { const int v = __shfl_up(incl, o, 32); if (e >= o) incl += v; }
        if (F.lane < 32) { ts[e] = incl - tl; ts[33 + e] = c; if (e == 31) ts[32] = incl; }
    }
    __syncthreads();
    return ts[32];
}
__device__ __forceinline__ void p9_final(const Frame& F0, const Args& a) {
    const Frame F = fresh(F0);
    float* out = a.out; const bf16_t* yg = (const bf16_t*)(a.ws + WS_YG); const float* fw = a.in[I_FNW]; const bf16_t* x1 = (const bf16_t*)(a.ws + WS_X1);
    const int gw = F.bid * 8 + F.wave, NGW = F.G * 8;
    for (int row = gw; row < NTOK; row += NGW) {
        f32x4* xr = (f32x4*)(out + (size_t)row * DM) + F.lane;
        f32x4 v[4]; const u32x2* x1r = (const u32x2*)(x1 + (size_t)row * DM) + F.lane;
#pragma unroll
        for (int j = 0; j < 4; ++j) { const u32x2 xw = __builtin_nontemporal_load(x1r + 64 * j); v[j] = (f32x4){bf_lo(xw.x), bf_hi(xw.x), bf_lo(xw.y), bf_hi(xw.y)}; }
#pragma unroll
        for (int k = 0; k < 4; ++k) {
            if constexpr (MOE_FP8) { const unsigned* yp = (const unsigned*)((const unsigned char*)yg + ((size_t)row * 4 + k) * DM) + F.lane;
#pragma unroll
                for (int j = 0; j < 4; ++j) { const unsigned w = __builtin_nontemporal_load(yp + 64 * j); const f32x2 lo = __builtin_amdgcn_cvt_pk_f32_fp8(w, false), hi = __builtin_amdgcn_cvt_pk_f32_fp8(w, true);
                    v[j].x += lo.x * (1.0f / S_YG); v[j].y += lo.y * (1.0f / S_YG); v[j].z += hi.x * (1.0f / S_YG); v[j].w += hi.y * (1.0f / S_YG); } }
            else { const u32x2* yp = (const u32x2*)(yg + ((size_t)row * 4 + k) * DM) + F.lane;
#pragma unroll
                for (int j = 0; j < 4; ++j) { const u32x2 w = yp[64 * j]; v[j].x += bf_lo(w.x); v[j].y += bf_hi(w.x); v[j].z += bf_lo(w.y); v[j].w += bf_hi(w.y); } } }
        float s = 0.f;
#pragma unroll
        for (int j = 0; j < 4; ++j) s += (v[j].x * v[j].x + v[j].y * v[j].y) + (v[j].z * v[j].z + v[j].w * v[j].w);
        const float rstd = 1.0f / sqrtf(wave_sum(s) * (1.0f / DM) + RMS_EPS);
        const f32x4* wr = (const f32x4*)fw + F.lane;
#if TIM_PHASE
        { const unsigned* tm = (const unsigned*)(a.ws + WS_CTL) + 208; const unsigned den = (TIM_SEL == 4 ? 1u : (tm[3] ? tm[3] : 1u)) * (unsigned)(TIM_UNIT); unsigned q = tm[TIM_SEL] / den; q = q > 24u ? 24u : q; const float sc_ = 1.0f + (float)q;
#pragma unroll
          for (int j = 0; j < 4; ++j) v[j] = v[j] * sc_; }
#endif
#pragma unroll
        for (int j = 0; j < 4; ++j) xr[64 * j] = v[j] * rstd * wr[64 * j];
    }
}

#define XB_TMO      128
#define XB_XCNT(j)  (256  + 64 * (j))
#define XB_XSUB(j)  (1280 + 64 * (j))
#define XB_XGEN(j)  (2304 + 64 * (j))
#define XB_TOP      3328
#define XB_TOPGEN   3392
#define XCD_BAR_WORDS 3456
#define XB_SPIN_CAP (1u << 18)

__device__ __forceinline__ unsigned xb_ld(unsigned* p)              { return __hip_atomic_load(p, __ATOMIC_RELAXED, __HIP_MEMORY_SCOPE_AGENT); }
__device__ __forceinline__ unsigned xb_add(unsigned* p, unsigned v) { return __hip_atomic_fetch_add(p, v, __ATOMIC_RELAXED, __HIP_MEMORY_SCOPE_AGENT); }
__device__ __forceinline__ unsigned xb_xcc_id() { return (unsigned)__builtin_amdgcn_s_getreg((3 << 11) | 20) & 0xFu; }
#define XB_SPIN(cond, bar) do { unsigned _sp = 0; while (cond) { __builtin_amdgcn_s_sleep(1); \
    if ((++_sp & 255u) == 0u) { if (xb_ld(&(bar)[XB_TMO])) break; if (_sp > XB_SPIN_CAP) { atomicAdd(&(bar)[XB_TMO], 1u); break; } } } } while (0)

struct XcdBarrier {
    unsigned* bar; unsigned x; int w;
    volatile LAS unsigned* st;
};

__device__ __forceinline__ XcdBarrier xcd_barrier_post(unsigned* bar, volatile LAS unsigned* st) {
    XcdBarrier b; b.bar = bar; b.x = xb_xcc_id(); b.st = st;
    if (threadIdx.x == 0) (void)xb_add(&bar[XB_XCNT(b.x)], 1u);
    return b;
}
__device__ __forceinline__ void xcd_barrier_complete(unsigned* bar, unsigned x, unsigned& nloc, unsigned& nx) {
    const unsigned G = gridDim.x * gridDim.y * gridDim.z;
    unsigned sum, cnt, mine, sp = 0u;
    for (;;) {
        sum = 0u; cnt = 0u; mine = 0u;
#pragma unroll
        for (unsigned j = 0; j < 16; ++j) { const unsigned c = xb_ld(&bar[XB_XCNT(j)]); sum += c; cnt += (c > 0u) ? 1u : 0u; mine = (j == x) ? c : mine; }
        if (sum == G) break;
        __builtin_amdgcn_s_sleep(1);
        if ((++sp & 255u) == 0u) { if (xb_ld(&bar[XB_TMO])) break; if (sp > XB_SPIN_CAP) { atomicAdd(&bar[XB_TMO], 1u); break; } }
    }
    nloc = mine > 0u ? mine : 1u; nx = cnt > 0u ? cnt : 1u;
}

__device__ __forceinline__ void xcd_barrier(const XcdBarrier& b) {
    asm volatile("s_waitcnt vmcnt(0)" ::: "memory");
    __syncthreads();
    if (b.w == 0 && lane_id_() == 0) {
        unsigned* bar = b.bar;
        __builtin_amdgcn_s_waitcnt(0);
        unsigned nloc = b.st[0], nx = b.st[1];
        if (nloc == 0u) { xcd_barrier_complete(bar, b.x, nloc, nx); b.st[0] = nloc; b.st[1] = nx; }
        const unsigned old = xb_add(&bar[XB_XSUB(b.x)], 1u);
        const unsigned gen = old / nloc;
        if (old + 1u == (gen + 1u) * nloc) {
            __builtin_amdgcn_fence(__ATOMIC_RELEASE, "agent");
            asm volatile("s_waitcnt vmcnt(0)" ::: "memory");
            const unsigned og = xb_add(&bar[XB_TOP], 1u);
            const unsigned tg = og / nx;
            if (og + 1u == (tg + 1u) * nx) xb_add(&bar[XB_TOPGEN], 1u);
            else XB_SPIN(xb_ld(&bar[XB_TOPGEN]) == tg, bar);
            __builtin_amdgcn_fence(__ATOMIC_ACQUIRE, "agent");
            xb_add(&bar[XB_XGEN(b.x)], 1u);
            asm volatile("s_waitcnt vmcnt(0)" ::: "memory");
        } else {
            XB_SPIN(xb_ld(&bar[XB_XGEN(b.x)]) == gen, bar);
            __builtin_amdgcn_fence(__ATOMIC_ACQUIRE, "agent");
            asm volatile("s_waitcnt vmcnt(0)" ::: "memory");
        }
    }
    __syncthreads();
}


__global__ void __launch_bounds__(512, 2) fwd_kernel(Args args) {
    extern __shared__ __attribute__((aligned(16))) unsigned char lds_raw[];
    Frame F; F.lds = (LAS unsigned char*)lds_raw; F.tid = threadIdx.x; F.lane = F.tid & 63; F.wave = __builtin_amdgcn_readfirstlane(F.tid >> 6); F.G = gridDim.x; F.bid = blockIdx.x;
#if USE_COOP
    cg::grid_group grid = cg::this_grid();
#endif
    volatile LAS unsigned* MISCW = (volatile LAS unsigned*)(F.lds + LDS_BYTES - 256);
    if (F.tid < 64) MISCW[F.tid] = 0u;
    __syncthreads();
    XcdBarrier xbar = xcd_barrier_post((unsigned*)(args.ws + WS_CTL) + CW_BAR, MISCW + 8); xbar.w = F.wave;
    unsigned char* ws = args.ws;
    const int lo = args.ph_lo, hi = args.ph_hi;
#ifndef REPMASK
#define REPMASK 0
#endif
#define NREP(k) (((REPMASK) >> (k)) & 1 ? 2 : 1)
#define IN(k) (lo <= (k) && (k) < hi)
#if USE_COOP
#define SEAM(k) do { if (IN(k) && IN((k) + 1)) xcd_barrier(xbar); } while (0)
#else
#define SEAM(k) do { if (IN(k) && IN((k) + 1)) xcd_barrier(xbar); } while (0)
#endif
    bf16_t* proj = (bf16_t*)(ws + WS_PROJ);

#if USE_COOP
    if (lo < 0) grid.sync();
#endif
    if (IN(0)) for (int rep_ = 0; rep_ < NREP(0); ++rep_) { p0_prologue(F, args); } SEAM(0);
    if (IN(1)) for (int rep_ = 0; rep_ < NREP(1); ++rep_) {
        pg8::Gemm g{(const bf16_t*)(ws + WS_XN), (const bf16_t*)(ws + WS_WIN), DIN, DM, nullptr, (const float*)(ws + WS_XS), (const float*)(ws + WS_WINS), TIM_PHASE == 1 ? (unsigned*)(ws + WS_CTL) + 208 : nullptr};
        pg8::DenseSched<DIN / 256> S; S.o.init(NTOK / 256, DIN / 256, F.G, F.bid);
        EpiProj E{proj, (float*)(ws + WS_LOGF), (const float*)(ws + WS_ROPE), (const float*)(ws + WS_LB)};
        pg8::gemm_phase<EpiProj, pg8::DenseSched<DIN / 256>, false, false, false, false, P1_I8>(F.lds, g, S, E, F.wave);
    } SEAM(1);
    if (IN(2)) for (int rep_ = 0; rep_ < NREP(2); ++rep_) { p2_kmean(F, args); h1_local_states_p(F, args); } SEAM(2);
    if (IN(3)) {
        h2_scan(F, args);
        const attn_body::AttnTensors AT{(const attn_body::bf16*)(proj + C_QA), (const attn_body::bf16*)(proj + C_KA), (const attn_body::bf16*)(proj + C_VA), (const attn_body::bf16*)(ws + WS_KMEAN), (attn_body::bf16*)(ws + WS_YA)};
        const attn_body::StaticOrder AS((int)F.G, (int)F.bid);
        if constexpr (DEFER_MOE_W) {
            const int cls = F.G == 256 ? (int)(F.bid & 3) : 0, convpos = cls == 0 ? 0 : cls + 1;
            attn_body::AttnUnit u;
#pragma unroll 1
            for (int i = 0;; ++i) {
                if (i == convpos) { __syncthreads(); moe_weight_copies(F, args); }
                if (!AS.next(i, u)) break;
                attn_body::attn_unit<8>(F.wave, u.bh / attn_body::NHEAD, u.bh % attn_body::NHEAD, u.qb, AT.Q, AT.K, AT.V, AT.KM, AT.O, (char*)lds_raw);
            }
        } else
        for (int rep_ = 0; rep_ < NREP(3); ++rep_) attn_body::attn_phase<attn_body::StaticOrder>((char*)lds_raw, AT, AS, F.wave);
    } SEAM(3);
    if (IN(4)) for (int rep_ = 0; rep_ < NREP(4); ++rep_) { h3_outputs_p(F, args); } SEAM(4);
    if (IN(5)) for (int rep_ = 0; rep_ < NREP(5); ++rep_) {
        pg8::DenseSched<DM / 256> S; S.o.init(NTOK / 256, DM / 256, F.G, F.bid);
        pg8::Gemm g{(const bf16_t*)(ws + WS_YA), (const bf16_t*)(ws + WS_MUP), DM, DM, nullptr};
        EpiMixF E{(bf16_t*)(ws + WS_MIXED), proj};
        pg8::gemm_phase<EpiMixF, pg8::DenseSched<DM / 256>, false, false, false, true>(F.lds, g, S, E, F.wave);
    } SEAM(5);
    if (IN(6)) for (int rep_ = 0; rep_ < NREP(6); ++rep_) {
        pg8::Gemm g{(const bf16_t*)(ws + WS_MIXED), (const bf16_t*)(ws + WS_WOUT), DM, DM, nullptr};
        pg8::DenseSched<DM / 256> S; S.o.init(NTOK / 256, DM / 256, F.G, F.bid);
        EpiOut E{args.in[I_X], (bf16_t*)(ws + WS_X1)};
        pg8::gemm_phase<EpiOut, pg8::DenseSched<DM / 256>, false>(F.lds, g, S, E, F.wave);
    } SEAM(6);
    if (IN(7)) { if (NREP(7) > 1) p6_route<true>(F, args); p6_route<false>(F, args); } SEAM(7);
    if (IN(8)) for (int rep_ = 0; rep_ < NREP(8); ++rep_) {
        LAS int* ts = (LAS int*)(F.lds + MISC_OFF + 8192);
        const int ntile = moe_tiles(F, args, ts);
        pg8::Gemm g{(const bf16_t*)(ws + WS_XN), (const bf16_t*)(ws + WS_WGU), 2 * DE, DM, (const int*)(ws + WS_ROWS), (const float*)(ws + WS_ROWHS), (const float*)(ws + WS_WGS), TIM_PHASE == 8 ? (unsigned*)(ws + WS_CTL) + 208 : nullptr};
        pg8::MoeSched<2 * DE / 256> S; S.o.init(ntile, 2 * DE / 256, F.G, F.bid); S.ts = ts;
        EpiMoe1 E{(bf16_t*)(ws + WS_HID), args.in[I_BGU]};
        pg8::gemm_phase<EpiMoe1, pg8::MoeSched<2 * DE / 256>, true, MOE_FP8 && !MOE1_I8, false, false, MOE1_I8>(F.lds, g, S, E, F.wave);
    } SEAM(8);
    if (IN(9)) for (int rep_ = 0; rep_ < NREP(9); ++rep_) {
        LAS int* ts = (LAS int*)(F.lds + MISC_OFF + 8192);
        const int ntile = moe_tiles(F, args, ts);
        pg8::Gemm g{(const bf16_t*)(ws + WS_HID), (const bf16_t*)(ws + WS_WD), DM, DE, nullptr, nullptr, nullptr, TIM_PHASE == 9 ? (unsigned*)(ws + WS_CTL) + 208 : nullptr};
        pg8::MoeSched<DM / 256> S; S.o.init(ntile, DM / 256, F.G, F.bid); S.ts = ts;
        EpiMoe2 E{(bf16_t*)(ws + WS_YG), args.in[I_BD], (const int*)(ws + WS_ROWS), (const float*)(ws + WS_ROWW)};
        pg8::gemm_phase<EpiMoe2, pg8::MoeSched<DM / 256>, false, MOE_FP8, false, false, false, MOE_FP8>(F.lds, g, S, E, F.wave);
    } SEAM(9);
    if (IN(10)) for (int rep_ = 0; rep_ < NREP(10); ++rep_) { p9_final(F, args); }
#undef IN
#undef SEAM
}

#ifndef N_LAUNCHES
#define N_LAUNCHES 1
#endif
extern "C" void kernel_launch(void* const* d_in, const int* in_sizes, int n_in, void* d_out, int out_size, void* d_ws, size_t ws_size, hipStream_t stream) {
    static int grid = 0;
    if (grid == 0) {
        if (n_in != 16 || in_sizes[0] != NTOK * DM || out_size != NTOK * DM || ws_size < WS_END) { fprintf(stderr, "kernel_launch: unexpected shapes (n_in %d, in0 %d, out %d, ws %zu)\n", n_in, n_in > 0 ? in_sizes[0] : -1, out_size, ws_size); grid = -1; return; }
        int dev = 0, cus = 0, per_cu = 0;
        (void)hipGetDevice(&dev); (void)hipDeviceGetAttribute(&cus, hipDeviceAttributeMultiprocessorCount, dev);
        if (hipFuncSetAttribute((const void*)fwd_kernel, hipFuncAttributeMaxDynamicSharedMemorySize, LDS_BYTES) != hipSuccess) { fprintf(stderr, "kernel_launch: hipFuncSetAttribute failed\n"); grid = -1; return; }
        if (hipOccupancyMaxActiveBlocksPerMultiprocessor(&per_cu, (const void*)fwd_kernel, 512, LDS_BYTES) != hipSuccess || per_cu < 1) { fprintf(stderr, "kernel_launch: occupancy query says %d\n", per_cu); per_cu = 1; }
        (void)hipGetLastError();
        grid = cus;
    }
    if (grid < 0) return;
    (void)hipMemsetAsync((char*)d_ws + WS_CTL, 0, CTL_BYTES, stream);
    Args a{};
    for (int i = 0; i < 16; ++i) a.in[i] = (const float*)d_in[i];
    a.out = (float*)d_out; a.ws = (unsigned char*)d_ws;
    if (N_LAUNCHES == 1) {
        a.ph_lo = 0; a.ph_hi = NPHASE; void* params[] = {&a};
#if USE_COOP
        hipError_t e = hipLaunchCooperativeKernel((const void*)fwd_kernel, dim3(grid), dim3(512), params, LDS_BYTES, stream);
        if (e != hipSuccess) fprintf(stderr, "cooperative launch failed: %s (grid %d)\n", hipGetErrorString(e), grid);
#else
        (void)params; hipLaunchKernelGGL(fwd_kernel, dim3(grid), dim3(512), LDS_BYTES, stream, a);
#endif
    } else {
        for (int p = 0; p < NPHASE; ++p) { a.ph_lo = p; a.ph_hi = p + 1; hipLaunchKernelGGL(fwd_kernel, dim3(grid), dim3(512), LDS_BYTES, stream, a); }
    }
}
```

```cpp
#include <hip/hip_runtime.h>
#include <hip/hip_cooperative_groups.h>
#include <cstdio>
#include <cstdint>
namespace cg = cooperative_groups;
#ifndef USE_COOP
#define USE_COOP 1
#endif

#define LAS __attribute__((address_space(3)))
#define GAS __attribute__((address_space(1)))
typedef unsigned short bf16_t;
typedef short bf16x8 __attribute__((ext_vector_type(8)));
typedef float f32x4 __attribute__((ext_vector_type(4)));
typedef float f32x2 __attribute__((ext_vector_type(2)));
typedef unsigned u32x4 __attribute__((ext_vector_type(4)));
typedef unsigned u32x2 __attribute__((ext_vector_type(2)));

constexpr int NTOK = 32768, DM = 1024, SEQ = 4096, NBATCH = 8;
constexpr int DIN = 5632;
constexpr int AH = 8, AD = 64;
constexpr int HH = 4, HK = 128;
constexpr int NE = 32, DE = 1024, CAP = 32768;
constexpr float RMS_EPS = 1e-6f;
constexpr float QSCALE = 0.125f * 1.4426950408889634f;
constexpr int C_QA = 0, C_KA = 512, C_VA = 1024, C_QB = 1536, C_FB = 2048, C_IB = 2560, C_GB = 3072, C_GA = 3584, C_GBT = 4608;

constexpr size_t MiB = 1u << 20;
constexpr size_t WS_CTL = 0, CTL_BYTES = 32768;
constexpr size_t WS_ROPE = 1 * MiB;
constexpr size_t WS_WIN = 2 * MiB;
constexpr size_t WS_MUP = 13 * MiB;
constexpr size_t WS_WOUT = 15 * MiB;
constexpr size_t WS_LB = 17 * MiB;
constexpr size_t WS_KMEAN = 17 * MiB + 65536;
constexpr size_t WS_SLOTW = 18 * MiB;
constexpr size_t WS_ROWS = 19 * MiB;
constexpr size_t WS_ROWW = 25 * MiB;
constexpr size_t WS_WGS = 18 * MiB;
constexpr size_t WS_XS = 18 * MiB + 512 * 1024;
constexpr size_t WS_WINS = 18 * MiB + 768 * 1024;
constexpr size_t WS_ROWHS = 672 * MiB;
constexpr size_t WS_GDEC = 24 * MiB;
constexpr size_t WS_WGU = 32 * MiB;
constexpr size_t WS_WD = 160 * MiB;
constexpr size_t WS_XN = 224 * MiB;
constexpr size_t WS_PROJ = 288 * MiB;
constexpr size_t WS_LOGF = 640 * MiB;
constexpr size_t WS_YA = 704 * MiB;
constexpr size_t WS_OB = 768 * MiB;
constexpr size_t WS_HST = 768 * MiB;
constexpr size_t WS_MIXED = 832 * MiB;
constexpr size_t WS_HID = 288 * MiB;
constexpr size_t WS_YG = 560 * MiB;
constexpr size_t WS_X1 = 896 * MiB;
constexpr size_t WS_END = 960 * MiB;
constexpr int CW_CNT = 64;
constexpr int CW_BAR = 4096;
static_assert((CW_BAR + 3456) * 4 <= (int)CTL_BYTES, "barrier words inside the zeroed control region");

constexpr int RING_BYTES = 131072;
constexpr int MISC_OFF = RING_BYTES;
constexpr int LDS_BYTES = 147456;

#ifndef MOE1_I8_
#define MOE1_I8_ 1
#endif
#ifndef MOE_FP8_
#define MOE_FP8_ 1
#endif
constexpr bool MOE1_I8 = (MOE1_I8_ != 0) && (MOE_FP8_ != 0);
#ifndef P1_I8_
#define P1_I8_ 1
#endif
constexpr bool P1_I8 = P1_I8_ != 0;
#ifndef DEFER_MOE_W_
#define DEFER_MOE_W_ 1
#endif
#ifndef TIM_PHASE
#define TIM_PHASE 0
#endif
#ifndef TIM_SEL
#define TIM_SEL 0
#endif
#ifndef TIM_UNIT
#define TIM_UNIT 1024
#endif
constexpr bool MOE_FP8 = MOE_FP8_ != 0;
constexpr float S_H2 = 16.0f, S_HID = 4.0f, S_W = 512.0f, S_YG = 32.0f;
constexpr float DQ1 = MOE_FP8 ? 1.0f / (S_H2 * S_W) : 1.0f, DQ2 = MOE_FP8 ? 1.0f / (S_HID * S_W) : 1.0f;
typedef int v8i __attribute__((ext_vector_type(8)));
typedef int v4i __attribute__((ext_vector_type(4)));
__device__ __forceinline__ unsigned pk4_i8(float a, float b, float c, float d) {
    const unsigned ua = __builtin_bit_cast(unsigned, __builtin_amdgcn_fmed3f(a, -127.f, 127.f) + 12582912.0f), ub = __builtin_bit_cast(unsigned, __builtin_amdgcn_fmed3f(b, -127.f, 127.f) + 12582912.0f);
    const unsigned uc = __builtin_bit_cast(unsigned, __builtin_amdgcn_fmed3f(c, -127.f, 127.f) + 12582912.0f), ud = __builtin_bit_cast(unsigned, __builtin_amdgcn_fmed3f(d, -127.f, 127.f) + 12582912.0f);
    return __builtin_amdgcn_perm(ub, ua, 0x0c0c0400u) | __builtin_amdgcn_perm(ud, uc, 0x04000c0cu); }
typedef _Float16 h16x4 __attribute__((ext_vector_type(4)));
typedef _Float16 h16x8 __attribute__((ext_vector_type(8)));
typedef float f32x8 __attribute__((ext_vector_type(8)));
__device__ __forceinline__ unsigned pk4_fp8_nc(float a, float b, float c, float d, float s) { unsigned w = 0u; w = __builtin_amdgcn_cvt_pk_fp8_f32(a * s, b * s, w, false); w = __builtin_amdgcn_cvt_pk_fp8_f32(c * s, d * s, w, true); return w; }
__device__ __forceinline__ unsigned pk4_u8(float a, float b, float c, float d) { unsigned w = 0u;
    w = __builtin_amdgcn_cvt_pk_u8_f32(fmaxf(a * 255.0f, 1.0f), 0, w); w = __builtin_amdgcn_cvt_pk_u8_f32(fmaxf(b * 255.0f, 1.0f), 1, w);
    w = __builtin_amdgcn_cvt_pk_u8_f32(fmaxf(c * 255.0f, 1.0f), 2, w); w = __builtin_amdgcn_cvt_pk_u8_f32(fmaxf(d * 255.0f, 1.0f), 3, w); return w; }
__device__ __forceinline__ f32x4 un4_u8(unsigned w) { return (f32x4){(float)(w & 0xffu), (float)((w >> 8) & 0xffu), (float)((w >> 16) & 0xffu), (float)(w >> 24)}; }
constexpr int GATE_BYTE0 = 2 * 3584;
__device__ __forceinline__ unsigned pk4_fp8(float a, float b, float c, float d, float s) {
    const float L = 440.0f;
    a = __builtin_amdgcn_fmed3f(a * s, -L, L); b = __builtin_amdgcn_fmed3f(b * s, -L, L); c = __builtin_amdgcn_fmed3f(c * s, -L, L); d = __builtin_amdgcn_fmed3f(d * s, -L, L);
    unsigned w = 0u; w = __builtin_amdgcn_cvt_pk_fp8_f32(a, b, w, false); w = __builtin_amdgcn_cvt_pk_fp8_f32(c, d, w, true); return w;
}
__device__ __forceinline__ unsigned f2bf(float f) { unsigned u = __builtin_bit_cast(unsigned, f); return (u + 0x7fffu + ((u >> 16) & 1u)) >> 16; }
typedef __bf16 bf16x2_t_ __attribute__((ext_vector_type(2)));
__device__ __forceinline__ unsigned pk2(float lo, float hi) { f32x2 v = {lo, hi}; bf16x2_t_ b = __builtin_convertvector(v, bf16x2_t_); return __builtin_bit_cast(unsigned, b); }
__device__ __forceinline__ float bf_lo(unsigned u) { return __builtin_bit_cast(float, u << 16); }
__device__ __forceinline__ float bf_hi(unsigned u) { return __builtin_bit_cast(float, u & 0xffff0000u); }
__device__ __forceinline__ float bf2f(bf16_t h) { return __builtin_bit_cast(float, (unsigned)h << 16); }
template <int CTRL> __device__ __forceinline__ float dppf_(float v) { return __builtin_bit_cast(float, __builtin_amdgcn_update_dpp(0, __builtin_bit_cast(int, v), CTRL, 0xF, 0xF, false)); }
__device__ __forceinline__ float rdlane_(float v, int l) { return __builtin_bit_cast(float, __builtin_amdgcn_readlane(__builtin_bit_cast(int, v), l)); }
__device__ __forceinline__ float wave_sum(float v) {
    v += dppf_<0xB1>(v); v += dppf_<0x4E>(v); v += dppf_<0x141>(v); v += dppf_<0x140>(v);
    return (rdlane_(v, 0) + rdlane_(v, 16)) + (rdlane_(v, 32) + rdlane_(v, 48));
}
__device__ __forceinline__ float wave_max(float v) {
    v = fmaxf(v, dppf_<0xB1>(v)); v = fmaxf(v, dppf_<0x4E>(v)); v = fmaxf(v, dppf_<0x141>(v)); v = fmaxf(v, dppf_<0x140>(v));
    return fmaxf(fmaxf(rdlane_(v, 0), rdlane_(v, 16)), fmaxf(rdlane_(v, 32), rdlane_(v, 48)));
}
__device__ __forceinline__ void lds_barrier() { asm volatile("s_waitcnt lgkmcnt(0)\n\ts_barrier" ::: "memory"); }
__device__ __forceinline__ f32x4 sigmoid4_(f32x4 x) {
    f32x4 t = x * (-1.4426950408889634f); t = (f32x4){__builtin_amdgcn_exp2f(t[0]), __builtin_amdgcn_exp2f(t[1]), __builtin_amdgcn_exp2f(t[2]), __builtin_amdgcn_exp2f(t[3])}; t = t + 1.0f;
    return (f32x4){__builtin_amdgcn_rcpf(t[0]), __builtin_amdgcn_rcpf(t[1]), __builtin_amdgcn_rcpf(t[2]), __builtin_amdgcn_rcpf(t[3])}; }
__device__ __forceinline__ float sigmoidf_(float x) { return __builtin_amdgcn_rcpf(1.0f + __builtin_amdgcn_exp2f(-1.4426950408889634f * x)); }
__device__ __forceinline__ int lane_id_() { int l; asm volatile("v_mbcnt_lo_u32_b32 %0, -1, 0\n\tv_mbcnt_hi_u32_b32 %0, -1, %0" : "=v"(l)); return l; }
__device__ __forceinline__ float rdlane(float v, int l) { return __builtin_bit_cast(float, __builtin_amdgcn_readlane(__builtin_bit_cast(int, v), l)); }

namespace pg8 {
constexpr int BM = 256, BK = 64, HALF = 128, HTB = HALF * BK * 2, STAGE_BYTES = 8 * HTB, NXCD = 8, WGM = 8;
__host__ __device__ __forceinline__ int lds_byte(int r, int c) { const int st = (r >> 4) * 2 + (c >> 5), rr = r & 15, cc = c & 31, ob = rr * 64 + cc * 2; return st * 1024 + (ob ^ (((ob >> 9) & 1) << 5)); }
__host__ __device__ __forceinline__ void stage_rc(int b, int& R, int& C) { const int st = b / 1024, sb = b % 1024, swz = sb ^ (((sb >> 9) & 1) << 5); R = (st >> 1) * 16 + swz / 64; C = (st & 1) * 32 + (swz % 64) / 2; }
__host__ __device__ __forceinline__ int perm32(int rho) { const int n = rho >> 4, i = rho & 15; return 8 * (i >> 2) + 4 * n + (i & 3); }

struct Unit { int pm, pn, e, lt, nvalid; };
struct Gemm { const bf16_t* A; const bf16_t* Bt; int N, K; const int* rows; const float* rs = nullptr; const float* cs = nullptr; unsigned* tim = nullptr; };

template <int NN> struct Order {
    static constexpr int nN = NN;
    int nM, nwg, G, c;
    __device__ void init(int nM_, int nN_, int G_, int c_) { nM = nM_; nwg = nM * nN; G = G_; c = c_; }
    __device__ bool map(int i, int& pm, int& pn) const {
        const long L = (long)i * G + c; if (L >= nwg) return false;
        int wgid = (int)L; { const int q = nwg / NXCD, r = nwg % NXCD, xcd = wgid % NXCD, off = wgid / NXCD; wgid = (xcd < r ? xcd * (q + 1) : r * (q + 1) + (xcd - r) * q) + off; }
        const int nig = WGM * nN, gid = wgid / nig, fm = gid * WGM, gsz = (nM - fm) < WGM ? (nM - fm) : WGM;
        const int rem = wgid - gid * nig;
        pm = fm + rem % gsz; pn = rem / gsz; return true;
    }
};
template <int NN> struct DenseSched {
    Order<NN> o;
    __device__ bool next(int i, Unit& u) const { if (!o.map(i, u.pm, u.pn)) return false; u.e = 0; u.lt = u.pm; u.nvalid = 256; return true; }
};
template <int NN> struct MoeSched {
    Order<NN> o; const LAS int* ts;
    __device__ bool next(int i, Unit& u) const {
        if (!o.map(i, u.pm, u.pn)) return false;
        const int lane = lane_id_(); const int tv = ts[(lane & 31) + 1];
        const unsigned long long bal = __ballot(lane < NE - 1 && tv <= u.pm);
        const int e = __builtin_amdgcn_readfirstlane((int)__popcll(bal));
        const int t0 = __builtin_amdgcn_readfirstlane(ts[e]), cn = __builtin_amdgcn_readfirstlane(ts[33 + e]);
        u.e = e; u.lt = u.pm - t0; const int rem = cn - u.lt * 256; u.nvalid = rem < 256 ? rem : 256; return true;
    }
};

struct NoPre {};
template <class T, class = void> struct HasPre { static constexpr bool v = false; };
template <class T> struct HasPre<T, decltype((void)sizeof(typename T::Pre))> { static constexpr bool v = true; };
template <class T, bool> struct PreOf { typedef NoPre type; };
template <class T> struct PreOf<T, true> { typedef typename T::Pre type; };
template <class Epi, class Sched, bool GATHER, bool FP8 = false, bool NOEPI = false, bool HOOK = false, bool I8 = false, bool P16 = false>
__device__ __forceinline__ void gemm_phase(LAS unsigned char* lds, const Gemm g, const Sched& S, const Epi& E, const int wid) {
    const int lane = lane_id_(), tid = wid * 64 + lane, wr = wid >> 2, wc = wid & 3, fr = lane & 15, fq = lane >> 4;
    const int K = g.K, RP = (FP8 || I8) ? K : 2 * K, nt = RP / 128;
    unsigned voffB[2];
#pragma unroll
    for (int i = 0; i < 2; ++i) { int R, C; stage_rc(tid * 16 + i * 8192, R, C); const int Rb = P16 ? 64 * (R >> 5) + 16 * ((R & 15) >> 2) + 4 * ((R >> 4) & 1) + (R & 3) : (R & ~31) + perm32(R & 31); voffB[i] = (unsigned)(Rb * RP + C * 2); }
    const size_t kstep = 128;
    const size_t hstep = (size_t)HALF * RP, hstepB = P16 ? (size_t)8 * RP : hstep;
    const size_t tstep = 2 * hstep;
    const size_t estride = (size_t)g.N * RP;
    const unsigned ldsw = (unsigned)wid * 1024u;
    const int aoff = lds_byte(wr * 64 + fr, fq * 8), boff = lds_byte(wc * 32 + fr, fq * 8);
    constexpr int KOFF = 1024;
#define PG8_SA(b, h) (((b) * 2 + (h)) * HTB)
#define PG8_SB(b, h) ((4 + (b) * 2 + (h)) * HTB)
#define PG8_STAGE(bufoff, gbase, voff) do { _Pragma("unroll") for (int _i = 0; _i < 2; ++_i) { unsigned _o = (voff)[_i]; asm volatile("" : "+v"(_o));     \
        __builtin_amdgcn_global_load_lds((const unsigned*)((const char*)(gbase) + _o), (LAS unsigned*)(lds + (bufoff) + ldsw + _i * 8192), 16, 0, 0); } } while (0)
#define PG8_STAGE2(bufoff, gbase, h) PG8_STAGE(bufoff, gbase, vC[h])
#define PG8_LDA(dst, b, h) do { _Pragma("unroll") for (int m = 0; m < 4; ++m) _Pragma("unroll") for (int k = 0; k < 2; ++k) dst[m][k] = *(const LAS bf16x8*)(lds + PG8_SA(b, h) + aoff + m * 2048 + k * KOFF); } while (0)
#define PG8_LDB(dst, b, h) do { _Pragma("unroll") for (int n = 0; n < 2; ++n) _Pragma("unroll") for (int k = 0; k < 2; ++k) dst[n][k] = *(const LAS bf16x8*)(lds + PG8_SB(b, h) + boff + n * 2048 + k * KOFF); } while (0)
#define PG8_CAT(x) __builtin_bit_cast(v8i, __builtin_shufflevector((x)[0], (x)[1], 0, 1, 2, 3, 4, 5, 6, 7, 8, 9, 10, 11, 12, 13, 14, 15))
#define PG8_MMA(ai, bj, At, Bt) do { __builtin_amdgcn_s_setprio(1); _Pragma("unroll") for (int m = 0; m < 4; ++m) _Pragma("unroll") for (int n = 0; n < 2; ++n) { \
        if constexpr (FP8) acc[ai][bj][m][n] = __builtin_amdgcn_mfma_scale_f32_16x16x128_f8f6f4(PG8_CAT(Bt[n]), PG8_CAT(At[m]), acc[ai][bj][m][n], 0, 0, 0, 0, 0, 0); \
        else if constexpr (I8) { _Pragma("unroll") for (int k = 0; k < 2; ++k) acci[ai][bj][m][n] = __builtin_amdgcn_mfma_i32_16x16x64_i8(__builtin_bit_cast(v4i, Bt[n][k]), __builtin_bit_cast(v4i, At[m][k]), acci[ai][bj][m][n], 0, 0, 0); } \
        else { _Pragma("unroll") for (int k = 0; k < 2; ++k) acc[ai][bj][m][n] = __builtin_amdgcn_mfma_f32_16x16x32_bf16(Bt[n][k], At[m][k], acc[ai][bj][m][n], 0, 0, 0); } } \
        __builtin_amdgcn_s_setprio(0); } while (0)
#define PG8_WAIT_V(n) asm volatile("s_waitcnt vmcnt(" #n ")" ::: "memory")
#define PG8_WAIT_V8R() do { if (NOEPI || Epi::NVMEM == 0 || !relax) asm volatile("s_waitcnt vmcnt(8)" ::: "memory"); else asm volatile("s_waitcnt vmcnt(%0)" :: "n"(8 + (NOEPI ? 0 : Epi::NVMEM)) : "memory"); } while (0)
#define PG8_WAIT_L(n) asm volatile("s_waitcnt lgkmcnt(" #n ")" ::: "memory")
#define PG8_BAR __builtin_amdgcn_s_barrier()
#define PG8_SCHED __builtin_amdgcn_sched_barrier(0)
#define PG8_SETV(u, v) do { _Pragma("unroll") for (int _h = 0; _h < 2; ++_h) _Pragma("unroll") for (int _i = 0; _i < 2; ++_i) { int _R, _C; stage_rc((wid * 64 + lane_id_()) * 16 + _i * 8192, _R, _C); \
        if (GATHER) { int _r = _h * HALF + _R; _r = _r < (u).nvalid ? _r : (u).nvalid - 1; const int _s = g.rows[(size_t)(u).e * CAP + (u).lt * 256 + _r]; \
                      (v)[_h][_i] = (unsigned)(_s >> 2) * (unsigned)RP + (unsigned)(_C * 2); } \
        else (v)[_h][_i] = (unsigned)(_R * RP + _C * 2) + (unsigned)(_h * hstep); } } while (0)
#define PG8_ABASE(u) (GATHER ? (const char*)g.A : (const char*)g.A + (size_t)(u).pm * tstep)
#define PG8_BBASE(u) ((const char*)g.Bt + (size_t)(u).e * estride + (size_t)(u).pn * tstep)
    Unit cur, nxt, nn; int ui = 0;
    if (!S.next(0, cur)) return;
    bool has_next = S.next(1, nxt);
    unsigned vC[2][2];
    PG8_SETV(cur, vC);
#define PG8_PARK ((LAS unsigned*)(lds + MISC_OFF) + (wid * 64 + lane_id_()) * 4)
    if (GATHER) { unsigned vP[2][2];
        if (has_next) PG8_SETV(nxt, vP); else { vP[0][0] = vC[0][0]; vP[0][1] = vC[0][1]; vP[1][0] = vC[1][0]; vP[1][1] = vC[1][1]; }
        LAS unsigned* pk = PG8_PARK; pk[0] = vP[0][0]; pk[1] = vP[0][1]; pk[2] = vP[1][0]; pk[3] = vP[1][1]; }
    f32x4 acc[2][2][4][2]; v4i acci[2][2][4][2];
#pragma unroll
    for (int a = 0; a < 2; ++a)
#pragma unroll
        for (int b = 0; b < 2; ++b)
#pragma unroll
            for (int m = 0; m < 4; ++m)
#pragma unroll
                for (int n = 0; n < 2; ++n) { acc[a][b][m][n] = (f32x4){0.f, 0.f, 0.f, 0.f}; acci[a][b][m][n] = (v4i){0, 0, 0, 0}; }
    bf16x8 At[4][2], B0[2][2], B1[2][2];
    const char* cA = PG8_ABASE(cur); const char* cB = PG8_BBASE(cur);
    PG8_STAGE(PG8_SB(0, 0), cB, voffB); PG8_STAGE(PG8_SB(0, 1), cB + hstepB, voffB); PG8_STAGE(PG8_SA(0, 0), cA, vC[0]); PG8_STAGE(PG8_SA(0, 1), cA, vC[1]);
    if (wr == 1) PG8_BAR;
    PG8_WAIT_V(2); PG8_BAR;
    PG8_STAGE(PG8_SB(1, 0), cB + kstep, voffB); PG8_STAGE(PG8_SA(1, 0), cA + kstep, vC[0]); PG8_STAGE(PG8_SB(1, 1), cB + hstepB + kstep, voffB);
    PG8_WAIT_V(6); PG8_BAR;
#if TIM_PHASE
    unsigned long long tk_ = 0, ta_ = 0, tb_ = 0, tu_ = 0; unsigned tl_ = 0; const unsigned long long ts_ = __builtin_amdgcn_s_memtime();
#endif
    for (;;) {
#if TIM_PHASE
        const unsigned long long t0_ = __builtin_amdgcn_s_memtime();
#endif
        const char* nA = has_next ? PG8_ABASE(nxt) : cA; const char* nB = has_next ? PG8_BBASE(nxt) : cB;
#pragma unroll 1
        for (int t = 0; t < nt; t += 2) {
            const bool last = (t == nt - 2); const bool relax = false;
            if constexpr (HOOK) { if (t == nt / 2) { const int l_ = lane_id_(); E.mid(acc, cur, wr, wc, l_ & 15, l_ >> 4); } }
            const char* a1 = cA + (size_t)(t + 1) * kstep;
            const char* a2 = last ? nA : cA + (size_t)(t + 2) * kstep; const char* b2 = last ? nB : cB + (size_t)(t + 2) * kstep;
            const char* a3 = a2 + kstep; const char* b3 = b2 + kstep;
            PG8_LDB(B0, 0, 0); PG8_LDB(B1, 0, 1); PG8_SCHED; PG8_LDA(At, 0, 0); PG8_STAGE(PG8_SA(1, 1), a1, vC[1]);
            if (GATHER && last) { const LAS unsigned* pk = PG8_PARK; vC[0][0] = pk[0]; vC[0][1] = pk[1]; vC[1][0] = pk[2]; vC[1][1] = pk[3]; }
            PG8_WAIT_V8R(); PG8_WAIT_L(0); PG8_BAR; PG8_MMA(0, 0, At, B0); PG8_MMA(0, 1, At, B1); PG8_BAR; PG8_SCHED;
            PG8_LDA(At, 0, 1); PG8_STAGE(PG8_SB(0, 0), b2, voffB); PG8_STAGE(PG8_SB(0, 1), b2 + hstepB, voffB); PG8_STAGE2(PG8_SA(0, 0), a2, 0);
            PG8_WAIT_V8R(); PG8_WAIT_L(0); PG8_BAR; PG8_MMA(1, 0, At, B0); PG8_MMA(1, 1, At, B1); PG8_BAR; PG8_SCHED;
            PG8_LDB(B0, 1, 0); PG8_LDB(B1, 1, 1); PG8_SCHED; PG8_LDA(At, 1, 0); PG8_STAGE2(PG8_SA(0, 1), a2, 1);
            PG8_WAIT_V(8); PG8_WAIT_L(0); PG8_BAR; PG8_MMA(0, 0, At, B0); PG8_MMA(0, 1, At, B1); PG8_BAR; PG8_SCHED;
            PG8_LDA(At, 1, 1); PG8_STAGE(PG8_SB(1, 0), b3, voffB); PG8_STAGE(PG8_SB(1, 1), b3 + hstepB, voffB); PG8_STAGE2(PG8_SA(1, 0), a3, 0);
            PG8_WAIT_V(8); PG8_WAIT_L(0); PG8_BAR; PG8_MMA(1, 0, At, B0); PG8_MMA(1, 1, At, B1); PG8_BAR; PG8_SCHED;
        }
#if TIM_PHASE
        const unsigned long long t1_ = __builtin_amdgcn_s_memtime();
#endif
        float rsv[2][4]; f32x4 csv[2][2]; typename PreOf<Epi, HasPre<Epi>::v>::type pf;
        { const int l_ = lane_id_();
          if constexpr (I8) {
            const float* rsp = g.rs + (GATHER ? (size_t)cur.e * CAP : (size_t)0) + (size_t)cur.lt * 256; const float* csp = g.cs + (size_t)cur.e * g.N + cur.pn * 256 + wc * 32 + 8 * (l_ >> 4);
#pragma unroll
            for (int a = 0; a < 2; ++a)
#pragma unroll
                for (int m = 0; m < 4; ++m) { int r = a * 128 + wr * 64 + m * 16 + (l_ & 15); r = r < cur.nvalid ? r : cur.nvalid - 1; rsv[a][m] = rsp[r]; }
#pragma unroll
            for (int b = 0; b < 2; ++b)
#pragma unroll
                for (int n = 0; n < 2; ++n) csv[b][n] = *(const f32x4*)(csp + b * 128 + 4 * n);
          }
          if constexpr (HasPre<Epi>::v && !NOEPI) pf = E.pre(cur, wr, wc, l_ & 15, l_ >> 4); }
        if (wr == 0) PG8_BAR;
        bool has_nn = false; unsigned vT[2][2];
        if (has_next) has_nn = S.next(ui + 2, nn);
        if (GATHER && has_nn) PG8_SETV(nn, vT);
#if TIM_PHASE
        const unsigned long long t2_ = __builtin_amdgcn_s_memtime();
#endif
        if constexpr (I8) {
#pragma unroll
            for (int a = 0; a < 2; ++a)
#pragma unroll
                for (int b = 0; b < 2; ++b)
#pragma unroll
                    for (int m = 0; m < 4; ++m)
#pragma unroll
                        for (int n = 0; n < 2; ++n)
#pragma unroll
                            for (int i = 0; i < 4; ++i) acc[a][b][m][n][i] = ((float)acci[a][b][m][n][i] * rsv[a][m]) * csv[b][n][i];
        }
        { const int l_ = lane_id_();
          if constexpr (!NOEPI) { if constexpr (HasPre<Epi>::v) E(acc, cur, wr, wc, l_ & 15, l_ >> 4, pf); else E(acc, cur, wr, wc, l_ & 15, l_ >> 4); }
          else { _Pragma("unroll") for (int a_ = 0; a_ < 2; ++a_) _Pragma("unroll") for (int b_ = 0; b_ < 2; ++b_) _Pragma("unroll") for (int m_ = 0; m_ < 4; ++m_) _Pragma("unroll") for (int n_ = 0; n_ < 2; ++n_) asm volatile("" :: "v"(acc[a_][b_][m_][n_])); } }
#if TIM_PHASE
        { const unsigned long long t3_ = __builtin_amdgcn_s_memtime(); tk_ += t1_ - t0_; ta_ += t2_ - t1_; tb_ += t3_ - t2_; tu_ += 1;
 }
#endif
        if (!has_next) break;
#pragma unroll
        for (int a = 0; a < 2; ++a)
#pragma unroll
            for (int b = 0; b < 2; ++b)
#pragma unroll
                for (int m = 0; m < 4; ++m)
#pragma unroll
                    for (int n = 0; n < 2; ++n) { acc[a][b][m][n] = (f32x4){0.f, 0.f, 0.f, 0.f}; acci[a][b][m][n] = (v4i){0, 0, 0, 0}; }
        cur = nxt; cA = nA; cB = nB; ++ui;
        if (GATHER && has_nn) { LAS unsigned* pk = PG8_PARK; pk[0] = vT[0][0]; pk[1] = vT[0][1]; pk[2] = vT[1][0]; pk[3] = vT[1][1]; }
        nxt = nn; has_next = has_nn;
        if (wr == 1) PG8_BAR;
    }
    PG8_WAIT_V(0);
    PG8_BAR;
#if TIM_PHASE
    if (g.tim && blockIdx.x == 0 && wid == 0 && lane_id_() == 0) { const unsigned long long te_ = __builtin_amdgcn_s_memtime(); g.tim[0] = (unsigned)tk_; g.tim[1] = (unsigned)ta_; g.tim[2] = (unsigned)tb_; g.tim[3] = (unsigned)tu_; g.tim[4] = (unsigned)(te_ - ts_); g.tim[5] = (unsigned)tl_; }
#endif
#undef PG8_SA
#undef PG8_SB
#undef PG8_STAGE
#undef PG8_STAGE2
#undef PG8_PARK
#undef PG8_LDA
#undef PG8_LDB
#undef PG8_MMA
#undef PG8_CAT
#undef PG8_WAIT_V
#undef PG8_WAIT_V8R
#undef PG8_WAIT_L
#undef PG8_BAR
#undef PG8_SCHED
#undef PG8_SETV
#undef PG8_ABASE
#undef PG8_BBASE
}

template <class F> struct EpiOct {
    F f;
    __device__ __forceinline__ void operator()(const f32x4 (&acc)[2][2][4][2], const Unit& u, int wr, int wc, int fr, int fq) const {
#pragma unroll
        for (int ai = 0; ai < 2; ++ai)
#pragma unroll
            for (int m = 0; m < 4; ++m) {
                const int r = ai * HALF + wr * 64 + m * 16 + fr;
#pragma unroll
                for (int bj = 0; bj < 2; ++bj) f(u, r, bj * HALF + wc * 32 + 8 * fq, acc[ai][bj][m][0], acc[ai][bj][m][1]);
            }
    }
};
}
using pg8::Unit;

__device__ __forceinline__ u32x4 pack8(f32x4 a, f32x4 b) { u32x4 w; w.x = pk2(a[0], a[1]); w.y = pk2(a[2], a[3]); w.z = pk2(b[0], b[1]); w.w = pk2(b[2], b[3]); return w; }
__device__ __forceinline__ void unpack8(u32x4 w, f32x4& a, f32x4& b) { a = (f32x4){bf_lo(w.x), bf_hi(w.x), bf_lo(w.y), bf_hi(w.y)}; b = (f32x4){bf_lo(w.z), bf_hi(w.z), bf_lo(w.w), bf_hi(w.w)}; }

template <bool NOSTORE = false> struct EpiProj_ {
    static constexpr int NVMEM = NOSTORE ? 0 : 16;
    bf16_t* proj; float* logf; const float* rope; const float* lb;
    __device__ __forceinline__ void operator()(const f32x4 (&acc)[2][2][4][2], const Unit& u, int wr, int wc, int fr, int fq) const {
        const int pn = u.pn, colb = pn * 256 + wc * 32 + 8 * fq, rowb = u.pm * 256 + wr * 64 + fr;
        if (pn < 4) {
            const int i0 = (colb & 63) >> 1; const float sc = pn < 2 ? QSCALE : 1.0f;
            f32x4 cs[2][4][2];
#pragma unroll
            for (int ai = 0; ai < 2; ++ai)
#pragma unroll
                for (int m = 0; m < 4; ++m) { const int pos = (rowb + ai * 128 + m * 16) & (SEQ - 1); const float* tp = rope + ((size_t)pos * 32 + i0) * 2; cs[ai][m][0] = *(const f32x4*)tp; cs[ai][m][1] = *(const f32x4*)(tp + 4); }
#pragma unroll
            for (int ai = 0; ai < 2; ++ai)
#pragma unroll
                for (int m = 0; m < 4; ++m) { const f32x4 c0 = cs[ai][m][0] * sc, c1 = cs[ai][m][1] * sc;
#pragma unroll
                    for (int bj = 0; bj < 2; ++bj) { const f32x4 v0 = acc[ai][bj][m][0], v1 = acc[ai][bj][m][1]; f32x4 o0, o1;
                        o0[0] = v0[0] * c0[0] - v0[1] * c0[1]; o0[1] = v0[1] * c0[0] + v0[0] * c0[1]; o0[2] = v0[2] * c0[2] - v0[3] * c0[3]; o0[3] = v0[3] * c0[2] + v0[2] * c0[3];
                        o1[0] = v1[0] * c1[0] - v1[1] * c1[1]; o1[1] = v1[1] * c1[0] + v1[0] * c1[1]; o1[2] = v1[2] * c1[2] - v1[3] * c1[3]; o1[3] = v1[3] * c1[2] + v1[2] * c1[3];
                        { const u32x4 w_ = pack8(o0, o1); if (NOSTORE) asm volatile("" :: "v"(w_)); else __builtin_nontemporal_store(w_, (u32x4*)(proj + (size_t)(rowb + ai * 128 + m * 16) * DIN + colb + bj * 128)); } } }
        } else if (pn == 8 || pn == 9) {
            f32x4 l[2][2];
#pragma unroll
            for (int bj = 0; bj < 2; ++bj) { const float* lp = lb + (colb - C_FB) + bj * 128; l[bj][0] = *(const f32x4*)lp; l[bj][1] = *(const f32x4*)(lp + 4); }
#pragma unroll
            for (int ai = 0; ai < 2; ++ai)
#pragma unroll
                for (int m = 0; m < 4; ++m)
#pragma unroll
                    for (int bj = 0; bj < 2; ++bj) { f32x4 o[2];
#pragma unroll
                        for (int n = 0; n < 2; ++n) { const f32x4 sg = sigmoid4_(acc[ai][bj][m][n]), lv = l[bj][n], t = lv + (1.0f - lv) * sg;
                            o[n] = (f32x4){__logf(t[0]), __logf(t[1]), __logf(t[2]), __logf(t[3])}; }
                        _Float16* p = (_Float16*)logf + (size_t)(rowb + ai * 128 + m * 16) * 512 + (colb - C_FB) + bj * 128;
                        const h16x8 hv = {(_Float16)o[0][0], (_Float16)o[0][1], (_Float16)o[0][2], (_Float16)o[0][3], (_Float16)o[1][0], (_Float16)o[1][1], (_Float16)o[1][2], (_Float16)o[1][3]};
                        if (NOSTORE) asm volatile("" :: "v"(hv)); else *(h16x8*)p = hv; }
        } else {
            const int mode = (pn == 6 || pn == 7 || pn == 12 || pn == 13) ? 1 : (pn >= 14 ? 2 : 0);
#define EPROJ_LOOP(EXPR) _Pragma("unroll") for (int ai = 0; ai < 2; ++ai) _Pragma("unroll") for (int m = 0; m < 4; ++m) _Pragma("unroll") for (int bj = 0; bj < 2; ++bj) { f32x4 o[2]; \
                _Pragma("unroll") for (int n = 0; n < 2; ++n) { const f32x4 x = acc[ai][bj][m][n]; o[n] = (EXPR); } \
                const u32x4 w_ = pack8(o[0], o[1]); if (NOSTORE) asm volatile("" :: "v"(w_)); else __builtin_nontemporal_store(w_, (u32x4*)(proj + (size_t)(rowb + ai * 128 + m * 16) * DIN + colb + bj * 128)); }
            if (mode == 0) { EPROJ_LOOP(x) } else if (mode == 1) { EPROJ_LOOP(x * sigmoid4_(x)) } else {
#pragma unroll
                for (int ai = 0; ai < 2; ++ai)
#pragma unroll
                    for (int m = 0; m < 4; ++m)
#pragma unroll
                        for (int bj = 0; bj < 2; ++bj) { f32x4 o[2];
#pragma unroll
                            for (int n = 0; n < 2; ++n) o[n] = sigmoid4_(acc[ai][bj][m][n]);
                            u32x2 w_; w_.x = pk4_u8(o[0][0], o[0][1], o[0][2], o[0][3]); w_.y = pk4_u8(o[1][0], o[1][1], o[1][2], o[1][3]);
                            unsigned char* gp = (unsigned char*)(proj + (size_t)(rowb + ai * 128 + m * 16) * DIN) + GATE_BYTE0 + (colb - C_GA) + bj * 128;
                            if (NOSTORE) asm volatile("" :: "v"(w_)); else *(u32x2*)gp = w_; }
            }
#undef EPROJ_LOOP
        }
    }
};
typedef EpiProj_<false> EpiProj;
template <bool ACCUM> struct EpiMix {
    bf16_t* mixed; const bf16_t* proj; int gcol;
    __device__ __forceinline__ void operator()(const f32x4 (&acc)[2][2][4][2], const Unit& u, int wr, int wc, int fr, int fq) const {
        const int colb = u.pn * 256 + wc * 32 + 8 * fq, rowb = u.pm * 256 + wr * 64 + fr;
#pragma unroll
        for (int ai = 0; ai < 2; ++ai) {
            u32x4 g[4][2], mx[4][2];
#pragma unroll
            for (int m = 0; m < 4; ++m)
#pragma unroll
                for (int bj = 0; bj < 2; ++bj) { const size_t row = (size_t)(rowb + ai * 128 + m * 16); g[m][bj] = *(const u32x4*)(proj + row * DIN + gcol + colb + bj * 128);
                    if (ACCUM) mx[m][bj] = *(const u32x4*)(mixed + row * DM + colb + bj * 128); }
#pragma unroll
            for (int m = 0; m < 4; ++m)
#pragma unroll
                for (int bj = 0; bj < 2; ++bj) { f32x4 g0, g1; unpack8(g[m][bj], g0, g1); f32x4 v0 = acc[ai][bj][m][0] * g0, v1 = acc[ai][bj][m][1] * g1;
                    if (ACCUM) { f32x4 m0, m1; unpack8(mx[m][bj], m0, m1); v0 = v0 + m0; v1 = v1 + m1; }
                    *(u32x4*)(mixed + (size_t)(rowb + ai * 128 + m * 16) * DM + colb + bj * 128) = pack8(v0, v1); }
        }
    }
};
struct EpiMixF {         static constexpr int NVMEM = 16;
    bf16_t* mixed; const bf16_t* proj;
    __device__ __forceinline__ void mid(f32x4 (&acc)[2][2][4][2], const Unit& u, int wr, int wc, int fr, int fq) const {
        const int colb = u.pn * 256 + wc * 32 + 8 * fq, rowb = u.pm * 256 + wr * 64 + fr;
        u32x2 ga[2][4][2], gb[2][4][2];
#pragma unroll
        for (int ai = 0; ai < 2; ++ai)
#pragma unroll
            for (int m = 0; m < 4; ++m)
#pragma unroll
                for (int bj = 0; bj < 2; ++bj) { const unsigned char* p = (const unsigned char*)(proj + (size_t)(rowb + ai * 128 + m * 16) * DIN) + GATE_BYTE0 + colb + bj * 128; ga[ai][m][bj] = *(const u32x2*)p; gb[ai][m][bj] = *(const u32x2*)(p + 1024); }
#pragma unroll
        for (int ai = 0; ai < 2; ++ai)
#pragma unroll
            for (int m = 0; m < 4; ++m)
#pragma unroll
                for (int bj = 0; bj < 2; ++bj) { const f32x4 a0 = un4_u8(ga[ai][m][bj].x), a1 = un4_u8(ga[ai][m][bj].y), b0 = un4_u8(gb[ai][m][bj].x), b1 = un4_u8(gb[ai][m][bj].y);
                    const f32x4 r0 = a0 * (f32x4){__builtin_amdgcn_rcpf(b0[0]), __builtin_amdgcn_rcpf(b0[1]), __builtin_amdgcn_rcpf(b0[2]), __builtin_amdgcn_rcpf(b0[3])};
                    const f32x4 r1 = a1 * (f32x4){__builtin_amdgcn_rcpf(b1[0]), __builtin_amdgcn_rcpf(b1[1]), __builtin_amdgcn_rcpf(b1[2]), __builtin_amdgcn_rcpf(b1[3])};
                    acc[ai][bj][m][0] = acc[ai][bj][m][0] * r0; acc[ai][bj][m][1] = acc[ai][bj][m][1] * r1; }
    }
    __device__ __forceinline__ void operator()(const f32x4 (&acc)[2][2][4][2], const Unit& u, int wr, int wc, int fr, int fq) const {
        const int colb = u.pn * 256 + wc * 32 + 8 * fq, rowb = u.pm * 256 + wr * 64 + fr;
        u32x2 gb[2][4][2];
#pragma unroll
        for (int ai = 0; ai < 2; ++ai)
#pragma unroll
            for (int m = 0; m < 4; ++m)
#pragma unroll
                for (int bj = 0; bj < 2; ++bj) gb[ai][m][bj] = *(const u32x2*)((const unsigned char*)(proj + (size_t)(rowb + ai * 128 + m * 16) * DIN) + GATE_BYTE0 + 1024 + colb + bj * 128);
#pragma unroll
        for (int ai = 0; ai < 2; ++ai)
#pragma unroll
            for (int m = 0; m < 4; ++m)
#pragma unroll
                for (int bj = 0; bj < 2; ++bj) { const f32x4 b0 = un4_u8(gb[ai][m][bj].x) * (1.0f / 255.0f), b1 = un4_u8(gb[ai][m][bj].y) * (1.0f / 255.0f);
                    *(u32x4*)(mixed + (size_t)(rowb + ai * 128 + m * 16) * DM + colb + bj * 128) = pack8(acc[ai][bj][m][0] * b0, acc[ai][bj][m][1] * b1); }
    }
};
struct EpiOut {
    static constexpr int NVMEM = 16;
    const float* x; bf16_t* x1;
    __device__ __forceinline__ void operator()(const f32x4 (&acc)[2][2][4][2], const Unit& u, int wr, int wc, int fr, int fq) const {
        const int colb = u.pn * 256 + wc * 32 + 8 * fq, rowb = u.pm * 256 + wr * 64 + fr;
#pragma unroll
        for (int ai = 0; ai < 2; ++ai) {
            f32x4 xv[4][2][2];
#pragma unroll
            for (int m = 0; m < 4; ++m)
#pragma unroll
                for (int bj = 0; bj < 2; ++bj) { const float* p = x + (size_t)(rowb + ai * 128 + m * 16) * DM + colb + bj * 128; xv[m][bj][0] = __builtin_nontemporal_load((const f32x4*)p); xv[m][bj][1] = __builtin_nontemporal_load((const f32x4*)(p + 4)); }
#pragma unroll
            for (int m = 0; m < 4; ++m)
#pragma unroll
                for (int bj = 0; bj < 2; ++bj) *(u32x4*)(x1 + (size_t)(rowb + ai * 128 + m * 16) * DM + colb + bj * 128) = pack8(xv[m][bj][0] + acc[ai][bj][m][0], xv[m][bj][1] + acc[ai][bj][m][1]);
        }
    }
};
struct EpiMoe1 {         static constexpr int NVMEM = 8;
    bf16_t* hid; const float* bias;
    struct Pre { f32x4 b[4]; };
    __device__ __forceinline__ Pre pre(const Unit& u, int wr, int wc, int fr, int fq) const { Pre p; const float* bp = bias + (size_t)u.e * 2048 + 2 * (128 * u.pn + wc * 32 + 8 * fq);
#pragma unroll
        for (int j = 0; j < 4; ++j) p.b[j] = *(const f32x4*)(bp + 4 * j);
        return p; }
    __device__ __forceinline__ void operator()(const f32x4 (&acc)[2][2][4][2], const Unit& u, int wr, int wc, int fr, int fq, const Pre& pf) const {
        const int jj0 = wc * 32 + 8 * fq, J0 = 128 * u.pn + jj0;
        const f32x4 (&b)[4] = pf.b;
        constexpr float DQ = MOE1_I8 ? 1.0f : DQ1;
        constexpr float HS = MOE_FP8 ? S_HID : 1.0f, KE = -1.702f * 1.4426950408889634f;
#pragma unroll
        for (int ai = 0; ai < 2; ++ai)
#pragma unroll
            for (int m = 0; m < 4; ++m) {
                const int r = ai * 128 + wr * 64 + m * 16 + fr;
                f32x2 h[4];
#pragma unroll
                for (int p = 0; p < 4; ++p) {
                    const f32x4 ag = acc[ai][0][m][p >> 1], au = acc[ai][1][m][p >> 1];
                    const f32x2 g0 = (p & 1) ? (f32x2){ag[2], ag[3]} : (f32x2){ag[0], ag[1]}, u0 = (p & 1) ? (f32x2){au[2], au[3]} : (f32x2){au[0], au[1]};
                    f32x2 gt = g0 * DQ + (f32x2){b[p][0], b[p][2]}, up = u0 * DQ + (f32x2){b[p][1], b[p][3]};
                    gt.x = fminf(gt.x, 7.0f); gt.y = fminf(gt.y, 7.0f); up.x = __builtin_amdgcn_fmed3f(up.x, -7.0f, 7.0f); up.y = __builtin_amdgcn_fmed3f(up.y, -7.0f, 7.0f);
                    f32x2 e = gt * KE; e.x = __builtin_amdgcn_exp2f(e.x); e.y = __builtin_amdgcn_exp2f(e.y);
                    f32x2 den = e * (1.0f / HS) + (1.0f / HS); den.x = __builtin_amdgcn_rcpf(den.x); den.y = __builtin_amdgcn_rcpf(den.y);
                    h[p] = (up * gt + gt) * den;
                }
                if constexpr (MOE_FP8) { u32x2 w; unsigned t = 0u;
                    t = __builtin_amdgcn_cvt_pk_fp8_f32(h[0].x, h[0].y, t, false); t = __builtin_amdgcn_cvt_pk_fp8_f32(h[1].x, h[1].y, t, true); w.x = t; t = 0u;
                    t = __builtin_amdgcn_cvt_pk_fp8_f32(h[2].x, h[2].y, t, false); t = __builtin_amdgcn_cvt_pk_fp8_f32(h[3].x, h[3].y, t, true); w.y = t;
                    *(u32x2*)((unsigned char*)hid + (size_t)(u.pm * 256 + r) * DE + J0) = w; }
                else { u32x4 w; w.x = pk2(h[0].x, h[0].y); w.y = pk2(h[1].x, h[1].y); w.z = pk2(h[2].x, h[2].y); w.w = pk2(h[3].x, h[3].y);
                    *(u32x4*)(hid + (size_t)(u.pm * 256 + r) * DE + J0) = w; }
            }
    }
};
struct EpiMoe2 {
    static constexpr int NVMEM = MOE_FP8 ? 8 : 16;
    bf16_t* yg; const float* bias; const int* rows; const float* roww;
    struct Pre { f32x4 b[2][2]; int slot[2][4]; float wgt[2][4]; };
    __device__ __forceinline__ Pre pre(const Unit& u, int wr, int wc, int fr, int fq) const { Pre p; f32x4 (&b)[2][2] = p.b; int (&slot)[2][4] = p.slot; float (&wgt)[2][4] = p.wgt;
        const int c0 = MOE_FP8 ? u.pn * 256 + 64 * wc + 16 * fq : 0;
#pragma unroll
        for (int bj = 0; bj < 2; ++bj) { const float* bp = MOE_FP8 ? bias + (size_t)u.e * DM + c0 + 8 * bj : bias + (size_t)u.e * DM + u.pn * 256 + bj * 128 + wc * 32 + 8 * fq; b[bj][0] = *(const f32x4*)bp; b[bj][1] = *(const f32x4*)(bp + 4); }
#pragma unroll
        for (int ai = 0; ai < 2; ++ai)
#pragma unroll
            for (int m = 0; m < 4; ++m) { int r = ai * 128 + wr * 64 + m * 16 + fr; r = r < u.nvalid ? r : u.nvalid - 1; const size_t pp = (size_t)u.e * CAP + u.lt * 256 + r; slot[ai][m] = rows[pp]; wgt[ai][m] = roww[pp]; }
        return p; }
    __device__ __forceinline__ void operator()(const f32x4 (&acc)[2][2][4][2], const Unit& u, int wr, int wc, int fr, int fq, const Pre& pf) const {
        const f32x4 (&b)[2][2] = pf.b; const int (&slot)[2][4] = pf.slot; const float (&wgt)[2][4] = pf.wgt;
        const int c0 = MOE_FP8 ? u.pn * 256 + 64 * wc + 16 * fq : 0;
#pragma unroll
        for (int ai = 0; ai < 2; ++ai)
#pragma unroll
            for (int m = 0; m < 4; ++m) {
                const int r = ai * 128 + wr * 64 + m * 16 + fr; const float w = wgt[ai][m];
                if (r < u.nvalid) {
                    if constexpr (MOE_FP8) { u32x4 q; const float ws = w * S_YG;
#define PK4Y_(A, B) ({ const f32x4 y_ = ((A) * DQ2 + (B)) * ws; unsigned t_ = 0u; \
                        t_ = __builtin_amdgcn_cvt_pk_fp8_f32(__builtin_amdgcn_fmed3f(y_[0], -440.0f, 440.0f), __builtin_amdgcn_fmed3f(y_[1], -440.0f, 440.0f), t_, false); \
                        t_ = __builtin_amdgcn_cvt_pk_fp8_f32(__builtin_amdgcn_fmed3f(y_[2], -440.0f, 440.0f), __builtin_amdgcn_fmed3f(y_[3], -440.0f, 440.0f), t_, true); t_; })
                        q.x = PK4Y_(acc[ai][0][m][0], b[0][0]); q.y = PK4Y_(acc[ai][0][m][1], b[0][1]); q.z = PK4Y_(acc[ai][1][m][0], b[1][0]); q.w = PK4Y_(acc[ai][1][m][1], b[1][1]);
#undef PK4Y_
                        *(u32x4*)((unsigned char*)yg + (size_t)slot[ai][m] * DM + c0) = q; }
                    else {
#pragma unroll
                        for (int bj = 0; bj < 2; ++bj) { const f32x4 y0 = (acc[ai][bj][m][0] * DQ2 + b[bj][0]) * w, y1 = (acc[ai][bj][m][1] * DQ2 + b[bj][1]) * w;
                            *(u32x4*)(yg + (size_t)slot[ai][m] * DM + u.pn * 256 + bj * 128 + wc * 32 + 8 * fq) = pack8(y0, y1); } }
                }
            }
    }
};

struct Args { const float* in[16]; float* out; unsigned char* ws; int ph_lo, ph_hi; };
enum { I_X = 0, I_N1, I_WIN, I_MUP, I_LBL, I_HNW, I_HUP, I_WOUT, I_N2, I_RW, I_RB, I_WGU, I_BGU, I_WD, I_BD, I_FNW };
constexpr int NPHASE = 11;

struct Frame { LAS unsigned char* lds; int tid, lane, wave, G, bid; };
__device__ __forceinline__ Frame fresh(const Frame& F0) { Frame F = F0; const int l = lane_id_(); F.lane = l; F.tid = F0.wave * 64 + l; return F; }

template <int MAP> __device__ __forceinline__ int rowmap(int n) {
    if (MAP == 1) return n < 1024 ? ((n & ~63) | (2 * (n & 31) + ((n >> 5) & 1))) : n;
    if (MAP == 2) { const int J = n >> 1, s = n & 1; return 256 * (J >> 7) + 128 * s + (J & 127); }
    return n;
}
template <int MAP> __device__ __forceinline__ void transpose_item(const float* W, int K, int N, bf16_t* WT, LAS float* scr, int item, int lane, int KP = 0) {
    if (KP == 0) KP = K;
    const int nblk = N / 32, kb = item / nblk, nb = item % nblk, k0 = 64 * kb, n0 = 32 * nb;
    f32x4 v[8];
#pragma unroll
    for (int i = 0; i < 8; ++i) v[i] = __builtin_nontemporal_load((const f32x4*)(W + (size_t)(k0 + 8 * i + (lane >> 3)) * N + n0 + 4 * (lane & 7)));
#pragma unroll
    for (int i = 0; i < 8; ++i) { LAS float* p = scr + (8 * i + (lane >> 3)) * 33 + 4 * (lane & 7); p[0] = v[i].x; p[1] = v[i].y; p[2] = v[i].z; p[3] = v[i].w; }
    asm volatile("s_waitcnt lgkmcnt(0)" ::: "memory");
    const int c = lane & 7;
#pragma unroll
    for (int j = 0; j < 4; ++j) { const int n = (lane >> 3) + 8 * j; const LAS float* s = scr + (8 * c) * 33 + n;
        u32x4 o; o.x = pk2(s[0 * 33], s[1 * 33]); o.y = pk2(s[2 * 33], s[3 * 33]); o.z = pk2(s[4 * 33], s[5 * 33]); o.w = pk2(s[6 * 33], s[7 * 33]);
        *(u32x4*)(WT + (size_t)rowmap<MAP>(n0 + n) * KP + k0 + 8 * c) = o; }
    asm volatile("s_waitcnt lgkmcnt(0)" ::: "memory");
}
template <int MAP> __device__ __forceinline__ void transpose_item_fp8(const float* W, int K, int N, unsigned char* WT, LAS float* scr, int item, int lane) {
    const int nblk = N / 32, kb = item / nblk, nb = item % nblk, k0 = 64 * kb, n0 = 32 * nb;
    f32x4 v[8];
#pragma unroll
    for (int i = 0; i < 8; ++i) v[i] = __builtin_nontemporal_load((const f32x4*)(W + (size_t)(k0 + 8 * i + (lane >> 3)) * N + n0 + 4 * (lane & 7)));
#pragma unroll
    for (int i = 0; i < 8; ++i) { LAS float* p = scr + (8 * i + (lane >> 3)) * 33 + 4 * (lane & 7); p[0] = v[i].x; p[1] = v[i].y; p[2] = v[i].z; p[3] = v[i].w; }
    asm volatile("s_waitcnt lgkmcnt(0)" ::: "memory");
    const int n = lane >> 1, hf = lane & 1; const LAS float* s = scr + (32 * hf) * 33 + n;
    u32x4 o0, o1;
    o0.x = pk4_fp8(s[0 * 33], s[1 * 33], s[2 * 33], s[3 * 33], S_W);     o0.y = pk4_fp8(s[4 * 33], s[5 * 33], s[6 * 33], s[7 * 33], S_W);
    o0.z = pk4_fp8(s[8 * 33], s[9 * 33], s[10 * 33], s[11 * 33], S_W);   o0.w = pk4_fp8(s[12 * 33], s[13 * 33], s[14 * 33], s[15 * 33], S_W);
    o1.x = pk4_fp8(s[16 * 33], s[17 * 33], s[18 * 33], s[19 * 33], S_W); o1.y = pk4_fp8(s[20 * 33], s[21 * 33], s[22 * 33], s[23 * 33], S_W);
    o1.z = pk4_fp8(s[24 * 33], s[25 * 33], s[26 * 33], s[27 * 33], S_W); o1.w = pk4_fp8(s[28 * 33], s[29 * 33], s[30 * 33], s[31 * 33], S_W);
    unsigned char* dst = WT + (size_t)rowmap<MAP>(n0 + n) * K + k0 + 32 * hf;
    *(u32x4*)dst = o0; *(u32x4*)(dst + 16) = o1;
    asm volatile("s_waitcnt lgkmcnt(0)" ::: "memory");
}
__device__ __forceinline__ void tp8_load(const float* W, int N, int item, f32x4 (&v)[8], int lane) {
    const int nblk = N / 32, kb = item / nblk, nb = item % nblk, k0 = 64 * kb, n0 = 32 * nb;
#pragma unroll
    for (int i = 0; i < 8; ++i) v[i] = __builtin_nontemporal_load((const f32x4*)(W + (size_t)(k0 + 8 * i + (lane >> 3)) * N + n0 + 4 * (lane & 7)));
}
template <int MAP> __device__ __forceinline__ void tp8_finish(const f32x4 (&v)[8], int K, int N, unsigned char* WT, LAS float* scr, int item, int lane) {
    const int nblk = N / 32, kb = item / nblk, nb = item % nblk, k0 = 64 * kb, n0 = 32 * nb;
#pragma unroll
    for (int i = 0; i < 8; ++i) { LAS float* p = scr + (8 * i + (lane >> 3)) * 33 + 4 * (lane & 7); p[0] = v[i].x; p[1] = v[i].y; p[2] = v[i].z; p[3] = v[i].w; }
    asm volatile("s_waitcnt lgkmcnt(0)" ::: "memory");
    const int n = lane >> 1, hf = lane & 1; const LAS float* s = scr + (32 * hf) * 33 + n;
    u32x4 o0, o1;
    o0.x = pk4_fp8(s[0 * 33], s[1 * 33], s[2 * 33], s[3 * 33], S_W);     o0.y = pk4_fp8(s[4 * 33], s[5 * 33], s[6 * 33], s[7 * 33], S_W);
    o0.z = pk4_fp8(s[8 * 33], s[9 * 33], s[10 * 33], s[11 * 33], S_W);   o0.w = pk4_fp8(s[12 * 33], s[13 * 33], s[14 * 33], s[15 * 33], S_W);
    o1.x = pk4_fp8(s[16 * 33], s[17 * 33], s[18 * 33], s[19 * 33], S_W); o1.y = pk4_fp8(s[20 * 33], s[21 * 33], s[22 * 33], s[23 * 33], S_W);
    o1.z = pk4_fp8(s[24 * 33], s[25 * 33], s[26 * 33], s[27 * 33], S_W); o1.w = pk4_fp8(s[28 * 33], s[29 * 33], s[30 * 33], s[31 * 33], S_W);
    unsigned char* dst = WT + (size_t)rowmap<MAP>(n0 + n) * K + k0 + 32 * hf;
    *(u32x4*)dst = o0; *(u32x4*)(dst + 16) = o1;
    asm volatile("s_waitcnt lgkmcnt(0)" ::: "memory");
}
struct QItem { const float* W; unsigned char* WT; float* scl; int N, n0, map; };
constexpr int NQ_IN = P1_I8 ? DIN / 32 : 0, NQ_GU = MOE1_I8 ? NE * 64 : 0, NQ = NQ_IN + NQ_GU;
constexpr bool DEFER_MOE_W = (DEFER_MOE_W_ != 0) && MOE1_I8 && MOE_FP8;
__device__ __forceinline__ QItem q_item(const float* win, const float* wgu, unsigned char* ws, int wi) {
    QItem q;
    if (wi < NQ_IN) { q.W = win; q.WT = ws + WS_WIN; q.scl = (float*)(ws + WS_WINS); q.N = DIN; q.n0 = 32 * wi; q.map = 1; }
    else { wi -= NQ_IN; const int e = wi >> 6; q.W = wgu + (size_t)e * DM * 2 * DE; q.WT = ws + WS_WGU + (size_t)e * 2 * DE * DM; q.scl = (float*)(ws + WS_WGS) + (size_t)e * 2 * DE; q.N = 2 * DE; q.n0 = 32 * (wi & 63); q.map = 2; }
    return q;
}
template <int I0 = 0, int CNT = 16> __device__ __forceinline__ void q_load(const QItem& q, f32x4 (&v)[16], int wave, int lane) {
#pragma unroll
    for (int i = I0; i < I0 + CNT; ++i) v[i] = __builtin_nontemporal_load((const f32x4*)(q.W + (size_t)(128 * wave + 8 * i + (lane >> 3)) * q.N + q.n0 + 4 * (lane & 7)));
}
#define Q_FENCE() asm volatile("" ::: "memory")
__device__ __forceinline__ void quant_cols_loop(const float* win, const float* wgu, unsigned char* ws, LAS unsigned char* lds, int wi0, int wi_end, int G, int wave, int lane) {
    LAS float* s = (LAS float*)lds; LAS float* pmax = (LAS float*)(lds + 1024 * 33 * 4);
    int wi = wi0; if (wi >= wi_end) return;
    QItem q = q_item(win, wgu, ws, wi); f32x4 v[16]; q_load(q, v, wave, lane);
    for (;;) {
#pragma unroll
        for (int i = 0; i < 16; ++i) { LAS float* p = s + (128 * wave + 8 * i + (lane >> 3)) * 33 + 4 * (lane & 7); p[0] = v[i].x; p[1] = v[i].y; p[2] = v[i].z; p[3] = v[i].w; }
        lds_barrier();
        const int nw = wi + G; const bool more = nw < wi_end; QItem qn = q;
        if (more) { qn = q_item(win, wgu, ws, nw); q_load<0, 4>(qn, v, wave, lane); }
        Q_FENCE();
        const int n = lane & 31, kb = 128 * wave + 64 * (lane >> 5);
        float x[64]; float am = 0.f;
#pragma unroll
        for (int kk = 0; kk < 32; ++kk) { x[kk] = s[(kb + kk) * 33 + n]; am = fmaxf(am, fabsf(x[kk])); }
        Q_FENCE(); if (more) q_load<4, 4>(qn, v, wave, lane); Q_FENCE();
#pragma unroll
        for (int kk = 32; kk < 64; ++kk) { x[kk] = s[(kb + kk) * 33 + n]; am = fmaxf(am, fabsf(x[kk])); }
        Q_FENCE(); if (more) q_load<8, 4>(qn, v, wave, lane); Q_FENCE();
        pmax[(2 * wave + (lane >> 5)) * 32 + n] = am;
        lds_barrier();
        if (more) q_load<12, 4>(qn, v, wave, lane);
        Q_FENCE();
        am = 0.f;
#pragma unroll
        for (int p = 0; p < 16; ++p) am = fmaxf(am, pmax[p * 32 + n]);
        const float inv = am > 0.f ? 127.0f / am : 0.f;
        const int r = q.map == 1 ? rowmap<1>(q.n0 + n) : rowmap<2>(q.n0 + n);
        if (wave == 0 && lane < 32) q.scl[r] = am * (1.0f / 127.0f);
        unsigned char* dst = q.WT + (size_t)r * 1024 + kb;
#pragma unroll
        for (int qq = 0; qq < 4; ++qq) { u32x4 o;
            o.x = pk4_i8(x[16 * qq + 0] * inv, x[16 * qq + 1] * inv, x[16 * qq + 2] * inv, x[16 * qq + 3] * inv);   o.y = pk4_i8(x[16 * qq + 4] * inv, x[16 * qq + 5] * inv, x[16 * qq + 6] * inv, x[16 * qq + 7] * inv);
            o.z = pk4_i8(x[16 * qq + 8] * inv, x[16 * qq + 9] * inv, x[16 * qq + 10] * inv, x[16 * qq + 11] * inv); o.w = pk4_i8(x[16 * qq + 12] * inv, x[16 * qq + 13] * inv, x[16 * qq + 14] * inv, x[16 * qq + 15] * inv);
            *(u32x4*)(dst + 16 * qq) = o; }
        if (!more) break;
        q = qn; wi = nw;
    }
    lds_barrier();
}
__device__ __forceinline__ void rms_row_to_bf16(const float* xrow, const float* w, bf16_t* orow, int lane) {
    const f32x4* xr = (const f32x4*)xrow + lane; const f32x4* wr = (const f32x4*)w + lane;
    f32x4 v[4]; float s = 0.f;
#pragma unroll
    for (int j = 0; j < 4; ++j) { v[j] = __builtin_nontemporal_load(xr + 64 * j); s += (v[j].x * v[j].x + v[j].y * v[j].y) + (v[j].z * v[j].z + v[j].w * v[j].w); }
    const float rstd = 1.0f / sqrtf(wave_sum(s) * (1.0f / DM) + RMS_EPS);
    u32x2* o8 = (u32x2*)orow + lane;
#pragma unroll
    for (int j = 0; j < 4; ++j) { const f32x4 ww = wr[64 * j]; u32x2 o; o.x = pk2(v[j].x * rstd * ww.x, v[j].y * rstd * ww.y); o.y = pk2(v[j].z * rstd * ww.z, v[j].w * rstd * ww.w); o8[64 * j] = o; }
}
__device__ __forceinline__ void rms_row_to_i8(const float* xrow, const float* w, unsigned char* orow, float* sc, int lane) {
    const f32x4* xr = (const f32x4*)xrow + lane; const f32x4* wr = (const f32x4*)w + lane;
    f32x4 v[4]; float s = 0.f;
#pragma unroll
    for (int j = 0; j < 4; ++j) { v[j] = __builtin_nontemporal_load(xr + 64 * j); s += (v[j].x * v[j].x + v[j].y * v[j].y) + (v[j].z * v[j].z + v[j].w * v[j].w); }
    const float rstd = 1.0f / sqrtf(wave_sum(s) * (1.0f / DM) + RMS_EPS);
    float am = 0.f;
#pragma unroll
    for (int j = 0; j < 4; ++j) { const f32x4 ww = wr[64 * j]; v[j] = v[j] * rstd * ww; am = fmaxf(fmaxf(am, fmaxf(fabsf(v[j].x), fabsf(v[j].y))), fmaxf(fabsf(v[j].z), fabsf(v[j].w))); }
    am = wave_max(am); const float inv = am > 0.f ? 127.0f / am : 0.f;
    unsigned* o4 = (unsigned*)orow + lane;
#pragma unroll
    for (int j = 0; j < 4; ++j) o4[64 * j] = pk4_i8(v[j].x * inv, v[j].y * inv, v[j].z * inv, v[j].w * inv);
    if (lane == 0) *sc = am * (1.0f / 127.0f);
}

__device__ __forceinline__ void p0_prologue(const Frame& F0, const Args& a) {
    const Frame F = fresh(F0);
    unsigned char* ws = a.ws;
    LAS float* scr = (LAS float*)(F.lds + F.wave * 16384);
    const int gw = F.bid * 8 + F.wave, NGW = F.G * 8;
    constexpr int I_IN = P1_I8 ? 0 : 16 * (DIN / 32), I_UP = 8 * 32, I_O = 16 * 32, I_GU = MOE1_I8 ? 0 : 16 * 64, I_D = 16 * 32;
    constexpr int NITEMS = I_IN + 2 * I_UP + I_O + NE * (I_GU + (DEFER_MOE_W ? 0 : I_D));
    for (int it = (DEFER_MOE_W && I_IN == 0) ? NITEMS : gw; it < NITEMS; it += NGW) {
        int r = it;
        if (r < I_IN) { transpose_item<1>(a.in[I_WIN], DM, DIN, (bf16_t*)(ws + WS_WIN), scr, r, F.lane); continue; } r -= I_IN;
        if (r < I_UP) { transpose_item<0>(a.in[I_MUP], 512, DM, (bf16_t*)(ws + WS_MUP), scr, r, F.lane, 1024); continue; } r -= I_UP;
        if (r < I_UP) { transpose_item<0>(a.in[I_HUP], 512, DM, (bf16_t*)(ws + WS_MUP) + 512, scr, r, F.lane, 1024); continue; } r -= I_UP;
        if (r < I_O) { transpose_item<0>(a.in[I_WOUT], DM, DM, (bf16_t*)(ws + WS_WOUT), scr, r, F.lane); continue; } r -= I_O;
        if (I_GU > 0 && r < NE * I_GU) { const int e = r / (I_GU > 0 ? I_GU : 1);
            if constexpr (MOE_FP8) transpose_item_fp8<2>(a.in[I_WGU] + (size_t)e * DM * 2 * DE, DM, 2 * DE, (unsigned char*)(ws + WS_WGU) + (size_t)e * 2 * DE * DM, scr, r % (I_GU > 0 ? I_GU : 1), F.lane);
            else transpose_item<2>(a.in[I_WGU] + (size_t)e * DM * 2 * DE, DM, 2 * DE, (bf16_t*)(ws + WS_WGU) + (size_t)e * 2 * DE * DM, scr, r % (I_GU > 0 ? I_GU : 1), F.lane);
            continue; } r -= NE * I_GU;
        { const int e = r / I_D;
            if constexpr (MOE_FP8) transpose_item_fp8<0>(a.in[I_WD] + (size_t)e * DE * DM, DE, DM, (unsigned char*)(ws + WS_WD) + (size_t)e * DM * DE, scr, r % I_D, F.lane);
            else transpose_item<0>(a.in[I_WD] + (size_t)e * DE * DM, DE, DM, (bf16_t*)(ws + WS_WD) + (size_t)e * DM * DE, scr, r % I_D, F.lane); }
    }
    if constexpr (P1_I8) { for (int m = gw; m < NTOK; m += NGW) rms_row_to_i8(a.in[I_X] + (size_t)m * DM, a.in[I_N1], ws + WS_XN + (size_t)m * DM, (float*)(ws + WS_XS) + m, F.lane); }
    else { for (int m = gw; m < NTOK; m += NGW) rms_row_to_bf16(a.in[I_X] + (size_t)m * DM, a.in[I_N1], (bf16_t*)(ws + WS_XN) + (size_t)m * DM, F.lane); }
    if constexpr (NQ > 0) {
        __syncthreads();
        quant_cols_loop(a.in[I_WIN], a.in[I_WGU], ws, F.lds, F.bid, DEFER_MOE_W ? NQ_IN : NQ, F.G, F.wave, F.lane);
    }
    float* rope = (float*)(ws + WS_ROPE);
    for (int idx = F.bid * 512 + F.tid; idx < SEQ * 32; idx += F.G * 512) {
        const int pos = idx >> 5, i = idx & 31;
        const double inv = exp2(-(double)i * (13.287712379549449 / 32.0));
        const double rev = (double)pos * inv * 0.15915494309189535;
        const float fr = (float)(rev - floor(rev));
        rope[2 * idx] = __builtin_amdgcn_cosf(fr); rope[2 * idx + 1] = __builtin_amdgcn_sinf(fr);
    }
    if (F.bid == 0) { const float* l = a.in[I_LBL]; const float a0 = l[F.tid], a1 = l[512 + F.tid]; ((float*)(ws + WS_LB))[F.tid] = 1.0f / (1.0f + __expf(a1 - a0)); }
}

__device__ __forceinline__ void moe_weight_copies(const Frame& F0, const Args& a) {
    const Frame F = fresh(F0);
    unsigned char* ws = a.ws;
    LAS float* scr = (LAS float*)(F.lds + F.wave * 16384);
    const int gw = F.bid * 8 + F.wave, NGW = F.G * 8;
    constexpr int I_D = 16 * 32;
    { constexpr int I_UP = 8 * 32, I_O = 16 * 32;
      for (int it = gw; it < 2 * I_UP + I_O; it += NGW) { int r = it;
          if (r < I_UP) { transpose_item<0>(a.in[I_MUP], 512, DM, (bf16_t*)(ws + WS_MUP), scr, r, F.lane, 1024); continue; } r -= I_UP;
          if (r < I_UP) { transpose_item<0>(a.in[I_HUP], 512, DM, (bf16_t*)(ws + WS_MUP) + 512, scr, r, F.lane, 1024); continue; } r -= I_UP;
          transpose_item<0>(a.in[I_WOUT], DM, DM, (bf16_t*)(ws + WS_WOUT), scr, r, F.lane); } }
    { f32x4 vc[8], vn[8]; int r = gw;
      if (r < NE * I_D) tp8_load(a.in[I_WD] + (size_t)(r / I_D) * DE * DM, DM, r % I_D, vc, F.lane);
      for (; r < NE * I_D; r += NGW) { const int rn = r + NGW, e = r / I_D;
          if (rn < NE * I_D) tp8_load(a.in[I_WD] + (size_t)(rn / I_D) * DE * DM, DM, rn % I_D, vn, F.lane);
          tp8_finish<0>(vc, DE, DM, (unsigned char*)(ws + WS_WD) + (size_t)e * DM * DE, scr, r % I_D, F.lane);
#pragma unroll
          for (int i = 0; i < 8; ++i) vc[i] = vn[i]; } }
    __syncthreads();
    quant_cols_loop(a.in[I_WIN], a.in[I_WGU], ws, F.lds, NQ_IN + F.bid, NQ, F.G, F.wave, F.lane);
    __syncthreads();
}
__device__ __forceinline__ void p2_kmean(const Frame& F0, const Args& a) {
    const Frame F = fresh(F0);
    const bf16_t* proj = (const bf16_t*)(a.ws + WS_PROJ); bf16_t* km = (bf16_t*)(a.ws + WS_KMEAN);
    LAS float* red = (LAS float*)F.lds;
    for (int it = F.bid; it < 128; it += F.G) {
        const int b = it >> 4, n = it & 15;
        float s[8] = {0, 0, 0, 0, 0, 0, 0, 0};
        const bf16_t* base = proj + (size_t)(b * SEQ + n * 256 + F.wave * 32) * DIN + C_KA + F.lane * 8;
#pragma unroll 8
        for (int r = 0; r < 32; ++r) { const u32x4 w = *(const u32x4*)(base + (size_t)r * DIN); f32x4 x0, x1; unpack8(w, x0, x1);
            s[0] += x0[0]; s[1] += x0[1]; s[2] += x0[2]; s[3] += x0[3]; s[4] += x1[0]; s[5] += x1[1]; s[6] += x1[2]; s[7] += x1[3]; }
#pragma unroll
        for (int j = 0; j < 8; ++j) red[F.wave * 512 + F.lane * 8 + j] = s[j];
        __syncthreads();
        float t = 0.f;
#pragma unroll
        for (int w = 0; w < 8; ++w) t += red[w * 512 + F.tid];
        km[((size_t)b * 64 + n) * 512 + F.tid] = (bf16_t)f2bf(t * (1.0f / 256.0f));
        km[((size_t)b * 64 + n + 16) * 512 + F.tid] = 0; km[((size_t)b * 64 + n + 32) * 512 + F.tid] = 0; km[((size_t)b * 64 + n + 48) * 512 + F.tid] = 0;
        __syncthreads();
    }
}

constexpr int HP = 72, HQ = 136;
__device__ __forceinline__ void h2_scan(const Frame& F0, const Args& a) {
    const Frame F = fresh(F0);
    bf16_t* hst = (bf16_t*)(a.ws + WS_HST); const float* gdec = (const float*)(a.ws + WS_GDEC);
    LAS float* G = (LAS float*)F.lds;
    for (int base = F.bid * 512; base < 32 * 128 * 32; base += F.G * 512) {
        const int idx = base + F.tid, bh = idx >> 12, v = (idx >> 5) & 127, d4 = idx & 31;
        { const f32x4* gp = (const f32x4*)(gdec + (size_t)bh * 64 * 128) + F.tid;
#pragma unroll
          for (int j = 0; j < 4; ++j) *(LAS f32x4*)(G + (F.tid + 512 * j) * 4) = gp[512 * j]; }
        lds_barrier();
        bf16_t* p = hst + ((size_t)bh * 64 * 128 + v) * 128 + d4 * 4;
        f32x4 s = {0.f, 0.f, 0.f, 0.f};
#pragma unroll 1
        for (int c0 = 0; c0 < 64; c0 += 16) {
            u32x2 u[16];
#pragma unroll
            for (int j = 0; j < 16; ++j) u[j] = __builtin_nontemporal_load((const u32x2*)(p + (size_t)(c0 + j) * 16384));
#pragma unroll
            for (int j = 0; j < 16; ++j) { const f32x4 gg = *(const LAS f32x4*)(G + (c0 + j) * 128 + d4 * 4);
                u32x2 w; w.x = pk2(s[0], s[1]); w.y = pk2(s[2], s[3]); *(u32x2*)(p + (size_t)(c0 + j) * 16384) = w;
                s = gg * s + (f32x4){bf_lo(u[j].x), bf_hi(u[j].x), bf_lo(u[j].y), bf_hi(u[j].y)}; }
        }
        lds_barrier();
    }
}
#define H_CVT_LF(LFR, LH) do { _Pragma("unroll") for (int j_ = 0; j_ < 2; ++j_) { const f32x8 f_ = __builtin_convertvector(LH[j_], f32x8); LFR[2 * j_] = (f32x4){f_[0], f_[1], f_[2], f_[3]}; LFR[2 * j_ + 1] = (f32x4){f_[4], f_[5], f_[6], f_[7]}; } } while (0)
constexpr int LFP = 132;
#define H_LOAD_LQI(it_, LFR, QR, IR, WITHQ) do { const int bh_ = (it_) >> 6, c_ = (it_) & 63; const size_t r_ = (size_t)(bh_ >> 2) * SEQ + c_ * 64 + t_r; const int hh_ = (bh_ & 3) * 128 + 16 * seg; \
    _Pragma("unroll") for (int j_ = 0; j_ < 2; ++j_) LFR[j_] = __builtin_nontemporal_load((const h16x8*)((const _Float16*)logf + r_ * 512 + hh_ + 8 * j_));     \
    _Pragma("unroll") for (int j_ = 0; j_ < 2; ++j_) { if (WITHQ) QR[j_] = __builtin_nontemporal_load((const u32x4*)(proj + r_ * DIN + C_QB + hh_ + 8 * j_)); IR[j_] = __builtin_nontemporal_load((const u32x4*)(proj + r_ * DIN + C_IB + hh_ + 8 * j_)); } } while (0)
__device__ __forceinline__ void scatter_it(LAS bf16_t* It, const u32x4 (&ir)[2], int seg, int t_r) {
    const int tsw = (((t_r >> 3) ^ seg) << 3) | (t_r & 7);
#pragma unroll
    for (int j = 0; j < 2; ++j) { const unsigned w[4] = {ir[j].x, ir[j].y, ir[j].z, ir[j].w};
#pragma unroll
        for (int q = 0; q < 4; ++q) { It[(16 * seg + 8 * j + 2 * q) * HP + tsw] = (bf16_t)(w[q] & 0xffffu); It[(16 * seg + 8 * j + 2 * q + 1) * HP + tsw] = (bf16_t)(w[q] >> 16); } }
}
__device__ __forceinline__ void h1_local_states_p(const Frame& F0, const Args& a) {
    const Frame F = fresh(F0);
    const bf16_t* proj = (const bf16_t*)(a.ws + WS_PROJ); const float* logf = (const float*)(a.ws + WS_LOGF);
    bf16_t* hst = (bf16_t*)(a.ws + WS_HST); float* gdec = (float*)(a.ws + WS_GDEC);
    LAS float* LF = (LAS float*)F.lds; LAS bf16_t* Kp = (LAS bf16_t*)(F.lds + 64 * LFP * 4); LAS bf16_t* It = Kp + 128 * HP;
    const int t_r = F.tid >> 3, seg = F.tid & 7, l15 = F.lane & 15, lq = F.lane >> 4;
    f32x4 lfr[4]; h16x8 lhr[2], lhn[2]; u32x4 qdum[2], ir[2], in_[2];
    int it = F.bid;
    if (it < 2048) H_LOAD_LQI(it, lhr, qdum, ir, false);
    for (; it < 2048; it += F.G) {
        const int bh = it >> 6, c = it & 63;
        H_CVT_LF(lfr, lhr);
#pragma unroll
        for (int j = 0; j < 4; ++j) *(LAS f32x4*)(LF + t_r * LFP + 16 * seg + 4 * j) = lfr[j];
        scatter_it(It, ir, seg, t_r);
        const int itn = it + F.G;
        if (itn < 2048) H_LOAD_LQI(itn, lhn, qdum, in_, false);
        lds_barrier();
        if (F.tid < 128) { float run = 0.f;
#pragma unroll 16
            for (int t = 0; t < 64; ++t) { run += LF[t * LFP + F.tid]; LF[t * LFP + F.tid] = run; }
            gdec[((size_t)bh * 64 + c) * 128 + F.tid] = __expf(run); }
        lds_barrier();
        {
            f32x4 bb[4], bl[4];
#pragma unroll
            for (int j = 0; j < 4; ++j) { bb[j] = *(const LAS f32x4*)(LF + t_r * LFP + 16 * seg + 4 * j); bl[j] = *(const LAS f32x4*)(LF + 63 * LFP + 16 * seg + 4 * j); }
#pragma unroll
            for (int j = 0; j < 4; ++j)
#pragma unroll
                for (int q = 0; q < 4; ++q) { const float kv = (1.0f - __expf(lfr[j][q])) * __expf(bl[j][q] - bb[j][q]); Kp[(16 * seg + 4 * j + q) * HP + ((((t_r >> 3) ^ seg) << 3) | (t_r & 7))] = (bf16_t)f2bf(kv); }
        }
        lds_barrier();
        bf16x8 af[2];
#pragma unroll
        for (int ks = 0; ks < 2; ++ks) af[ks] = *(const LAS bf16x8*)(Kp + (16 * F.wave + l15) * HP + (((ks * 4 + lq) ^ F.wave) << 3));
#pragma unroll
        for (int vt = 0; vt < 8; ++vt) {
            f32x4 acc = {0.f, 0.f, 0.f, 0.f};
#pragma unroll
            for (int ks = 0; ks < 2; ++ks) { const bf16x8 bfr = *(const LAS bf16x8*)(It + (16 * vt + l15) * HP + (((ks * 4 + lq) ^ vt) << 3)); acc = __builtin_amdgcn_mfma_f32_16x16x32_bf16(af[ks], bfr, acc, 0, 0, 0); }
            u32x2 w; w.x = pk2(acc[0], acc[1]); w.y = pk2(acc[2], acc[3]);
            *(u32x2*)(hst + (((size_t)bh * 64 + c) * 128 + 16 * vt + l15) * 128 + 16 * F.wave + 4 * lq) = w;
        }
        lds_barrier();
        lhr[0] = lhn[0]; lhr[1] = lhn[1];
        ir[0] = in_[0]; ir[1] = in_[1];
    }
}
#define H3_LOAD_SF(it_, SF) do { const int bh_ = (it_) >> 6, c_ = (it_) & 63; \
    _Pragma("unroll") for (int ks_ = 0; ks_ < 4; ++ks_) SF[ks_] = __builtin_nontemporal_load((const bf16x8*)(hst + (((size_t)bh_ * 64 + c_) * 128 + 16 * w + l15) * 128 + ks_ * 32 + 8 * lq)); } while (0)
#define H3_LOAD_GR(it_, GR) do { const int bh_ = (it_) >> 6, c_ = (it_) & 63; const size_t row0_ = (size_t)(bh_ >> 2) * SEQ + c_ * 64; \
    _Pragma("unroll") for (int tt_ = 0; tt_ < 4; ++tt_) GR[tt_] = __builtin_nontemporal_load((const u32x2*)(proj + (row0_ + 16 * tt_ + l15) * DIN + C_GB + (bh_ & 3) * 128 + 16 * w + 4 * lq)); } while (0)
#define H3_LOAD_Q(it_, QR) do { const int bh_ = (it_) >> 6, c_ = (it_) & 63; const size_t r_ = (size_t)(bh_ >> 2) * SEQ + c_ * 64 + t_r; const int hh_ = (bh_ & 3) * 128 + 16 * seg; \
    _Pragma("unroll") for (int j_ = 0; j_ < 2; ++j_) QR[j_] = __builtin_nontemporal_load((const u32x4*)(proj + r_ * DIN + C_QB + hh_ + 8 * j_)); } while (0)
#define H3_LOAD_LATE(it_, SF, GR) do { H3_LOAD_SF(it_, SF); H3_LOAD_GR(it_, GR); } while (0)
__device__ __forceinline__ void h3_outputs_p(const Frame& F0, const Args& a) {
    const Frame F = fresh(F0);
    const bf16_t* proj = (const bf16_t*)(a.ws + WS_PROJ); const float* logf = (const float*)(a.ws + WS_LOGF);
    const bf16_t* hst = (const bf16_t*)(a.ws + WS_HST); bf16_t* yb = (bf16_t*)(a.ws + WS_YA); const float* nw = a.in[I_HNW];
    LAS float* LF = (LAS float*)F.lds; LAS bf16_t* Qt = (LAS bf16_t*)(F.lds + 64 * LFP * 4); LAS bf16_t* Kt = Qt + 64 * HQ; LAS bf16_t* It = Kt + 64 * HQ; LAS bf16_t* Pm = It + 128 * HP;
    LAS float* rsq = (LAS float*)(Pm + 64 * HP);
    const int t_r = F.tid >> 3, seg = F.tid & 7, l15 = F.lane & 15, lq = F.lane >> 4, w = F.wave;
    f32x4 lfr[4]; h16x8 lhr[2], lhn[2]; u32x4 qr[2], qn[2], ir[2], in_[2]; bf16x8 sf[4], sfn[4]; u32x2 gr[4], grn[4];
    int it = F.bid;
    if (it < 2048) { H_LOAD_LQI(it, lhr, qr, ir, true); H3_LOAD_LATE(it, sf, gr); }
    for (; it < 2048; it += F.G) {
        const int bh = it >> 6, c = it & 63, b = bh >> 2, h = bh & 3; const size_t row0 = (size_t)b * SEQ + c * 64;
        H_CVT_LF(lfr, lhr);
#pragma unroll
        for (int j = 0; j < 4; ++j) *(LAS f32x4*)(LF + t_r * LFP + 16 * seg + 4 * j) = lfr[j];
        scatter_it(It, ir, seg, t_r);
        const int itn = it + F.G;
        if (itn < 2048) H_LOAD_LQI(itn, lhn, qn, in_, false);
        lds_barrier();
        if (itn < 2048) H3_LOAD_Q(itn, qn);
        if (F.tid < 128) { float run = 0.f;
#pragma unroll 16
            for (int t = 0; t < 64; ++t) { run += LF[t * LFP + F.tid]; LF[t * LFP + F.tid] = run; } }
        lds_barrier();
        if (itn < 2048) H3_LOAD_SF(itn, sfn);
        {
            float qv[16], kv[16];
#pragma unroll
            for (int j = 0; j < 4; ++j) { const f32x4 bb = *(const LAS f32x4*)(LF + t_r * LFP + 16 * seg + 4 * j);
#pragma unroll
                for (int q = 0; q < 4; ++q) { const float eb = __expf(bb[q]); const unsigned qw = (j < 2 ? qr[0] : qr[1])[(2 * j + (q >> 1)) & 3];
                    const float qs = (q & 1) ? bf_hi(qw) : bf_lo(qw);
                    qv[4 * j + q] = qs * eb; kv[4 * j + q] = (1.0f - __expf(lfr[j][q])) * __builtin_amdgcn_rcpf(eb); } }
            u32x4 o0, o1;
            o0.x = pk2(qv[0], qv[1]); o0.y = pk2(qv[2], qv[3]); o0.z = pk2(qv[4], qv[5]); o0.w = pk2(qv[6], qv[7]); o1.x = pk2(qv[8], qv[9]); o1.y = pk2(qv[10], qv[11]); o1.z = pk2(qv[12], qv[13]); o1.w = pk2(qv[14], qv[15]);
            *(LAS u32x4*)(Qt + t_r * HQ + 16 * seg) = o0; *(LAS u32x4*)(Qt + t_r * HQ + 16 * seg + 8) = o1;
            o0.x = pk2(kv[0], kv[1]); o0.y = pk2(kv[2], kv[3]); o0.z = pk2(kv[4], kv[5]); o0.w = pk2(kv[6], kv[7]); o1.x = pk2(kv[8], kv[9]); o1.y = pk2(kv[10], kv[11]); o1.z = pk2(kv[12], kv[13]); o1.w = pk2(kv[14], kv[15]);
            *(LAS u32x4*)(Kt + t_r * HQ + 16 * seg) = o0; *(LAS u32x4*)(Kt + t_r * HQ + 16 * seg + 8) = o1;
        }
        lds_barrier();
        if (itn < 2048) H3_LOAD_GR(itn, grn);
        {
            const int tt = w >> 1; bf16x8 qa[4];
#pragma unroll
            for (int ks = 0; ks < 4; ++ks) qa[ks] = *(const LAS bf16x8*)(Qt + (16 * tt + l15) * HQ + ks * 32 + 8 * lq);
#pragma unroll
            for (int j = 0; j < 2; ++j) {
                const int st = (w & 1) * 2 + j; f32x4 acc = {0.f, 0.f, 0.f, 0.f};
#pragma unroll
                for (int ks = 0; ks < 4; ++ks) { const bf16x8 kb = *(const LAS bf16x8*)(Kt + (16 * st + l15) * HQ + ks * 32 + 8 * lq); acc = __builtin_amdgcn_mfma_f32_16x16x32_bf16(qa[ks], kb, acc, 0, 0, 0); }
                const int s = 16 * st + l15;
#pragma unroll
                for (int r = 0; r < 4; ++r) { const int t = 16 * tt + 4 * lq + r; Pm[t * HP + s] = (bf16_t)(s <= t ? f2bf(acc[r]) : 0u); }
            }
        }
        lds_barrier();
        f32x4 o[4];
        {
            bf16x8 ia[2];
#pragma unroll
            for (int ks = 0; ks < 2; ++ks) ia[ks] = *(const LAS bf16x8*)(It + (16 * w + l15) * HP + (((ks * 4 + lq) ^ w) << 3));
#pragma unroll
            for (int tt = 0; tt < 4; ++tt) {
                f32x4 acc = {0.f, 0.f, 0.f, 0.f};
#pragma unroll
                for (int ks = 0; ks < 2; ++ks) { const bf16x8 pb = *(const LAS bf16x8*)(Pm + (16 * tt + l15) * HP + ks * 32 + 8 * lq); acc = __builtin_amdgcn_mfma_f32_16x16x32_bf16(ia[ks], pb, acc, 0, 0, 0); }
#pragma unroll
                for (int ks = 0; ks < 4; ++ks) { const bf16x8 qb = *(const LAS bf16x8*)(Qt + (16 * tt + l15) * HQ + ks * 32 + 8 * lq); acc = __builtin_amdgcn_mfma_f32_16x16x32_bf16(sf[ks], qb, acc, 0, 0, 0); }
                o[tt] = acc;
                float sq = (acc[0] * acc[0] + acc[1] * acc[1]) + (acc[2] * acc[2] + acc[3] * acc[3]);
                sq += __shfl_xor(sq, 16); sq += __shfl_xor(sq, 32);
                if (F.lane < 16) rsq[w * 64 + 16 * tt + F.lane] = sq;
            }
        }
        lds_barrier();
        const int v0 = 16 * w + 4 * lq; const f32x4 nw4 = *(const f32x4*)(nw + h * 128 + v0);
#pragma unroll
        for (int tt = 0; tt < 4; ++tt) {
            const int t = 16 * tt + l15; float tot = 0.f;
#pragma unroll
            for (int ww = 0; ww < 8; ++ww) tot += rsq[ww * 64 + t];
            const float rstd = __builtin_amdgcn_rsqf(tot * (1.0f / 128.0f) + RMS_EPS);
            const u32x2 gg = gr[tt];
            u32x2 y; y.x = pk2(o[tt][0] * rstd * nw4[0] * bf_lo(gg.x), o[tt][1] * rstd * nw4[1] * bf_hi(gg.x)); y.y = pk2(o[tt][2] * rstd * nw4[2] * bf_lo(gg.y), o[tt][3] * rstd * nw4[3] * bf_hi(gg.y));
            *(u32x2*)(yb + (row0 + t) * 1024 + 512 + h * 128 + v0) = y;
        }
        lds_barrier();
        lhr[0] = lhn[0]; lhr[1] = lhn[1];
        qr[0] = qn[0]; qr[1] = qn[1]; ir[0] = in_[0]; ir[1] = in_[1];
#pragma unroll
        for (int j = 0; j < 4; ++j) { sf[j] = sfn[j]; gr[j] = grn[j]; }
    }
}
#undef H3_LOAD_LATE
#undef H3_LOAD_SF
#undef H3_LOAD_Q
#undef H3_LOAD_GR

#include <hip/hip_bf16.h>
#include <cmath>
namespace attn_body {
using bf16=__hip_bfloat16;
using bf16x8=__attribute__((ext_vector_type(8)))short;
using s16x4=__attribute__((ext_vector_type(4)))short;
using f32x16=__attribute__((ext_vector_type(16)))float;
using u32x4=__attribute__((ext_vector_type(4)))unsigned;
constexpr int BATCH=8,NHEAD=8,SEQ=4096,D=64,PIN=5632,POUT=1024,PKM=512;
constexpr int NW=8,QBLK=32,QB=QBLK*NW,KVBLK=64,NQB=SEQ/QB;
constexpr int ATTN_UNIT_ROWS=QB;
__device__ __forceinline__ int crow(int r,int hi){return (r&3)+8*(r>>2)+4*hi;}
#define SBAR() __builtin_amdgcn_sched_barrier(0)
__device__ __forceinline__ void cmask(f32x16&p0,f32x16&p1,int jb,int qrel,int hi){
  const float NEG=-INFINITY; int kb=64*jb+4*hi;
  #pragma unroll
  for(int r=0;r<16;++r){int kv=kb+(r&3)+8*(r>>2); if(kv>qrel)p0[r]=NEG; if(kv+32>qrel)p1[r]=NEG;}
}

__device__ __forceinline__ void smask(f32x16&p0,f32x16&p1,unsigned selm,int n){ if(!((selm>>n)&1u)){ const float NEG=-INFINITY;
  #pragma unroll
  for(int r=0;r<16;++r){p0[r]=NEG;p1[r]=NEG;} } }
constexpr int NSLOT=3, SLOTB=8192;
constexpr int LDS_K=0, LDS_V=NSLOT*SLOTB, LDS_WS=2*NSLOT*SLOTB, LDS_OST=LDS_WS+NW*64*4, LDS_BYTES=LDS_OST+NW*4096;
constexpr float C2=0.125f*1.4426950408889634f;
__device__ __forceinline__ void glds16(const void*gsrc,unsigned lds_dst){unsigned keep;
  asm volatile("s_mov_b32 %0, m0\n\ts_mov_b32 m0, %2\n\ts_nop 0\n\tglobal_load_lds_dwordx4 %1, off\n\ts_mov_b32 m0, %0":"=&s"(keep):"v"(gsrc),"s"(lds_dst):"memory");}
__device__ __forceinline__ float max3f(float a,float b,float c){float r;asm("v_max3_f32 %0, %1, %2, %3":"=v"(r):"v"(a),"v"(b),"v"(c));return r;}
__device__ __forceinline__ float max2f(float a,float b){float r;asm("v_max_f32_e32 %0, %1, %2":"=v"(r):"v"(a),"v"(b));return r;}
__device__ __forceinline__ float fadd_s(float a,float b){float r;asm("v_add_f32_e32 %0, %1, %2":"=v"(r):"v"(a),"v"(b));return r;}
__device__ __forceinline__ float fsub_s(float a,float b){float r;asm("v_sub_f32_e32 %0, %1, %2":"=v"(r):"v"(a),"v"(b));return r;}
typedef float f32x2_t __attribute__((ext_vector_type(2))); typedef __bf16 bf16x2_t __attribute__((ext_vector_type(2)));
__device__ __forceinline__ unsigned cvtpk_s(float lo,float hi){f32x2_t v={lo,hi};bf16x2_t b=__builtin_convertvector(v,bf16x2_t);return __builtin_bit_cast(unsigned,b);}
#define WAIT_BAR(N) asm volatile("s_waitcnt vmcnt(" #N ") lgkmcnt(0)\n\ts_barrier":::"memory")

__device__ __forceinline__ void qkt(f32x16&p0,f32x16&p1,const char*Kslot,const bf16x8*qr,int r32,int hi){
  const char*kb=Kslot+hi*1024+r32*16;
  #pragma unroll
  for(int d0=0;d0<4;++d0){
    const bf16x8 b0=*reinterpret_cast<const bf16x8*>(kb+d0*2048);
    const bf16x8 b1=*reinterpret_cast<const bf16x8*>(kb+d0*2048+512);
    if(d0==0){p0=__builtin_amdgcn_mfma_f32_32x32x16_bf16(b0,qr[0],f32x16{},0,0,0);p1=__builtin_amdgcn_mfma_f32_32x32x16_bf16(b1,qr[0],f32x16{},0,0,0);}
    else{p0=__builtin_amdgcn_mfma_f32_32x32x16_bf16(b0,qr[d0],p0,0,0,0);p1=__builtin_amdgcn_mfma_f32_32x32x16_bf16(b1,qr[d0],p1,0,0,0);}}
}
typedef __attribute__((address_space(3))) const char* lds_cptr;
typedef short v4i16_t __attribute__((ext_vector_type(4)));
__device__ __forceinline__ void kload8(bf16x8*kf,lds_cptr kp){
  kf[0]=*(const __attribute__((address_space(3))) bf16x8*)(kp);      kf[1]=*(const __attribute__((address_space(3))) bf16x8*)(kp+512);
  kf[2]=*(const __attribute__((address_space(3))) bf16x8*)(kp+2048); kf[3]=*(const __attribute__((address_space(3))) bf16x8*)(kp+2560);
  kf[4]=*(const __attribute__((address_space(3))) bf16x8*)(kp+4096); kf[5]=*(const __attribute__((address_space(3))) bf16x8*)(kp+4608);
  kf[6]=*(const __attribute__((address_space(3))) bf16x8*)(kp+6144); kf[7]=*(const __attribute__((address_space(3))) bf16x8*)(kp+6656);
}
__device__ __forceinline__ void kload2(bf16x8*kf,lds_cptr kp,int j){ kf[2*j]=*(const __attribute__((address_space(3))) bf16x8*)(kp+j*2048); kf[2*j+1]=*(const __attribute__((address_space(3))) bf16x8*)(kp+j*2048+512); }
__device__ __forceinline__ s16x4 vtr(lds_cptr p){ return __builtin_bit_cast(s16x4,__builtin_amdgcn_ds_read_tr16_b64_v4i16((__attribute__((address_space(3))) v4i16_t*)p)); }
__device__ __forceinline__ float rowmax(const f32x16&p0,const f32x16&p1){
  float a=max3f(p0[0],p0[1],p1[0]),b=max3f(p0[2],p0[3],p1[1]);a=max3f(a,p1[2],p1[3]);
  #pragma unroll
  for(int r=4;r<16;r+=4){a=max3f(a,p0[r],p0[r+1]);b=max3f(b,p0[r+2],p0[r+3]);a=max3f(a,p1[r],p1[r+1]);b=max3f(b,p1[r+2],p1[r+3]);}
  const float m=max2f(a,b);
  auto rr=__builtin_amdgcn_permlane32_swap(__float_as_uint(m),__float_as_uint(m),false,false);
  return max2f(__uint_as_float(rr[0]),__uint_as_float(rr[1]));
}
__device__ __forceinline__ void pv(f32x16*o,int vb,bf16x8 pa0,bf16x8 pa1,bf16x8 pa2,bf16x8 pa3){
  #pragma unroll
  for(int d0=0;d0<2;++d0){s16x4 lo[4],hi[4];
    #pragma unroll
    for(int ks=0;ks<4;++ks){
      asm volatile("ds_read_b64_tr_b16 %0,%1 offset:%c2":"=&v"(lo[ks]):"v"(vb),"i"(d0*4096+ks*1024):"memory");
      asm volatile("ds_read_b64_tr_b16 %0,%1 offset:%c2":"=&v"(hi[ks]):"v"(vb),"i"(d0*4096+ks*1024+512):"memory");}
    asm volatile("s_waitcnt lgkmcnt(0)":::"memory");SBAR();
    #define PK(k) (bf16x8){lo[k][0],lo[k][1],lo[k][2],lo[k][3],hi[k][0],hi[k][1],hi[k][2],hi[k][3]}
    o[d0]=__builtin_amdgcn_mfma_f32_32x32x16_bf16(pa0,PK(0),o[d0],0,0,0);
    o[d0]=__builtin_amdgcn_mfma_f32_32x32x16_bf16(pa1,PK(1),o[d0],0,0,0);
    o[d0]=__builtin_amdgcn_mfma_f32_32x32x16_bf16(pa2,PK(2),o[d0],0,0,0);
    o[d0]=__builtin_amdgcn_mfma_f32_32x32x16_bf16(pa3,PK(3),o[d0],0,0,0);
    #undef PK
  }
}

#ifndef ATTN_STORE16
#define ATTN_STORE16(p,v) (*(u32x4*)(p)=(v))
#endif
template<int THRL> __device__ __forceinline__ void attn_unit(int wave_,int b,int h,int qb,const bf16*Q,const bf16*__restrict__ K,const bf16*__restrict__ V,const bf16*__restrict__ KM,bf16*O,char*shm){
  const int lane=lane_id_(),tid=wave_*64+lane,r32=lane&31,hi=lane>>5; const int wid=wave_;
  const long rowbase=(long)b*SEQ; const int q0=qb*QB;
  const bf16*Qw=Q+(rowbase+q0+wid*QBLK)*PIN+h*D;
  const bf16*Kh=K+rowbase*PIN+h*D,*Vh=V+rowbase*PIN+h*D;
  const unsigned lds0=(unsigned)(uintptr_t)shm;
  float*wsf=(float*)(shm+LDS_WS)+wid*64;
  const bf16*ksrc=Kh+(long)lane*PIN+wid*8;
  const bf16*kmsrc=KM+((long)b*64+lane)*PKM+h*D+wid*8;
  const bf16*vsrc=Vh+(long)(16*(wid&3)+(lane>>2))*PIN+(wid>>2)*32+(lane&3)*8;
  const unsigned kdst=lds0+LDS_K+wid*1024, vdst=lds0+LDS_V+wid*1024;
  #define DMA_K(t,slot) glds16(ksrc+(long)(t)*KVBLK*PIN,(unsigned)__builtin_amdgcn_readfirstlane(kdst+(slot)))
  #define DMA_V(t,slot) glds16(vsrc+(long)(t)*KVBLK*PIN,(unsigned)__builtin_amdgcn_readfirstlane(vdst+(slot)))
  const int vb0=(int)(lds0+LDS_V)+((lane>>4)&1)*32+(lane&3)*8+(4*hi+((lane&15)>>2))*64;
  const char*Kbase=shm+LDS_K; bf16x8 kf[8];
  const lds_cptr shm3=(lds_cptr)shm; const lds_cptr kp0=shm3+LDS_K+hi*1024+r32*16; const lds_cptr vp0=shm3+LDS_V+((lane>>4)&1)*32+(lane&3)*8+(4*hi+((lane&15)>>2))*64;
  const int NT=(q0+QB)/KVBLK;
  glds16(kmsrc,(unsigned)__builtin_amdgcn_readfirstlane(lds0+LDS_V+2*SLOTB+wid*1024));
  DMA_K(0,0);DMA_V(0,0);DMA_K(1,SLOTB);
  bf16x8 qr[4];
  #pragma unroll
  for(int d0=0;d0<4;++d0)qr[d0]=*reinterpret_cast<const bf16x8*>(&Qw[(long)r32*PIN+d0*16+hi*8]);
  float mhat=0.f,l_reg=0.f;f32x16 o[2];o[0]=f32x16{};o[1]=f32x16{};
  const int qrel=wid*QBLK+r32;
  #define CMASK(P0,P1,t) do{int jb_=(t)-(NT-4); const float sb_=(jb_>=0||((selm>>((t)>>2))&1u))?mhat:INFINITY; {const float nsb_=-sb_;P0=P0+nsb_;P1=P1+nsb_;} if(jb_>=0)cmask(P0,P1,jb_,qrel,hi);}while(0)
  bool resc=false;
  #define START(P0,P1) do{ const float rm=rowmax(P0,P1); resc=false; \
    { const float dl=(rm>-1.0e30f)?rm:0.f; mhat=fadd_s(mhat,dl); \
      _Pragma("unroll") for(int r=0;r<16;++r){P0[r]=fsub_s(P0[r],dl);P1[r]=fsub_s(P1[r],dl);} \
      } \
    _Pragma("unroll") for(int r=0;r<16;++r)P0[r]=__builtin_amdgcn_exp2f(P0[r]); }while(0)
  #define RESC() do{ if(resc){ asm volatile("s_waitcnt lgkmcnt(0)":::"memory"); \
      _Pragma("unroll") for(int d_=0;d_<2;++d_) _Pragma("unroll") for(int r=0;r<16;++r)o[d_][r]*=wsf[crow(r,hi)]; } }while(0)
  f32x16 pA0,pA1,pB0,pB1;
  int sl_prev=0,sl_cur=0,sl_next=SLOTB;
  #define ROT() do{sl_prev=sl_cur;sl_cur=sl_next;sl_next=(sl_next==(NSLOT-1)*SLOTB)?0:sl_next+SLOTB;}while(0)
  DMA_K(2,2*SLOTB);
  unsigned selm=0u;
  WAIT_BAR(4);
  { f32x16 g0,g1;
    qkt(g0,g1,shm+LDS_V+2*SLOTB,qr,r32,hi); asm volatile("s_nop 15\n\ts_nop 7":"+v"(g0),"+v"(g1));
    float gm[8],go[8],g[16];
    #pragma unroll
    for(int r=0;r<8;++r){gm[r]=g0[r];go[r]=__shfl_xor(gm[r],32);}
    #pragma unroll
    for(int j=0;j<4;++j){ g[j]=hi?go[j]:gm[j]; g[4+j]=hi?gm[j]:go[j]; g[8+j]=hi?go[4+j]:gm[4+j]; g[12+j]=hi?gm[4+j]:go[4+j]; }
    #pragma unroll
    for(int s=0;s<3;++s){ float best=-3.0e38f; int bi=-1;
      #pragma unroll
      for(int n=0;n<16;++n){ const bool ok=(n<qb)&&!((selm>>n)&1u)&&(g[n]>best); if(ok){best=g[n];bi=n;} }
      if(bi>=0)selm|=1u<<bi; } }
  WAIT_BAR(3);
  qkt(pA0,pA1,Kbase,qr,r32,hi);asm volatile("s_nop 15\n\ts_nop 7":"+v"(pA0),"+v"(pA1));CMASK(pA0,pA1,0);
  START(pA0,pA1);
  _Pragma("unroll") for(int r=0;r<16;++r)pA1[r]=__builtin_amdgcn_exp2f(pA1[r]);
  WAIT_BAR(0);
  DMA_K(3,0);DMA_V(1,SLOTB);
  ROT();
  kload8(kf,kp0+sl_cur);
  WAIT_BAR(2);
  s16x4 vlo[8],vhi[8]; u32x4 pw0,pw1,pw2,pw3;
  #define PKW(P,B) cvtpk_s(P[B],P[B+1])
  #define PAF(k) __builtin_bit_cast(bf16x8,pw##k)
  #define VFR(i) (bf16x8){vlo[i][0],vlo[i][1],vlo[i][2],vlo[i][3],vhi[i][0],vhi[i][1],vhi[i][2],vhi[i][3]}
  #define PIN(x) asm volatile("":"+v"(x))
  #define MX3(a,b,c) __builtin_fmaxf(__builtin_fmaxf((a),(b)),(c))
  #define GAPA(MF,A0,A1,A2,A3,W0,W1,PW) do{ MF; sacc+=A0; sacc+=A1; sacc+=A2; sacc+=A3; PIN(sacc); W0; W1; PIN(PW); SBAR(); }while(0)
  #define EX(v) __builtin_amdgcn_exp2f(v)
  #define GAPB(MF,X,B) do{ MF; X[B]=EX(X[B]); X[B+1]=EX(X[B+1]); X[B+2]=EX(X[B+2]); X[B+3]=EX(X[B+3]); PIN(X); SBAR(); }while(0)
  #define VRD(i) do{ vlo[i]=vtr(vp_+(((i)>>2)*4096+((i)&3)*1024)); vhi[i]=vtr(vp_+(((i)>>2)*4096+((i)&3)*1024+512)); }while(0)
  #define KRD(G,j) do{ if(G){ kload2(kf,kp0+sl_next,j); SBAR(); } }while(0)
  #define STEP(C0,C1,P0,P1,t,GK,GV,GL) do{ SBAR(); \
    const lds_cptr vp_=vp0+sl_prev; \
    VRD(0); SBAR(); float sacc=(P0[0]+P0[1]); \
    GAPA(C0=__builtin_amdgcn_mfma_f32_32x32x16_bf16(kf[0],qr[0],f32x16{},0,0,0), P0[2],P0[3],P0[4],P0[5],     pw0[0]=PKW(P0,0), pw0[1]=PKW(P0,2), pw0); \
    VRD(4); SBAR(); GAPA(C1=__builtin_amdgcn_mfma_f32_32x32x16_bf16(kf[1],qr[0],f32x16{},0,0,0), P0[6],P0[7],P0[8],P0[9],     pw0[2]=PKW(P0,4), pw0[3]=PKW(P0,6), pw0); \
    VRD(1); SBAR(); GAPA(C0=__builtin_amdgcn_mfma_f32_32x32x16_bf16(kf[2],qr[1],C0,0,0,0),   P0[10],P0[11],P0[12],P0[13], pw1[0]=PKW(P0,8), pw1[1]=PKW(P0,10), pw1); \
    VRD(5); SBAR(); GAPA(C1=__builtin_amdgcn_mfma_f32_32x32x16_bf16(kf[3],qr[1],C1,0,0,0),   P0[14],P0[15],P1[0],P1[1],   pw1[2]=PKW(P0,12),pw1[3]=PKW(P0,14), pw1); \
    VRD(2); SBAR(); GAPA(C0=__builtin_amdgcn_mfma_f32_32x32x16_bf16(kf[4],qr[2],C0,0,0,0),   P1[2],P1[3],P1[4],P1[5],     pw2[0]=PKW(P1,0), pw2[1]=PKW(P1,2), pw2); \
    VRD(6); SBAR(); GAPA(C1=__builtin_amdgcn_mfma_f32_32x32x16_bf16(kf[5],qr[2],C1,0,0,0),   P1[6],P1[7],P1[8],P1[9],     pw2[2]=PKW(P1,4), pw2[3]=PKW(P1,6), pw2); \
    VRD(3); SBAR(); GAPA(C0=__builtin_amdgcn_mfma_f32_32x32x16_bf16(kf[6],qr[3],C0,0,0,0),   P1[10],P1[11],P1[12],P1[13], pw3[0]=PKW(P1,8), pw3[1]=PKW(P1,10), pw3); \
    VRD(7); SBAR(); GAPA(C1=__builtin_amdgcn_mfma_f32_32x32x16_bf16(kf[7],qr[3],C1,0,0,0),   P1[14],P1[15],0.f,0.f,       pw3[2]=PKW(P1,12),pw3[3]=PKW(P1,14), pw3); \
    l_reg+=sacc; \
    if(GK){DMA_K((t)+3,sl_cur);} if(GV){DMA_V((t)+1,sl_next);} \
    CMASK(C0,C1,t); \
    { float a=MX3(C0[0],C0[1],C1[0]),b=MX3(C0[2],C0[3],C1[1]); a=MX3(a,C1[2],C1[3]); \
      _Pragma("unroll") for(int r=4;r<16;r+=4){a=MX3(a,C0[r],C0[r+1]);b=MX3(b,C0[r+2],C0[r+3]);a=MX3(a,C1[r],C1[r+1]);b=MX3(b,C1[r+2],C1[r+3]);} \
      float rm=__builtin_fmaxf(a,b); { auto rr=__builtin_amdgcn_permlane32_swap(__float_as_uint(rm),__float_as_uint(rm),false,false); rm=__builtin_fmaxf(__uint_as_float(rr[0]),__uint_as_float(rr[1])); } \
      resc=false; \
      if(__builtin_expect(__any(rm>(float)THRL),0)){ const float dl=__builtin_fmaxf(rm,0.f); mhat+=dl; \
        _Pragma("unroll") for(int r=0;r<16;++r){C0[r]-=dl;C1[r]-=dl;} \
        const float f=__builtin_amdgcn_exp2f(-dl); l_reg*=f; if(hi==0){int r_=r32; asm volatile("":"+v"(r_)); wsf[r_]=f;} resc=true; } } \
    SBAR(); \
    GAPB(o[0]=__builtin_amdgcn_mfma_f32_32x32x16_bf16(PAF(0),VFR(0),o[0],0,0,0), C0,0); \
    GAPB(o[1]=__builtin_amdgcn_mfma_f32_32x32x16_bf16(PAF(0),VFR(4),o[1],0,0,0), C0,4); \
    KRD(GL,0); GAPB(o[0]=__builtin_amdgcn_mfma_f32_32x32x16_bf16(PAF(1),VFR(1),o[0],0,0,0), C0,8); \
    KRD(GL,1); GAPB(o[1]=__builtin_amdgcn_mfma_f32_32x32x16_bf16(PAF(1),VFR(5),o[1],0,0,0), C0,12); \
    KRD(GL,2); GAPB(o[0]=__builtin_amdgcn_mfma_f32_32x32x16_bf16(PAF(2),VFR(2),o[0],0,0,0), C1,0); \
    KRD(GL,3); GAPB(o[1]=__builtin_amdgcn_mfma_f32_32x32x16_bf16(PAF(2),VFR(6),o[1],0,0,0), C1,4); \
    GAPB(o[0]=__builtin_amdgcn_mfma_f32_32x32x16_bf16(PAF(3),VFR(3),o[0],0,0,0), C1,8); \
    GAPB(o[1]=__builtin_amdgcn_mfma_f32_32x32x16_bf16(PAF(3),VFR(7),o[1],0,0,0), C1,12); \
    }while(0)
  int t=1;
  #undef CMASK
  #define CMASK(P0,P1,t) do{ const float sb_=((selm>>((t)>>2))&1u)?mhat:INFINITY; {const float nsb_=-sb_;P0=P0+nsb_;P1=P1+nsb_;} }while(0)
  for(;t+5<NT;t+=2){
    STEP(pB0,pB1,pA0,pA1,t,true,true,true);     WAIT_BAR(2); RESC(); ROT();
    STEP(pA0,pA1,pB0,pB1,t+1,true,true,true);   WAIT_BAR(2); RESC(); ROT();
  }
  #undef CMASK
  #define CMASK(P0,P1,t) do{int jb_=(t)-(NT-4); const float sb_=(jb_>=0||((selm>>((t)>>2))&1u))?mhat:INFINITY; {const float nsb_=-sb_;P0=P0+nsb_;P1=P1+nsb_;} if(jb_>=0)cmask(P0,P1,jb_,qrel,hi);}while(0)
  #define ENDW(tt) do{ if((tt)+3<NT){WAIT_BAR(2);} else if((tt)+2<NT){WAIT_BAR(1);} else {WAIT_BAR(0);} }while(0)
  for(;t+1<NT;t+=2){
    STEP(pB0,pB1,pA0,pA1,t,(t+3<NT),(t+1<NT),(t+1<NT));       ENDW(t);   RESC(); ROT();
    STEP(pA0,pA1,pB0,pB1,t+1,(t+4<NT),(t+2<NT),(t+2<NT));     ENDW(t+1); RESC(); ROT();
  }
  STEP(pB0,pB1,pA0,pA1,NT-1,false,false,false); RESC();
  { float sacc=pB0[0]+pB0[1]; _Pragma("unroll") for(int r=2;r<16;++r)sacc+=pB0[r]; _Pragma("unroll") for(int r=0;r<16;++r)sacc+=pB1[r]; l_reg+=sacc;
    pw0=(u32x4){PKW(pB0,0),PKW(pB0,2),PKW(pB0,4),PKW(pB0,6)};pw1=(u32x4){PKW(pB0,8),PKW(pB0,10),PKW(pB0,12),PKW(pB0,14)};pw2=(u32x4){PKW(pB1,0),PKW(pB1,2),PKW(pB1,4),PKW(pB1,6)};pw3=(u32x4){PKW(pB1,8),PKW(pB1,10),PKW(pB1,12),PKW(pB1,14)};
    SBAR(); pv(o,vb0+sl_cur,PAF(0),PAF(1),PAF(2),PAF(3)); }
  #undef PKW
  #undef PAF
  #undef VFR
  #undef PIN
  #undef MX3
  #undef GAPA
  #undef GAPB
  #undef EX
  #undef VRD
  #undef KRD
  #undef STEP
  #undef ENDW
  {auto rr=__builtin_amdgcn_permlane32_swap(__float_as_uint(l_reg),__float_as_uint(l_reg),false,false);l_reg=__uint_as_float(rr[0])+__uint_as_float(rr[1]);}
  if(hi==0)wsf[32+r32]=l_reg;asm volatile("s_waitcnt lgkmcnt(0)":::"memory");
  float rli[16];
  #pragma unroll
  for(int r=0;r<16;++r)rli[r]=__builtin_amdgcn_rcpf(wsf[32+crow(r,hi)]);
  bf16*Ow=O+(rowbase+q0+wid*QBLK)*POUT+h*D;
  { bf16*stg=(bf16*)(shm+LDS_OST)+wid*2048;
    #pragma unroll
    for(int r=0;r<16;++r){const int orow=crow(r,hi);
      #pragma unroll
      for(int d0=0;d0<2;++d0)stg[orow*64+d0*32+r32]=__float2bfloat16(o[d0][r]*rli[r]);}
    asm volatile("s_waitcnt lgkmcnt(0)":::"memory");
    #pragma unroll
    for(int i=0;i<4;++i){const int row=i*8+(lane>>3),ch=lane&7; const u32x4 v=*(const u32x4*)(stg+row*64+ch*8); ATTN_STORE16(Ow+(long)row*POUT+ch*8,v);} }
  asm volatile("s_waitcnt lgkmcnt(0)\n\ts_barrier":::"memory");
  #undef DMA_K
  #undef DMA_V
  #undef CMASK
  #undef START
  #undef RESC
  #undef ROT
}
constexpr int ATTN_LDS_BYTES=LDS_BYTES;
struct AttnTensors { const bf16* Q; const bf16* K; const bf16* V; const bf16* KM; bf16* O; };
struct AttnUnit { int bh; int qb; };
struct StaticOrder {
  int vcu,G,blk;
  __device__ __forceinline__ explicit StaticOrder(int grid,int block):vcu((grid%8==0)?(block%8)*(grid/8)+block/8:block),G(grid),blk(block){}
  __device__ __forceinline__ bool next(int i,AttnUnit&u)const{
    if(G==256){ if(i>=4)return false; const int s=vcu&3; u.bh=vcu>>2; u.qb=(i==0)?s:(i==1)?7-s:(i==2)?8+s:15-s; return true; }
    const int idx=i*G+blk; if(idx>=BATCH*NHEAD*NQB)return false; u.bh=idx/NQB; u.qb=idx%NQB; return true; }
  __device__ __forceinline__ void a_ready(const AttnUnit&)const{}
  __device__ __forceinline__ void done(const AttnUnit&)const{}
};
template<class Sched,int THRL=8> __device__ __forceinline__ void attn_phase(char*lds,const AttnTensors&T,const Sched&S,int wave_){
  AttnUnit u;
  for(int i=0;S.next(i,u);++i){ S.a_ready(u); attn_unit<THRL>(wave_,u.bh/NHEAD,u.bh%NHEAD,u.qb,T.Q,T.K,T.V,T.KM,T.O,lds); S.done(u); }
}
#undef SBAR
#undef WAIT_BAR
}

template <bool DRY = false> __device__ __forceinline__ void p6_route(const Frame& F0, const Args& a) {
    const Frame F = fresh(F0);
    const bf16_t* x1 = (const bf16_t*)(a.ws + WS_X1); bf16_t* xn = (bf16_t*)(a.ws + WS_XN); const float* rw = a.in[I_RW]; const float* rb = a.in[I_RB]; const float* n2 = a.in[I_N2];
    unsigned* cnt = (unsigned*)(a.ws + WS_CTL) + CW_CNT; int* rows = (int*)(a.ws + WS_ROWS); float* roww = (float*)(a.ws + WS_ROWW);
    constexpr int HP2 = 1040;
    LAS float* H2 = (LAS float*)F.lds;
    LAS float* PL = (LAS float*)(F.lds + 16 * HP2 * 4);
    LAS int* lcnt = (LAS int*)(F.lds + MISC_OFF); LAS int* lbase = lcnt + 32; LAS int* ae = lbase + 32; LAS int* ap = ae + 512; LAS float* aw = (LAS float*)(ap + 512); LAS float* hsrow = aw + 512;
    float* rowhs = (float*)(a.ws + WS_ROWHS);
    const int lane = F.lane, e = lane & 31, w = F.wave, l15 = lane & 15, kq = lane >> 4;
    float rwq[8][4][2];
#pragma unroll
    for (int g = 0; g < 8; ++g)
#pragma unroll
        for (int s = 0; s < 4; ++s)
#pragma unroll
            for (int h = 0; h < 2; ++h) rwq[g][s][h] = rw[(size_t)(128 * w + 16 * g + 4 * kq + s) * NE + 16 * h + l15];
    const float bias = rb[e];
    for (int blk = F.bid; blk < NTOK / 128; blk += F.G) {
        if (F.tid < 32) lcnt[F.tid] = 0;
        u32x2 xq[2][4];
#pragma unroll
        for (int rr = 0; rr < 2; ++rr) { const u32x2* xr = (const u32x2*)(x1 + ((size_t)blk * 128 + 2 * w + rr) * DM) + lane;
#pragma unroll
            for (int j = 0; j < 4; ++j) xq[rr][j] = __builtin_nontemporal_load(xr + 64 * j); }
#pragma unroll 1
        for (int sub = 0; sub < 8; ++sub) {
#pragma unroll
            for (int rr = 0; rr < 2; ++rr) {
                const int rl = 2 * w + rr; const size_t row = (size_t)blk * 128 + sub * 16 + rl;
                const f32x4* wr = (const f32x4*)n2 + lane;
                f32x4 v[4]; float s = 0.f;
#pragma unroll
                for (int j = 0; j < 4; ++j) { const u32x2 xw = xq[rr][j]; v[j] = (f32x4){bf_lo(xw.x), bf_hi(xw.x), bf_lo(xw.y), bf_hi(xw.y)}; s += (v[j].x * v[j].x + v[j].y * v[j].y) + (v[j].z * v[j].z + v[j].w * v[j].w); }
                const float rstd = __builtin_amdgcn_rsqf(wave_sum(s) * (1.0f / DM) + RMS_EPS);
                u32x2* o8 = (u32x2*)(xn + row * DM) + lane; unsigned* o4 = (unsigned*)((unsigned char*)xn + row * DM) + lane;
#pragma unroll
                for (int j = 0; j < 4; ++j) { const f32x4 ww = wr[64 * j]; const f32x4 hv = v[j] * rstd * ww;
                    if constexpr (MOE1_I8) v[j] = hv;
                    else if constexpr (MOE_FP8) o4[64 * j] = pk4_fp8(hv.x, hv.y, hv.z, hv.w, S_H2);
                    else { u32x2 o; o.x = pk2(hv.x, hv.y); o.y = pk2(hv.z, hv.w); o8[64 * j] = o; }
                    *(LAS f32x4*)(H2 + rl * HP2 + 256 * j + 4 * lane) = hv; }
                if constexpr (MOE1_I8) {
                    float am = 0.f;
#pragma unroll
                    for (int j = 0; j < 4; ++j) am = fmaxf(fmaxf(am, fmaxf(fabsf(v[j].x), fabsf(v[j].y))), fmaxf(fabsf(v[j].z), fabsf(v[j].w)));
                    am = wave_max(am); const float inv = am > 0.f ? 127.0f / am : 0.f;
#pragma unroll
                    for (int j = 0; j < 4; ++j) o4[64 * j] = pk4_i8(v[j].x * inv, v[j].y * inv, v[j].z * inv, v[j].w * inv);
                    if (lane == 0) hsrow[sub * 16 + rl] = am * (1.0f / 127.0f); }
            }
            if (sub < 7) {
#pragma unroll
                for (int rr = 0; rr < 2; ++rr) { const u32x2* xr = (const u32x2*)(x1 + ((size_t)blk * 128 + (sub + 1) * 16 + 2 * w + rr) * DM) + lane;
#pragma unroll
                    for (int j = 0; j < 4; ++j) xq[rr][j] = __builtin_nontemporal_load(xr + 64 * j); }
            }
            lds_barrier();
            {
                f32x4 acc0 = {0.f, 0.f, 0.f, 0.f}, acc1 = {0.f, 0.f, 0.f, 0.f};
#pragma unroll
                for (int g = 0; g < 8; ++g) {
                    const f32x4 hq = *(const LAS f32x4*)(H2 + l15 * HP2 + 128 * w + 16 * g + 4 * kq);
#pragma unroll
                    for (int s = 0; s < 4; ++s) { acc0 = __builtin_amdgcn_mfma_f32_16x16x4f32(hq[s], rwq[g][s][0], acc0, 0, 0, 0); acc1 = __builtin_amdgcn_mfma_f32_16x16x4f32(hq[s], rwq[g][s][1], acc1, 0, 0, 0); }
                }
#pragma unroll
                for (int r = 0; r < 4; ++r) { PL[(w * 16 + 4 * kq + r) * 32 + l15] = acc0[r]; PL[(w * 16 + 4 * kq + r) * 32 + 16 + l15] = acc1[r]; }
            }
            lds_barrier();
            {
                const int rl = 2 * w + (lane >> 5); float val = bias;
#pragma unroll
                for (int ww = 0; ww < 8; ++ww) val += PL[(ww * 16 + rl) * 32 + e];
                unsigned key; { unsigned u = __builtin_bit_cast(unsigned, val); u ^= (unsigned)((int)u >> 31) | 0x80000000u; key = (u & ~31u) | (unsigned)(31 - e); }
                float tv[4]; int te[4];
#pragma unroll
                for (int k = 0; k < 4; ++k) {
                    unsigned m = key, o;
                    o = (unsigned)__builtin_amdgcn_update_dpp(0, (int)m, 0xB1, 0xF, 0xF, false);  m = m > o ? m : o;
                    o = (unsigned)__builtin_amdgcn_update_dpp(0, (int)m, 0x4E, 0xF, 0xF, false);  m = m > o ? m : o;
                    o = (unsigned)__builtin_amdgcn_update_dpp(0, (int)m, 0x141, 0xF, 0xF, false); m = m > o ? m : o;
                    o = (unsigned)__builtin_amdgcn_update_dpp(0, (int)m, 0x140, 0xF, 0xF, false); m = m > o ? m : o;
                    o = (unsigned)__shfl_xor((int)m, 16); m = m > o ? m : o;
                    te[k] = 31 - (int)(m & 31u); { const unsigned vb = m & ~31u; tv[k] = __builtin_bit_cast(float, (vb & 0x80000000u) ? (vb ^ 0x80000000u) : ~vb); }
                    if (e == te[k]) key = 0u;
                }
                if (e == 0) {
                    const float p1 = __expf(tv[1] - tv[0]), p2 = __expf(tv[2] - tv[0]), p3 = __expf(tv[3] - tv[0]); const float inv = 1.0f / (1.0f + p1 + p2 + p3);
                    const float w4[4] = {inv, p1 * inv, p2 * inv, p3 * inv};
                    const int rb_ = sub * 16 + rl;
#pragma unroll
                    for (int k = 0; k < 4; ++k) { const int pos = atomicAdd((int*)&lcnt[te[k]], 1); ae[rb_ * 4 + k] = te[k]; ap[rb_ * 4 + k] = pos; aw[rb_ * 4 + k] = w4[k]; }
                }
            }
        }
        lds_barrier();
        if (!DRY) { if (F.tid < 32) lbase[F.tid] = (int)__hip_atomic_fetch_add(cnt + F.tid, (unsigned)lcnt[F.tid], __ATOMIC_RELAXED, __HIP_MEMORY_SCOPE_AGENT); }
        lds_barrier();
        if (!DRY) { const int ee = ae[F.tid]; const size_t p = (size_t)ee * CAP + lbase[ee] + ap[F.tid]; rows[p] = blk * 512 + F.tid; roww[p] = aw[F.tid]; if constexpr (MOE1_I8) rowhs[p] = hsrow[F.tid >> 2]; }
        lds_barrier();
    }
}
__device__ __forceinline__ int moe_tiles(const Frame& F, const Args& a, LAS int* ts) {
    if (F.wave == 0) {
        const unsigned* cnt = (const unsigned*)(a.ws + WS_CTL) + CW_CNT; const int e = F.lane & 31;
        const int c = (int)__hip_atomic_load(cnt + e, __ATOMIC_RELAXED, __HIP_MEMORY_SCOPE_AGENT); const int tl = (c + 255) >> 8;
        int incl = tl;
#pragma unroll
        for (int o = 1; o < 32; o <<= 1) { const int v = __shfl_up(incl, o, 32); if (e >= o) incl += v; }
        if (F.lane < 32) { ts[e] = incl - tl; ts[33 + e] = c; if (e == 31) ts[32] = incl; }
    }
    __syncthreads();
    return ts[32];
}
__device__ __forceinline__ void p9_final(const Frame& F0, const Args& a) {
    const Frame F = fresh(F0);
    float* out = a.out; const bf16_t* yg = (const bf16_t*)(a.ws + WS_YG); const float* fw = a.in[I_FNW]; const bf16_t* x1 = (const bf16_t*)(a.ws + WS_X1);
    const int gw = F.bid * 8 + F.wave, NGW = F.G * 8;
    for (int row = gw; row < NTOK; row += NGW) {
        f32x4* xr = (f32x4*)(out + (size_t)row * DM) + F.lane;
        f32x4 v[4]; const u32x2* x1r = (const u32x2*)(x1 + (size_t)row * DM) + F.lane;
#pragma unroll
        for (int j = 0; j < 4; ++j) { const u32x2 xw = __builtin_nontemporal_load(x1r + 64 * j); v[j] = (f32x4){bf_lo(xw.x), bf_hi(xw.x), bf_lo(xw.y), bf_hi(xw.y)}; }
#pragma unroll
        for (int k = 0; k < 4; ++k) {
            if constexpr (MOE_FP8) { const unsigned* yp = (const unsigned*)((const unsigned char*)yg + ((size_t)row * 4 + k) * DM) + F.lane;
#pragma unroll
                for (int j = 0; j < 4; ++j) { const unsigned w = __builtin_nontemporal_load(yp + 64 * j); const f32x2 lo = __builtin_amdgcn_cvt_pk_f32_fp8(w, false), hi = __builtin_amdgcn_cvt_pk_f32_fp8(w, true);
                    v[j].x += lo.x * (1.0f / S_YG); v[j].y += lo.y * (1.0f / S_YG); v[j].z += hi.x * (1.0f / S_YG); v[j].w += hi.y * (1.0f / S_YG); } }
            else { const u32x2* yp = (const u32x2*)(yg + ((size_t)row * 4 + k) * DM) + F.lane;
#pragma unroll
                for (int j = 0; j < 4; ++j) { const u32x2 w = yp[64 * j]; v[j].x += bf_lo(w.x); v[j].y += bf_hi(w.x); v[j].z += bf_lo(w.y); v[j].w += bf_hi(w.y); } } }
        float s = 0.f;
#pragma unroll
        for (int j = 0; j < 4; ++j) s += (v[j].x * v[j].x + v[j].y * v[j].y) + (v[j].z * v[j].z + v[j].w * v[j].w);
        const float rstd = 1.0f / sqrtf(wave_sum(s) * (1.0f / DM) + RMS_EPS);
        const f32x4* wr = (const f32x4*)fw + F.lane;
#if TIM_PHASE
        { const unsigned* tm = (const unsigned*)(a.ws + WS_CTL) + 208; const unsigned den = (TIM_SEL == 4 ? 1u : (tm[3] ? tm[3] : 1u)) * (unsigned)(TIM_UNIT); unsigned q = tm[TIM_SEL] / den; q = q > 24u ? 24u : q; const float sc_ = 1.0f + (float)q;
#pragma unroll
          for (int j = 0; j < 4; ++j) v[j] = v[j] * sc_; }
#endif
#pragma unroll
        for (int j = 0; j < 4; ++j) xr[64 * j] = v[j] * rstd * wr[64 * j];
    }
}

#define XB_TMO      128
#define XB_XCNT(j)  (256  + 64 * (j))
#define XB_XSUB(j)  (1280 + 64 * (j))
#define XB_XGEN(j)  (2304 + 64 * (j))
#define XB_TOP      3328
#define XB_TOPGEN   3392
#define XCD_BAR_WORDS 3456
#define XB_SPIN_CAP (1u << 18)

__device__ __forceinline__ unsigned xb_ld(unsigned* p)              { return __hip_atomic_load(p, __ATOMIC_RELAXED, __HIP_MEMORY_SCOPE_AGENT); }
__device__ __forceinline__ unsigned xb_add(unsigned* p, unsigned v) { return __hip_atomic_fetch_add(p, v, __ATOMIC_RELAXED, __HIP_MEMORY_SCOPE_AGENT); }
__device__ __forceinline__ unsigned xb_xcc_id() { return (unsigned)__builtin_amdgcn_s_getreg((3 << 11) | 20) & 0xFu; }
#define XB_SPIN(cond, bar) do { unsigned _sp = 0; while (cond) { __builtin_amdgcn_s_sleep(1); \
    if ((++_sp & 255u) == 0u) { if (xb_ld(&(bar)[XB_TMO])) break; if (_sp > XB_SPIN_CAP) { atomicAdd(&(bar)[XB_TMO], 1u); break; } } } } while (0)

struct XcdBarrier {
    unsigned* bar; unsigned x; int w;
    volatile LAS unsigned* st;
};

__device__ __forceinline__ XcdBarrier xcd_barrier_post(unsigned* bar, volatile LAS unsigned* st) {
    XcdBarrier b; b.bar = bar; b.x = xb_xcc_id(); b.st = st;
    if (threadIdx.x == 0) (void)xb_add(&bar[XB_XCNT(b.x)], 1u);
    return b;
}
__device__ __forceinline__ void xcd_barrier_complete(unsigned* bar, unsigned x, unsigned& nloc, unsigned& nx) {
    const unsigned G = gridDim.x * gridDim.y * gridDim.z;
    unsigned sum, cnt, mine, sp = 0u;
    for (;;) {
        sum = 0u; cnt = 0u; mine = 0u;
#pragma unroll
        for (unsigned j = 0; j < 16; ++j) { const unsigned c = xb_ld(&bar[XB_XCNT(j)]); sum += c; cnt += (c > 0u) ? 1u : 0u; mine = (j == x) ? c : mine; }
        if (sum == G) break;
        __builtin_amdgcn_s_sleep(1);
        if ((++sp & 255u) == 0u) { if (xb_ld(&bar[XB_TMO])) break; if (sp > XB_SPIN_CAP) { atomicAdd(&bar[XB_TMO], 1u); break; } }
    }
    nloc = mine > 0u ? mine : 1u; nx = cnt > 0u ? cnt : 1u;
}

__device__ __forceinline__ void xcd_barrier(const XcdBarrier& b) {
    asm volatile("s_waitcnt vmcnt(0)" ::: "memory");
    __syncthreads();
    if (b.w == 0 && lane_id_() == 0) {
        unsigned* bar = b.bar;
        __builtin_amdgcn_s_waitcnt(0);
        unsigned nloc = b.st[0], nx = b.st[1];
        if (nloc == 0u) { xcd_barrier_complete(bar, b.x, nloc, nx); b.st[0] = nloc; b.st[1] = nx; }
        const unsigned old = xb_add(&bar[XB_XSUB(b.x)], 1u);
        const unsigned gen = old / nloc;
        if (old + 1u == (gen + 1u) * nloc) {
            __builtin_amdgcn_fence(__ATOMIC_RELEASE, "agent");
            asm volatile("s_waitcnt vmcnt(0)" ::: "memory");
            const unsigned og = xb_add(&bar[XB_TOP], 1u);
            const unsigned tg = og / nx;
            if (og + 1u == (tg + 1u) * nx) xb_add(&bar[XB_TOPGEN], 1u);
            else XB_SPIN(xb_ld(&bar[XB_TOPGEN]) == tg, bar);
            __builtin_amdgcn_fence(__ATOMIC_ACQUIRE, "agent");
            xb_add(&bar[XB_XGEN(b.x)], 1u);
            asm volatile("s_waitcnt vmcnt(0)" ::: "memory");
        } else {
            XB_SPIN(xb_ld(&bar[XB_XGEN(b.x)]) == gen, bar);
            __builtin_amdgcn_fence(__ATOMIC_ACQUIRE, "agent");
            asm volatile("s_waitcnt vmcnt(0)" ::: "memory");
        }
    }
    __syncthreads();
}


__global__ void __launch_bounds__(512, 2) fwd_kernel(Args args) {
    extern __shared__ __attribute__((aligned(16))) unsigned char lds_raw[];
    Frame F; F.lds = (LAS unsigned char*)lds_raw; F.tid = threadIdx.x; F.lane = F.tid & 63; F.wave = __builtin_amdgcn_readfirstlane(F.tid >> 6); F.G = gridDim.x; F.bid = blockIdx.x;
#if USE_COOP
    cg::grid_group grid = cg::this_grid();
#endif
    volatile LAS unsigned* MISCW = (volatile LAS unsigned*)(F.lds + LDS_BYTES - 256);
    if (F.tid < 64) MISCW[F.tid] = 0u;
    __syncthreads();
    XcdBarrier xbar = xcd_barrier_post((unsigned*)(args.ws + WS_CTL) + CW_BAR, MISCW + 8); xbar.w = F.wave;
    unsigned char* ws = args.ws;
    const int lo = args.ph_lo, hi = args.ph_hi;
#ifndef REPMASK
#define REPMASK 0
#endif
#define NREP(k) (((REPMASK) >> (k)) & 1 ? 2 : 1)
#define IN(k) (lo <= (k) && (k) < hi)
#if USE_COOP
#define SEAM(k) do { if (IN(k) && IN((k) + 1)) xcd_barrier(xbar); } while (0)
#else
#define SEAM(k) do { if (IN(k) && IN((k) + 1)) xcd_barrier(xbar); } while (0)
#endif
    bf16_t* proj = (bf16_t*)(ws + WS_PROJ);

#if USE_COOP
    if (lo < 0) grid.sync();
#endif
    if (IN(0)) for (int rep_ = 0; rep_ < NREP(0); ++rep_) { p0_prologue(F, args); } SEAM(0);
    if (IN(1)) for (int rep_ = 0; rep_ < NREP(1); ++rep_) {
        pg8::Gemm g{(const bf16_t*)(ws + WS_XN), (const bf16_t*)(ws + WS_WIN), DIN, DM, nullptr, (const float*)(ws + WS_XS), (const float*)(ws + WS_WINS), TIM_PHASE == 1 ? (unsigned*)(ws + WS_CTL) + 208 : nullptr};
        pg8::DenseSched<DIN / 256> S; S.o.init(NTOK / 256, DIN / 256, F.G, F.bid);
        EpiProj E{proj, (float*)(ws + WS_LOGF), (const float*)(ws + WS_ROPE), (const float*)(ws + WS_LB)};
        pg8::gemm_phase<EpiProj, pg8::DenseSched<DIN / 256>, false, false, false, false, P1_I8>(F.lds, g, S, E, F.wave);
    } SEAM(1);
    if (IN(2)) for (int rep_ = 0; rep_ < NREP(2); ++rep_) { p2_kmean(F, args); h1_local_states_p(F, args); } SEAM(2);
    if (IN(3)) {
        h2_scan(F, args);
        const attn_body::AttnTensors AT{(const attn_body::bf16*)(proj + C_QA), (const attn_body::bf16*)(proj + C_KA), (const attn_body::bf16*)(proj + C_VA), (const attn_body::bf16*)(ws + WS_KMEAN), (attn_body::bf16*)(ws + WS_YA)};
        const attn_body::StaticOrder AS((int)F.G, (int)F.bid);
        if constexpr (DEFER_MOE_W) {
            const int cls = F.G == 256 ? (int)(F.bid & 3) : 0, convpos = cls == 0 ? 0 : cls + 1;
            attn_body::AttnUnit u;
#pragma unroll 1
            for (int i = 0;; ++i) {
                if (i == convpos) { __syncthreads(); moe_weight_copies(F, args); }
                if (!AS.next(i, u)) break;
                attn_body::attn_unit<8>(F.wave, u.bh / attn_body::NHEAD, u.bh % attn_body::NHEAD, u.qb, AT.Q, AT.K, AT.V, AT.KM, AT.O, (char*)lds_raw);
            }
        } else
        for (int rep_ = 0; rep_ < NREP(3); ++rep_) attn_body::attn_phase<attn_body::StaticOrder>((char*)lds_raw, AT, AS, F.wave);
    } SEAM(3);
    if (IN(4)) for (int rep_ = 0; rep_ < NREP(4); ++rep_) { h3_outputs_p(F, args); } SEAM(4);
    if (IN(5)) for (int rep_ = 0; rep_ < NREP(5); ++rep_) {
        pg8::DenseSched<DM / 256> S; S.o.init(NTOK / 256, DM / 256, F.G, F.bid);
        pg8::Gemm g{(const bf16_t*)(ws + WS_YA), (const bf16_t*)(ws + WS_MUP), DM, DM, nullptr};
        EpiMixF E{(bf16_t*)(ws + WS_MIXED), proj};
        pg8::gemm_phase<EpiMixF, pg8::DenseSched<DM / 256>, false, false, false, true>(F.lds, g, S, E, F.wave);
    } SEAM(5);
    if (IN(6)) for (int rep_ = 0; rep_ < NREP(6); ++rep_) {
        pg8::Gemm g{(const bf16_t*)(ws + WS_MIXED), (const bf16_t*)(ws + WS_WOUT), DM, DM, nullptr};
        pg8::DenseSched<DM / 256> S; S.o.init(NTOK / 256, DM / 256, F.G, F.bid);
        EpiOut E{args.in[I_X], (bf16_t*)(ws + WS_X1)};
        pg8::gemm_phase<EpiOut, pg8::DenseSched<DM / 256>, false>(F.lds, g, S, E, F.wave);
    } SEAM(6);
    if (IN(7)) { if (NREP(7) > 1) p6_route<true>(F, args); p6_route<false>(F, args); } SEAM(7);
    if (IN(8)) for (int rep_ = 0; rep_ < NREP(8); ++rep_) {
        LAS int* ts = (LAS int*)(F.lds + MISC_OFF + 8192);
        const int ntile = moe_tiles(F, args, ts);
        pg8::Gemm g{(const bf16_t*)(ws + WS_XN), (const bf16_t*)(ws + WS_WGU), 2 * DE, DM, (const int*)(ws + WS_ROWS), (const float*)(ws + WS_ROWHS), (const float*)(ws + WS_WGS), TIM_PHASE == 8 ? (unsigned*)(ws + WS_CTL) + 208 : nullptr};
        pg8::MoeSched<2 * DE / 256> S; S.o.init(ntile, 2 * DE / 256, F.G, F.bid); S.ts = ts;
        EpiMoe1 E{(bf16_t*)(ws + WS_HID), args.in[I_BGU]};
        pg8::gemm_phase<EpiMoe1, pg8::MoeSched<2 * DE / 256>, true, MOE_FP8 && !MOE1_I8, false, false, MOE1_I8>(F.lds, g, S, E, F.wave);
    } SEAM(8);
    if (IN(9)) for (int rep_ = 0; rep_ < NREP(9); ++rep_) {
        LAS int* ts = (LAS int*)(F.lds + MISC_OFF + 8192);
        const int ntile = moe_tiles(F, args, ts);
        pg8::Gemm g{(const bf16_t*)(ws + WS_HID), (const bf16_t*)(ws + WS_WD), DM, DE, nullptr, nullptr, nullptr, TIM_PHASE == 9 ? (unsigned*)(ws + WS_CTL) + 208 : nullptr};
        pg8::MoeSched<DM / 256> S; S.o.init(ntile, DM / 256, F.G, F.bid); S.ts = ts;
        EpiMoe2 E{(bf16_t*)(ws + WS_YG), args.in[I_BD], (const int*)(ws + WS_ROWS), (const float*)(ws + WS_ROWW)};
        pg8::gemm_phase<EpiMoe2, pg8::MoeSched<DM / 256>, false, MOE_FP8, false, false, false, MOE_FP8>(F.lds, g, S, E, F.wave);
    } SEAM(9);
    if (IN(10)) for (int rep_ = 0; rep_ < NREP(10); ++rep_) { p9_final(F, args); }
#undef IN
#undef SEAM
}

#ifndef N_LAUNCHES
#define N_LAUNCHES 1
#endif
extern "C" void kernel_launch(void* const* d_in, const int* in_sizes, int n_in, void* d_out, int out_size, void* d_ws, size_t ws_size, hipStream_t stream) {
    static int grid = 0;
    if (grid == 0) {
        if (n_in != 16 || in_sizes[0] != NTOK * DM || out_size != NTOK * DM || ws_size < WS_END) { fprintf(stderr, "kernel_launch: unexpected shapes (n_in %d, in0 %d, out %d, ws %zu)\n", n_in, n_in > 0 ? in_sizes[0] : -1, out_size, ws_size); grid = -1; return; }
        int dev = 0, cus = 0, per_cu = 0;
        (void)hipGetDevice(&dev); (void)hipDeviceGetAttribute(&cus, hipDeviceAttributeMultiprocessorCount, dev);
        if (hipFuncSetAttribute((const void*)fwd_kernel, hipFuncAttributeMaxDynamicSharedMemorySize, LDS_BYTES) != hipSuccess) { fprintf(stderr, "kernel_launch: hipFuncSetAttribute failed\n"); grid = -1; return; }
        if (hipOccupancyMaxActiveBlocksPerMultiprocessor(&per_cu, (const void*)fwd_kernel, 512, LDS_BYTES) != hipSuccess || per_cu < 1) { fprintf(stderr, "kernel_launch: occupancy query says %d\n", per_cu); per_cu = 1; }
        (void)hipGetLastError();
        grid = cus;
    }
    if (grid < 0) return;
    (void)hipMemsetAsync((char*)d_ws + WS_CTL, 0, CTL_BYTES, stream);
    Args a{};
    for (int i = 0; i < 16; ++i) a.in[i] = (const float*)d_in[i];
    a.out = (float*)d_out; a.ws = (unsigned char*)d_ws;
    if (N_LAUNCHES == 1) {
        a.ph_lo = 0; a.ph_hi = NPHASE; void* params[] = {&a};
#if USE_COOP
        hipError_t e = hipLaunchCooperativeKernel((const void*)fwd_kernel, dim3(grid), dim3(512), params, LDS_BYTES, stream);
        if (e != hipSuccess) fprintf(stderr, "cooperative launch failed: %s (grid %d)\n", hipGetErrorString(e), grid);
#else
        (void)params; hipLaunchKernelGGL(fwd_kernel, dim3(grid), dim3(512), LDS_BYTES, stream, a);
#endif
    } else {
        for (int p = 0; p < NPHASE; ++p) { a.ph_lo = p; a.ph_hi = p + 1; hipLaunchKernelGGL(fwd_kernel, dim3(grid), dim3(512), LDS_BYTES, stream, a); }
    }
}
```
